# Optimizing an MI355X kernel written in HIP

```python
import math
import jax
import jax.numpy as jnp
from jax import lax
import numpy as np

D_MODEL = 1024
BATCH = 4
SEQ = 4096
DEPTH = 2

N_A_LAYERS = DEPTH // 2
N_B_LAYERS = DEPTH - N_A_LAYERS

RWKV_HEAD = 64
RWKV_HEADS = D_MODEL // RWKV_HEAD
DECAY_LORA = 64
AAA_LORA = 64
GATE_LORA = 128
RWKV_GN_EPS = 64e-5

DIFF_QK_DIM = 64
DIFF_V_DIM = 2 * DIFF_QK_DIM
DIFF_HEADS = D_MODEL // DIFF_V_DIM
Q_BLOCK = 128
SUBLN_EPS = 1e-5

N_GROUPS = 4
EXPERTS_PER_GROUP = 8
N_EXPERTS = N_GROUPS * EXPERTS_PER_GROUP
TOP_K = 2
EXPERT_FF = 512
MOE_BLOCK = 128

RMS_EPS = 1e-6

kernel_name = 'hybrid_rwkv7_diffattn_hmoe_yoco'


def rmsnorm(x, g, eps=RMS_EPS):
    xf = x.astype(jnp.float32)
    y = xf * lax.rsqrt(jnp.mean(xf * xf, axis=-1, keepdims=True) + eps)
    return (y * g.astype(jnp.float32)).astype(x.dtype)


def modulate(h, shift, scale):
    return h * (1 + scale[:, None, :]) + shift[:, None, :]


def rwkv7_time_mix(h, mu, w_rkv, w0, w1, w2, a0, a1, a2, g1, g2, k_k, k_a, r_k, gn_g, gn_b, w_o):
    B, T, D = h.shape
    H, N = RWKV_HEADS, RWKV_HEAD
    xx = jnp.pad(h, ((0, 0), (1, 0), (0, 0)))[:, :-1] - h
    xs = h[None] + xx[None] * mu[:, None, None, :]
    r, k, v = jnp.einsum('ibtd,ide->ibte', xs[:3], w_rkv)
    xw, xa, xg = xs[3], xs[4], xs[5]
    w_log = -jax.nn.softplus(-(w0 + jnp.tanh(xw @ w1) @ w2)) - 0.5
    decay = jnp.exp(-jnp.exp(w_log.astype(jnp.float32)))
    a = jax.nn.sigmoid(a0 + (xa @ a1) @ a2)
    g = jax.nn.sigmoid(xg @ g1) @ g2
    heads = lambda t: t.reshape(B, T, H, N).astype(jnp.float32)
    kk = heads(k * k_k)
    kk = kk / jnp.maximum(jnp.linalg.norm(kk, axis=-1, keepdims=True), 1e-12)
    k = k * (1 + (a - 1) * k_a)
    r_h, k_h, v_h, a_h = heads(r), heads(k), heads(v), heads(a)
    w_h = decay.reshape(B, T, H, N)
    a_vec = -kk
    b_vec = kk * a_h

    def step(S, inp):
        r_t, w_t, k_t, v_t, a_t, b_t = inp
        sa = jnp.einsum('bhij,bhj->bhi', S, a_t)
        S = S * w_t[:, :, None, :] + sa[..., None] * b_t[:, :, None, :] + v_t[..., None] * k_t[:, :, None, :]
        return S, jnp.einsum('bhij,bhj->bhi', S, r_t)

    tm = lambda t: jnp.moveaxis(t, 1, 0)
    S0 = jnp.zeros((B, H, N, N), jnp.float32)
    _, y = lax.scan(step, S0, (tm(r_h), tm(w_h), tm(k_h), tm(v_h), tm(a_vec), tm(b_vec)))
    y = jnp.moveaxis(y, 0, 1)
    mean = jnp.mean(y, axis=-1, keepdims=True)
    var = jnp.mean(jnp.square(y - mean), axis=-1, keepdims=True)
    y = ((y - mean) * lax.rsqrt(var + RWKV_GN_EPS)).reshape(B, T, D) * gn_g + gn_b
    bonus = jnp.sum(r_h * k_h * r_k, axis=-1, keepdims=True) * v_h
    y = y + bonus.reshape(B, T, D)
    return (y.astype(h.dtype) * g) @ w_o


def diff_attention(h, k_sh, v_sh, w_q, lq1, lk1, lq2, lk2, subln_g, w_o, lambda_init):
    B, T, D = h.shape
    H = DIFF_HEADS
    q = (h @ w_q).reshape(B, T, H, 2, DIFF_QK_DIM)
    lam = (jnp.exp(jnp.sum(lq1 * lk1).astype(jnp.float32))
           - jnp.exp(jnp.sum(lq2 * lk2).astype(jnp.float32)) + lambda_init)
    nb = T // Q_BLOCK
    qb = jnp.moveaxis(q.reshape(B, nb, Q_BLOCK, H, 2, DIFF_QK_DIM), 1, 0)
    k_pos = jnp.arange(T)
    scale = DIFF_QK_DIM ** -0.5

    def attend(args):
        q_i, i = args
        s = jnp.einsum('bqhcd,bkhcd->bhcqk', q_i, k_sh).astype(jnp.float32) * scale
        q_pos = i * Q_BLOCK + jnp.arange(Q_BLOCK)
        mask = k_pos[None, :] <= q_pos[:, None]
        p = jax.nn.softmax(jnp.where(mask, s, -jnp.inf), axis=-1)
        attn = p[:, :, 0] - lam * p[:, :, 1]
        return jnp.einsum('bhqk,bkhe->bqhe', attn.astype(v_sh.dtype), v_sh)

    o = lax.map(attend, (qb, jnp.arange(nb)))
    o = jnp.moveaxis(o, 0, 1).reshape(B, T, H, DIFF_V_DIM)
    o = rmsnorm(o, subln_g, eps=SUBLN_EPS) * (1 - lambda_init)
    return o.reshape(B, T, D) @ w_o


def hier_moe(h, w_rg, w_re, w_gate, w_up, w_down):
    B, T, D = h.shape
    n_tok = B * T
    x = h.reshape(n_tok, D)
    grp_logits = (x @ w_rg).astype(jnp.float32)
    grp_prob = jax.nn.softmax(grp_logits, axis=-1)
    grp_idx = jnp.argmax(grp_logits, axis=-1).astype(jnp.int32)
    grp_gate = jnp.max(grp_prob, axis=-1, keepdims=True)
    exp_logits = (x @ w_re).astype(jnp.float32).reshape(n_tok, N_GROUPS, EXPERTS_PER_GROUP)
    exp_logits = exp_logits[jnp.arange(n_tok), grp_idx]
    top_val, top_idx = lax.top_k(exp_logits, TOP_K)
    gate = grp_gate * jax.nn.softmax(top_val, axis=-1)
    eid = grp_idx[:, None] * EXPERTS_PER_GROUP + top_idx.astype(jnp.int32)
    n_asg = n_tok * TOP_K
    flat_e = eid.reshape(-1)
    flat_tok = jnp.repeat(jnp.arange(n_tok, dtype=jnp.int32), TOP_K)
    flat_w = gate.reshape(-1)
    order = jnp.argsort(flat_e)
    se = flat_e[order]
    counts = jax.ops.segment_sum(jnp.ones_like(flat_e), flat_e, num_segments=N_EXPERTS)
    padded = (counts + MOE_BLOCK - 1) // MOE_BLOCK * MOE_BLOCK
    pad_end = jnp.cumsum(padded)
    pad_start = pad_end - padded
    start = jnp.cumsum(counts) - counts
    dest = pad_start[se] + jnp.arange(n_asg, dtype=jnp.int32) - start[se]
    n_rows = (n_asg + N_EXPERTS * MOE_BLOCK + MOE_BLOCK - 1) // MOE_BLOCK * MOE_BLOCK
    n_blocks = n_rows // MOE_BLOCK
    row_tok = jnp.zeros((n_rows,), jnp.int32).at[dest].set(flat_tok[order])
    row_w = jnp.zeros((n_rows,), jnp.float32).at[dest].set(flat_w[order])
    blk_start = jnp.arange(n_blocks, dtype=jnp.int32) * MOE_BLOCK
    blk_e = jnp.minimum(jnp.searchsorted(pad_end, blk_start, side='right'), N_EXPERTS - 1)
    xb = x[row_tok].reshape(n_blocks, MOE_BLOCK, D)

    def expert_block(args):
        xi, e = args
        hdn = jax.nn.silu(xi @ w_gate[e]) * (xi @ w_up[e])
        return hdn @ w_down[e]

    yb = lax.map(expert_block, (xb, blk_e)).reshape(n_rows, D)
    out = jnp.zeros((n_tok, D), jnp.float32).at[row_tok].add(yb.astype(jnp.float32) * row_w[:, None])
    return out.astype(h.dtype).reshape(B, T, D)


def setup_inputs(seed: int = 0) -> dict:
    key = jax.random.key(seed)
    ks = iter(jax.random.split(key, 64))
    D = D_MODEL
    NA, NB, L = N_A_LAYERS, N_B_LAYERS, DEPTH

    def nrm(shape, scale):
        return jax.random.normal(next(ks), shape, jnp.float32) * scale

    def gain(shape):
        return 1.0 + nrm(shape, 0.02)

    def unif(shape, lo, hi):
        return jax.random.uniform(next(ks), shape, jnp.float32, lo, hi)

    return {
        'x': nrm((BATCH, SEQ, D), 1.0),
        'c': nrm((BATCH, D), 1.0),
        'ada_w': nrm((L, D, 6 * D), 0.5 * D ** -0.5),
        'ada_b': nrm((L, 6 * D), 0.02),
        'norm_mix_g': gain((L, D)),
        'norm_ffn_g': gain((L, D)),
        'rw_mu': unif((NA, 6, D), 0.0, 1.0),
        'rw_w_rkv': nrm((NA, 3, D, D), D ** -0.5),
        'rw_w0': unif((NA, D), -6.0, -1.0),
        'rw_w1': nrm((NA, D, DECAY_LORA), D ** -0.5),
        'rw_w2': nrm((NA, DECAY_LORA, D), 0.1 * DECAY_LORA ** -0.5),
        'rw_a0': nrm((NA, D), 0.1),
        'rw_a1': nrm((NA, D, AAA_LORA), D ** -0.5),
        'rw_a2': nrm((NA, AAA_LORA, D), 0.1 * AAA_LORA ** -0.5),
        'rw_g1': nrm((NA, D, GATE_LORA), D ** -0.5),
        'rw_g2': nrm((NA, GATE_LORA, D), GATE_LORA ** -0.5),
        'rw_k_k': 0.85 + nrm((NA, D), 0.05),
        'rw_k_a': 1.0 + nrm((NA, D), 0.05),
        'rw_r_k': nrm((NA, RWKV_HEADS, RWKV_HEAD), 0.1),
        'rw_gn_g': gain((NA, D)),
        'rw_gn_b': nrm((NA, D), 0.02),
        'rw_w_o': nrm((NA, D, D), D ** -0.5),
        'ada_kv_w': nrm((D, 2 * D), 0.5 * D ** -0.5),
        'ada_kv_b': nrm((2 * D,), 0.02),
        'norm_kv_g': gain((D,)),
        'w_kv': nrm((D, 2 * D), D ** -0.5),
        'df_w_q': nrm((NB, D, D), D ** -0.5),
        'df_lq1': nrm((NB, DIFF_QK_DIM), 0.1),
        'df_lk1': nrm((NB, DIFF_QK_DIM), 0.1),
        'df_lq2': nrm((NB, DIFF_QK_DIM), 0.1),
        'df_lk2': nrm((NB, DIFF_QK_DIM), 0.1),
        'df_subln_g': gain((NB, DIFF_V_DIM)),
        'df_w_o': nrm((NB, D, D), D ** -0.5),
        'moe_w_rg': nrm((L, D, N_GROUPS), D ** -0.5),
        'moe_w_re': nrm((L, D, N_EXPERTS), D ** -0.5),
        'moe_w_gate': nrm((L, N_EXPERTS, D, EXPERT_FF), D ** -0.5),
        'moe_w_up': nrm((L, N_EXPERTS, D, EXPERT_FF), D ** -0.5),
        'moe_w_down': nrm((L, N_EXPERTS, EXPERT_FF, D), EXPERT_FF ** -0.5),
        'final_g': gain((D,)),
    }


def reference(x, c, ada_w, ada_b, norm_mix_g, norm_ffn_g,
              rw_mu, rw_w_rkv, rw_w0, rw_w1, rw_w2, rw_a0, rw_a1, rw_a2, rw_g1, rw_g2,
              rw_k_k, rw_k_a, rw_r_k, rw_gn_g, rw_gn_b, rw_w_o,
              ada_kv_w, ada_kv_b, norm_kv_g, w_kv,
              df_w_q, df_lq1, df_lk1, df_lq2, df_lk2, df_subln_g, df_w_o,
              moe_w_rg, moe_w_re, moe_w_gate, moe_w_up, moe_w_down, final_g):
    B, T, D = x.shape
    c_act = jax.nn.silu(c)
    k_sh = None
    v_sh = None
    for l in range(DEPTH):
        mod = c_act @ ada_w[l] + ada_b[l]
        sh_m, sc_m, g_m, sh_f, sc_f, g_f = jnp.split(mod, 6, axis=-1)
        if l < N_A_LAYERS:
            i = l
            h = modulate(rmsnorm(x, norm_mix_g[l]), sh_m, sc_m)
            y = rwkv7_time_mix(h, rw_mu[i], rw_w_rkv[i], rw_w0[i], rw_w1[i], rw_w2[i],
                               rw_a0[i], rw_a1[i], rw_a2[i], rw_g1[i], rw_g2[i],
                               rw_k_k[i], rw_k_a[i], rw_r_k[i], rw_gn_g[i], rw_gn_b[i], rw_w_o[i])
        else:
            if l == N_A_LAYERS:
                sh_kv, sc_kv = jnp.split(c_act @ ada_kv_w + ada_kv_b, 2, axis=-1)
                hk = modulate(rmsnorm(x, norm_kv_g), sh_kv, sc_kv)
                kv = hk @ w_kv
                k_sh = kv[..., :D].reshape(B, T, DIFF_HEADS, 2, DIFF_QK_DIM)
                v_sh = kv[..., D:].reshape(B, T, DIFF_HEADS, DIFF_V_DIM)
            j = l - N_A_LAYERS
            h = modulate(rmsnorm(x, norm_mix_g[l]), sh_m, sc_m)
            lambda_init = 0.8 - 0.6 * math.exp(-0.3 * l)
            y = diff_attention(h, k_sh, v_sh, df_w_q[j], df_lq1[j], df_lk1[j], df_lq2[j], df_lk2[j],
                               df_subln_g[j], df_w_o[j], lambda_init)
        x = x + g_m[:, None, :] * y
        h = modulate(rmsnorm(x, norm_ffn_g[l]), sh_f, sc_f)
        x = x + g_f[:, None, :] * hier_moe(h, moe_w_rg[l], moe_w_re[l], moe_w_gate[l],
                                           moe_w_up[l], moe_w_down[l])
    return rmsnorm(x, final_g)
```

```cpp
#include <hip/hip_runtime.h>
#include <hip/hip_bf16.h>
#include <cstdio>
#include <cstdint>
#include <cmath>

namespace pg8 {
#define PG8_LAS __attribute__((address_space(3)))
typedef unsigned short bf16_t;
typedef short bf16x8 __attribute__((ext_vector_type(8)));
typedef float f32x4 __attribute__((ext_vector_type(4)));
typedef unsigned u32x4 __attribute__((ext_vector_type(4)));
typedef unsigned u32x2 __attribute__((ext_vector_type(2)));
constexpr int BM = 256, BK = 64, HALF = 128, HTB = HALF * BK * 2  , STAGE_BYTES = 8 * HTB, NXCD = 8, WGM = 8;

__host__ __device__ __forceinline__ int lds_byte(int r, int c) { const int st = (r >> 4) * 2 + (c >> 5), rr = r & 15, cc = c & 31, ob = rr * 64 + cc * 2; return st * 1024 + (ob ^ (((ob >> 9) & 1) << 5)); }
__host__ __device__ __forceinline__ void stage_rc(int b, int& R, int& C) { const int st = b / 1024, sb = b % 1024, swz = sb ^ (((sb >> 9) & 1) << 5); R = (st >> 1) * 16 + swz / 64; C = (st & 1) * 32 + (swz % 64) / 2; }
__host__ __device__ __forceinline__ int perm32(int rho) { const int n = rho >> 4, i = rho & 15; return 8 * (i >> 2) + 4 * n + (i & 3); }

struct Unit { int pm, pn, z; };

__device__ __forceinline__ unsigned cvt_pk_bf16(float lo, float hi) { unsigned r; asm("v_cvt_pk_bf16_f32 %0, %1, %2" : "=v"(r) : "v"(lo), "v"(hi)); return r; }

struct BatchOrder {
    const char* A; const char* B; size_t sa, sb, tst; int nM, nN, nwg, tot, G, c;
    __device__ __forceinline__ void init(const void* A_, const void* B_, size_t sa_, size_t sb_, int M, int N, int Z, int K, int G_, int c_) {
        A = (const char*)A_; B = (const char*)B_; sa = sa_; sb = sb_; tst = (size_t)BM * K * 2; nM = M / BM; nN = N / BM; nwg = nM * nN; tot = nwg * Z; G = G_; c = c_; }
    __device__ __forceinline__ bool next(int i, Unit& u) const {
        const int L = i * G + c; if (L >= tot) return false;
        u.z = L / nwg; int wgid = L - u.z * nwg; { const int q = nwg / NXCD, r = nwg % NXCD, xcd = wgid % NXCD, off = wgid / NXCD; wgid = (xcd < r ? xcd * (q + 1) : r * (q + 1) + (xcd - r) * q) + off; }
        const int nig = WGM * nN, gid = wgid / nig, fm = gid * WGM, gsz = (nM - fm) < WGM ? (nM - fm) : WGM;
        u.pm = fm + ((wgid % nig) % gsz); u.pn = (wgid % nig) / gsz; return true;
    }
    __device__ __forceinline__ const char* a_base(const Unit& u) const { return A + (size_t)u.z * sa + (size_t)u.pm * tst; }
    __device__ __forceinline__ const char* b_base(const Unit& u) const { return B + (size_t)u.z * sb + (size_t)u.pn * tst; }
    __device__ __forceinline__ void a_ready(const Unit&) const {}
    __device__ __forceinline__ void done(const Unit&) const {}
};
struct MoeOrder {
    const char* A; const char* B; size_t sbe, tst; const PG8_LAS int* toff; int nNt, tot, G, c;
    __device__ __forceinline__ void init(const void* A_, const void* B_, size_t sbe_, const PG8_LAS int* toff_, int nNt_, int K, int G_, int c_) {
        A = (const char*)A_; B = (const char*)B_; sbe = sbe_; tst = (size_t)BM * K * 2; toff = toff_; nNt = nNt_; tot = toff_[32] * nNt_; G = G_; c = c_; }
    __device__ __forceinline__ bool next(int i, Unit& u) const {
        const int L = i * G + c; if (L >= tot) return false;
        const int tI = L / nNt; u.pm = tI; u.pn = L - tI * nNt; int e = 0;
#pragma unroll
        for (int j = 1; j < 32; ++j) e += (toff[j] <= tI) ? 1 : 0;
        u.z = e; return true;
    }
    __device__ __forceinline__ const char* a_base(const Unit& u) const { return A + (size_t)u.pm * tst; }
    __device__ __forceinline__ const char* b_base(const Unit& u) const { return B + (size_t)u.z * sbe + (size_t)u.pn * tst; }
    __device__ __forceinline__ void a_ready(const Unit&) const {}
    __device__ __forceinline__ void done(const Unit&) const {}
};

__device__ __forceinline__ float sigmoidf_(float x) { return 1.0f / (1.0f + __expf(-x)); }
__device__ __forceinline__ float tanh_fast(float x) { return 1.0f - 2.0f / (__expf(2.0f * x) + 1.0f); }

struct EpiZBf16 {
    static constexpr bool PERM = true, AFTER_DRAIN = false;
    bf16_t* O; size_t zstride; float scale0;
    __device__ __forceinline__ void operator()(const f32x4 (&acc)[2][2][4][2], const Unit& u, int wr, int wc, int fr, int fq) const {
        const int row0 = u.pm * BM + wr * 64 + fr, col0 = u.pn * BM + wc * 32 + 8 * fq; bf16_t* base = O + (size_t)u.z * zstride; const float sc = (u.z == 0) ? scale0 : 1.0f;
#pragma unroll
        for (int ai = 0; ai < 2; ++ai)
#pragma unroll
            for (int m = 0; m < 4; ++m) { bf16_t* rowp = base + (size_t)(row0 + ai * HALF + m * 16) * 1024 + col0;
#pragma unroll
                for (int bj = 0; bj < 2; ++bj) { const f32x4 v0 = acc[ai][bj][m][0] * sc, v1 = acc[ai][bj][m][1] * sc;
                    u32x4 w; w.x = cvt_pk_bf16(v0[0], v0[1]); w.y = cvt_pk_bf16(v0[2], v0[3]); w.z = cvt_pk_bf16(v1[0], v1[1]); w.w = cvt_pk_bf16(v1[2], v1[3]);
                    *(u32x4*)(rowp + bj * HALF) = w; } }
    }
};
struct EpiLora1 {
    static constexpr bool PERM = true, AFTER_DRAIN = false;
    bf16_t* O;
    __device__ __forceinline__ void operator()(const f32x4 (&acc)[2][2][4][2], const Unit& u, int wr, int wc, int fr, int fq) const {
        const int row0 = u.pm * BM + wr * 64 + fr, col0 = wc * 32 + 8 * fq;
#pragma unroll
        for (int ai = 0; ai < 2; ++ai)
#pragma unroll
            for (int m = 0; m < 4; ++m) { bf16_t* rowp = O + (size_t)(row0 + ai * HALF + m * 16) * 256 + col0;
#pragma unroll
                for (int bj = 0; bj < 2; ++bj) { f32x4 v0 = acc[ai][bj][m][0], v1 = acc[ai][bj][m][1];
                    if (bj == 0 && wc < 2) {
#pragma unroll
                        for (int j = 0; j < 4; ++j) { v0[j] = tanh_fast(v0[j]); v1[j] = tanh_fast(v1[j]); } }
                    if (bj == 1) {
#pragma unroll
                        for (int j = 0; j < 4; ++j) { v0[j] = sigmoidf_(v0[j]); v1[j] = sigmoidf_(v1[j]); } }
                    u32x4 w; w.x = cvt_pk_bf16(v0[0], v0[1]); w.y = cvt_pk_bf16(v0[2], v0[3]); w.z = cvt_pk_bf16(v1[0], v1[1]); w.w = cvt_pk_bf16(v1[2], v1[3]);
                    *(u32x4*)(rowp + bj * HALF) = w; } }
    }
};
struct EpiLora2 {
    static constexpr bool PERM = false, AFTER_DRAIN = false;
    float* LW; bf16_t* AS; bf16_t* GG; const float* w0; const float* a0;
    __device__ __forceinline__ void operator()(const f32x4 (&acc)[2][2][4][2], const Unit& u, int wr, int wc, int fr, int fq) const {
        const int sect = u.pn >> 2, row0 = u.pm * BM + wr * 64 + fr, col0 = (u.pn & 3) * BM + wc * 32 + 4 * fq;
#pragma unroll
        for (int ai = 0; ai < 2; ++ai)
#pragma unroll
            for (int m = 0; m < 4; ++m) { const size_t ro = (size_t)(row0 + ai * HALF + m * 16) * 1024;
#pragma unroll
                for (int bj = 0; bj < 2; ++bj)
#pragma unroll
                    for (int n = 0; n < 2; ++n) { const int c = col0 + bj * HALF + n * 16; f32x4 v = acc[ai][bj][m][n];
                        if (sect == 0) { const f32x4 b = *(const f32x4*)(w0 + c);
#pragma unroll
                            for (int j = 0; j < 4; ++j) { const float x = -(v[j] + b[j]); const float sp = fmaxf(x, 0.f) + __logf(1.0f + __expf(-fabsf(x))); v[j] = -__expf(-sp - 0.5f); }
                            *(f32x4*)(LW + ro + c) = v; }
                        else if (sect == 1) { const f32x4 b = *(const f32x4*)(a0 + c);
#pragma unroll
                            for (int j = 0; j < 4; ++j) v[j] = sigmoidf_(v[j] + b[j]);
                            u32x2 w; w.x = cvt_pk_bf16(v[0], v[1]); w.y = cvt_pk_bf16(v[2], v[3]); *(u32x2*)(AS + ro + c) = w; }
                        else { u32x2 w; w.x = cvt_pk_bf16(v[0], v[1]); w.y = cvt_pk_bf16(v[2], v[3]); *(u32x2*)(GG + ro + c) = w; } } }
    }
};
struct EpiResid {
    static constexpr bool PERM = false, AFTER_DRAIN = false;
    const float* xin; float* xout; const float* gate;
    __device__ __forceinline__ void operator()(const f32x4 (&acc)[2][2][4][2], const Unit& u, int wr, int wc, int fr, int fq) const {
        const int row0 = u.pm * BM + wr * 64 + fr, col0 = u.pn * BM + wc * 32 + 4 * fq; const float* gp = gate + (size_t)(u.pm >> 4) * 6144 + col0;
        f32x4 gv[2][2];
#pragma unroll
        for (int bj = 0; bj < 2; ++bj)
#pragma unroll
            for (int n = 0; n < 2; ++n) gv[bj][n] = *(const f32x4*)(gp + bj * HALF + n * 16);
#pragma unroll
        for (int ai = 0; ai < 2; ++ai)
#pragma unroll
            for (int m = 0; m < 4; ++m) { const size_t ro = (size_t)(row0 + ai * HALF + m * 16) * 1024 + col0;
#pragma unroll
                for (int bj = 0; bj < 2; ++bj)
#pragma unroll
                    for (int n = 0; n < 2; ++n) { const f32x4 xi = *(const f32x4*)(xin + ro + bj * HALF + n * 16); *(f32x4*)(xout + ro + bj * HALF + n * 16) = xi + gv[bj][n] * acc[ai][bj][m][n]; } }
    }
};
struct EpiGU {
    static constexpr bool PERM = true, AFTER_DRAIN = false;
    bf16_t* H;
    __device__ __forceinline__ void operator()(const f32x4 (&acc)[2][2][4][2], const Unit& u, int wr, int wc, int fr, int fq) const {
        const int row0 = u.pm * BM + wr * 64 + fr, col0 = u.pn * HALF + wc * 32 + 8 * fq;
#pragma unroll
        for (int ai = 0; ai < 2; ++ai)
#pragma unroll
            for (int m = 0; m < 4; ++m) { float h[8];
#pragma unroll
                for (int n = 0; n < 2; ++n)
#pragma unroll
                    for (int j = 0; j < 4; ++j) { const float g = acc[ai][0][m][n][j], up = acc[ai][1][m][n][j]; h[n * 4 + j] = g * sigmoidf_(g) * up; }
                u32x4 w; w.x = cvt_pk_bf16(h[0], h[1]); w.y = cvt_pk_bf16(h[2], h[3]); w.z = cvt_pk_bf16(h[4], h[5]); w.w = cvt_pk_bf16(h[6], h[7]);
                *(u32x4*)(H + (size_t)(row0 + ai * HALF + m * 16) * 512 + col0) = w; }
    }
};
struct EpiDown {
    static constexpr bool PERM = true, AFTER_DRAIN = false;
    bf16_t* Y; const float* rowgate;
    __device__ __forceinline__ void operator()(const f32x4 (&acc)[2][2][4][2], const Unit& u, int wr, int wc, int fr, int fq) const {
        const int row0 = u.pm * BM + wr * 64 + fr, col0 = u.pn * BM + wc * 32 + 8 * fq;
#pragma unroll
        for (int ai = 0; ai < 2; ++ai)
#pragma unroll
            for (int m = 0; m < 4; ++m) { const int r = row0 + ai * HALF + m * 16; const float gt = rowgate[r]; bf16_t* rowp = Y + (size_t)r * 1024 + col0;
#pragma unroll
                for (int bj = 0; bj < 2; ++bj) { const f32x4 v0 = acc[ai][bj][m][0] * gt, v1 = acc[ai][bj][m][1] * gt;
                    u32x4 w; w.x = cvt_pk_bf16(v0[0], v0[1]); w.y = cvt_pk_bf16(v0[2], v0[3]); w.z = cvt_pk_bf16(v1[0], v1[1]); w.w = cvt_pk_bf16(v1[2], v1[3]);
                    *(u32x4*)(rowp + bj * HALF) = w; } }
    }
};

template <class Epi, class Sched, bool ALIGN_EPI = false, bool SP2 = false>
__device__ __forceinline__ void gemm_phase(PG8_LAS unsigned char* lds, const int K_, const Sched& S, const Epi& E) {
    const int tid = threadIdx.x, wid = __builtin_amdgcn_readfirstlane(tid >> 6), lane = tid & 63, wr = wid >> 2, wc = wid & 3, fr = lane & 15, fq = lane >> 4;
    const int K = K_, nt = K / BK;
    unsigned voffA[2], voffB[2];
#pragma unroll
    for (int i = 0; i < 2; ++i) { int R, C; stage_rc(tid * 16 + i * 8192, R, C); const int Rb = Epi::PERM ? ((R & ~31) + perm32(R & 31)) : R;
        voffA[i] = (unsigned)(R * K + C) * 2u; voffB[i] = (unsigned)(Rb * K + C) * 2u; }
    const size_t kstep = (size_t)(BK * 2);
    const size_t hstep = (size_t)HALF * K * 2;
    const unsigned ldsw = (unsigned)wid * 1024u;
    const int aoff = lds_byte(wr * 64 + fr, fq * 8), boff = lds_byte(wc * 32 + fr, fq * 8);
#define PG8_SA(b, h) (((b) * 2 + (h)) * HTB)
#define PG8_SB(b, h) ((4 + (b) * 2 + (h)) * HTB)
#define PG8_STAGE(bufoff, gbase, voff) do { _Pragma("unroll") for (int _i = 0; _i < 2; ++_i) \
        __builtin_amdgcn_global_load_lds((const unsigned*)((const char*)(gbase) + (voff)[_i]), (PG8_LAS unsigned*)(lds + (bufoff) + ldsw + _i * 8192), 16, 0, 0); } while (0)
#define PG8_LDA(dst, b, h) do { _Pragma("unroll") for (int m = 0; m < 4; ++m) _Pragma("unroll") for (int k = 0; k < 2; ++k) dst[m][k] = *(const PG8_LAS bf16x8*)(lds + PG8_SA(b, h) + aoff + m * 2048 + k * 1024); } while (0)
#define PG8_LDB(dst, b, h) do { _Pragma("unroll") for (int n = 0; n < 2; ++n) _Pragma("unroll") for (int k = 0; k < 2; ++k) dst[n][k] = *(const PG8_LAS bf16x8*)(lds + PG8_SB(b, h) + boff + n * 2048 + k * 1024); } while (0)
#define PG8_MMA(ai, bj, At, Bt) do { __builtin_amdgcn_s_setprio(1); _Pragma("unroll") for (int m = 0; m < 4; ++m) _Pragma("unroll") for (int n = 0; n < 2; ++n) _Pragma("unroll") for (int k = 0; k < 2; ++k) \
        acc[ai][bj][m][n] = __builtin_amdgcn_mfma_f32_16x16x32_bf16(Bt[n][k], At[m][k], acc[ai][bj][m][n], 0, 0, 0); __builtin_amdgcn_s_setprio(0); } while (0)
#define PG8_WAIT_V(n) asm volatile("s_waitcnt vmcnt(" #n ")" ::: "memory")
#define PG8_WAIT_L(n) asm volatile("s_waitcnt lgkmcnt(" #n ")" ::: "memory")
#define PG8_BAR __builtin_amdgcn_s_barrier()
#define PG8_SCHED __builtin_amdgcn_sched_barrier(0)
    Unit cur, nxt; int ui = 0;
    if (!S.next(0, cur)) return;
    f32x4 acc[2][2][4][2];
#pragma unroll
    for (int a = 0; a < 2; ++a)
#pragma unroll
        for (int b = 0; b < 2; ++b)
#pragma unroll
            for (int m = 0; m < 4; ++m)
#pragma unroll
                for (int n = 0; n < 2; ++n) acc[a][b][m][n] = (f32x4){0.f, 0.f, 0.f, 0.f};
    bf16x8 At[4][2], B0[2][2], B1[2][2];
    const char* cA = S.a_base(cur); const char* cB = S.b_base(cur);
    S.a_ready(cur);
    if constexpr (SP2) {
        PG8_STAGE(PG8_SB(0, 0), cB, voffB); PG8_STAGE(PG8_SB(0, 1), cB + hstep, voffB); PG8_STAGE(PG8_SA(0, 0), cA, voffA); PG8_STAGE(PG8_SA(0, 1), cA + hstep, voffA);
        if (wr == 1) PG8_BAR;
        PG8_WAIT_V(2); PG8_BAR;
        PG8_STAGE(PG8_SB(1, 0), cB + kstep, voffB); PG8_STAGE(PG8_SA(1, 0), cA + kstep, voffA); PG8_STAGE(PG8_SB(1, 1), cB + hstep + kstep, voffB);
        PG8_WAIT_V(6); PG8_BAR;
    } else {
        PG8_STAGE(PG8_SB(0, 0), cB, voffB); PG8_STAGE(PG8_SA(0, 0), cA, voffA); PG8_STAGE(PG8_SB(0, 1), cB + hstep, voffB); PG8_STAGE(PG8_SA(0, 1), cA + hstep, voffA);
        if (wr == 1) PG8_BAR;
        PG8_WAIT_V(4); PG8_BAR;
        PG8_STAGE(PG8_SB(1, 0), cB + kstep, voffB); PG8_STAGE(PG8_SA(1, 0), cA + kstep, voffA); PG8_STAGE(PG8_SB(1, 1), cB + hstep + kstep, voffB);
        PG8_WAIT_V(6); PG8_BAR;
    }
    for (;;) {
        const bool has_next = S.next(ui + 1, nxt);
        const char* nA = has_next ? S.a_base(nxt) : cA; const char* nB = has_next ? S.b_base(nxt) : cB;
        for (int t = 0; t < nt; t += 2) {
            const bool last = (t == nt - 2);
            const char* a1 = cA + (size_t)(t + 1) * kstep;
            const char* a2 = last ? nA : cA + (size_t)(t + 2) * kstep; const char* b2 = last ? nB : cB + (size_t)(t + 2) * kstep;
            const char* a3 = a2 + kstep; const char* b3 = b2 + kstep;
            if (last && has_next) S.a_ready(nxt);
            if constexpr (SP2) {
            PG8_LDB(B0, 0, 0); PG8_LDB(B1, 0, 1); PG8_SCHED; PG8_LDA(At, 0, 0); PG8_STAGE(PG8_SA(1, 1), a1 + hstep, voffA);
            PG8_WAIT_V(8); PG8_WAIT_L(0); PG8_BAR; PG8_MMA(0, 0, At, B0); PG8_MMA(0, 1, At, B1); PG8_BAR; PG8_SCHED;
            PG8_LDA(At, 0, 1); PG8_STAGE(PG8_SB(0, 0), b2, voffB); PG8_STAGE(PG8_SB(0, 1), b2 + hstep, voffB); PG8_STAGE(PG8_SA(0, 0), a2, voffA);
            PG8_WAIT_V(8); PG8_WAIT_L(0); PG8_BAR; PG8_MMA(1, 0, At, B0); PG8_MMA(1, 1, At, B1); PG8_BAR; PG8_SCHED;
            PG8_LDB(B0, 1, 0); PG8_LDB(B1, 1, 1); PG8_SCHED; PG8_LDA(At, 1, 0); PG8_STAGE(PG8_SA(0, 1), a2 + hstep, voffA);
            PG8_WAIT_V(8); PG8_WAIT_L(0); PG8_BAR; PG8_MMA(0, 0, At, B0); PG8_MMA(0, 1, At, B1); PG8_BAR; PG8_SCHED;
            PG8_LDA(At, 1, 1); PG8_STAGE(PG8_SB(1, 0), b3, voffB); PG8_STAGE(PG8_SB(1, 1), b3 + hstep, voffB); PG8_STAGE(PG8_SA(1, 0), a3, voffA);
            PG8_WAIT_V(8); PG8_WAIT_L(0); PG8_BAR; PG8_MMA(1, 0, At, B0); PG8_MMA(1, 1, At, B1); PG8_BAR; PG8_SCHED;
            } else {
            PG8_LDB(B0, 0, 0); PG8_SCHED; PG8_LDA(At, 0, 0); PG8_STAGE(PG8_SA(1, 1), a1 + hstep, voffA);
            PG8_WAIT_L(8); PG8_BAR; PG8_WAIT_L(0); PG8_MMA(0, 0, At, B0); PG8_BAR; PG8_SCHED;
            PG8_LDB(B1, 0, 1); PG8_STAGE(PG8_SB(0, 0), b2, voffB);
            PG8_BAR; PG8_WAIT_L(0); PG8_MMA(0, 1, At, B1); PG8_BAR;
            PG8_LDA(At, 0, 1); PG8_STAGE(PG8_SA(0, 0), a2, voffA);
            PG8_BAR; PG8_WAIT_L(0); PG8_MMA(1, 0, At, B0); PG8_BAR; PG8_SCHED;
            PG8_STAGE(PG8_SB(0, 1), b2 + hstep, voffB);
            PG8_WAIT_V(6); PG8_BAR; PG8_MMA(1, 1, At, B1); PG8_BAR;
            PG8_LDB(B0, 1, 0); PG8_SCHED; PG8_LDA(At, 1, 0); PG8_STAGE(PG8_SA(0, 1), a2 + hstep, voffA);
            PG8_WAIT_L(8); PG8_BAR; PG8_WAIT_L(0); PG8_MMA(0, 0, At, B0); PG8_BAR; PG8_SCHED;
            PG8_LDB(B1, 1, 1); PG8_STAGE(PG8_SB(1, 0), b3, voffB);
            PG8_BAR; PG8_WAIT_L(0); PG8_MMA(0, 1, At, B1); PG8_BAR;
            PG8_LDA(At, 1, 1); PG8_STAGE(PG8_SA(1, 0), a3, voffA);
            PG8_BAR; PG8_WAIT_L(0); PG8_MMA(1, 0, At, B0); PG8_BAR; PG8_SCHED;
            PG8_STAGE(PG8_SB(1, 1), b3 + hstep, voffB);
            PG8_WAIT_V(6); PG8_BAR; PG8_MMA(1, 1, At, B1); PG8_BAR;
            }
        }
        if constexpr (ALIGN_EPI) { if (wr == 0) PG8_BAR; }
        if constexpr (!Epi::AFTER_DRAIN) { E(acc, cur, wr, wc, fr, fq); S.done(cur); }
        if (!has_next) break;
#pragma unroll
        for (int a = 0; a < 2; ++a)
#pragma unroll
            for (int b = 0; b < 2; ++b)
#pragma unroll
                for (int m = 0; m < 4; ++m)
#pragma unroll
                    for (int n = 0; n < 2; ++n) acc[a][b][m][n] = (f32x4){0.f, 0.f, 0.f, 0.f};
        cur = nxt; cA = nA; cB = nB; ++ui;
        if constexpr (ALIGN_EPI) { if (wr == 1) PG8_BAR; }
    }
    PG8_WAIT_V(0);
    if constexpr (!ALIGN_EPI) { if (wr == 0) PG8_BAR; }
    PG8_BAR;
    if constexpr (Epi::AFTER_DRAIN) { E.fused(acc, cur, wr, wc, fr, fq, lds, wid, lane); S.done(cur); }
#undef PG8_SA
#undef PG8_SB
#undef PG8_STAGE
#undef PG8_LDA
#undef PG8_LDB
#undef PG8_MMA
#undef PG8_WAIT_V
#undef PG8_WAIT_L
#undef PG8_BAR
#undef PG8_SCHED
}
}

namespace attn_body {
using bf16=__hip_bfloat16;
using bf16x8=__attribute__((ext_vector_type(8)))short;
using s16x4=__attribute__((ext_vector_type(4)))short;
using f32x16=__attribute__((ext_vector_type(16)))float;
using u32x4=__attribute__((ext_vector_type(4)))unsigned;
constexpr int BATCH=4,SEQ=4096,D=64,QP=1024,KP=1024,VP=1024,OP=2048;
constexpr int NW=8,QBLK=32,QB=QBLK*NW,KVBLK=64,NQB=SEQ/QB;
constexpr int ATTN_UNIT_ROWS=QB;
__device__ __forceinline__ int crow(int r,int hi){return (r&3)+8*(r>>2)+4*hi;}
#define SBAR() __builtin_amdgcn_sched_barrier(0)
__device__ __forceinline__ void cmask(f32x16&p0,f32x16&p1,int jb,int qrel,int hi){
  const float NEG=-INFINITY; int kb=64*jb+4*hi;
  #pragma unroll
  for(int r=0;r<16;++r){int kv=kb+(r&3)+8*(r>>2); if(kv>qrel)p0[r]=NEG; if(kv+32>qrel)p1[r]=NEG;}
}

constexpr int NSLOT=3, SLOTB=8192;
constexpr int LDS_K=0, LDS_V=NSLOT*SLOTB, LDS_WS=2*NSLOT*SLOTB, LDS_OST=LDS_WS+NW*64*4, LDS_BYTES=LDS_OST+NW*4096;
constexpr float C2=0.125f*1.4426950408889634f;
__device__ __forceinline__ void glds16(const void*gsrc,unsigned lds_dst){unsigned keep;
  asm volatile("s_mov_b32 %0, m0\n\ts_mov_b32 m0, %2\n\ts_nop 0\n\tglobal_load_lds_dwordx4 %1, off\n\ts_mov_b32 m0, %0":"=&s"(keep):"v"(gsrc),"s"(lds_dst):"memory");}
__device__ __forceinline__ float max3f(float a,float b,float c){float r;asm("v_max3_f32 %0, %1, %2, %3":"=v"(r):"v"(a),"v"(b),"v"(c));return r;}
__device__ __forceinline__ float max2f(float a,float b){float r;asm("v_max_f32_e32 %0, %1, %2":"=v"(r):"v"(a),"v"(b));return r;}
__device__ __forceinline__ float fadd_s(float a,float b){float r;asm("v_add_f32_e32 %0, %1, %2":"=v"(r):"v"(a),"v"(b));return r;}
__device__ __forceinline__ float fsub_s(float a,float b){float r;asm("v_sub_f32_e32 %0, %1, %2":"=v"(r):"v"(a),"v"(b));return r;}
typedef float f32x2_t __attribute__((ext_vector_type(2))); typedef __bf16 bf16x2_t __attribute__((ext_vector_type(2)));
__device__ __forceinline__ unsigned cvtpk_s(float lo,float hi){f32x2_t v={lo,hi};bf16x2_t b=__builtin_convertvector(v,bf16x2_t);return __builtin_bit_cast(unsigned,b);}
#define WAIT_BAR(N) asm volatile("s_waitcnt vmcnt(" #N ") lgkmcnt(0)\n\ts_barrier":::"memory")

__device__ __forceinline__ void qkt(f32x16&p0,f32x16&p1,const char*Kslot,const bf16x8*qr,const f32x16&negm,int r32,int hi){
  const char*kb=Kslot+hi*1024+r32*16;
  #pragma unroll
  for(int d0=0;d0<4;++d0){
    const bf16x8 b0=*reinterpret_cast<const bf16x8*>(kb+d0*2048);
    const bf16x8 b1=*reinterpret_cast<const bf16x8*>(kb+d0*2048+512);
    if(d0==0){p0=__builtin_amdgcn_mfma_f32_32x32x16_bf16(b0,qr[0],negm,0,0,0);p1=__builtin_amdgcn_mfma_f32_32x32x16_bf16(b1,qr[0],negm,0,0,0);}
    else{p0=__builtin_amdgcn_mfma_f32_32x32x16_bf16(b0,qr[d0],p0,0,0,0);p1=__builtin_amdgcn_mfma_f32_32x32x16_bf16(b1,qr[d0],p1,0,0,0);}}
}
typedef __attribute__((address_space(3))) const char* lds_cptr;
typedef short v4i16_t __attribute__((ext_vector_type(4)));
__device__ __forceinline__ void kload8(bf16x8*kf,lds_cptr kp){
  kf[0]=*(const __attribute__((address_space(3))) bf16x8*)(kp);      kf[1]=*(const __attribute__((address_space(3))) bf16x8*)(kp+512);
  kf[2]=*(const __attribute__((address_space(3))) bf16x8*)(kp+2048); kf[3]=*(const __attribute__((address_space(3))) bf16x8*)(kp+2560);
  kf[4]=*(const __attribute__((address_space(3))) bf16x8*)(kp+4096); kf[5]=*(const __attribute__((address_space(3))) bf16x8*)(kp+4608);
  kf[6]=*(const __attribute__((address_space(3))) bf16x8*)(kp+6144); kf[7]=*(const __attribute__((address_space(3))) bf16x8*)(kp+6656);
}
__device__ __forceinline__ void kload2(bf16x8*kf,lds_cptr kp,int j){ kf[2*j]=*(const __attribute__((address_space(3))) bf16x8*)(kp+j*2048); kf[2*j+1]=*(const __attribute__((address_space(3))) bf16x8*)(kp+j*2048+512); }
__device__ __forceinline__ s16x4 vtr(lds_cptr p){ return __builtin_bit_cast(s16x4,__builtin_amdgcn_ds_read_tr16_b64_v4i16((__attribute__((address_space(3))) v4i16_t*)p)); }
__device__ __forceinline__ float rowmax(const f32x16&p0,const f32x16&p1){
  float a=max3f(p0[0],p0[1],p1[0]),b=max3f(p0[2],p0[3],p1[1]);a=max3f(a,p1[2],p1[3]);
  #pragma unroll
  for(int r=4;r<16;r+=4){a=max3f(a,p0[r],p0[r+1]);b=max3f(b,p0[r+2],p0[r+3]);a=max3f(a,p1[r],p1[r+1]);b=max3f(b,p1[r+2],p1[r+3]);}
  const float m=max2f(a,b);
  auto rr=__builtin_amdgcn_permlane32_swap(__float_as_uint(m),__float_as_uint(m),false,false);
  return max2f(__uint_as_float(rr[0]),__uint_as_float(rr[1]));
}
__device__ __forceinline__ void pv(f32x16*o,int vb,bf16x8 pa0,bf16x8 pa1,bf16x8 pa2,bf16x8 pa3){
  #pragma unroll
  for(int d0=0;d0<2;++d0){s16x4 lo[4],hi[4];
    #pragma unroll
    for(int ks=0;ks<4;++ks){
      asm volatile("ds_read_b64_tr_b16 %0,%1 offset:%c2":"=&v"(lo[ks]):"v"(vb),"i"(d0*4096+ks*1024):"memory");
      asm volatile("ds_read_b64_tr_b16 %0,%1 offset:%c2":"=&v"(hi[ks]):"v"(vb),"i"(d0*4096+ks*1024+512):"memory");}
    asm volatile("s_waitcnt lgkmcnt(0)":::"memory");SBAR();
    #define PK(k) (bf16x8){lo[k][0],lo[k][1],lo[k][2],lo[k][3],hi[k][0],hi[k][1],hi[k][2],hi[k][3]}
    o[d0]=__builtin_amdgcn_mfma_f32_32x32x16_bf16(pa0,PK(0),o[d0],0,0,0);
    o[d0]=__builtin_amdgcn_mfma_f32_32x32x16_bf16(pa1,PK(1),o[d0],0,0,0);
    o[d0]=__builtin_amdgcn_mfma_f32_32x32x16_bf16(pa2,PK(2),o[d0],0,0,0);
    o[d0]=__builtin_amdgcn_mfma_f32_32x32x16_bf16(pa3,PK(3),o[d0],0,0,0);
    #undef PK
  }
}

#ifndef ATTN_STORE16
#define ATTN_STORE16(p,v) (*(u32x4*)(p)=(v))
#endif
template<int THRL> __device__ __forceinline__ void attn_unit(int b,int qb,const bf16*Q,const bf16*__restrict__ K,const bf16*__restrict__ V,bf16*O,char*shm){
  const int tid=threadIdx.x,lane=tid&63,r32=lane&31,hi=lane>>5; const int wid=__builtin_amdgcn_readfirstlane(tid>>6);
  const long rowbase=(long)b*SEQ; const int q0=qb*QB;
  const bf16*Qw=Q+(rowbase+q0+wid*QBLK)*QP;
  const bf16*Kh=K+rowbase*KP,*Vh=V+rowbase*VP;
  const unsigned lds0=(unsigned)(uintptr_t)shm;
  float*wsf=(float*)(shm+LDS_WS)+wid*64;
  const bf16*ksrc=Kh+(long)lane*KP+wid*8;
  const bf16*vsrc=Vh+(long)(16*(wid&3)+(lane>>2))*VP+(wid>>2)*32+(lane&3)*8;
  const unsigned kdst=lds0+LDS_K+wid*1024, vdst=lds0+LDS_V+wid*1024;
  #define DMA_K(t,slot) glds16(ksrc+(long)(t)*KVBLK*KP,(unsigned)__builtin_amdgcn_readfirstlane(kdst+(slot)))
  #define DMA_V(t,slot) glds16(vsrc+(long)(t)*KVBLK*VP,(unsigned)__builtin_amdgcn_readfirstlane(vdst+(slot)))
  const int vb0=(int)(lds0+LDS_V)+((lane>>4)&1)*32+(lane&3)*8+(4*hi+((lane&15)>>2))*64;
  const char*Kbase=shm+LDS_K; bf16x8 kf[8];
  const lds_cptr shm3=(lds_cptr)shm; const lds_cptr kp0=shm3+LDS_K+hi*1024+r32*16; const lds_cptr vp0=shm3+LDS_V+((lane>>4)&1)*32+(lane&3)*8+(4*hi+((lane&15)>>2))*64;
  const int NT=(q0+QB)/KVBLK;
  DMA_K(0,0);DMA_V(0,0);DMA_K(1,SLOTB);
  bf16x8 qr[4];
  #pragma unroll
  for(int d0=0;d0<4;++d0)qr[d0]=*reinterpret_cast<const bf16x8*>(&Qw[(long)r32*QP+d0*16+hi*8]);
  float mhat=0.f,l_reg=0.f;f32x16 o[2];o[0]=f32x16{};o[1]=f32x16{};f32x16 negm=f32x16{};asm volatile("":"+v"(negm));
  const int qrel=wid*QBLK+r32;
  #define CMASK(P0,P1,t) do{int jb_=(t)-(NT-4); if(jb_>=0)cmask(P0,P1,jb_,qrel,hi);}while(0)
  bool resc=false;
  #define START(P0,P1) do{ const float rm=rowmax(P0,P1); resc=false; \
    { const float dl=rm; mhat=fadd_s(mhat,dl); \
      _Pragma("unroll") for(int r=0;r<16;++r){P0[r]=fsub_s(P0[r],dl);P1[r]=fsub_s(P1[r],dl);} \
      _Pragma("unroll") for(int r=0;r<16;++r)negm[r]=-mhat; asm volatile("":"+v"(negm)); } \
    _Pragma("unroll") for(int r=0;r<16;++r)P0[r]=__builtin_amdgcn_exp2f(P0[r]); }while(0)
  #define RESC() do{ if(resc){ asm volatile("s_waitcnt lgkmcnt(0)":::"memory"); \
      _Pragma("unroll") for(int d_=0;d_<2;++d_) _Pragma("unroll") for(int r=0;r<16;++r)o[d_][r]*=wsf[crow(r,hi)]; } }while(0)
  f32x16 pA0,pA1,pB0,pB1;
  int sl_prev=0,sl_cur=0,sl_next=SLOTB;
  #define ROT() do{sl_prev=sl_cur;sl_cur=sl_next;sl_next=(sl_next==(NSLOT-1)*SLOTB)?0:sl_next+SLOTB;}while(0)
  DMA_K(2,2*SLOTB);
  WAIT_BAR(3);
  qkt(pA0,pA1,Kbase,qr,negm,r32,hi);asm volatile("s_nop 15\n\ts_nop 7":"+v"(pA0),"+v"(pA1));CMASK(pA0,pA1,0);
  START(pA0,pA1);
  _Pragma("unroll") for(int r=0;r<16;++r)pA1[r]=__builtin_amdgcn_exp2f(pA1[r]);
  WAIT_BAR(0);
  DMA_K(3,0);DMA_V(1,SLOTB);
  ROT();
  kload8(kf,kp0+sl_cur);
  WAIT_BAR(2);
  s16x4 vlo[8],vhi[8]; u32x4 pw0,pw1,pw2,pw3;
  #define PKW(P,B) cvtpk_s(P[B],P[B+1])
  #define PAF(k) __builtin_bit_cast(bf16x8,pw##k)
  #define VFR(i) (bf16x8){vlo[i][0],vlo[i][1],vlo[i][2],vlo[i][3],vhi[i][0],vhi[i][1],vhi[i][2],vhi[i][3]}
  #define PIN(x) asm volatile("":"+v"(x))
  #define MX3(a,b,c) __builtin_fmaxf(__builtin_fmaxf((a),(b)),(c))
  #define GAPA(MF,A0,A1,A2,A3,W0,W1,PW) do{ MF; sacc+=A0; sacc+=A1; sacc+=A2; sacc+=A3; PIN(sacc); W0; W1; PIN(PW); SBAR(); }while(0)
  #define EX(v) __builtin_amdgcn_exp2f(v)
  #define GAPB(MF,X,B) do{ MF; X[B]=EX(X[B]); X[B+1]=EX(X[B+1]); X[B+2]=EX(X[B+2]); X[B+3]=EX(X[B+3]); PIN(X); SBAR(); }while(0)
  #define VRD(i) do{ vlo[i]=vtr(vp_+(((i)>>2)*4096+((i)&3)*1024)); vhi[i]=vtr(vp_+(((i)>>2)*4096+((i)&3)*1024+512)); }while(0)
  #define KRD(G,j) do{ if(G){ kload2(kf,kp0+sl_next,j); SBAR(); } }while(0)
  #define STEP(C0,C1,P0,P1,t,GK,GV,GL) do{ SBAR(); \
    const lds_cptr vp_=vp0+sl_prev; \
    VRD(0); SBAR(); float sacc=(P0[0]+P0[1]); \
    GAPA(C0=__builtin_amdgcn_mfma_f32_32x32x16_bf16(kf[0],qr[0],negm,0,0,0), P0[2],P0[3],P0[4],P0[5],     pw0[0]=PKW(P0,0), pw0[1]=PKW(P0,2), pw0); \
    VRD(4); SBAR(); GAPA(C1=__builtin_amdgcn_mfma_f32_32x32x16_bf16(kf[1],qr[0],negm,0,0,0), P0[6],P0[7],P0[8],P0[9],     pw0[2]=PKW(P0,4), pw0[3]=PKW(P0,6), pw0); \
    VRD(1); SBAR(); GAPA(C0=__builtin_amdgcn_mfma_f32_32x32x16_bf16(kf[2],qr[1],C0,0,0,0),   P0[10],P0[11],P0[12],P0[13], pw1[0]=PKW(P0,8), pw1[1]=PKW(P0,10), pw1); \
    VRD(5); SBAR(); GAPA(C1=__builtin_amdgcn_mfma_f32_32x32x16_bf16(kf[3],qr[1],C1,0,0,0),   P0[14],P0[15],P1[0],P1[1],   pw1[2]=PKW(P0,12),pw1[3]=PKW(P0,14), pw1); \
    VRD(2); SBAR(); GAPA(C0=__builtin_amdgcn_mfma_f32_32x32x16_bf16(kf[4],qr[2],C0,0,0,0),   P1[2],P1[3],P1[4],P1[5],     pw2[0]=PKW(P1,0), pw2[1]=PKW(P1,2), pw2); \
    VRD(6); SBAR(); GAPA(C1=__builtin_amdgcn_mfma_f32_32x32x16_bf16(kf[5],qr[2],C1,0,0,0),   P1[6],P1[7],P1[8],P1[9],     pw2[2]=PKW(P1,4), pw2[3]=PKW(P1,6), pw2); \
    VRD(3); SBAR(); GAPA(C0=__builtin_amdgcn_mfma_f32_32x32x16_bf16(kf[6],qr[3],C0,0,0,0),   P1[10],P1[11],P1[12],P1[13], pw3[0]=PKW(P1,8), pw3[1]=PKW(P1,10), pw3); \
    VRD(7); SBAR(); GAPA(C1=__builtin_amdgcn_mfma_f32_32x32x16_bf16(kf[7],qr[3],C1,0,0,0),   P1[14],P1[15],0.f,0.f,       pw3[2]=PKW(P1,12),pw3[3]=PKW(P1,14), pw3); \
    l_reg+=sacc; \
    if(GK){DMA_K((t)+3,sl_cur);} if(GV){DMA_V((t)+1,sl_next);} \
    CMASK(C0,C1,t); \
    { float a=MX3(C0[0],C0[1],C1[0]),b=MX3(C0[2],C0[3],C1[1]); a=MX3(a,C1[2],C1[3]); \
      _Pragma("unroll") for(int r=4;r<16;r+=4){a=MX3(a,C0[r],C0[r+1]);b=MX3(b,C0[r+2],C0[r+3]);a=MX3(a,C1[r],C1[r+1]);b=MX3(b,C1[r+2],C1[r+3]);} \
      float rm=__builtin_fmaxf(a,b); { auto rr=__builtin_amdgcn_permlane32_swap(__float_as_uint(rm),__float_as_uint(rm),false,false); rm=__builtin_fmaxf(__uint_as_float(rr[0]),__uint_as_float(rr[1])); } \
      resc=false; \
      if(__builtin_expect(__any(rm>(float)THRL),0)){ const float dl=__builtin_fmaxf(rm,0.f); mhat+=dl; \
        _Pragma("unroll") for(int r=0;r<16;++r){C0[r]-=dl;C1[r]-=dl;} \
        _Pragma("unroll") for(int r=0;r<16;++r)negm[r]=-mhat; asm volatile("":"+v"(negm)); \
        const float f=__builtin_amdgcn_exp2f(-dl); l_reg*=f; if(hi==0)wsf[r32]=f; resc=true; } } \
    SBAR(); \
    GAPB(o[0]=__builtin_amdgcn_mfma_f32_32x32x16_bf16(PAF(0),VFR(0),o[0],0,0,0), C0,0); \
    GAPB(o[1]=__builtin_amdgcn_mfma_f32_32x32x16_bf16(PAF(0),VFR(4),o[1],0,0,0), C0,4); \
    KRD(GL,0); GAPB(o[0]=__builtin_amdgcn_mfma_f32_32x32x16_bf16(PAF(1),VFR(1),o[0],0,0,0), C0,8); \
    KRD(GL,1); GAPB(o[1]=__builtin_amdgcn_mfma_f32_32x32x16_bf16(PAF(1),VFR(5),o[1],0,0,0), C0,12); \
    KRD(GL,2); GAPB(o[0]=__builtin_amdgcn_mfma_f32_32x32x16_bf16(PAF(2),VFR(2),o[0],0,0,0), C1,0); \
    KRD(GL,3); GAPB(o[1]=__builtin_amdgcn_mfma_f32_32x32x16_bf16(PAF(2),VFR(6),o[1],0,0,0), C1,4); \
    GAPB(o[0]=__builtin_amdgcn_mfma_f32_32x32x16_bf16(PAF(3),VFR(3),o[0],0,0,0), C1,8); \
    GAPB(o[1]=__builtin_amdgcn_mfma_f32_32x32x16_bf16(PAF(3),VFR(7),o[1],0,0,0), C1,12); \
    }while(0)
  int t=1;
  #undef CMASK
  #define CMASK(P0,P1,t) do{}while(0)
  for(;t+5<NT;t+=2){
    STEP(pB0,pB1,pA0,pA1,t,true,true,true);     WAIT_BAR(2); RESC(); ROT();
    STEP(pA0,pA1,pB0,pB1,t+1,true,true,true);   WAIT_BAR(2); RESC(); ROT();
  }
  #undef CMASK
  #define CMASK(P0,P1,t) do{int jb_=(t)-(NT-4); if(jb_>=0)cmask(P0,P1,jb_,qrel,hi);}while(0)
  #define ENDW(tt) do{ if((tt)+3<NT){WAIT_BAR(2);} else if((tt)+2<NT){WAIT_BAR(1);} else {WAIT_BAR(0);} }while(0)
  for(;t+1<NT;t+=2){
    STEP(pB0,pB1,pA0,pA1,t,(t+3<NT),(t+1<NT),(t+1<NT));       ENDW(t);   RESC(); ROT();
    STEP(pA0,pA1,pB0,pB1,t+1,(t+4<NT),(t+2<NT),(t+2<NT));     ENDW(t+1); RESC(); ROT();
  }
  STEP(pB0,pB1,pA0,pA1,NT-1,false,false,false); RESC();
  { float sacc=pB0[0]+pB0[1]; _Pragma("unroll") for(int r=2;r<16;++r)sacc+=pB0[r]; _Pragma("unroll") for(int r=0;r<16;++r)sacc+=pB1[r]; l_reg+=sacc;
    pw0=(u32x4){PKW(pB0,0),PKW(pB0,2),PKW(pB0,4),PKW(pB0,6)};pw1=(u32x4){PKW(pB0,8),PKW(pB0,10),PKW(pB0,12),PKW(pB0,14)};pw2=(u32x4){PKW(pB1,0),PKW(pB1,2),PKW(pB1,4),PKW(pB1,6)};pw3=(u32x4){PKW(pB1,8),PKW(pB1,10),PKW(pB1,12),PKW(pB1,14)};
    SBAR(); pv(o,vb0+sl_cur,PAF(0),PAF(1),PAF(2),PAF(3)); }
  #undef PKW
  #undef PAF
  #undef VFR
  #undef PIN
  #undef MX3
  #undef GAPA
  #undef GAPB
  #undef EX
  #undef VRD
  #undef KRD
  #undef STEP
  #undef ENDW
  {auto rr=__builtin_amdgcn_permlane32_swap(__float_as_uint(l_reg),__float_as_uint(l_reg),false,false);l_reg=__uint_as_float(rr[0])+__uint_as_float(rr[1]);}
  if(hi==0)wsf[32+r32]=l_reg;asm volatile("s_waitcnt lgkmcnt(0)":::"memory");
  float rli[16];
  #pragma unroll
  for(int r=0;r<16;++r)rli[r]=__builtin_amdgcn_rcpf(wsf[32+crow(r,hi)]);
  bf16*Ow=O+(rowbase+q0+wid*QBLK)*OP;
  { bf16*stg=(bf16*)(shm+LDS_OST)+wid*2048;
    #pragma unroll
    for(int r=0;r<16;++r){const int orow=crow(r,hi);
      #pragma unroll
      for(int d0=0;d0<2;++d0)stg[orow*64+d0*32+r32]=__float2bfloat16(o[d0][r]*rli[r]);}
    asm volatile("s_waitcnt lgkmcnt(0)":::"memory");
    #pragma unroll
    for(int i=0;i<4;++i){const int row=i*8+(lane>>3),ch=lane&7; const u32x4 v=*(const u32x4*)(stg+row*64+ch*8); ATTN_STORE16(Ow+(long)row*OP+ch*8,v);} }
  asm volatile("s_waitcnt lgkmcnt(0)\n\ts_barrier":::"memory");
  #undef DMA_K
  #undef DMA_V
  #undef CMASK
  #undef START
  #undef RESC
  #undef ROT
}
constexpr int ATTN_LDS_BYTES=LDS_BYTES;
struct AttnUnit { int bh; int qb; };
#undef SBAR
#undef WAIT_BAR
}

constexpr int NWAVES = 8;
constexpr int BATCH = 4, T = 4096, D = 1024, M = BATCH * T;
constexpr int NE = 32, FF = 512, NGRP = 4, EPG = 8;
constexpr int MAXROWS = 40960;
constexpr float RMS_EPS = 1e-6f, GN_EPS = 64e-5f, SUBLN_EPS = 1e-5f;
constexpr float LAMBDA_INIT1 = 0.35550906759f;

constexpr size_t MiB = 1u << 20;
constexpr size_t WS_CTL = 0, CTL_ZERO_BYTES = 1 * MiB;
constexpr size_t WS_MOD = 1 * MiB;
constexpr size_t WS_WRKV = 2 * MiB, WS_WL1 = 8 * MiB, WS_WL2 = 9 * MiB, WS_WO0 = 11 * MiB, WS_WQKV = 13 * MiB, WS_WO1 = 19 * MiB;
constexpr size_t WS_ROUTE = 21 * MiB;
constexpr size_t WS_MOEGU = 32 * MiB, WS_MOED = 96 * MiB;
constexpr size_t WS_XA = 128 * MiB;
constexpr size_t WS_R = 192 * MiB;
constexpr size_t WS_VIEWS = WS_R, WS_H2 = WS_R + 96 * MiB, WS_A2 = WS_R + 160 * MiB, WS_RKV = WS_R + 168 * MiB;
constexpr size_t WS_LOGW = WS_R, WS_ASIG = WS_R + 64 * MiB, WS_GG = WS_R + 96 * MiB, WS_YG = WS_R + 128 * MiB;
constexpr size_t WS_H2N = WS_R, WS_XS = WS_R + 32 * MiB, WS_HS = WS_R + 112 * MiB, WS_Y = WS_R + 152 * MiB;
constexpr size_t WS_HQ = WS_R, WS_HK = WS_R + 32 * MiB, WS_QKV = WS_R + 64 * MiB, WS_OC = WS_R + 160 * MiB, WS_ON = WS_R + 224 * MiB;
constexpr size_t WS_END = WS_R + 264 * MiB;
static_assert(WS_RKV + 96 * MiB <= WS_END && WS_Y + 80 * MiB <= WS_END && WS_ON + 32 * MiB <= WS_END, "d_ws map");
constexpr int CW_BAR = 4096;
constexpr int CW_CNT = 8192;

constexpr int RING_OFF = 0, RING_BYTES = 131072;
constexpr int LDSCTL_OFF = RING_BYTES, MISC_OFF = LDSCTL_OFF + 320;
constexpr int LDS_BYTES = 147456;

#define GAS __attribute__((address_space(1)))
#define LAS __attribute__((address_space(3)))
typedef unsigned short bf16;
typedef unsigned v4u __attribute__((ext_vector_type(4)));
typedef unsigned v2u __attribute__((ext_vector_type(2)));
typedef float f32x4 __attribute__((ext_vector_type(4)));
typedef short bf16x8 __attribute__((ext_vector_type(8)));
typedef GAS unsigned gu32;
#define RLX_AGENT __ATOMIC_RELAXED, __HIP_MEMORY_SCOPE_AGENT
#define LDS_WAIT() asm volatile("s_waitcnt lgkmcnt(0)" ::: "memory")
#define VM_WAIT() asm volatile("s_waitcnt vmcnt(0)" ::: "memory")
__device__ __forceinline__ unsigned pk2(float lo, float hi) { return pg8::cvt_pk_bf16(lo, hi); }
__device__ __forceinline__ float bflo(unsigned w) { return __uint_as_float(w << 16); }
__device__ __forceinline__ float bfhi(unsigned w) { return __uint_as_float(w & 0xffff0000u); }

#define XB_TMO      128
#define XB_XCNT(j)  (256  + 64 * (j))
#define XB_XSUB(j)  (1280 + 64 * (j))
#define XB_XGEN(j)  (2304 + 64 * (j))
#define XB_TOP      3328
#define XB_TOPGEN   3392
#define XCD_BAR_WORDS 3456
#define XB_SPIN_CAP (1u << 18)

__device__ __forceinline__ unsigned xb_ld(unsigned* p)              { return __hip_atomic_load(p, __ATOMIC_RELAXED, __HIP_MEMORY_SCOPE_AGENT); }
__device__ __forceinline__ unsigned xb_add(unsigned* p, unsigned v) { return __hip_atomic_fetch_add(p, v, __ATOMIC_RELAXED, __HIP_MEMORY_SCOPE_AGENT); }
__device__ __forceinline__ unsigned xb_xcc_id() { return (unsigned)__builtin_amdgcn_s_getreg((3 << 11) | 20) & 0xFu; }
#define XB_SPIN(cond, bar) do { unsigned _sp = 0; while (cond) { __builtin_amdgcn_s_sleep(1); \
    if ((++_sp & 255u) == 0u) { if (xb_ld(&(bar)[XB_TMO])) break; if (_sp > XB_SPIN_CAP) { atomicAdd(&(bar)[XB_TMO], 1u); break; } } } } while (0)

struct XcdBarrier {
    unsigned* bar; unsigned x;
    volatile LAS unsigned* st;
};

__device__ __forceinline__ XcdBarrier xcd_barrier_post(unsigned* bar, volatile LAS unsigned* st) {
    XcdBarrier b; b.bar = bar; b.x = xb_xcc_id(); b.st = st;
    if (threadIdx.x == 0) (void)xb_add(&bar[XB_XCNT(b.x)], 1u);
    return b;
}
__device__ __forceinline__ void xcd_barrier_complete(unsigned* bar, unsigned x, unsigned& nloc, unsigned& nx) {
    const unsigned G = gridDim.x * gridDim.y * gridDim.z;
    unsigned sum, cnt, mine, sp = 0u;
    for (;;) {
        sum = 0u; cnt = 0u; mine = 0u;
#pragma unroll
        for (unsigned j = 0; j < 16; ++j) { const unsigned c = xb_ld(&bar[XB_XCNT(j)]); sum += c; cnt += (c > 0u) ? 1u : 0u; mine = (j == x) ? c : mine; }
        if (sum == G) break;
        __builtin_amdgcn_s_sleep(1);
        if ((++sp & 255u) == 0u) { if (xb_ld(&bar[XB_TMO])) break; if (sp > XB_SPIN_CAP) { atomicAdd(&bar[XB_TMO], 1u); break; } }
    }
    nloc = mine > 0u ? mine : 1u; nx = cnt > 0u ? cnt : 1u;
}

__device__ __forceinline__ void xcd_barrier(const XcdBarrier& b) {
    asm volatile("s_waitcnt vmcnt(0)" ::: "memory");
    __syncthreads();
    if (threadIdx.x == 0) {
        unsigned* bar = b.bar;
        __builtin_amdgcn_s_waitcnt(0);
        unsigned nloc = b.st[0], nx = b.st[1];
        if (nloc == 0u) { xcd_barrier_complete(bar, b.x, nloc, nx); b.st[0] = nloc; b.st[1] = nx; }
        const unsigned old = xb_add(&bar[XB_XSUB(b.x)], 1u);
        const unsigned gen = old / nloc;
        if (old + 1u == (gen + 1u) * nloc) {
            __builtin_amdgcn_fence(__ATOMIC_RELEASE, "agent");
            asm volatile("s_waitcnt vmcnt(0)" ::: "memory");
            const unsigned og = xb_add(&bar[XB_TOP], 1u);
            const unsigned tg = og / nx;
            if (og + 1u == (tg + 1u) * nx) xb_add(&bar[XB_TOPGEN], 1u);
            else XB_SPIN(xb_ld(&bar[XB_TOPGEN]) == tg, bar);
            __builtin_amdgcn_fence(__ATOMIC_ACQUIRE, "agent");
            xb_add(&bar[XB_XGEN(b.x)], 1u);
            asm volatile("s_waitcnt vmcnt(0)" ::: "memory");
        } else {
            XB_SPIN(xb_ld(&bar[XB_XGEN(b.x)]) == gen, bar);
            __builtin_amdgcn_fence(__ATOMIC_ACQUIRE, "agent");
            asm volatile("s_waitcnt vmcnt(0)" ::: "memory");
        }
    }
    __syncthreads();
}


struct Frame {
    LAS unsigned char* lds;
    volatile LAS unsigned* MISC;
    gu32* ctl;
    unsigned char* ws;
    const float* const* in;
    float* out;
    int tid, lane, wave, vcu, G;
};
__device__ __forceinline__ int lane_id() { int l = threadIdx.x & 63; asm volatile("" : "+v"(l)); return l; }
__device__ __forceinline__ float wave_sum(float v) {
#pragma unroll
    for (int o = 1; o < 64; o <<= 1) v += __shfl_xor(v, o);
    return v;
}
__device__ __forceinline__ void transpose_item(const float* W, int ldw, int k0, int n0, bf16* WT, int ldo, int orow0, int ok0, const float* kscale, LAS float* scr, int lane) {
#pragma unroll 8
    for (int i = 0; i < 32; ++i) { const int kk = 2 * i + (lane >> 5); float v = W[(size_t)(k0 + kk) * ldw + n0 + (lane & 31)]; if (kscale) v *= kscale[k0 + kk]; scr[kk * 33 + (lane & 31)] = v; }
    LDS_WAIT(); asm volatile("" ::: "memory");
    const int c = lane & 7;
#pragma unroll
    for (int j = 0; j < 4; ++j) { const int n = (lane >> 3) + 8 * j; const LAS float* s = scr + (8 * c) * 33 + n;
        v4u o; o.x = pk2(s[0 * 33], s[1 * 33]); o.y = pk2(s[2 * 33], s[3 * 33]); o.z = pk2(s[4 * 33], s[5 * 33]); o.w = pk2(s[6 * 33], s[7 * 33]);
        *(GAS v4u*)(WT + (size_t)(orow0 + n) * ldo + ok0 + k0 + 8 * c) = o; }
    LDS_WAIT(); asm volatile("" ::: "memory");
}
__device__ __forceinline__ void transpose_mat(Frame& F, const float* W, int K, int N, bf16* WT, int ldo, int row_off, int ok0, const float* kscale, int gw, int NGW) {
    LAS float* scr = (LAS float*)(F.lds + RING_OFF + F.wave * 16384);
    const int nblk = N / 32, items = (K / 64) * nblk;
    for (int it = gw; it < items; it += NGW) { const int kb = it / nblk, nb = it % nblk; transpose_item(W, N, 64 * kb, 32 * nb, WT, ldo, row_off + 32 * nb, ok0, kscale, scr, F.lane); }
}

__device__ __forceinline__ void p0_mod(Frame& F) {
    LAS float* cact = (LAS float*)(F.lds + RING_OFF);
    LAS float* red = cact + 4096;
    const float* c = F.in[1];
    for (int i = F.tid; i < 4096; i += 512) { const float v = c[i]; cact[i] = v / (1.0f + __expf(-v)); }
    __syncthreads();
    float* modbase = (float*)(F.ws + WS_MOD);
    for (int it = blockIdx.x; it < 224; it += F.G) {
        const float* W; const float* bias; float* outp; int N, cc;
        if (it < 96) { W = F.in[2]; bias = F.in[3]; outp = modbase; N = 6144; cc = it; }
        else if (it < 192) { W = F.in[2] + (size_t)1024 * 6144; bias = F.in[3] + 6144; outp = modbase + 4 * 6144; N = 6144; cc = it - 96; }
        else { W = F.in[22]; bias = F.in[23]; outp = modbase + 8 * 6144; N = 2048; cc = it - 192; }
        const int kg = F.tid >> 4, cq = F.tid & 15, col = cc * 64 + cq * 4;
        f32x4 a0 = {0, 0, 0, 0}, a1 = a0, a2 = a0, a3 = a0;
#pragma unroll 4
        for (int kk = 0; kk < 32; ++kk) { const int k = kg * 32 + kk; const f32x4 w = *(const f32x4*)(W + (size_t)k * N + col);
            a0 += w * cact[k]; a1 += w * cact[1024 + k]; a2 += w * cact[2048 + k]; a3 += w * cact[3072 + k]; }
        LAS f32x4* rp = (LAS f32x4*)red + (kg * 16 + cq) * 4;
        rp[0] = a0; rp[1] = a1; rp[2] = a2; rp[3] = a3;
        __syncthreads();
        if (F.tid < 256) { const int b = F.tid >> 6, cl = F.tid & 63, cq2 = cl >> 2, j = cl & 3; float s = 0.f;
            for (int g = 0; g < 32; ++g) s += red[((g * 16 + cq2) * 4 + b) * 4 + j];
            outp[(size_t)b * N + cc * 64 + cl] = s + bias[cc * 64 + cl]; }
        __syncthreads();
    }
}
__device__ __forceinline__ void p0_weights(Frame& F) {
    const int gw = F.vcu * NWAVES + F.wave, NGW = F.G * NWAVES;
    bf16* Wrkv = (bf16*)(F.ws + WS_WRKV); bf16* Wl1 = (bf16*)(F.ws + WS_WL1); bf16* Wl2 = (bf16*)(F.ws + WS_WL2);
    bf16* Wo0 = (bf16*)(F.ws + WS_WO0); bf16* Wqkv = (bf16*)(F.ws + WS_WQKV); bf16* Wo1 = (bf16*)(F.ws + WS_WO1);
    for (int z = 0; z < 3; ++z) transpose_mat(F, F.in[7] + (size_t)z * D * D, D, D, Wrkv + (size_t)z * D * D, D, 0, 0, nullptr, gw, NGW);
    transpose_mat(F, F.in[21], D, D, Wo0, D, 0, 0, nullptr, gw, NGW);
    transpose_mat(F, F.in[26], D, D, Wqkv, D, 0, 0, nullptr, gw, NGW);
    transpose_mat(F, F.in[25], D, 2 * D, Wqkv, D, D, 0, nullptr, gw, NGW);
    transpose_mat(F, F.in[32], D, D, Wo1, D, 0, 0, nullptr, gw, NGW);
    const float* mu = F.in[6];
    transpose_mat(F, F.in[9], D, 64, Wl1, 2048, 0, 0, nullptr, gw, NGW);    transpose_mat(F, F.in[9], D, 64, Wl1, 2048, 0, 1024, mu + 3 * D, gw, NGW);
    transpose_mat(F, F.in[12], D, 64, Wl1, 2048, 64, 0, nullptr, gw, NGW);  transpose_mat(F, F.in[12], D, 64, Wl1, 2048, 64, 1024, mu + 4 * D, gw, NGW);
    transpose_mat(F, F.in[14], D, 128, Wl1, 2048, 128, 0, nullptr, gw, NGW); transpose_mat(F, F.in[14], D, 128, Wl1, 2048, 128, 1024, mu + 5 * D, gw, NGW);
    const float* w2 = F.in[10]; const float* a2 = F.in[13]; const float* g2 = F.in[15];
    for (int idx = (blockIdx.x * 512 + F.tid); idx < 3072 * 256; idx += F.G * 512) {
        const int k = idx / 3072, n = idx % 3072; float v = 0.f;
        if (n < 1024) { if (k < 64) v = w2[(size_t)k * 1024 + n]; }
        else if (n < 2048) { if (k >= 64 && k < 128) v = a2[(size_t)(k - 64) * 1024 + (n - 1024)]; }
        else { if (k >= 128) v = g2[(size_t)(k - 128) * 1024 + (n - 2048)]; }
        Wl2[(size_t)n * 256 + k] = (bf16)(pk2(v, 0.f) & 0xffffu);
    }
}
__device__ __forceinline__ void moe_weights(Frame& F, int l) {
    const int gw = F.vcu * NWAVES + F.wave, NGW = F.G * NWAVES;
    LAS float* scr = (LAS float*)(F.lds + RING_OFF + F.wave * 16384);
    bf16* GU = (bf16*)(F.ws + WS_MOEGU); bf16* DW = (bf16*)(F.ws + WS_MOED);
    const float* wg = F.in[35] + (size_t)l * NE * D * FF; const float* wu = F.in[36] + (size_t)l * NE * D * FF; const float* wd = F.in[37] + (size_t)l * NE * FF * D;
    for (int it = gw; it < NE * 768; it += NGW) {
        const int e = it / 768, r = it % 768;
        if (r < 512) { const int up = r >> 8, q = r & 255, kb = q >> 4, nb = q & 15, n0 = 32 * nb;
            const float* W = (up ? wu : wg) + (size_t)e * D * FF;
            transpose_item(W, FF, 64 * kb, n0, GU + (size_t)e * 1024 * 1024, 1024, 256 * (n0 >> 7) + (n0 & 127) + (up ? 128 : 0), 0, nullptr, scr, F.lane); }
        else { const int q = r - 512, kb = q >> 5, nb = q & 31;
            transpose_item(wd + (size_t)e * FF * D, D, 64 * kb, 32 * nb, DW + (size_t)e * 1024 * 512, 512, 32 * nb, 0, nullptr, scr, F.lane); }
    }
}

__device__ __forceinline__ void p1_norm_views(Frame& F) {
    LAS float* hrow = (LAS float*)(F.lds + RING_OFF);
    const float* x = F.in[0]; const float* g = F.in[4]; const float* mu = F.in[6];
    const float* mod = (const float*)(F.ws + WS_MOD);
    bf16* views = (bf16*)(F.ws + WS_VIEWS); bf16* H2 = (bf16*)(F.ws + WS_H2);
    for (int grp = blockIdx.x; grp < M / 8; grp += F.G) {
        const int m0 = grp * 8, b = m0 / T, t0 = m0 % T;
        const float* sh = mod + (size_t)b * 6144; const float* sc = sh + 1024;
        f32x4 hv[4];
        for (int pass = 0; pass < 2; ++pass) {
            if (pass == 1 && F.wave != 0) break;
            const int row = (pass == 0) ? (m0 + F.wave) : (m0 - 1);
            f32x4 v[4];
            if (pass == 1 && t0 == 0) {
#pragma unroll
                for (int j = 0; j < 4; ++j) v[j] = (f32x4){0.f, 0.f, 0.f, 0.f};
            } else {
                const f32x4* xr = (const f32x4*)(x + (size_t)row * D) + F.lane; float ss = 0.f;
#pragma unroll
                for (int j = 0; j < 4; ++j) { v[j] = xr[64 * j]; ss += (v[j].x * v[j].x + v[j].y * v[j].y) + (v[j].z * v[j].z + v[j].w * v[j].w); }
                const float rstd = 1.0f / sqrtf(wave_sum(ss) * (1.f / D) + RMS_EPS);
#pragma unroll
                for (int j = 0; j < 4; ++j) { const int c = 4 * F.lane + 256 * j; const f32x4 gg = *(const f32x4*)(g + c), s1 = *(const f32x4*)(sc + c), s0 = *(const f32x4*)(sh + c);
                    v[j] = v[j] * rstd * gg * (s1 + 1.0f) + s0; }
            }
            LAS f32x4* hp = (LAS f32x4*)(hrow + ((pass == 0) ? (F.wave + 1) : 0) * 1024) + F.lane;
#pragma unroll
            for (int j = 0; j < 4; ++j) { hp[64 * j] = v[j]; if (pass == 0) hv[j] = v[j]; }
        }
        __syncthreads();
        {
            const int row = m0 + F.wave;
            const LAS f32x4* pp = (const LAS f32x4*)(hrow + F.wave * 1024) + F.lane;
#pragma unroll
            for (int j = 0; j < 4; ++j) { const int c = 4 * F.lane + 256 * j; const f32x4 xx = pp[64 * j] - hv[j];
#pragma unroll
                for (int i = 0; i < 3; ++i) { const f32x4 mm = *(const f32x4*)(mu + i * D + c); const f32x4 o = hv[j] + xx * mm;
                    v2u w; w.x = pk2(o.x, o.y); w.y = pk2(o.z, o.w); *(v2u*)(views + ((size_t)i * M + row) * D + c) = w; }
                v2u w; w.x = pk2(hv[j].x, hv[j].y); w.y = pk2(hv[j].z, hv[j].w); *(v2u*)(H2 + (size_t)row * 2048 + c) = w;
                w.x = pk2(xx.x, xx.y); w.y = pk2(xx.z, xx.w); *(v2u*)(H2 + (size_t)row * 2048 + 1024 + c) = w; }
        }
        __syncthreads();
    }
}

__device__ __forceinline__ void p4_scan_seq(Frame& F) {
    constexpr int TS = 32;
    LAS float* sA = (LAS float*)(F.lds + RING_OFF);
    LAS float* sW = sA + TS * 64; LAS float* sB = sW + TS * 64; LAS float* sK = sB + TS * 64; LAS float* sR = sK + TS * 64; LAS float* sV = sR + TS * 64;
    LAS float* sY = sV + TS * 64; LAS float* sRK = sY + TS * 64;
    const bf16* Rb = (const bf16*)(F.ws + WS_RKV); const bf16* Kb = Rb + (size_t)M * D; const bf16* Vb = Kb + (size_t)M * D;
    const float* LW = (const float*)(F.ws + WS_LOGW); const bf16* AS = (const bf16*)(F.ws + WS_ASIG); const bf16* GG = (const bf16*)(F.ws + WS_GG);
    bf16* YG = (bf16*)(F.ws + WS_YG);
    const float* k_k = F.in[16]; const float* k_a = F.in[17]; const float* r_k = F.in[18]; const float* gn_g = F.in[19]; const float* gn_b = F.in[20];
    for (int bh = blockIdx.x; bh < BATCH * 16; bh += F.G) {
        const int b = bh >> 4, h = bh & 15;
        const int i = F.tid >> 3, q = F.tid & 7;
        const int st = F.tid >> 4, d4 = (F.tid & 15) * 4;
        const int cg = h * 64 + d4;
        const f32x4 kkv = *(const f32x4*)(k_k + cg), kav = *(const f32x4*)(k_a + cg), rkv = *(const f32x4*)(r_k + cg), gng = *(const f32x4*)(gn_g + cg), gnb = *(const f32x4*)(gn_b + cg);
        float s[8];
#pragma unroll
        for (int j = 0; j < 8; ++j) s[j] = 0.f;
        for (int t0 = 0; t0 < T; t0 += TS) {
            const size_t ro = ((size_t)b * T + t0 + st) * D + cg;
            {
                const v2u rr = *(const v2u*)(Rb + ro), kk2 = *(const v2u*)(Kb + ro), vv = *(const v2u*)(Vb + ro), aa = *(const v2u*)(AS + ro); const f32x4 lw = *(const f32x4*)(LW + ro);
                const f32x4 r4 = {bflo(rr.x), bfhi(rr.x), bflo(rr.y), bfhi(rr.y)}, k4 = {bflo(kk2.x), bfhi(kk2.x), bflo(kk2.y), bfhi(kk2.y)};
                const f32x4 v4 = {bflo(vv.x), bfhi(vv.x), bflo(vv.y), bfhi(vv.y)}, a4 = {bflo(aa.x), bfhi(aa.x), bflo(aa.y), bfhi(aa.y)};
                const f32x4 kr = k4 * kkv; float ss = (kr.x * kr.x + kr.y * kr.y) + (kr.z * kr.z + kr.w * kr.w);
                ss += __shfl_xor(ss, 1); ss += __shfl_xor(ss, 2); ss += __shfl_xor(ss, 4); ss += __shfl_xor(ss, 8);
                const float inv = 1.0f / fmaxf(sqrtf(ss), 1e-12f);
                const f32x4 kkn = kr * inv; const f32x4 km = k4 * ((a4 - 1.0f) * kav + 1.0f);
                const f32x4 rk4 = r4 * km * rkv; float rs = (rk4.x + rk4.y) + (rk4.z + rk4.w);
                rs += __shfl_xor(rs, 1); rs += __shfl_xor(rs, 2); rs += __shfl_xor(rs, 4); rs += __shfl_xor(rs, 8);
                f32x4 wv; wv.x = __expf(lw.x); wv.y = __expf(lw.y); wv.z = __expf(lw.z); wv.w = __expf(lw.w);
                *(LAS f32x4*)(sA + st * 64 + d4) = -kkn; *(LAS f32x4*)(sW + st * 64 + d4) = wv; *(LAS f32x4*)(sB + st * 64 + d4) = kkn * a4;
                *(LAS f32x4*)(sK + st * 64 + d4) = km; *(LAS f32x4*)(sR + st * 64 + d4) = r4; *(LAS f32x4*)(sV + st * 64 + d4) = v4;
                if ((F.tid & 15) == 0) sRK[st] = rs;
            }
            __syncthreads();
            for (int t = 0; t < TS; ++t) {
                const LAS f32x4* pa = (const LAS f32x4*)(sA + t * 64 + q * 8); const LAS f32x4* pw = (const LAS f32x4*)(sW + t * 64 + q * 8); const LAS f32x4* pb = (const LAS f32x4*)(sB + t * 64 + q * 8);
                const LAS f32x4* pk = (const LAS f32x4*)(sK + t * 64 + q * 8); const LAS f32x4* pr = (const LAS f32x4*)(sR + t * 64 + q * 8);
                const f32x4 a0 = pa[0], a1 = pa[1], w0 = pw[0], w1 = pw[1], b0 = pb[0], b1 = pb[1], k0 = pk[0], k1 = pk[1], r0 = pr[0], r1 = pr[1];
                const float vi = sV[t * 64 + i];
                float sa = (s[0] * a0.x + s[1] * a0.y) + (s[2] * a0.z + s[3] * a0.w) + (s[4] * a1.x + s[5] * a1.y) + (s[6] * a1.z + s[7] * a1.w);
                sa += __shfl_xor(sa, 1); sa += __shfl_xor(sa, 2); sa += __shfl_xor(sa, 4);
                s[0] = s[0] * w0.x + sa * b0.x + vi * k0.x; s[1] = s[1] * w0.y + sa * b0.y + vi * k0.y; s[2] = s[2] * w0.z + sa * b0.z + vi * k0.z; s[3] = s[3] * w0.w + sa * b0.w + vi * k0.w;
                s[4] = s[4] * w1.x + sa * b1.x + vi * k1.x; s[5] = s[5] * w1.y + sa * b1.y + vi * k1.y; s[6] = s[6] * w1.z + sa * b1.z + vi * k1.z; s[7] = s[7] * w1.w + sa * b1.w + vi * k1.w;
                float y = (s[0] * r0.x + s[1] * r0.y) + (s[2] * r0.z + s[3] * r0.w) + (s[4] * r1.x + s[5] * r1.y) + (s[6] * r1.z + s[7] * r1.w);
                y += __shfl_xor(y, 1); y += __shfl_xor(y, 2); y += __shfl_xor(y, 4);
                if (q == 0) sY[t * 64 + i] = y;
            }
            __syncthreads();
            {
                const f32x4 y4 = *(const LAS f32x4*)(sY + st * 64 + d4); const f32x4 v4 = *(const LAS f32x4*)(sV + st * 64 + d4);
                float sm = (y4.x + y4.y) + (y4.z + y4.w);
                sm += __shfl_xor(sm, 1); sm += __shfl_xor(sm, 2); sm += __shfl_xor(sm, 4); sm += __shfl_xor(sm, 8);
                const float mean = sm * (1.f / 64.f); const f32x4 dv = y4 - mean;
                float vs = (dv.x * dv.x + dv.y * dv.y) + (dv.z * dv.z + dv.w * dv.w);
                vs += __shfl_xor(vs, 1); vs += __shfl_xor(vs, 2); vs += __shfl_xor(vs, 4); vs += __shfl_xor(vs, 8);
                const float rstd = 1.0f / sqrtf(vs * (1.f / 64.f) + GN_EPS);
                const v2u gg = *(const v2u*)(GG + ro); const f32x4 g4 = {bflo(gg.x), bfhi(gg.x), bflo(gg.y), bfhi(gg.y)};
                const f32x4 o = (dv * rstd * gng + gnb + v4 * sRK[st]) * g4;
                v2u w; w.x = pk2(o.x, o.y); w.y = pk2(o.z, o.w); *(v2u*)(YG + ro) = w;
            }
            __syncthreads();
        }
    }
}

__device__ __forceinline__ void moe_router(Frame& F, int l, const float* xin) {
    const float* g = F.in[5] + (size_t)l * D; const float* wrg = F.in[33] + (size_t)l * D * NGRP; const float* wre = F.in[34] + (size_t)l * D * NE;
    const float* mod = (const float*)(F.ws + WS_MOD) + (size_t)l * 4 * 6144;
    bf16* H2N = (bf16*)(F.ws + WS_H2N);
    int* asg_e = (int*)(F.ws + WS_ROUTE); int* asg_pos = asg_e + 2 * M; float* asg_gate = (float*)(asg_pos + 2 * M);
    unsigned* cnt = (unsigned*)F.ctl + CW_CNT + 64 * l;
    const int gw = blockIdx.x * NWAVES + F.wave, NGW = F.G * NWAVES;
    for (int row = gw; row < M; row += NGW) {
        const int b = row / T; const float* sh = mod + (size_t)b * 6144 + 3072; const float* sc = sh + 1024;
        const f32x4* xr = (const f32x4*)(xin + (size_t)row * D) + F.lane; f32x4 v[4]; float ss = 0.f;
#pragma unroll
        for (int j = 0; j < 4; ++j) { v[j] = xr[64 * j]; ss += (v[j].x * v[j].x + v[j].y * v[j].y) + (v[j].z * v[j].z + v[j].w * v[j].w); }
        const float rstd = 1.0f / sqrtf(wave_sum(ss) * (1.f / D) + RMS_EPS);
        float acc[36];
#pragma unroll
        for (int o = 0; o < 36; ++o) acc[o] = 0.f;
#pragma unroll
        for (int j = 0; j < 4; ++j) { const int c = 4 * F.lane + 256 * j; const f32x4 gg = *(const f32x4*)(g + c), s1 = *(const f32x4*)(sc + c), s0 = *(const f32x4*)(sh + c);
            v[j] = v[j] * rstd * gg * (s1 + 1.0f) + s0;
            v2u w; w.x = pk2(v[j].x, v[j].y); w.y = pk2(v[j].z, v[j].w); *(v2u*)(H2N + (size_t)row * D + c) = w; }
        const float* wel = wre + (size_t)F.lane * 128; const float* wgl = wrg + (size_t)F.lane * 16;
        asm volatile("" : "+v"(wel), "+v"(wgl));
#pragma unroll
        for (int j = 0; j < 4; ++j) { const float* wej = wel + (size_t)j * 256 * 32; const float* wgj = wgl + (size_t)j * 256 * 4;
#pragma unroll
            for (int e = 0; e < 4; ++e) { const float hvv = v[j][e];
                const f32x4 wg4 = *(const f32x4*)(wgj + e * 4);
                acc[0] += hvv * wg4.x; acc[1] += hvv * wg4.y; acc[2] += hvv * wg4.z; acc[3] += hvv * wg4.w;
#pragma unroll
                for (int q = 0; q < 8; ++q) { const f32x4 we = *(const f32x4*)(wej + e * 32 + q * 4);
                    acc[4 + q * 4 + 0] += hvv * we.x; acc[4 + q * 4 + 1] += hvv * we.y; acc[4 + q * 4 + 2] += hvv * we.z; acc[4 + q * 4 + 3] += hvv * we.w; } } }
#pragma unroll
        for (int o = 0; o < 36; ++o) acc[o] = wave_sum(acc[o]);
        int gi = 0; float gm = acc[0];
#pragma unroll
        for (int j = 1; j < 4; ++j) if (acc[j] > gm) { gm = acc[j]; gi = j; }
        float gs = 0.f;
#pragma unroll
        for (int j = 0; j < 4; ++j) gs += __expf(acc[j] - gm);
        const float ggate = 1.0f / gs;
        float el[8];
#pragma unroll
        for (int j = 0; j < 8; ++j) el[j] = (gi == 0) ? acc[4 + j] : (gi == 1) ? acc[12 + j] : (gi == 2) ? acc[20 + j] : acc[28 + j];
        int i1 = 0; float v1 = el[0];
#pragma unroll
        for (int j = 1; j < 8; ++j) if (el[j] > v1) { v1 = el[j]; i1 = j; }
        int i2 = -1; float v2 = -INFINITY;
#pragma unroll
        for (int j = 0; j < 8; ++j) if (j != i1 && el[j] > v2) { v2 = el[j]; i2 = j; }
        const float e2 = __expf(v2 - v1), p1 = 1.0f / (1.0f + e2), p2 = e2 * p1;
        if (F.lane == 0) { const int ea = gi * 8 + i1, eb = gi * 8 + i2;
            const unsigned pa = atomicAdd(cnt + ea, 1u), pb = atomicAdd(cnt + eb, 1u);
            asg_e[2 * row] = ea; asg_e[2 * row + 1] = eb; asg_pos[2 * row] = (int)pa; asg_pos[2 * row + 1] = (int)pb;
            asg_gate[2 * row] = ggate * p1; asg_gate[2 * row + 1] = ggate * p2; }
    }
}
__device__ __forceinline__ void moe_toff(Frame& F, int l) {
    LAS int* toff = (LAS int*)(F.lds + LDSCTL_OFF);
    if (F.tid == 0) { const unsigned* cnt = (const unsigned*)F.ctl + CW_CNT + 64 * l; int acc = 0;
        for (int e = 0; e < 32; ++e) { toff[e] = acc; acc += (int)((__hip_atomic_load(cnt + e, RLX_AGENT) + 255u) >> 8); }
        toff[32] = acc; }
    __syncthreads();
}
__device__ __forceinline__ void moe_gather(Frame& F, int l) {
    moe_toff(F, l);
    const LAS int* toff = (const LAS int*)(F.lds + LDSCTL_OFF);
    const bf16* H2N = (const bf16*)(F.ws + WS_H2N); bf16* XS = (bf16*)(F.ws + WS_XS);
    const int* asg_e = (const int*)(F.ws + WS_ROUTE); const int* asg_pos = asg_e + 2 * M; const float* asg_gate = (const float*)(asg_pos + 2 * M);
    int* asg_row = (int*)(asg_gate + 2 * M); float* rowgate = (float*)(asg_row + 2 * M);
    const int gw = blockIdx.x * NWAVES + F.wave, NGW = F.G * NWAVES;
    for (int a = gw; a < 2 * M; a += NGW) {
        const int tok = a >> 1, e = asg_e[a], pos = asg_pos[a]; const int row = toff[e] * 256 + pos;
        const v4u* src = (const v4u*)(H2N + (size_t)tok * D) + F.lane; v4u* dst = (v4u*)(XS + (size_t)row * D) + F.lane;
        const v4u x0 = src[0], x1 = src[64]; dst[0] = x0; dst[64] = x1;
        if (F.lane == 0) { rowgate[row] = asg_gate[a]; asg_row[a] = row; }
    }
}
template <int MODE> __device__ __forceinline__ void moe_combine(Frame& F, int l, const float* xin, float* xout) {
    const bf16* Y = (const bf16*)(F.ws + WS_Y);
    const int* asg_row = (const int*)(F.ws + WS_ROUTE) + 6 * M;
    const float* mod = (const float*)(F.ws + WS_MOD) + (size_t)l * 4 * 6144;
    const float* mod1 = (const float*)(F.ws + WS_MOD) + (size_t)4 * 6144;
    const float* modkv = (const float*)(F.ws + WS_MOD) + (size_t)8 * 6144;
    const float* gq = F.in[4] + D; const float* gkv = F.in[24]; const float* gfin = F.in[38];
    bf16* HQ = (bf16*)(F.ws + WS_HQ); bf16* HK = (bf16*)(F.ws + WS_HK);
    const int gw = blockIdx.x * NWAVES + F.wave, NGW = F.G * NWAVES;
    for (int row = gw; row < M; row += NGW) {
        const int b = row / T; const float* gf = mod + (size_t)b * 6144 + 5120;
        const int r0 = asg_row[2 * row], r1 = asg_row[2 * row + 1];
        const f32x4* xr = (const f32x4*)(xin + (size_t)row * D) + F.lane; f32x4 v[4]; float ss = 0.f;
#pragma unroll
        for (int j = 0; j < 4; ++j) { const int c = 4 * F.lane + 256 * j;
            const v2u y0 = *(const v2u*)(Y + (size_t)r0 * D + c), y1 = *(const v2u*)(Y + (size_t)r1 * D + c); const f32x4 gg = *(const f32x4*)(gf + c);
            const f32x4 ys = {bflo(y0.x) + bflo(y1.x), bfhi(y0.x) + bfhi(y1.x), bflo(y0.y) + bflo(y1.y), bfhi(y0.y) + bfhi(y1.y)};
            v[j] = xr[64 * j] + gg * ys; ss += (v[j].x * v[j].x + v[j].y * v[j].y) + (v[j].z * v[j].z + v[j].w * v[j].w); }
        const float rstd = 1.0f / sqrtf(wave_sum(ss) * (1.f / D) + RMS_EPS);
        if (MODE == 0) {
            const float* shq = mod1 + (size_t)b * 6144; const float* scq = shq + 1024; const float* shk = modkv + (size_t)b * 2048; const float* sck = shk + 1024;
#pragma unroll
            for (int j = 0; j < 4; ++j) { const int c = 4 * F.lane + 256 * j;
                *((f32x4*)(xout + (size_t)row * D) + F.lane + 64 * j) = v[j];
                const f32x4 n = v[j] * rstd;
                const f32x4 hq = n * *(const f32x4*)(gq + c) * (*(const f32x4*)(scq + c) + 1.0f) + *(const f32x4*)(shq + c);
                const f32x4 hk = n * *(const f32x4*)(gkv + c) * (*(const f32x4*)(sck + c) + 1.0f) + *(const f32x4*)(shk + c);
                v2u w; w.x = pk2(hq.x, hq.y); w.y = pk2(hq.z, hq.w); *(v2u*)(HQ + (size_t)row * D + c) = w;
                w.x = pk2(hk.x, hk.y); w.y = pk2(hk.z, hk.w); *(v2u*)(HK + (size_t)row * D + c) = w; }
        } else {
#pragma unroll
            for (int j = 0; j < 4; ++j) { const int c = 4 * F.lane + 256 * j; *((f32x4*)(xout + (size_t)row * D) + F.lane + 64 * j) = v[j] * rstd * *(const f32x4*)(gfin + c); }
        }
    }
}
__device__ __forceinline__ void attn_subln(Frame& F) {
    const bf16* OC = (const bf16*)(F.ws + WS_OC); bf16* ON = (bf16*)(F.ws + WS_ON);
    const float l1 = wave_sum(F.in[27][F.lane] * F.in[28][F.lane]), l2 = wave_sum(F.in[29][F.lane] * F.in[30][F.lane]);
    const float lam = __expf(l1) - __expf(l2) + LAMBDA_INIT1;
    const float* sg = F.in[31] + (F.lane & 7) * 16;
    float gsc[16];
#pragma unroll
    for (int e = 0; e < 16; ++e) gsc[e] = sg[e] * (1.0f - LAMBDA_INIT1);
    const int gw = blockIdx.x * NWAVES + F.wave, NGW = F.G * NWAVES; const int hd = F.lane >> 3, sub = (F.lane & 7) * 16;
    for (int row = gw; row < M; row += NGW) {
        const v4u* p0 = (const v4u*)(OC + (size_t)row * 2048 + (hd * 2) * 128 + sub); const v4u* p1 = (const v4u*)(OC + (size_t)row * 2048 + (hd * 2 + 1) * 128 + sub);
        const v4u a0 = p0[0], a1 = p0[1], b0 = p1[0], b1 = p1[1];
        float d[16];
#define DF(i, A, B) d[2 * (i)] = bflo(A) - lam * bflo(B); d[2 * (i) + 1] = bfhi(A) - lam * bfhi(B)
        DF(0, a0.x, b0.x); DF(1, a0.y, b0.y); DF(2, a0.z, b0.z); DF(3, a0.w, b0.w); DF(4, a1.x, b1.x); DF(5, a1.y, b1.y); DF(6, a1.z, b1.z); DF(7, a1.w, b1.w);
#undef DF
        float ss = 0.f;
#pragma unroll
        for (int e = 0; e < 16; ++e) ss += d[e] * d[e];
        ss += __shfl_xor(ss, 1); ss += __shfl_xor(ss, 2); ss += __shfl_xor(ss, 4);
        const float rstd = 1.0f / sqrtf(ss * (1.f / 128.f) + SUBLN_EPS);
        v4u w0, w1;
        w0.x = pk2(d[0] * rstd * gsc[0], d[1] * rstd * gsc[1]); w0.y = pk2(d[2] * rstd * gsc[2], d[3] * rstd * gsc[3]); w0.z = pk2(d[4] * rstd * gsc[4], d[5] * rstd * gsc[5]); w0.w = pk2(d[6] * rstd * gsc[6], d[7] * rstd * gsc[7]);
        w1.x = pk2(d[8] * rstd * gsc[8], d[9] * rstd * gsc[9]); w1.y = pk2(d[10] * rstd * gsc[10], d[11] * rstd * gsc[11]); w1.z = pk2(d[12] * rstd * gsc[12], d[13] * rstd * gsc[13]); w1.w = pk2(d[14] * rstd * gsc[14], d[15] * rstd * gsc[15]);
        v4u* op = (v4u*)(ON + (size_t)row * D + F.lane * 16); op[0] = w0; op[1] = w1;
    }
}
struct AttnOrder {
    int vcu;
    __device__ __forceinline__ explicit AttnOrder(int grid, int block) : vcu((block % 8) * (grid / 8) + block / 8) {}
    __device__ __forceinline__ bool next(int i, attn_body::AttnUnit& u) const { if (i >= 8) return false; const int s = 2 * (i >> 1) + (vcu & 1); u.bh = vcu >> 1; u.qb = (i & 1) ? s : 15 - s; return true; }
    __device__ __forceinline__ void a_ready(const attn_body::AttnUnit&) const {}
    __device__ __forceinline__ void done(const attn_body::AttnUnit&) const {}
};

constexpr int NPHASE = 22;
#define IN(k) (lo <= (k) && (k) < hi)
#define SEAM(k) do { if (IN(k) && (k) + 1 < hi) xcd_barrier(bar); } while (0)
template <int L> __device__ __forceinline__ void moe_phases(Frame& F, const int lo, const int hi, const XcdBarrier& bar) {
    constexpr int pb = 11 * L;
    LAS unsigned char* ring = F.lds + RING_OFF;
    const LAS int* toff = (const LAS int*)(F.lds + LDSCTL_OFF);
        if (IN(pb + 6)) { F.lane = lane_id(); moe_router(F, L, (const float*)(F.ws + WS_XA)); moe_weights(F, L); } SEAM(pb + 6);
        if (IN(pb + 7)) { F.lane = lane_id(); moe_gather(F, L); } SEAM(pb + 7);
        if (IN(pb + 8)) { F.lane = lane_id();
            moe_toff(F, L);
            pg8::MoeOrder S; S.init(F.ws + WS_XS, F.ws + WS_MOEGU, (size_t)1024 * 1024 * 2, toff, 4, D, F.G, (int)blockIdx.x);
            pg8::EpiGU E{(bf16*)(F.ws + WS_HS)};
            pg8::gemm_phase<pg8::EpiGU, pg8::MoeOrder, true, true>(ring, D, S, E);
        } SEAM(pb + 8);
        if (IN(pb + 9)) { F.lane = lane_id();
            moe_toff(F, L);
            pg8::MoeOrder S; S.init(F.ws + WS_HS, F.ws + WS_MOED, (size_t)1024 * 512 * 2, toff, 4, FF, F.G, (int)blockIdx.x);
            pg8::EpiDown E{(bf16*)(F.ws + WS_Y), (const float*)(F.ws + WS_ROUTE) + 8 * M};
            pg8::gemm_phase<pg8::EpiDown, pg8::MoeOrder, true, true>(ring, FF, S, E);
        } SEAM(pb + 9);
        if (IN(pb + 10)) { F.lane = lane_id();
            moe_combine<L>(F, L, (const float*)(F.ws + WS_XA), F.out);
        } SEAM(pb + 10);
}
#undef IN
#undef SEAM
struct Args { const float* in[39]; float* out; unsigned char* ws; int ph_lo, ph_hi; };
__global__ void __launch_bounds__(NWAVES * 64, 2) trunk_fwd(Args args) {
    extern __shared__ __attribute__((aligned(16))) unsigned char lds[];
    Frame F;
    F.lds = (LAS unsigned char*)lds;
    F.MISC = (volatile LAS unsigned*)(F.lds + MISC_OFF);
    F.tid = threadIdx.x; F.lane = lane_id(); F.wave = __builtin_amdgcn_readfirstlane(F.tid >> 6);
    F.G = gridDim.x; { const int bx = blockIdx.x; F.vcu = (F.G % 8 == 0) ? (bx % 8) * (F.G / 8) + bx / 8 : bx; }
    F.ws = args.ws; F.ctl = (gu32*)(args.ws + WS_CTL); F.in = args.in; F.out = args.out;
    for (int u = F.tid; u < (LDS_BYTES - LDSCTL_OFF) / 4; u += NWAVES * 64) ((LAS unsigned*)(F.lds + LDSCTL_OFF))[u] = 0u;
    __syncthreads();
    const int lo = args.ph_lo, hi = args.ph_hi;
    const bool multi = (hi - lo) > 1;
    XcdBarrier bar; bar.bar = (unsigned*)(F.ctl + CW_BAR); bar.x = 0; bar.st = nullptr;
    if (multi) bar = xcd_barrier_post((unsigned*)(F.ctl + CW_BAR), F.MISC + 8);
#define IN(k) (lo <= (k) && (k) < hi)
#define SEAM(k) do { if (IN(k) && (k) + 1 < hi) xcd_barrier(bar); } while (0)
    LAS unsigned char* ring = F.lds + RING_OFF;
    const LAS int* toff = (const LAS int*)(F.lds + LDSCTL_OFF);

    {
        {
            if (IN(0)) { F.lane = lane_id(); p0_mod(F); p0_weights(F); } SEAM(0);
            if (IN(1)) { F.lane = lane_id(); p1_norm_views(F); } SEAM(1);
            if (IN(2)) { F.lane = lane_id();
                { pg8::BatchOrder S; S.init(F.ws + WS_VIEWS, F.ws + WS_WRKV, (size_t)M * D * 2, (size_t)D * D * 2, M, D, 3, D, F.G, (int)blockIdx.x);
                  pg8::EpiZBf16 E{(bf16*)(F.ws + WS_RKV), (size_t)M * D, 1.0f};
                  pg8::gemm_phase<pg8::EpiZBf16, pg8::BatchOrder, true, true>(ring, D, S, E); }
                { pg8::BatchOrder S; S.init(F.ws + WS_H2, F.ws + WS_WL1, 0, 0, M, 256, 1, 2048, F.G, (int)blockIdx.x);
                  pg8::EpiLora1 E{(bf16*)(F.ws + WS_A2)};
                  pg8::gemm_phase<pg8::EpiLora1, pg8::BatchOrder, true, true>(ring, 2048, S, E); }
            } SEAM(2);
            if (IN(3)) { F.lane = lane_id();
                pg8::BatchOrder S; S.init(F.ws + WS_A2, F.ws + WS_WL2, 0, 0, M, 3072, 1, 256, F.G, (int)blockIdx.x);
                pg8::EpiLora2 E{(float*)(F.ws + WS_LOGW), (bf16*)(F.ws + WS_ASIG), (bf16*)(F.ws + WS_GG), F.in[8], F.in[11]};
                pg8::gemm_phase<pg8::EpiLora2, pg8::BatchOrder, true, true>(ring, 256, S, E);
            } SEAM(3);
            if (IN(4)) { F.lane = lane_id(); p4_scan_seq(F); } SEAM(4);
            if (IN(5)) { F.lane = lane_id();
                pg8::BatchOrder S; S.init(F.ws + WS_YG, F.ws + WS_WO0, 0, 0, M, D, 1, D, F.G, (int)blockIdx.x);
                pg8::EpiResid E{F.in[0], (float*)(F.ws + WS_XA), (const float*)(F.ws + WS_MOD) + 2048};
                pg8::gemm_phase<pg8::EpiResid, pg8::BatchOrder, true, true>(ring, D, S, E);
            } SEAM(5);
        }
        moe_phases<0>(F, lo, hi, bar);
        {
            if (IN(11)) { F.lane = lane_id();
                { pg8::BatchOrder S; S.init(F.ws + WS_HQ, F.ws + WS_WQKV, (size_t)M * D * 2, (size_t)D * D * 2, M, D, 2, D, F.G, (int)blockIdx.x);
                  pg8::EpiZBf16 E{(bf16*)(F.ws + WS_QKV), (size_t)M * D, attn_body::C2};
                  pg8::gemm_phase<pg8::EpiZBf16, pg8::BatchOrder, true, true>(ring, D, S, E); }
                { pg8::BatchOrder S; S.init(F.ws + WS_HK, F.ws + WS_WQKV + (size_t)2 * D * D * 2, 0, 0, M, D, 1, D, F.G, (int)blockIdx.x);
                  pg8::EpiZBf16 E{(bf16*)(F.ws + WS_QKV) + (size_t)2 * M * D, 0, 1.0f};
                  pg8::gemm_phase<pg8::EpiZBf16, pg8::BatchOrder, true, true>(ring, D, S, E); }
            } SEAM(11);
            if (IN(12)) { F.lane = lane_id();
                const attn_body::bf16* Q = (const attn_body::bf16*)(F.ws + WS_QKV); const attn_body::bf16* Kp = Q + (size_t)M * D; const attn_body::bf16* Vp = Kp + (size_t)M * D;
                attn_body::bf16* O = (attn_body::bf16*)(F.ws + WS_OC);
                const AttnOrder S((int)F.G, (int)blockIdx.x); attn_body::AttnUnit u;
                for (int i = 0; S.next(i, u); ++i) {
                    const int b = u.bh >> 5, h = (u.bh >> 2) & 7, c = (u.bh >> 1) & 1, vh = u.bh & 1;
                    attn_body::attn_unit<8>(b, u.qb, Q + (h * 2 + c) * 64, Kp + (h * 2 + c) * 64, Vp + h * 128 + vh * 64, O + (h * 2 + c) * 128 + vh * 64, (char*)lds + RING_OFF);
                }
            } SEAM(12);
            if (IN(13)) { F.lane = lane_id(); attn_subln(F); } SEAM(13);
            if (IN(14)) { F.lane = lane_id();
                pg8::BatchOrder S; S.init(F.ws + WS_ON, F.ws + WS_WO1, 0, 0, M, D, 1, D, F.G, (int)blockIdx.x);
                pg8::EpiResid E{F.out, (float*)(F.ws + WS_XA), (const float*)(F.ws + WS_MOD) + 4 * 6144 + 2048};
                pg8::gemm_phase<pg8::EpiResid, pg8::BatchOrder, true, true>(ring, D, S, E);
            } SEAM(14);
        }
        moe_phases<1>(F, lo, hi, bar);
    }
    if (multi && hi == NPHASE) { if (__hip_atomic_load((gu32*)((unsigned*)(F.ctl + CW_BAR) + XB_TMO), RLX_AGENT) != 0u) {
        const float q = __builtin_nanf(""); for (size_t i = (size_t)blockIdx.x * 512 + F.tid; i < (size_t)M * D; i += (size_t)F.G * 512) F.out[i] = q; } }
#undef IN
#undef SEAM
}

#ifndef N_LAUNCH_MODE
#define N_LAUNCH_MODE 0
#endif
extern "C" void kernel_launch(void* const* d_in, const int* in_sizes, int n_in, void* d_out, int out_size, void* d_ws, size_t ws_size, hipStream_t stream) {
    static int grid = 0;
    if (grid == 0) {
        if (n_in != 39 || in_sizes[0] != M * D || out_size != M * D || ws_size < WS_END) { fprintf(stderr, "kernel_launch: unexpected problem (n_in %d, in0 %d, out %d, ws %zu < %zu); nothing launched\n", n_in, n_in > 0 ? in_sizes[0] : -1, out_size, ws_size, (size_t)WS_END); grid = -1; return; }
        int dev = 0, cus = 0, per_cu = 0;
        if (hipGetDevice(&dev) != hipSuccess || hipDeviceGetAttribute(&cus, hipDeviceAttributeMultiprocessorCount, dev) != hipSuccess) { grid = -1; return; }
        if (hipFuncSetAttribute((const void*)trunk_fwd, hipFuncAttributeMaxDynamicSharedMemorySize, LDS_BYTES) != hipSuccess) { fprintf(stderr, "kernel_launch: hipFuncSetAttribute failed\n"); grid = -1; return; }
        if (hipOccupancyMaxActiveBlocksPerMultiprocessor(&per_cu, (const void*)trunk_fwd, NWAVES * 64, LDS_BYTES) != hipSuccess || per_cu < 1) fprintf(stderr, "kernel_launch: occupancy query reports %d\n", per_cu);
        (void)hipGetLastError();
        grid = cus;
    }
    if (grid < 0) return;
    if (hipMemsetAsync((char*)d_ws + WS_CTL, 0, CTL_ZERO_BYTES, stream) != hipSuccess) return;
    Args a{};
    for (int i = 0; i < 39; ++i) a.in[i] = (const float*)d_in[i];
    a.out = (float*)d_out; a.ws = (unsigned char*)d_ws;
    if (N_LAUNCH_MODE == 1) {
        a.ph_lo = 0; a.ph_hi = NPHASE;
        hipLaunchKernelGGL(trunk_fwd, dim3(grid), dim3(NWAVES * 64), LDS_BYTES, stream, a);
    } else {
        const int ids[20] = {0, 1, 2, 3, 4, 5, 6, 7, 8, 9, 10, 11, 12, 13, 14, 17, 18, 19, 20, 21};
        for (int k = 0; k < 20; ++k) { a.ph_lo = ids[k]; a.ph_hi = ids[k] + 1; hipLaunchKernelGGL(trunk_fwd, dim3(grid), dim3(NWAVES * 64), LDS_BYTES, stream, a); }
    }
}
```

```cpp
#include <hip/hip_runtime.h>
#include <hip/hip_bf16.h>
#include <cstdio>
#include <cstdint>
#include <cmath>

namespace pg8 {
#define PG8_LAS __attribute__((address_space(3)))
typedef unsigned short bf16_t;
typedef short bf16x8 __attribute__((ext_vector_type(8)));
typedef float f32x4 __attribute__((ext_vector_type(4)));
typedef unsigned u32x4 __attribute__((ext_vector_type(4)));
typedef unsigned u32x2 __attribute__((ext_vector_type(2)));
constexpr int BM = 256, BK = 64, HALF = 128, HTB = HALF * BK * 2  , STAGE_BYTES = 8 * HTB, NXCD = 8, WGM = 8;

__host__ __device__ __forceinline__ int lds_byte(int r, int c) { const int st = (r >> 4) * 2 + (c >> 5), rr = r & 15, cc = c & 31, ob = rr * 64 + cc * 2; return st * 1024 + (ob ^ (((ob >> 9) & 1) << 5)); }
__host__ __device__ __forceinline__ void stage_rc(int b, int& R, int& C) { const int st = b / 1024, sb = b % 1024, swz = sb ^ (((sb >> 9) & 1) << 5); R = (st >> 1) * 16 + swz / 64; C = (st & 1) * 32 + (swz % 64) / 2; }
__host__ __device__ __forceinline__ int perm32(int rho) { const int n = rho >> 4, i = rho & 15; return 8 * (i >> 2) + 4 * n + (i & 3); }

struct Unit { int pm, pn, z; };

__device__ __forceinline__ unsigned cvt_pk_bf16(float lo, float hi) { unsigned r; asm("v_cvt_pk_bf16_f32 %0, %1, %2" : "=v"(r) : "v"(lo), "v"(hi)); return r; }

struct BatchOrder {
    const char* A; const char* B; size_t sa, sb, tst; int nM, nN, nwg, tot, G, c;
    __device__ __forceinline__ void init(const void* A_, const void* B_, size_t sa_, size_t sb_, int M, int N, int Z, int K, int G_, int c_) {
        A = (const char*)A_; B = (const char*)B_; sa = sa_; sb = sb_; tst = (size_t)BM * K * 2; nM = M / BM; nN = N / BM; nwg = nM * nN; tot = nwg * Z; G = G_; c = c_; }
    __device__ __forceinline__ bool next(int i, Unit& u) const {
        const int L = i * G + c; if (L >= tot) return false;
        u.z = L / nwg; int wgid = L - u.z * nwg; { const int q = nwg / NXCD, r = nwg % NXCD, xcd = wgid % NXCD, off = wgid / NXCD; wgid = (xcd < r ? xcd * (q + 1) : r * (q + 1) + (xcd - r) * q) + off; }
        const int nig = WGM * nN, gid = wgid / nig, fm = gid * WGM, gsz = (nM - fm) < WGM ? (nM - fm) : WGM;
        u.pm = fm + ((wgid % nig) % gsz); u.pn = (wgid % nig) / gsz; return true;
    }
    __device__ __forceinline__ const char* a_base(const Unit& u) const { return A + (size_t)u.z * sa + (size_t)u.pm * tst; }
    __device__ __forceinline__ const char* b_base(const Unit& u) const { return B + (size_t)u.z * sb + (size_t)u.pn * tst; }
    __device__ __forceinline__ void a_ready(const Unit&) const {}
    __device__ __forceinline__ void done(const Unit&) const {}
};
struct MoeOrder {
    const char* A; const char* B; size_t sbe, tst; const PG8_LAS int* toff; int nNt, tot, G, c;
    __device__ __forceinline__ void init(const void* A_, const void* B_, size_t sbe_, const PG8_LAS int* toff_, int nNt_, int K, int G_, int c_) {
        A = (const char*)A_; B = (const char*)B_; sbe = sbe_; tst = (size_t)BM * K * 2; toff = toff_; nNt = nNt_; tot = toff_[32] * nNt_; G = G_; c = c_; }
    __device__ __forceinline__ bool next(int i, Unit& u) const {
        const int L = i * G + c; if (L >= tot) return false;
        const int tI = L / nNt; u.pm = tI; u.pn = L - tI * nNt; int e = 0;
#pragma unroll
        for (int j = 1; j < 32; ++j) e += (toff[j] <= tI) ? 1 : 0;
        u.z = e; return true;
    }
    __device__ __forceinline__ const char* a_base(const Unit& u) const { return A + (size_t)u.pm * tst; }
    __device__ __forceinline__ const char* b_base(const Unit& u) const { return B + (size_t)u.z * sbe + (size_t)u.pn * tst; }
    __device__ __forceinline__ void a_ready(const Unit&) const {}
    __device__ __forceinline__ void done(const Unit&) const {}
};

__device__ __forceinline__ float sigmoidf_(float x) { return 1.0f / (1.0f + __expf(-x)); }
__device__ __forceinline__ float tanh_fast(float x) { return 1.0f - 2.0f / (__expf(2.0f * x) + 1.0f); }

struct EpiZBf16 {
    static constexpr bool PERM = true, AFTER_DRAIN = false;
    bf16_t* O; size_t zstride; float scale0;
    __device__ __forceinline__ void operator()(const f32x4 (&acc)[2][2][4][2], const Unit& u, int wr, int wc, int fr, int fq) const {
        const int row0 = u.pm * BM + wr * 64 + fr, col0 = u.pn * BM + wc * 32 + 8 * fq; bf16_t* base = O + (size_t)u.z * zstride; const float sc = (u.z == 0) ? scale0 : 1.0f;
#pragma unroll
        for (int ai = 0; ai < 2; ++ai)
#pragma unroll
            for (int m = 0; m < 4; ++m) { bf16_t* rowp = base + (size_t)(row0 + ai * HALF + m * 16) * 1024 + col0;
#pragma unroll
                for (int bj = 0; bj < 2; ++bj) { const f32x4 v0 = acc[ai][bj][m][0] * sc, v1 = acc[ai][bj][m][1] * sc;
                    u32x4 w; w.x = cvt_pk_bf16(v0[0], v0[1]); w.y = cvt_pk_bf16(v0[2], v0[3]); w.z = cvt_pk_bf16(v1[0], v1[1]); w.w = cvt_pk_bf16(v1[2], v1[3]);
                    *(u32x4*)(rowp + bj * HALF) = w; } }
    }
};
struct EpiLora1 {
    static constexpr bool PERM = true, AFTER_DRAIN = false;
    bf16_t* O;
    __device__ __forceinline__ void operator()(const f32x4 (&acc)[2][2][4][2], const Unit& u, int wr, int wc, int fr, int fq) const {
        const int row0 = u.pm * BM + wr * 64 + fr, col0 = wc * 32 + 8 * fq;
#pragma unroll
        for (int ai = 0; ai < 2; ++ai)
#pragma unroll
            for (int m = 0; m < 4; ++m) { bf16_t* rowp = O + (size_t)(row0 + ai * HALF + m * 16) * 256 + col0;
#pragma unroll
                for (int bj = 0; bj < 2; ++bj) { f32x4 v0 = acc[ai][bj][m][0], v1 = acc[ai][bj][m][1];
                    if (bj == 0 && wc < 2) {
#pragma unroll
                        for (int j = 0; j < 4; ++j) { v0[j] = tanh_fast(v0[j]); v1[j] = tanh_fast(v1[j]); } }
                    if (bj == 1) {
#pragma unroll
                        for (int j = 0; j < 4; ++j) { v0[j] = sigmoidf_(v0[j]); v1[j] = sigmoidf_(v1[j]); } }
                    u32x4 w; w.x = cvt_pk_bf16(v0[0], v0[1]); w.y = cvt_pk_bf16(v0[2], v0[3]); w.z = cvt_pk_bf16(v1[0], v1[1]); w.w = cvt_pk_bf16(v1[2], v1[3]);
                    *(u32x4*)(rowp + bj * HALF) = w; } }
    }
};
struct EpiLora2 {
    static constexpr bool PERM = false, AFTER_DRAIN = false;
    float* LW; bf16_t* AS; bf16_t* GG; const float* w0; const float* a0;
    __device__ __forceinline__ void operator()(const f32x4 (&acc)[2][2][4][2], const Unit& u, int wr, int wc, int fr, int fq) const {
        const int sect = u.pn >> 2, row0 = u.pm * BM + wr * 64 + fr, col0 = (u.pn & 3) * BM + wc * 32 + 4 * fq;
#pragma unroll
        for (int ai = 0; ai < 2; ++ai)
#pragma unroll
            for (int m = 0; m < 4; ++m) { const size_t ro = (size_t)(row0 + ai * HALF + m * 16) * 1024;
#pragma unroll
                for (int bj = 0; bj < 2; ++bj)
#pragma unroll
                    for (int n = 0; n < 2; ++n) { const int c = col0 + bj * HALF + n * 16; f32x4 v = acc[ai][bj][m][n];
                        if (sect == 0) { const f32x4 b = *(const f32x4*)(w0 + c);
#pragma unroll
                            for (int j = 0; j < 4; ++j) { const float x = -(v[j] + b[j]); const float sp = fmaxf(x, 0.f) + __logf(1.0f + __expf(-fabsf(x))); v[j] = -__expf(-sp - 0.5f); }
                            *(f32x4*)(LW + ro + c) = v; }
                        else if (sect == 1) { const f32x4 b = *(const f32x4*)(a0 + c);
#pragma unroll
                            for (int j = 0; j < 4; ++j) v[j] = sigmoidf_(v[j] + b[j]);
                            u32x2 w; w.x = cvt_pk_bf16(v[0], v[1]); w.y = cvt_pk_bf16(v[2], v[3]); *(u32x2*)(AS + ro + c) = w; }
                        else { u32x2 w; w.x = cvt_pk_bf16(v[0], v[1]); w.y = cvt_pk_bf16(v[2], v[3]); *(u32x2*)(GG + ro + c) = w; } } }
    }
};
struct EpiResid {
    static constexpr bool PERM = false, AFTER_DRAIN = false;
    const float* xin; float* xout; const float* gate;
    __device__ __forceinline__ void operator()(const f32x4 (&acc)[2][2][4][2], const Unit& u, int wr, int wc, int fr, int fq) const {
        const int row0 = u.pm * BM + wr * 64 + fr, col0 = u.pn * BM + wc * 32 + 4 * fq; const float* gp = gate + (size_t)(u.pm >> 4) * 6144 + col0;
        f32x4 gv[2][2];
#pragma unroll
        for (int bj = 0; bj < 2; ++bj)
#pragma unroll
            for (int n = 0; n < 2; ++n) gv[bj][n] = *(const f32x4*)(gp + bj * HALF + n * 16);
#pragma unroll
        for (int ai = 0; ai < 2; ++ai)
#pragma unroll
            for (int m = 0; m < 4; ++m) { const size_t ro = (size_t)(row0 + ai * HALF + m * 16) * 1024 + col0;
#pragma unroll
                for (int bj = 0; bj < 2; ++bj)
#pragma unroll
                    for (int n = 0; n < 2; ++n) { const f32x4 xi = *(const f32x4*)(xin + ro + bj * HALF + n * 16); *(f32x4*)(xout + ro + bj * HALF + n * 16) = xi + gv[bj][n] * acc[ai][bj][m][n]; } }
    }
};
struct EpiGU {
    static constexpr bool PERM = true, AFTER_DRAIN = false;
    bf16_t* H;
    __device__ __forceinline__ void operator()(const f32x4 (&acc)[2][2][4][2], const Unit& u, int wr, int wc, int fr, int fq) const {
        const int row0 = u.pm * BM + wr * 64 + fr, col0 = u.pn * HALF + wc * 32 + 8 * fq;
#pragma unroll
        for (int ai = 0; ai < 2; ++ai)
#pragma unroll
            for (int m = 0; m < 4; ++m) { float h[8];
#pragma unroll
                for (int n = 0; n < 2; ++n)
#pragma unroll
                    for (int j = 0; j < 4; ++j) { const float g = acc[ai][0][m][n][j], up = acc[ai][1][m][n][j]; h[n * 4 + j] = g * sigmoidf_(g) * up; }
                u32x4 w; w.x = cvt_pk_bf16(h[0], h[1]); w.y = cvt_pk_bf16(h[2], h[3]); w.z = cvt_pk_bf16(h[4], h[5]); w.w = cvt_pk_bf16(h[6], h[7]);
                *(u32x4*)(H + (size_t)(row0 + ai * HALF + m * 16) * 512 + col0) = w; }
    }
};
struct EpiDown {
    static constexpr bool PERM = true, AFTER_DRAIN = false;
    bf16_t* Y; const float* rowgate;
    __device__ __forceinline__ void operator()(const f32x4 (&acc)[2][2][4][2], const Unit& u, int wr, int wc, int fr, int fq) const {
        const int row0 = u.pm * BM + wr * 64 + fr, col0 = u.pn * BM + wc * 32 + 8 * fq;
#pragma unroll
        for (int ai = 0; ai < 2; ++ai)
#pragma unroll
            for (int m = 0; m < 4; ++m) { const int r = row0 + ai * HALF + m * 16; const float gt = rowgate[r]; bf16_t* rowp = Y + (size_t)r * 1024 + col0;
#pragma unroll
                for (int bj = 0; bj < 2; ++bj) { const f32x4 v0 = acc[ai][bj][m][0] * gt, v1 = acc[ai][bj][m][1] * gt;
                    u32x4 w; w.x = cvt_pk_bf16(v0[0], v0[1]); w.y = cvt_pk_bf16(v0[2], v0[3]); w.z = cvt_pk_bf16(v1[0], v1[1]); w.w = cvt_pk_bf16(v1[2], v1[3]);
                    *(u32x4*)(rowp + bj * HALF) = w; } }
    }
};

template <class Epi, class Sched, bool ALIGN_EPI = false, bool SP2 = false>
__device__ __forceinline__ void gemm_phase(PG8_LAS unsigned char* lds, const int K_, const Sched& S, const Epi& E) {
    const int tid = threadIdx.x, wid = __builtin_amdgcn_readfirstlane(tid >> 6), lane = tid & 63, wr = wid >> 2, wc = wid & 3, fr = lane & 15, fq = lane >> 4;
    const int K = K_, nt = K / BK;
    unsigned voffA[2], voffB[2];
#pragma unroll
    for (int i = 0; i < 2; ++i) { int R, C; stage_rc(tid * 16 + i * 8192, R, C); const int Rb = Epi::PERM ? ((R & ~31) + perm32(R & 31)) : R;
        voffA[i] = (unsigned)(R * K + C) * 2u; voffB[i] = (unsigned)(Rb * K + C) * 2u; }
    const size_t kstep = (size_t)(BK * 2);
    const size_t hstep = (size_t)HALF * K * 2;
    const unsigned ldsw = (unsigned)wid * 1024u;
    const int aoff = lds_byte(wr * 64 + fr, fq * 8), boff = lds_byte(wc * 32 + fr, fq * 8);
#define PG8_SA(b, h) (((b) * 2 + (h)) * HTB)
#define PG8_SB(b, h) ((4 + (b) * 2 + (h)) * HTB)
#define PG8_STAGE(bufoff, gbase, voff) do { _Pragma("unroll") for (int _i = 0; _i < 2; ++_i) \
        __builtin_amdgcn_global_load_lds((const unsigned*)((const char*)(gbase) + (voff)[_i]), (PG8_LAS unsigned*)(lds + (bufoff) + ldsw + _i * 8192), 16, 0, 0); } while (0)
#define PG8_LDA(dst, b, h) do { _Pragma("unroll") for (int m = 0; m < 4; ++m) _Pragma("unroll") for (int k = 0; k < 2; ++k) dst[m][k] = *(const PG8_LAS bf16x8*)(lds + PG8_SA(b, h) + aoff + m * 2048 + k * 1024); } while (0)
#define PG8_LDB(dst, b, h) do { _Pragma("unroll") for (int n = 0; n < 2; ++n) _Pragma("unroll") for (int k = 0; k < 2; ++k) dst[n][k] = *(const PG8_LAS bf16x8*)(lds + PG8_SB(b, h) + boff + n * 2048 + k * 1024); } while (0)
#define PG8_MMA(ai, bj, At, Bt) do { __builtin_amdgcn_s_setprio(1); _Pragma("unroll") for (int m = 0; m < 4; ++m) _Pragma("unroll") for (int n = 0; n < 2; ++n) _Pragma("unroll") for (int k = 0; k < 2; ++k) \
        acc[ai][bj][m][n] = __builtin_amdgcn_mfma_f32_16x16x32_bf16(Bt[n][k], At[m][k], acc[ai][bj][m][n], 0, 0, 0); __builtin_amdgcn_s_setprio(0); } while (0)
#define PG8_WAIT_V(n) asm volatile("s_waitcnt vmcnt(" #n ")" ::: "memory")
#define PG8_WAIT_L(n) asm volatile("s_waitcnt lgkmcnt(" #n ")" ::: "memory")
#define PG8_BAR __builtin_amdgcn_s_barrier()
#define PG8_SCHED __builtin_amdgcn_sched_barrier(0)
    Unit cur, nxt; int ui = 0;
    if (!S.next(0, cur)) return;
    f32x4 acc[2][2][4][2];
#pragma unroll
    for (int a = 0; a < 2; ++a)
#pragma unroll
        for (int b = 0; b < 2; ++b)
#pragma unroll
            for (int m = 0; m < 4; ++m)
#pragma unroll
                for (int n = 0; n < 2; ++n) acc[a][b][m][n] = (f32x4){0.f, 0.f, 0.f, 0.f};
    bf16x8 At[4][2], B0[2][2], B1[2][2];
    const char* cA = S.a_base(cur); const char* cB = S.b_base(cur);
    S.a_ready(cur);
    if constexpr (SP2) {
        PG8_STAGE(PG8_SB(0, 0), cB, voffB); PG8_STAGE(PG8_SB(0, 1), cB + hstep, voffB); PG8_STAGE(PG8_SA(0, 0), cA, voffA); PG8_STAGE(PG8_SA(0, 1), cA + hstep, voffA);
        if (wr == 1) PG8_BAR;
        PG8_WAIT_V(2); PG8_BAR;
        PG8_STAGE(PG8_SB(1, 0), cB + kstep, voffB); PG8_STAGE(PG8_SA(1, 0), cA + kstep, voffA); PG8_STAGE(PG8_SB(1, 1), cB + hstep + kstep, voffB);
        PG8_WAIT_V(6); PG8_BAR;
    } else {
        PG8_STAGE(PG8_SB(0, 0), cB, voffB); PG8_STAGE(PG8_SA(0, 0), cA, voffA); PG8_STAGE(PG8_SB(0, 1), cB + hstep, voffB); PG8_STAGE(PG8_SA(0, 1), cA + hstep, voffA);
        if (wr == 1) PG8_BAR;
        PG8_WAIT_V(4); PG8_BAR;
        PG8_STAGE(PG8_SB(1, 0), cB + kstep, voffB); PG8_STAGE(PG8_SA(1, 0), cA + kstep, voffA); PG8_STAGE(PG8_SB(1, 1), cB + hstep + kstep, voffB);
        PG8_WAIT_V(6); PG8_BAR;
    }
    for (;;) {
        const bool has_next = S.next(ui + 1, nxt);
        const char* nA = has_next ? S.a_base(nxt) : cA; const char* nB = has_next ? S.b_base(nxt) : cB;
        for (int t = 0; t < nt; t += 2) {
            const bool last = (t == nt - 2);
            const char* a1 = cA + (size_t)(t + 1) * kstep;
            const char* a2 = last ? nA : cA + (size_t)(t + 2) * kstep; const char* b2 = last ? nB : cB + (size_t)(t + 2) * kstep;
            const char* a3 = a2 + kstep; const char* b3 = b2 + kstep;
            if (last && has_next) S.a_ready(nxt);
            if constexpr (SP2) {
            PG8_LDB(B0, 0, 0); PG8_LDB(B1, 0, 1); PG8_SCHED; PG8_LDA(At, 0, 0); PG8_STAGE(PG8_SA(1, 1), a1 + hstep, voffA);
            PG8_WAIT_V(8); PG8_WAIT_L(0); PG8_BAR; PG8_MMA(0, 0, At, B0); PG8_MMA(0, 1, At, B1); PG8_BAR; PG8_SCHED;
            PG8_LDA(At, 0, 1); PG8_STAGE(PG8_SB(0, 0), b2, voffB); PG8_STAGE(PG8_SB(0, 1), b2 + hstep, voffB); PG8_STAGE(PG8_SA(0, 0), a2, voffA);
            PG8_WAIT_V(8); PG8_WAIT_L(0); PG8_BAR; PG8_MMA(1, 0, At, B0); PG8_MMA(1, 1, At, B1); PG8_BAR; PG8_SCHED;
            PG8_LDB(B0, 1, 0); PG8_LDB(B1, 1, 1); PG8_SCHED; PG8_LDA(At, 1, 0); PG8_STAGE(PG8_SA(0, 1), a2 + hstep, voffA);
            PG8_WAIT_V(8); PG8_WAIT_L(0); PG8_BAR; PG8_MMA(0, 0, At, B0); PG8_MMA(0, 1, At, B1); PG8_BAR; PG8_SCHED;
            PG8_LDA(At, 1, 1); PG8_STAGE(PG8_SB(1, 0), b3, voffB); PG8_STAGE(PG8_SB(1, 1), b3 + hstep, voffB); PG8_STAGE(PG8_SA(1, 0), a3, voffA);
            PG8_WAIT_V(8); PG8_WAIT_L(0); PG8_BAR; PG8_MMA(1, 0, At, B0); PG8_MMA(1, 1, At, B1); PG8_BAR; PG8_SCHED;
            } else {
            PG8_LDB(B0, 0, 0); PG8_SCHED; PG8_LDA(At, 0, 0); PG8_STAGE(PG8_SA(1, 1), a1 + hstep, voffA);
            PG8_WAIT_L(8); PG8_BAR; PG8_WAIT_L(0); PG8_MMA(0, 0, At, B0); PG8_BAR; PG8_SCHED;
            PG8_LDB(B1, 0, 1); PG8_STAGE(PG8_SB(0, 0), b2, voffB);
            PG8_BAR; PG8_WAIT_L(0); PG8_MMA(0, 1, At, B1); PG8_BAR;
            PG8_LDA(At, 0, 1); PG8_STAGE(PG8_SA(0, 0), a2, voffA);
            PG8_BAR; PG8_WAIT_L(0); PG8_MMA(1, 0, At, B0); PG8_BAR; PG8_SCHED;
            PG8_STAGE(PG8_SB(0, 1), b2 + hstep, voffB);
            PG8_WAIT_V(6); PG8_BAR; PG8_MMA(1, 1, At, B1); PG8_BAR;
            PG8_LDB(B0, 1, 0); PG8_SCHED; PG8_LDA(At, 1, 0); PG8_STAGE(PG8_SA(0, 1), a2 + hstep, voffA);
            PG8_WAIT_L(8); PG8_BAR; PG8_WAIT_L(0); PG8_MMA(0, 0, At, B0); PG8_BAR; PG8_SCHED;
            PG8_LDB(B1, 1, 1); PG8_STAGE(PG8_SB(1, 0), b3, voffB);
            PG8_BAR; PG8_WAIT_L(0); PG8_MMA(0, 1, At, B1); PG8_BAR;
            PG8_LDA(At, 1, 1); PG8_STAGE(PG8_SA(1, 0), a3, voffA);
            PG8_BAR; PG8_WAIT_L(0); PG8_MMA(1, 0, At, B0); PG8_BAR; PG8_SCHED;
            PG8_STAGE(PG8_SB(1, 1), b3 + hstep, voffB);
            PG8_WAIT_V(6); PG8_BAR; PG8_MMA(1, 1, At, B1); PG8_BAR;
            }
        }
        if constexpr (ALIGN_EPI) { if (wr == 0) PG8_BAR; }
        if constexpr (!Epi::AFTER_DRAIN) { E(acc, cur, wr, wc, fr, fq); S.done(cur); }
        if (!has_next) break;
#pragma unroll
        for (int a = 0; a < 2; ++a)
#pragma unroll
            for (int b = 0; b < 2; ++b)
#pragma unroll
                for (int m = 0; m < 4; ++m)
#pragma unroll
                    for (int n = 0; n < 2; ++n) acc[a][b][m][n] = (f32x4){0.f, 0.f, 0.f, 0.f};
        cur = nxt; cA = nA; cB = nB; ++ui;
        if constexpr (ALIGN_EPI) { if (wr == 1) PG8_BAR; }
    }
    PG8_WAIT_V(0);
    if constexpr (!ALIGN_EPI) { if (wr == 0) PG8_BAR; }
    PG8_BAR;
    if constexpr (Epi::AFTER_DRAIN) { E.fused(acc, cur, wr, wc, fr, fq, lds, wid, lane); S.done(cur); }
#undef PG8_SA
#undef PG8_SB
#undef PG8_STAGE
#undef PG8_LDA
#undef PG8_LDB
#undef PG8_MMA
#undef PG8_WAIT_V
#undef PG8_WAIT_L
#undef PG8_BAR
#undef PG8_SCHED
}
}

namespace attn_body {
using bf16=__hip_bfloat16;
using bf16x8=__attribute__((ext_vector_type(8)))short;
using s16x4=__attribute__((ext_vector_type(4)))short;
using f32x16=__attribute__((ext_vector_type(16)))float;
using u32x4=__attribute__((ext_vector_type(4)))unsigned;
constexpr int BATCH=4,SEQ=4096,D=64,QP=1024,KP=1024,VP=1024,OP=2048;
constexpr int NW=8,QBLK=32,QB=QBLK*NW,KVBLK=64,NQB=SEQ/QB;
constexpr int ATTN_UNIT_ROWS=QB;
__device__ __forceinline__ int crow(int r,int hi){return (r&3)+8*(r>>2)+4*hi;}
#define SBAR() __builtin_amdgcn_sched_barrier(0)
__device__ __forceinline__ void cmask(f32x16&p0,f32x16&p1,int jb,int qrel,int hi){
  const float NEG=-INFINITY; int kb=64*jb+4*hi;
  #pragma unroll
  for(int r=0;r<16;++r){int kv=kb+(r&3)+8*(r>>2); if(kv>qrel)p0[r]=NEG; if(kv+32>qrel)p1[r]=NEG;}
}

constexpr int NSLOT=3, SLOTB=8192;
constexpr int LDS_K=0, LDS_V=NSLOT*SLOTB, LDS_WS=2*NSLOT*SLOTB, LDS_OST=LDS_WS+NW*64*4, LDS_BYTES=LDS_OST+NW*4096;
constexpr float C2=0.125f*1.4426950408889634f;
__device__ __forceinline__ void glds16(const void*gsrc,unsigned lds_dst){unsigned keep;
  asm volatile("s_mov_b32 %0, m0\n\ts_mov_b32 m0, %2\n\ts_nop 0\n\tglobal_load_lds_dwordx4 %1, off\n\ts_mov_b32 m0, %0":"=&s"(keep):"v"(gsrc),"s"(lds_dst):"memory");}
__device__ __forceinline__ float max3f(float a,float b,float c){float r;asm("v_max3_f32 %0, %1, %2, %3":"=v"(r):"v"(a),"v"(b),"v"(c));return r;}
__device__ __forceinline__ float max2f(float a,float b){float r;asm("v_max_f32_e32 %0, %1, %2":"=v"(r):"v"(a),"v"(b));return r;}
__device__ __forceinline__ float fadd_s(float a,float b){float r;asm("v_add_f32_e32 %0, %1, %2":"=v"(r):"v"(a),"v"(b));return r;}
__device__ __forceinline__ float fsub_s(float a,float b){float r;asm("v_sub_f32_e32 %0, %1, %2":"=v"(r):"v"(a),"v"(b));return r;}
typedef float f32x2_t __attribute__((ext_vector_type(2))); typedef __bf16 bf16x2_t __attribute__((ext_vector_type(2)));
__device__ __forceinline__ unsigned cvtpk_s(float lo,float hi){f32x2_t v={lo,hi};bf16x2_t b=__builtin_convertvector(v,bf16x2_t);return __builtin_bit_cast(unsigned,b);}
#define WAIT_BAR(N) asm volatile("s_waitcnt vmcnt(" #N ") lgkmcnt(0)\n\ts_barrier":::"memory")

__device__ __forceinline__ void qkt(f32x16&p0,f32x16&p1,const char*Kslot,const bf16x8*qr,const f32x16&negm,int r32,int hi){
  const char*kb=Kslot+hi*1024+r32*16;
  #pragma unroll
  for(int d0=0;d0<4;++d0){
    const bf16x8 b0=*reinterpret_cast<const bf16x8*>(kb+d0*2048);
    const bf16x8 b1=*reinterpret_cast<const bf16x8*>(kb+d0*2048+512);
    if(d0==0){p0=__builtin_amdgcn_mfma_f32_32x32x16_bf16(b0,qr[0],negm,0,0,0);p1=__builtin_amdgcn_mfma_f32_32x32x16_bf16(b1,qr[0],negm,0,0,0);}
    else{p0=__builtin_amdgcn_mfma_f32_32x32x16_bf16(b0,qr[d0],p0,0,0,0);p1=__builtin_amdgcn_mfma_f32_32x32x16_bf16(b1,qr[d0],p1,0,0,0);}}
}
typedef __attribute__((address_space(3))) const char* lds_cptr;
typedef short v4i16_t __attribute__((ext_vector_type(4)));
__device__ __forceinline__ void kload8(bf16x8*kf,lds_cptr kp){
  kf[0]=*(const __attribute__((address_space(3))) bf16x8*)(kp);      kf[1]=*(const __attribute__((address_space(3))) bf16x8*)(kp+512);
  kf[2]=*(const __attribute__((address_space(3))) bf16x8*)(kp+2048); kf[3]=*(const __attribute__((address_space(3))) bf16x8*)(kp+2560);
  kf[4]=*(const __attribute__((address_space(3))) bf16x8*)(kp+4096); kf[5]=*(const __attribute__((address_space(3))) bf16x8*)(kp+4608);
  kf[6]=*(const __attribute__((address_space(3))) bf16x8*)(kp+6144); kf[7]=*(const __attribute__((address_space(3))) bf16x8*)(kp+6656);
}
__device__ __forceinline__ void kload2(bf16x8*kf,lds_cptr kp,int j){ kf[2*j]=*(const __attribute__((address_space(3))) bf16x8*)(kp+j*2048); kf[2*j+1]=*(const __attribute__((address_space(3))) bf16x8*)(kp+j*2048+512); }
__device__ __forceinline__ s16x4 vtr(lds_cptr p){ return __builtin_bit_cast(s16x4,__builtin_amdgcn_ds_read_tr16_b64_v4i16((__attribute__((address_space(3))) v4i16_t*)p)); }
__device__ __forceinline__ float rowmax(const f32x16&p0,const f32x16&p1){
  float a=max3f(p0[0],p0[1],p1[0]),b=max3f(p0[2],p0[3],p1[1]);a=max3f(a,p1[2],p1[3]);
  #pragma unroll
  for(int r=4;r<16;r+=4){a=max3f(a,p0[r],p0[r+1]);b=max3f(b,p0[r+2],p0[r+3]);a=max3f(a,p1[r],p1[r+1]);b=max3f(b,p1[r+2],p1[r+3]);}
  const float m=max2f(a,b);
  auto rr=__builtin_amdgcn_permlane32_swap(__float_as_uint(m),__float_as_uint(m),false,false);
  return max2f(__uint_as_float(rr[0]),__uint_as_float(rr[1]));
}
__device__ __forceinline__ void pv(f32x16*o,int vb,bf16x8 pa0,bf16x8 pa1,bf16x8 pa2,bf16x8 pa3){
  #pragma unroll
  for(int d0=0;d0<2;++d0){s16x4 lo[4],hi[4];
    #pragma unroll
    for(int ks=0;ks<4;++ks){
      asm volatile("ds_read_b64_tr_b16 %0,%1 offset:%c2":"=&v"(lo[ks]):"v"(vb),"i"(d0*4096+ks*1024):"memory");
      asm volatile("ds_read_b64_tr_b16 %0,%1 offset:%c2":"=&v"(hi[ks]):"v"(vb),"i"(d0*4096+ks*1024+512):"memory");}
    asm volatile("s_waitcnt lgkmcnt(0)":::"memory");SBAR();
    #define PK(k) (bf16x8){lo[k][0],lo[k][1],lo[k][2],lo[k][3],hi[k][0],hi[k][1],hi[k][2],hi[k][3]}
    o[d0]=__builtin_amdgcn_mfma_f32_32x32x16_bf16(pa0,PK(0),o[d0],0,0,0);
    o[d0]=__builtin_amdgcn_mfma_f32_32x32x16_bf16(pa1,PK(1),o[d0],0,0,0);
    o[d0]=__builtin_amdgcn_mfma_f32_32x32x16_bf16(pa2,PK(2),o[d0],0,0,0);
    o[d0]=__builtin_amdgcn_mfma_f32_32x32x16_bf16(pa3,PK(3),o[d0],0,0,0);
    #undef PK
  }
}

#ifndef ATTN_STORE16
#define ATTN_STORE16(p,v) (*(u32x4*)(p)=(v))
#endif
template<int THRL> __device__ __forceinline__ void attn_unit(int b,int qb,const bf16*Q,const bf16*__restrict__ K,const bf16*__restrict__ V,bf16*O,char*shm){
  const int tid=threadIdx.x,lane=tid&63,r32=lane&31,hi=lane>>5; const int wid=__builtin_amdgcn_readfirstlane(tid>>6);
  const long rowbase=(long)b*SEQ; const int q0=qb*QB;
  const bf16*Qw=Q+(rowbase+q0+wid*QBLK)*QP;
  const bf16*Kh=K+rowbase*KP,*Vh=V+rowbase*VP;
  const unsigned lds0=(unsigned)(uintptr_t)shm;
  float*wsf=(float*)(shm+LDS_WS)+wid*64;
  const bf16*ksrc=Kh+(long)lane*KP+wid*8;
  const bf16*vsrc=Vh+(long)(16*(wid&3)+(lane>>2))*VP+(wid>>2)*32+(lane&3)*8;
  const unsigned kdst=lds0+LDS_K+wid*1024, vdst=lds0+LDS_V+wid*1024;
  #define DMA_K(t,slot) glds16(ksrc+(long)(t)*KVBLK*KP,(unsigned)__builtin_amdgcn_readfirstlane(kdst+(slot)))
  #define DMA_V(t,slot) glds16(vsrc+(long)(t)*KVBLK*VP,(unsigned)__builtin_amdgcn_readfirstlane(vdst+(slot)))
  const int vb0=(int)(lds0+LDS_V)+((lane>>4)&1)*32+(lane&3)*8+(4*hi+((lane&15)>>2))*64;
  const char*Kbase=shm+LDS_K; bf16x8 kf[8];
  const lds_cptr shm3=(lds_cptr)shm; const lds_cptr kp0=shm3+LDS_K+hi*1024+r32*16; const lds_cptr vp0=shm3+LDS_V+((lane>>4)&1)*32+(lane&3)*8+(4*hi+((lane&15)>>2))*64;
  const int NT=(q0+QB)/KVBLK;
  DMA_K(0,0);DMA_V(0,0);DMA_K(1,SLOTB);
  bf16x8 qr[4];
  #pragma unroll
  for(int d0=0;d0<4;++d0)qr[d0]=*reinterpret_cast<const bf16x8*>(&Qw[(long)r32*QP+d0*16+hi*8]);
  float mhat=0.f,l_reg=0.f;f32x16 o[2];o[0]=f32x16{};o[1]=f32x16{};f32x16 negm=f32x16{};asm volatile("":"+v"(negm));
  const int qrel=wid*QBLK+r32;
  #define CMASK(P0,P1,t) do{int jb_=(t)-(NT-4); if(jb_>=0)cmask(P0,P1,jb_,qrel,hi);}while(0)
  bool resc=false;
  #define START(P0,P1) do{ const float rm=rowmax(P0,P1); resc=false; \
    { const float dl=rm; mhat=fadd_s(mhat,dl); \
      _Pragma("unroll") for(int r=0;r<16;++r){P0[r]=fsub_s(P0[r],dl);P1[r]=fsub_s(P1[r],dl);} \
      _Pragma("unroll") for(int r=0;r<16;++r)negm[r]=-mhat; asm volatile("":"+v"(negm)); } \
    _Pragma("unroll") for(int r=0;r<16;++r)P0[r]=__builtin_amdgcn_exp2f(P0[r]); }while(0)
  #define RESC() do{ if(resc){ asm volatile("s_waitcnt lgkmcnt(0)":::"memory"); \
      _Pragma("unroll") for(int d_=0;d_<2;++d_) _Pragma("unroll") for(int r=0;r<16;++r)o[d_][r]*=wsf[crow(r,hi)]; } }while(0)
  f32x16 pA0,pA1,pB0,pB1;
  int sl_prev=0,sl_cur=0,sl_next=SLOTB;
  #define ROT() do{sl_prev=sl_cur;sl_cur=sl_next;sl_next=(sl_next==(NSLOT-1)*SLOTB)?0:sl_next+SLOTB;}while(0)
  DMA_K(2,2*SLOTB);
  WAIT_BAR(3);
  qkt(pA0,pA1,Kbase,qr,negm,r32,hi);asm volatile("s_nop 15\n\ts_nop 7":"+v"(pA0),"+v"(pA1));CMASK(pA0,pA1,0);
  START(pA0,pA1);
  _Pragma("unroll") for(int r=0;r<16;++r)pA1[r]=__builtin_amdgcn_exp2f(pA1[r]);
  WAIT_BAR(0);
  DMA_K(3,0);DMA_V(1,SLOTB);
  ROT();
  kload8(kf,kp0+sl_cur);
  WAIT_BAR(2);
  s16x4 vlo[8],vhi[8]; u32x4 pw0,pw1,pw2,pw3;
  #define PKW(P,B) cvtpk_s(P[B],P[B+1])
  #define PAF(k) __builtin_bit_cast(bf16x8,pw##k)
  #define VFR(i) (bf16x8){vlo[i][0],vlo[i][1],vlo[i][2],vlo[i][3],vhi[i][0],vhi[i][1],vhi[i][2],vhi[i][3]}
  #define PIN(x) asm volatile("":"+v"(x))
  #define MX3(a,b,c) __builtin_fmaxf(__builtin_fmaxf((a),(b)),(c))
  #define GAPA(MF,A0,A1,A2,A3,W0,W1,PW) do{ MF; sacc+=A0; sacc+=A1; sacc+=A2; sacc+=A3; PIN(sacc); W0; W1; PIN(PW); SBAR(); }while(0)
  #define EX(v) __builtin_amdgcn_exp2f(v)
  #define GAPB(MF,X,B) do{ MF; X[B]=EX(X[B]); X[B+1]=EX(X[B+1]); X[B+2]=EX(X[B+2]); X[B+3]=EX(X[B+3]); PIN(X); SBAR(); }while(0)
  #define VRD(i) do{ vlo[i]=vtr(vp_+(((i)>>2)*4096+((i)&3)*1024)); vhi[i]=vtr(vp_+(((i)>>2)*4096+((i)&3)*1024+512)); }while(0)
  #define KRD(G,j) do{ if(G){ kload2(kf,kp0+sl_next,j); SBAR(); } }while(0)
  #define STEP(C0,C1,P0,P1,t,GK,GV,GL) do{ SBAR(); \
    const lds_cptr vp_=vp0+sl_prev; \
    VRD(0); SBAR(); float sacc=(P0[0]+P0[1]); \
    GAPA(C0=__builtin_amdgcn_mfma_f32_32x32x16_bf16(kf[0],qr[0],negm,0,0,0), P0[2],P0[3],P0[4],P0[5],     pw0[0]=PKW(P0,0), pw0[1]=PKW(P0,2), pw0); \
    VRD(4); SBAR(); GAPA(C1=__builtin_amdgcn_mfma_f32_32x32x16_bf16(kf[1],qr[0],negm,0,0,0), P0[6],P0[7],P0[8],P0[9],     pw0[2]=PKW(P0,4), pw0[3]=PKW(P0,6), pw0); \
    VRD(1); SBAR(); GAPA(C0=__builtin_amdgcn_mfma_f32_32x32x16_bf16(kf[2],qr[1],C0,0,0,0),   P0[10],P0[11],P0[12],P0[13], pw1[0]=PKW(P0,8), pw1[1]=PKW(P0,10), pw1); \
    VRD(5); SBAR(); GAPA(C1=__builtin_amdgcn_mfma_f32_32x32x16_bf16(kf[3],qr[1],C1,0,0,0),   P0[14],P0[15],P1[0],P1[1],   pw1[2]=PKW(P0,12),pw1[3]=PKW(P0,14), pw1); \
    VRD(2); SBAR(); GAPA(C0=__builtin_amdgcn_mfma_f32_32x32x16_bf16(kf[4],qr[2],C0,0,0,0),   P1[2],P1[3],P1[4],P1[5],     pw2[0]=PKW(P1,0), pw2[1]=PKW(P1,2), pw2); \
    VRD(6); SBAR(); GAPA(C1=__builtin_amdgcn_mfma_f32_32x32x16_bf16(kf[5],qr[2],C1,0,0,0),   P1[6],P1[7],P1[8],P1[9],     pw2[2]=PKW(P1,4), pw2[3]=PKW(P1,6), pw2); \
    VRD(3); SBAR(); GAPA(C0=__builtin_amdgcn_mfma_f32_32x32x16_bf16(kf[6],qr[3],C0,0,0,0),   P1[10],P1[11],P1[12],P1[13], pw3[0]=PKW(P1,8), pw3[1]=PKW(P1,10), pw3); \
    VRD(7); SBAR(); GAPA(C1=__builtin_amdgcn_mfma_f32_32x32x16_bf16(kf[7],qr[3],C1,0,0,0),   P1[14],P1[15],0.f,0.f,       pw3[2]=PKW(P1,12),pw3[3]=PKW(P1,14), pw3); \
    l_reg+=sacc; \
    if(GK){DMA_K((t)+3,sl_cur);} if(GV){DMA_V((t)+1,sl_next);} \
    CMASK(C0,C1,t); \
    { float a=MX3(C0[0],C0[1],C1[0]),b=MX3(C0[2],C0[3],C1[1]); a=MX3(a,C1[2],C1[3]); \
      _Pragma("unroll") for(int r=4;r<16;r+=4){a=MX3(a,C0[r],C0[r+1]);b=MX3(b,C0[r+2],C0[r+3]);a=MX3(a,C1[r],C1[r+1]);b=MX3(b,C1[r+2],C1[r+3]);} \
      float rm=__builtin_fmaxf(a,b); { auto rr=__builtin_amdgcn_permlane32_swap(__float_as_uint(rm),__float_as_uint(rm),false,false); rm=__builtin_fmaxf(__uint_as_float(rr[0]),__uint_as_float(rr[1])); } \
      resc=false; \
      if(__builtin_expect(__any(rm>(float)THRL),0)){ const float dl=__builtin_fmaxf(rm,0.f); mhat+=dl; \
        _Pragma("unroll") for(int r=0;r<16;++r){C0[r]-=dl;C1[r]-=dl;} \
        _Pragma("unroll") for(int r=0;r<16;++r)negm[r]=-mhat; asm volatile("":"+v"(negm)); \
        const float f=__builtin_amdgcn_exp2f(-dl); l_reg*=f; if(hi==0)wsf[r32]=f; resc=true; } } \
    SBAR(); \
    GAPB(o[0]=__builtin_amdgcn_mfma_f32_32x32x16_bf16(PAF(0),VFR(0),o[0],0,0,0), C0,0); \
    GAPB(o[1]=__builtin_amdgcn_mfma_f32_32x32x16_bf16(PAF(0),VFR(4),o[1],0,0,0), C0,4); \
    KRD(GL,0); GAPB(o[0]=__builtin_amdgcn_mfma_f32_32x32x16_bf16(PAF(1),VFR(1),o[0],0,0,0), C0,8); \
    KRD(GL,1); GAPB(o[1]=__builtin_amdgcn_mfma_f32_32x32x16_bf16(PAF(1),VFR(5),o[1],0,0,0), C0,12); \
    KRD(GL,2); GAPB(o[0]=__builtin_amdgcn_mfma_f32_32x32x16_bf16(PAF(2),VFR(2),o[0],0,0,0), C1,0); \
    KRD(GL,3); GAPB(o[1]=__builtin_amdgcn_mfma_f32_32x32x16_bf16(PAF(2),VFR(6),o[1],0,0,0), C1,4); \
    GAPB(o[0]=__builtin_amdgcn_mfma_f32_32x32x16_bf16(PAF(3),VFR(3),o[0],0,0,0), C1,8); \
    GAPB(o[1]=__builtin_amdgcn_mfma_f32_32x32x16_bf16(PAF(3),VFR(7),o[1],0,0,0), C1,12); \
    }while(0)
  int t=1;
  #undef CMASK
  #define CMASK(P0,P1,t) do{}while(0)
  for(;t+5<NT;t+=2){
    STEP(pB0,pB1,pA0,pA1,t,true,true,true);     WAIT_BAR(2); RESC(); ROT();
    STEP(pA0,pA1,pB0,pB1,t+1,true,true,true);   WAIT_BAR(2); RESC(); ROT();
  }
  #undef CMASK
  #define CMASK(P0,P1,t) do{int jb_=(t)-(NT-4); if(jb_>=0)cmask(P0,P1,jb_,qrel,hi);}while(0)
  #define ENDW(tt) do{ if((tt)+3<NT){WAIT_BAR(2);} else if((tt)+2<NT){WAIT_BAR(1);} else {WAIT_BAR(0);} }while(0)
  for(;t+1<NT;t+=2){
    STEP(pB0,pB1,pA0,pA1,t,(t+3<NT),(t+1<NT),(t+1<NT));       ENDW(t);   RESC(); ROT();
    STEP(pA0,pA1,pB0,pB1,t+1,(t+4<NT),(t+2<NT),(t+2<NT));     ENDW(t+1); RESC(); ROT();
  }
  STEP(pB0,pB1,pA0,pA1,NT-1,false,false,false); RESC();
  { float sacc=pB0[0]+pB0[1]; _Pragma("unroll") for(int r=2;r<16;++r)sacc+=pB0[r]; _Pragma("unroll") for(int r=0;r<16;++r)sacc+=pB1[r]; l_reg+=sacc;
    pw0=(u32x4){PKW(pB0,0),PKW(pB0,2),PKW(pB0,4),PKW(pB0,6)};pw1=(u32x4){PKW(pB0,8),PKW(pB0,10),PKW(pB0,12),PKW(pB0,14)};pw2=(u32x4){PKW(pB1,0),PKW(pB1,2),PKW(pB1,4),PKW(pB1,6)};pw3=(u32x4){PKW(pB1,8),PKW(pB1,10),PKW(pB1,12),PKW(pB1,14)};
    SBAR(); pv(o,vb0+sl_cur,PAF(0),PAF(1),PAF(2),PAF(3)); }
  #undef PKW
  #undef PAF
  #undef VFR
  #undef PIN
  #undef MX3
  #undef GAPA
  #undef GAPB
  #undef EX
  #undef VRD
  #undef KRD
  #undef STEP
  #undef ENDW
  {auto rr=__builtin_amdgcn_permlane32_swap(__float_as_uint(l_reg),__float_as_uint(l_reg),false,false);l_reg=__uint_as_float(rr[0])+__uint_as_float(rr[1]);}
  if(hi==0)wsf[32+r32]=l_reg;asm volatile("s_waitcnt lgkmcnt(0)":::"memory");
  float rli[16];
  #pragma unroll
  for(int r=0;r<16;++r)rli[r]=__builtin_amdgcn_rcpf(wsf[32+crow(r,hi)]);
  bf16*Ow=O+(rowbase+q0+wid*QBLK)*OP;
  { bf16*stg=(bf16*)(shm+LDS_OST)+wid*2048;
    #pragma unroll
    for(int r=0;r<16;++r){const int orow=crow(r,hi);
      #pragma unroll
      for(int d0=0;d0<2;++d0)stg[orow*64+d0*32+r32]=__float2bfloat16(o[d0][r]*rli[r]);}
    asm volatile("s_waitcnt lgkmcnt(0)":::"memory");
    #pragma unroll
    for(int i=0;i<4;++i){const int row=i*8+(lane>>3),ch=lane&7; const u32x4 v=*(const u32x4*)(stg+row*64+ch*8); ATTN_STORE16(Ow+(long)row*OP+ch*8,v);} }
  asm volatile("s_waitcnt lgkmcnt(0)\n\ts_barrier":::"memory");
  #undef DMA_K
  #undef DMA_V
  #undef CMASK
  #undef START
  #undef RESC
  #undef ROT
}
constexpr int ATTN_LDS_BYTES=LDS_BYTES;
struct AttnUnit { int bh; int qb; };
#undef SBAR
#undef WAIT_BAR
}

constexpr int NWAVES = 8;
constexpr int BATCH = 4, T = 4096, D = 1024, M = BATCH * T;
constexpr int NE = 32, FF = 512, NGRP = 4, EPG = 8;
constexpr int MAXROWS = 40960;
constexpr float RMS_EPS = 1e-6f, GN_EPS = 64e-5f, SUBLN_EPS = 1e-5f;
constexpr float LAMBDA_INIT1 = 0.35550906759f;

constexpr size_t MiB = 1u << 20;
constexpr size_t WS_CTL = 0, CTL_ZERO_BYTES = 1 * MiB;
constexpr size_t WS_MOD = 1 * MiB;
constexpr size_t WS_WRKV = 2 * MiB, WS_WL1 = 8 * MiB, WS_WL2 = 9 * MiB, WS_WO0 = 11 * MiB, WS_WQKV = 13 * MiB, WS_WO1 = 19 * MiB;
constexpr size_t WS_ROUTE = 21 * MiB;
constexpr size_t WS_MOEGU = 32 * MiB, WS_MOED = 96 * MiB;
constexpr size_t WS_XA = 128 * MiB;
constexpr size_t WS_R = 192 * MiB;
constexpr size_t WS_VIEWS = WS_R, WS_H2 = WS_R + 96 * MiB, WS_A2 = WS_R + 160 * MiB, WS_RKV = WS_R + 168 * MiB;
constexpr size_t WS_LOGW = WS_R, WS_ASIG = WS_R + 64 * MiB, WS_GG = WS_R + 96 * MiB, WS_YG = WS_R + 128 * MiB;
constexpr size_t WS_H2N = WS_R, WS_XS = WS_R + 32 * MiB, WS_HS = WS_R + 112 * MiB, WS_Y = WS_R + 152 * MiB;
constexpr size_t WS_HQ = WS_R, WS_HK = WS_R + 32 * MiB, WS_QKV = WS_R + 64 * MiB, WS_OC = WS_R + 160 * MiB, WS_ON = WS_R + 224 * MiB;
constexpr size_t WS_END = WS_R + 264 * MiB;
static_assert(WS_RKV + 96 * MiB <= WS_END && WS_Y + 80 * MiB <= WS_END && WS_ON + 32 * MiB <= WS_END, "d_ws map");
constexpr int CW_BAR = 4096;
constexpr int CW_CNT = 8192;

constexpr int RING_OFF = 0, RING_BYTES = 131072;
constexpr int LDSCTL_OFF = RING_BYTES, MISC_OFF = LDSCTL_OFF + 320;
constexpr int LDS_BYTES = 147456;

#define GAS __attribute__((address_space(1)))
#define LAS __attribute__((address_space(3)))
typedef unsigned short bf16;
typedef unsigned v4u __attribute__((ext_vector_type(4)));
typedef unsigned v2u __attribute__((ext_vector_type(2)));
typedef float f32x4 __attribute__((ext_vector_type(4)));
typedef short bf16x8 __attribute__((ext_vector_type(8)));
typedef GAS unsigned gu32;
#define RLX_AGENT __ATOMIC_RELAXED, __HIP_MEMORY_SCOPE_AGENT
#define LDS_WAIT() asm volatile("s_waitcnt lgkmcnt(0)" ::: "memory")
#define VM_WAIT() asm volatile("s_waitcnt vmcnt(0)" ::: "memory")
__device__ __forceinline__ unsigned pk2(float lo, float hi) { return pg8::cvt_pk_bf16(lo, hi); }
__device__ __forceinline__ float bflo(unsigned w) { return __uint_as_float(w << 16); }
__device__ __forceinline__ float bfhi(unsigned w) { return __uint_as_float(w & 0xffff0000u); }

#define XB_TMO      128
#define XB_XCNT(j)  (256  + 64 * (j))
#define XB_XSUB(j)  (1280 + 64 * (j))
#define XB_XGEN(j)  (2304 + 64 * (j))
#define XB_TOP      3328
#define XB_TOPGEN   3392
#define XCD_BAR_WORDS 3456
#define XB_SPIN_CAP (1u << 18)

__device__ __forceinline__ unsigned xb_ld(unsigned* p)              { return __hip_atomic_load(p, __ATOMIC_RELAXED, __HIP_MEMORY_SCOPE_AGENT); }
__device__ __forceinline__ unsigned xb_add(unsigned* p, unsigned v) { return __hip_atomic_fetch_add(p, v, __ATOMIC_RELAXED, __HIP_MEMORY_SCOPE_AGENT); }
__device__ __forceinline__ unsigned xb_xcc_id() { return (unsigned)__builtin_amdgcn_s_getreg((3 << 11) | 20) & 0xFu; }
#define XB_SPIN(cond, bar) do { unsigned _sp = 0; while (cond) { __builtin_amdgcn_s_sleep(1); \
    if ((++_sp & 255u) == 0u) { if (xb_ld(&(bar)[XB_TMO])) break; if (_sp > XB_SPIN_CAP) { atomicAdd(&(bar)[XB_TMO], 1u); break; } } } } while (0)

struct XcdBarrier {
    unsigned* bar; unsigned x;
    volatile LAS unsigned* st;
};

__device__ __forceinline__ XcdBarrier xcd_barrier_post(unsigned* bar, volatile LAS unsigned* st) {
    XcdBarrier b; b.bar = bar; b.x = xb_xcc_id(); b.st = st;
    if (threadIdx.x == 0) (void)xb_add(&bar[XB_XCNT(b.x)], 1u);
    return b;
}
__device__ __forceinline__ void xcd_barrier_complete(unsigned* bar, unsigned x, unsigned& nloc, unsigned& nx) {
    const unsigned G = gridDim.x * gridDim.y * gridDim.z;
    unsigned sum, cnt, mine, sp = 0u;
    for (;;) {
        sum = 0u; cnt = 0u; mine = 0u;
#pragma unroll
        for (unsigned j = 0; j < 16; ++j) { const unsigned c = xb_ld(&bar[XB_XCNT(j)]); sum += c; cnt += (c > 0u) ? 1u : 0u; mine = (j == x) ? c : mine; }
        if (sum == G) break;
        __builtin_amdgcn_s_sleep(1);
        if ((++sp & 255u) == 0u) { if (xb_ld(&bar[XB_TMO])) break; if (sp > XB_SPIN_CAP) { atomicAdd(&bar[XB_TMO], 1u); break; } }
    }
    nloc = mine > 0u ? mine : 1u; nx = cnt > 0u ? cnt : 1u;
}

__device__ __forceinline__ void xcd_barrier(const XcdBarrier& b) {
    asm volatile("s_waitcnt vmcnt(0)" ::: "memory");
    __syncthreads();
    if (threadIdx.x == 0) {
        unsigned* bar = b.bar;
        __builtin_amdgcn_s_waitcnt(0);
        unsigned nloc = b.st[0], nx = b.st[1];
        if (nloc == 0u) { xcd_barrier_complete(bar, b.x, nloc, nx); b.st[0] = nloc; b.st[1] = nx; }
        const unsigned old = xb_add(&bar[XB_XSUB(b.x)], 1u);
        const unsigned gen = old / nloc;
        if (old + 1u == (gen + 1u) * nloc) {
            __builtin_amdgcn_fence(__ATOMIC_RELEASE, "agent");
            asm volatile("s_waitcnt vmcnt(0)" ::: "memory");
            const unsigned og = xb_add(&bar[XB_TOP], 1u);
            const unsigned tg = og / nx;
            if (og + 1u == (tg + 1u) * nx) xb_add(&bar[XB_TOPGEN], 1u);
            else XB_SPIN(xb_ld(&bar[XB_TOPGEN]) == tg, bar);
            __builtin_amdgcn_fence(__ATOMIC_ACQUIRE, "agent");
            xb_add(&bar[XB_XGEN(b.x)], 1u);
            asm volatile("s_waitcnt vmcnt(0)" ::: "memory");
        } else {
            XB_SPIN(xb_ld(&bar[XB_XGEN(b.x)]) == gen, bar);
            __builtin_amdgcn_fence(__ATOMIC_ACQUIRE, "agent");
            asm volatile("s_waitcnt vmcnt(0)" ::: "memory");
        }
    }
    __syncthreads();
}


struct Frame {
    LAS unsigned char* lds;
    volatile LAS unsigned* MISC;
    gu32* ctl;
    unsigned char* ws;
    const float* const* in;
    float* out;
    int tid, lane, wave, vcu, G;
};
__device__ __forceinline__ int lane_id() { int l = threadIdx.x & 63; asm volatile("" : "+v"(l)); return l; }
__device__ __forceinline__ float wave_sum(float v) {
#pragma unroll
    for (int o = 1; o < 64; o <<= 1) v += __shfl_xor(v, o);
    return v;
}
__device__ __forceinline__ void transpose_item(const float* W, int ldw, int k0, int n0, bf16* WT, int ldo, int orow0, int ok0, const float* kscale, LAS float* scr, int lane) {
#pragma unroll 8
    for (int i = 0; i < 32; ++i) { const int kk = 2 * i + (lane >> 5); float v = W[(size_t)(k0 + kk) * ldw + n0 + (lane & 31)]; if (kscale) v *= kscale[k0 + kk]; scr[kk * 33 + (lane & 31)] = v; }
    LDS_WAIT(); asm volatile("" ::: "memory");
    const int c = lane & 7;
#pragma unroll
    for (int j = 0; j < 4; ++j) { const int n = (lane >> 3) + 8 * j; const LAS float* s = scr + (8 * c) * 33 + n;
        v4u o; o.x = pk2(s[0 * 33], s[1 * 33]); o.y = pk2(s[2 * 33], s[3 * 33]); o.z = pk2(s[4 * 33], s[5 * 33]); o.w = pk2(s[6 * 33], s[7 * 33]);
        *(GAS v4u*)(WT + (size_t)(orow0 + n) * ldo + ok0 + k0 + 8 * c) = o; }
    LDS_WAIT(); asm volatile("" ::: "memory");
}
__device__ __forceinline__ void transpose_mat(Frame& F, const float* W, int K, int N, bf16* WT, int ldo, int row_off, int ok0, const float* kscale, int gw, int NGW) {
    LAS float* scr = (LAS float*)(F.lds + RING_OFF + F.wave * 16384);
    const int nblk = N / 32, items = (K / 64) * nblk;
    for (int it = gw; it < items; it += NGW) { const int kb = it / nblk, nb = it % nblk; transpose_item(W, N, 64 * kb, 32 * nb, WT, ldo, row_off + 32 * nb, ok0, kscale, scr, F.lane); }
}

__device__ __forceinline__ void p0_mod(Frame& F) {
    LAS float* cact = (LAS float*)(F.lds + RING_OFF);
    LAS float* red = cact + 4096;
    const float* c = F.in[1];
    for (int i = F.tid; i < 4096; i += 512) { const float v = c[i]; cact[i] = v / (1.0f + __expf(-v)); }
    __syncthreads();
    float* modbase = (float*)(F.ws + WS_MOD);
    for (int it = blockIdx.x; it < 224; it += F.G) {
        const float* W; const float* bias; float* outp; int N, cc;
        if (it < 96) { W = F.in[2]; bias = F.in[3]; outp = modbase; N = 6144; cc = it; }
        else if (it < 192) { W = F.in[2] + (size_t)1024 * 6144; bias = F.in[3] + 6144; outp = modbase + 4 * 6144; N = 6144; cc = it - 96; }
        else { W = F.in[22]; bias = F.in[23]; outp = modbase + 8 * 6144; N = 2048; cc = it - 192; }
        const int kg = F.tid >> 4, cq = F.tid & 15, col = cc * 64 + cq * 4;
        f32x4 a0 = {0, 0, 0, 0}, a1 = a0, a2 = a0, a3 = a0;
#pragma unroll 4
        for (int kk = 0; kk < 32; ++kk) { const int k = kg * 32 + kk; const f32x4 w = *(const f32x4*)(W + (size_t)k * N + col);
            a0 += w * cact[k]; a1 += w * cact[1024 + k]; a2 += w * cact[2048 + k]; a3 += w * cact[3072 + k]; }
        LAS f32x4* rp = (LAS f32x4*)red + (kg * 16 + cq) * 4;
        rp[0] = a0; rp[1] = a1; rp[2] = a2; rp[3] = a3;
        __syncthreads();
        if (F.tid < 256) { const int b = F.tid >> 6, cl = F.tid & 63, cq2 = cl >> 2, j = cl & 3; float s = 0.f;
            for (int g = 0; g < 32; ++g) s += red[((g * 16 + cq2) * 4 + b) * 4 + j];
            outp[(size_t)b * N + cc * 64 + cl] = s + bias[cc * 64 + cl]; }
        __syncthreads();
    }
}
__device__ __forceinline__ void p0_weights(Frame& F) {
    const int gw = F.vcu * NWAVES + F.wave, NGW = F.G * NWAVES;
    bf16* Wrkv = (bf16*)(F.ws + WS_WRKV); bf16* Wl1 = (bf16*)(F.ws + WS_WL1); bf16* Wl2 = (bf16*)(F.ws + WS_WL2);
    bf16* Wo0 = (bf16*)(F.ws + WS_WO0); bf16* Wqkv = (bf16*)(F.ws + WS_WQKV); bf16* Wo1 = (bf16*)(F.ws + WS_WO1);
    for (int z = 0; z < 3; ++z) transpose_mat(F, F.in[7] + (size_t)z * D * D, D, D, Wrkv + (size_t)z * D * D, D, 0, 0, nullptr, gw, NGW);
    transpose_mat(F, F.in[21], D, D, Wo0, D, 0, 0, nullptr, gw, NGW);
    transpose_mat(F, F.in[26], D, D, Wqkv, D, 0, 0, nullptr, gw, NGW);
    transpose_mat(F, F.in[25], D, 2 * D, Wqkv, D, D, 0, nullptr, gw, NGW);
    transpose_mat(F, F.in[32], D, D, Wo1, D, 0, 0, nullptr, gw, NGW);
    const float* mu = F.in[6];
    transpose_mat(F, F.in[9], D, 64, Wl1, 2048, 0, 0, nullptr, gw, NGW);    transpose_mat(F, F.in[9], D, 64, Wl1, 2048, 0, 1024, mu + 3 * D, gw, NGW);
    transpose_mat(F, F.in[12], D, 64, Wl1, 2048, 64, 0, nullptr, gw, NGW);  transpose_mat(F, F.in[12], D, 64, Wl1, 2048, 64, 1024, mu + 4 * D, gw, NGW);
    transpose_mat(F, F.in[14], D, 128, Wl1, 2048, 128, 0, nullptr, gw, NGW); transpose_mat(F, F.in[14], D, 128, Wl1, 2048, 128, 1024, mu + 5 * D, gw, NGW);
    const float* w2 = F.in[10]; const float* a2 = F.in[13]; const float* g2 = F.in[15];
    for (int idx = (blockIdx.x * 512 + F.tid); idx < 3072 * 256; idx += F.G * 512) {
        const int k = idx / 3072, n = idx % 3072; float v = 0.f;
        if (n < 1024) { if (k < 64) v = w2[(size_t)k * 1024 + n]; }
        else if (n < 2048) { if (k >= 64 && k < 128) v = a2[(size_t)(k - 64) * 1024 + (n - 1024)]; }
        else { if (k >= 128) v = g2[(size_t)(k - 128) * 1024 + (n - 2048)]; }
        Wl2[(size_t)n * 256 + k] = (bf16)(pk2(v, 0.f) & 0xffffu);
    }
}
__device__ __forceinline__ void moe_weights(Frame& F, int l) {
    const int gw = F.vcu * NWAVES + F.wave, NGW = F.G * NWAVES;
    LAS float* scr = (LAS float*)(F.lds + RING_OFF + F.wave * 16384);
    bf16* GU = (bf16*)(F.ws + WS_MOEGU); bf16* DW = (bf16*)(F.ws + WS_MOED);
    const float* wg = F.in[35] + (size_t)l * NE * D * FF; const float* wu = F.in[36] + (size_t)l * NE * D * FF; const float* wd = F.in[37] + (size_t)l * NE * FF * D;
    for (int it = gw; it < NE * 768; it += NGW) {
        const int e = it / 768, r = it % 768;
        if (r < 512) { const int up = r >> 8, q = r & 255, kb = q >> 4, nb = q & 15, n0 = 32 * nb;
            const float* W = (up ? wu : wg) + (size_t)e * D * FF;
            transpose_item(W, FF, 64 * kb, n0, GU + (size_t)e * 1024 * 1024, 1024, 256 * (n0 >> 7) + (n0 & 127) + (up ? 128 : 0), 0, nullptr, scr, F.lane); }
        else { const int q = r - 512, kb = q >> 5, nb = q & 31;
            transpose_item(wd + (size_t)e * FF * D, D, 64 * kb, 32 * nb, DW + (size_t)e * 1024 * 512, 512, 32 * nb, 0, nullptr, scr, F.lane); }
    }
}

__device__ __forceinline__ void p1_norm_views(Frame& F) {
    LAS float* hrow = (LAS float*)(F.lds + RING_OFF);
    const float* x = F.in[0]; const float* g = F.in[4]; const float* mu = F.in[6];
    const float* mod = (const float*)(F.ws + WS_MOD);
    bf16* views = (bf16*)(F.ws + WS_VIEWS); bf16* H2 = (bf16*)(F.ws + WS_H2);
    for (int grp = blockIdx.x; grp < M / 8; grp += F.G) {
        const int m0 = grp * 8, b = m0 / T, t0 = m0 % T;
        const float* sh = mod + (size_t)b * 6144; const float* sc = sh + 1024;
        f32x4 hv[4];
        for (int pass = 0; pass < 2; ++pass) {
            if (pass == 1 && F.wave != 0) break;
            const int row = (pass == 0) ? (m0 + F.wave) : (m0 - 1);
            f32x4 v[4];
            if (pass == 1 && t0 == 0) {
#pragma unroll
                for (int j = 0; j < 4; ++j) v[j] = (f32x4){0.f, 0.f, 0.f, 0.f};
            } else {
                const f32x4* xr = (const f32x4*)(x + (size_t)row * D) + F.lane; float ss = 0.f;
#pragma unroll
                for (int j = 0; j < 4; ++j) { v[j] = xr[64 * j]; ss += (v[j].x * v[j].x + v[j].y * v[j].y) + (v[j].z * v[j].z + v[j].w * v[j].w); }
                const float rstd = 1.0f / sqrtf(wave_sum(ss) * (1.f / D) + RMS_EPS);
#pragma unroll
                for (int j = 0; j < 4; ++j) { const int c = 4 * F.lane + 256 * j; const f32x4 gg = *(const f32x4*)(g + c), s1 = *(const f32x4*)(sc + c), s0 = *(const f32x4*)(sh + c);
                    v[j] = v[j] * rstd * gg * (s1 + 1.0f) + s0; }
            }
            LAS f32x4* hp = (LAS f32x4*)(hrow + ((pass == 0) ? (F.wave + 1) : 0) * 1024) + F.lane;
#pragma unroll
            for (int j = 0; j < 4; ++j) { hp[64 * j] = v[j]; if (pass == 0) hv[j] = v[j]; }
        }
        __syncthreads();
        {
            const int row = m0 + F.wave;
            const LAS f32x4* pp = (const LAS f32x4*)(hrow + F.wave * 1024) + F.lane;
#pragma unroll
            for (int j = 0; j < 4; ++j) { const int c = 4 * F.lane + 256 * j; const f32x4 xx = pp[64 * j] - hv[j];
#pragma unroll
                for (int i = 0; i < 3; ++i) { const f32x4 mm = *(const f32x4*)(mu + i * D + c); const f32x4 o = hv[j] + xx * mm;
                    v2u w; w.x = pk2(o.x, o.y); w.y = pk2(o.z, o.w); *(v2u*)(views + ((size_t)i * M + row) * D + c) = w; }
                v2u w; w.x = pk2(hv[j].x, hv[j].y); w.y = pk2(hv[j].z, hv[j].w); *(v2u*)(H2 + (size_t)row * 2048 + c) = w;
                w.x = pk2(xx.x, xx.y); w.y = pk2(xx.z, xx.w); *(v2u*)(H2 + (size_t)row * 2048 + 1024 + c) = w; }
        }
        __syncthreads();
    }
}

__device__ __forceinline__ void p4_scan_seq(Frame& F) {
    constexpr int TS = 32;
    LAS float* sA = (LAS float*)(F.lds + RING_OFF);
    LAS float* sW = sA + TS * 64; LAS float* sB = sW + TS * 64; LAS float* sK = sB + TS * 64; LAS float* sR = sK + TS * 64; LAS float* sV = sR + TS * 64;
    LAS float* sY = sV + TS * 64; LAS float* sRK = sY + TS * 64;
    const bf16* Rb = (const bf16*)(F.ws + WS_RKV); const bf16* Kb = Rb + (size_t)M * D; const bf16* Vb = Kb + (size_t)M * D;
    const float* LW = (const float*)(F.ws + WS_LOGW); const bf16* AS = (const bf16*)(F.ws + WS_ASIG); const bf16* GG = (const bf16*)(F.ws + WS_GG);
    bf16* YG = (bf16*)(F.ws + WS_YG);
    const float* k_k = F.in[16]; const float* k_a = F.in[17]; const float* r_k = F.in[18]; const float* gn_g = F.in[19]; const float* gn_b = F.in[20];
    for (int bh = blockIdx.x; bh < BATCH * 16; bh += F.G) {
        const int b = bh >> 4, h = bh & 15;
        const int i = F.tid >> 3, q = F.tid & 7;
        const int st = F.tid >> 4, d4 = (F.tid & 15) * 4;
        const int cg = h * 64 + d4;
        const f32x4 kkv = *(const f32x4*)(k_k + cg), kav = *(const f32x4*)(k_a + cg), rkv = *(const f32x4*)(r_k + cg), gng = *(const f32x4*)(gn_g + cg), gnb = *(const f32x4*)(gn_b + cg);
        float s[8];
#pragma unroll
        for (int j = 0; j < 8; ++j) s[j] = 0.f;
        for (int t0 = 0; t0 < T; t0 += TS) {
            const size_t ro = ((size_t)b * T + t0 + st) * D + cg;
            {
                const v2u rr = *(const v2u*)(Rb + ro), kk2 = *(const v2u*)(Kb + ro), vv = *(const v2u*)(Vb + ro), aa = *(const v2u*)(AS + ro); const f32x4 lw = *(const f32x4*)(LW + ro);
                const f32x4 r4 = {bflo(rr.x), bfhi(rr.x), bflo(rr.y), bfhi(rr.y)}, k4 = {bflo(kk2.x), bfhi(kk2.x), bflo(kk2.y), bfhi(kk2.y)};
                const f32x4 v4 = {bflo(vv.x), bfhi(vv.x), bflo(vv.y), bfhi(vv.y)}, a4 = {bflo(aa.x), bfhi(aa.x), bflo(aa.y), bfhi(aa.y)};
                const f32x4 kr = k4 * kkv; float ss = (kr.x * kr.x + kr.y * kr.y) + (kr.z * kr.z + kr.w * kr.w);
                ss += __shfl_xor(ss, 1); ss += __shfl_xor(ss, 2); ss += __shfl_xor(ss, 4); ss += __shfl_xor(ss, 8);
                const float inv = 1.0f / fmaxf(sqrtf(ss), 1e-12f);
                const f32x4 kkn = kr * inv; const f32x4 km = k4 * ((a4 - 1.0f) * kav + 1.0f);
                const f32x4 rk4 = r4 * km * rkv; float rs = (rk4.x + rk4.y) + (rk4.z + rk4.w);
                rs += __shfl_xor(rs, 1); rs += __shfl_xor(rs, 2); rs += __shfl_xor(rs, 4); rs += __shfl_xor(rs, 8);
                f32x4 wv; wv.x = __expf(lw.x); wv.y = __expf(lw.y); wv.z = __expf(lw.z); wv.w = __expf(lw.w);
                *(LAS f32x4*)(sA + st * 64 + d4) = -kkn; *(LAS f32x4*)(sW + st * 64 + d4) = wv; *(LAS f32x4*)(sB + st * 64 + d4) = kkn * a4;
                *(LAS f32x4*)(sK + st * 64 + d4) = km; *(LAS f32x4*)(sR + st * 64 + d4) = r4; *(LAS f32x4*)(sV + st * 64 + d4) = v4;
                if ((F.tid & 15) == 0) sRK[st] = rs;
            }
            __syncthreads();
            for (int t = 0; t < TS; ++t) {
                const LAS f32x4* pa = (const LAS f32x4*)(sA + t * 64 + q * 8); const LAS f32x4* pw = (const LAS f32x4*)(sW + t * 64 + q * 8); const LAS f32x4* pb = (const LAS f32x4*)(sB + t * 64 + q * 8);
                const LAS f32x4* pk = (const LAS f32x4*)(sK + t * 64 + q * 8); const LAS f32x4* pr = (const LAS f32x4*)(sR + t * 64 + q * 8);
                const f32x4 a0 = pa[0], a1 = pa[1], w0 = pw[0], w1 = pw[1], b0 = pb[0], b1 = pb[1], k0 = pk[0], k1 = pk[1], r0 = pr[0], r1 = pr[1];
                const float vi = sV[t * 64 + i];
                float sa = (s[0] * a0.x + s[1] * a0.y) + (s[2] * a0.z + s[3] * a0.w) + (s[4] * a1.x + s[5] * a1.y) + (s[6] * a1.z + s[7] * a1.w);
                sa += __shfl_xor(sa, 1); sa += __shfl_xor(sa, 2); sa += __shfl_xor(sa, 4);
                s[0] = s[0] * w0.x + sa * b0.x + vi * k0.x; s[1] = s[1] * w0.y + sa * b0.y + vi * k0.y; s[2] = s[2] * w0.z + sa * b0.z + vi * k0.z; s[3] = s[3] * w0.w + sa * b0.w + vi * k0.w;
                s[4] = s[4] * w1.x + sa * b1.x + vi * k1.x; s[5] = s[5] * w1.y + sa * b1.y + vi * k1.y; s[6] = s[6] * w1.z + sa * b1.z + vi * k1.z; s[7] = s[7] * w1.w + sa * b1.w + vi * k1.w;
                float y = (s[0] * r0.x + s[1] * r0.y) + (s[2] * r0.z + s[3] * r0.w) + (s[4] * r1.x + s[5] * r1.y) + (s[6] * r1.z + s[7] * r1.w);
                y += __shfl_xor(y, 1); y += __shfl_xor(y, 2); y += __shfl_xor(y, 4);
                if (q == 0) sY[t * 64 + i] = y;
            }
            __syncthreads();
            {
                const f32x4 y4 = *(const LAS f32x4*)(sY + st * 64 + d4); const f32x4 v4 = *(const LAS f32x4*)(sV + st * 64 + d4);
                float sm = (y4.x + y4.y) + (y4.z + y4.w);
                sm += __shfl_xor(sm, 1); sm += __shfl_xor(sm, 2); sm += __shfl_xor(sm, 4); sm += __shfl_xor(sm, 8);
                const float mean = sm * (1.f / 64.f); const f32x4 dv = y4 - mean;
                float vs = (dv.x * dv.x + dv.y * dv.y) + (dv.z * dv.z + dv.w * dv.w);
                vs += __shfl_xor(vs, 1); vs += __shfl_xor(vs, 2); vs += __shfl_xor(vs, 4); vs += __shfl_xor(vs, 8);
                const float rstd = 1.0f / sqrtf(vs * (1.f / 64.f) + GN_EPS);
                const v2u gg = *(const v2u*)(GG + ro); const f32x4 g4 = {bflo(gg.x), bfhi(gg.x), bflo(gg.y), bfhi(gg.y)};
                const f32x4 o = (dv * rstd * gng + gnb + v4 * sRK[st]) * g4;
                v2u w; w.x = pk2(o.x, o.y); w.y = pk2(o.z, o.w); *(v2u*)(YG + ro) = w;
            }
            __syncthreads();
        }
    }
}

__device__ __forceinline__ void moe_router(Frame& F, int l, const float* xin) {
    const float* g = F.in[5] + (size_t)l * D; const float* wrg = F.in[33] + (size_t)l * D * NGRP; const float* wre = F.in[34] + (size_t)l * D * NE;
    const float* mod = (const float*)(F.ws + WS_MOD) + (size_t)l * 4 * 6144;
    bf16* H2N = (bf16*)(F.ws + WS_H2N);
    int* asg_e = (int*)(F.ws + WS_ROUTE); int* asg_pos = asg_e + 2 * M; float* asg_gate = (float*)(asg_pos + 2 * M);
    unsigned* cnt = (unsigned*)F.ctl + CW_CNT + 64 * l;
    const int gw = blockIdx.x * NWAVES + F.wave, NGW = F.G * NWAVES;
    for (int row = gw; row < M; row += NGW) {
        const int b = row / T; const float* sh = mod + (size_t)b * 6144 + 3072; const float* sc = sh + 1024;
        const f32x4* xr = (const f32x4*)(xin + (size_t)row * D) + F.lane; f32x4 v[4]; float ss = 0.f;
#pragma unroll
        for (int j = 0; j < 4; ++j) { v[j] = xr[64 * j]; ss += (v[j].x * v[j].x + v[j].y * v[j].y) + (v[j].z * v[j].z + v[j].w * v[j].w); }
        const float rstd = 1.0f / sqrtf(wave_sum(ss) * (1.f / D) + RMS_EPS);
        float acc[36];
#pragma unroll
        for (int o = 0; o < 36; ++o) acc[o] = 0.f;
#pragma unroll
        for (int j = 0; j < 4; ++j) { const int c = 4 * F.lane + 256 * j; const f32x4 gg = *(const f32x4*)(g + c), s1 = *(const f32x4*)(sc + c), s0 = *(const f32x4*)(sh + c);
            v[j] = v[j] * rstd * gg * (s1 + 1.0f) + s0;
            v2u w; w.x = pk2(v[j].x, v[j].y); w.y = pk2(v[j].z, v[j].w); *(v2u*)(H2N + (size_t)row * D + c) = w; }
        const float* wel = wre + (size_t)F.lane * 128; const float* wgl = wrg + (size_t)F.lane * 16;
        asm volatile("" : "+v"(wel), "+v"(wgl));
#pragma unroll
        for (int j = 0; j < 4; ++j) { const float* wej = wel + (size_t)j * 256 * 32; const float* wgj = wgl + (size_t)j * 256 * 4;
#pragma unroll
            for (int e = 0; e < 4; ++e) { const float hvv = v[j][e];
                const f32x4 wg4 = *(const f32x4*)(wgj + e * 4);
                acc[0] += hvv * wg4.x; acc[1] += hvv * wg4.y; acc[2] += hvv * wg4.z; acc[3] += hvv * wg4.w;
#pragma unroll
                for (int q = 0; q < 8; ++q) { const f32x4 we = *(const f32x4*)(wej + e * 32 + q * 4);
                    acc[4 + q * 4 + 0] += hvv * we.x; acc[4 + q * 4 + 1] += hvv * we.y; acc[4 + q * 4 + 2] += hvv * we.z; acc[4 + q * 4 + 3] += hvv * we.w; } } }
#pragma unroll
        for (int o = 0; o < 36; ++o) acc[o] = wave_sum(acc[o]);
        int gi = 0; float gm = acc[0];
#pragma unroll
        for (int j = 1; j < 4; ++j) if (acc[j] > gm) { gm = acc[j]; gi = j; }
        float gs = 0.f;
#pragma unroll
        for (int j = 0; j < 4; ++j) gs += __expf(acc[j] - gm);
        const float ggate = 1.0f / gs;
        float el[8];
#pragma unroll
        for (int j = 0; j < 8; ++j) el[j] = (gi == 0) ? acc[4 + j] : (gi == 1) ? acc[12 + j] : (gi == 2) ? acc[20 + j] : acc[28 + j];
        int i1 = 0; float v1 = el[0];
#pragma unroll
        for (int j = 1; j < 8; ++j) if (el[j] > v1) { v1 = el[j]; i1 = j; }
        int i2 = -1; float v2 = -INFINITY;
#pragma unroll
        for (int j = 0; j < 8; ++j) if (j != i1 && el[j] > v2) { v2 = el[j]; i2 = j; }
        const float e2 = __expf(v2 - v1), p1 = 1.0f / (1.0f + e2), p2 = e2 * p1;
        if (F.lane == 0) { const int ea = gi * 8 + i1, eb = gi * 8 + i2;
            const unsigned pa = atomicAdd(cnt + ea, 1u), pb = atomicAdd(cnt + eb, 1u);
            asg_e[2 * row] = ea; asg_e[2 * row + 1] = eb; asg_pos[2 * row] = (int)pa; asg_pos[2 * row + 1] = (int)pb;
            asg_gate[2 * row] = ggate * p1; asg_gate[2 * row + 1] = ggate * p2; }
    }
}
__device__ __forceinline__ void moe_toff(Frame& F, int l) {
    LAS int* toff = (LAS int*)(F.lds + LDSCTL_OFF);
    if (F.tid == 0) { const unsigned* cnt = (const unsigned*)F.ctl + CW_CNT + 64 * l; int acc = 0;
        for (int e = 0; e < 32; ++e) { toff[e] = acc; acc += (int)((__hip_atomic_load(cnt + e, RLX_AGENT) + 255u) >> 8); }
        toff[32] = acc; }
    __syncthreads();
}
__device__ __forceinline__ void moe_gather(Frame& F, int l) {
    moe_toff(F, l);
    const LAS int* toff = (const LAS int*)(F.lds + LDSCTL_OFF);
    const bf16* H2N = (const bf16*)(F.ws + WS_H2N); bf16* XS = (bf16*)(F.ws + WS_XS);
    const int* asg_e = (const int*)(F.ws + WS_ROUTE); const int* asg_pos = asg_e + 2 * M; const float* asg_gate = (const float*)(asg_pos + 2 * M);
    int* asg_row = (int*)(asg_gate + 2 * M); float* rowgate = (float*)(asg_row + 2 * M);
    const int gw = blockIdx.x * NWAVES + F.wave, NGW = F.G * NWAVES;
    for (int a = gw; a < 2 * M; a += NGW) {
        const int tok = a >> 1, e = asg_e[a], pos = asg_pos[a]; const int row = toff[e] * 256 + pos;
        const v4u* src = (const v4u*)(H2N + (size_t)tok * D) + F.lane; v4u* dst = (v4u*)(XS + (size_t)row * D) + F.lane;
        const v4u x0 = src[0], x1 = src[64]; dst[0] = x0; dst[64] = x1;
        if (F.lane == 0) { rowgate[row] = asg_gate[a]; asg_row[a] = row; }
    }
}
template <int MODE> __device__ __forceinline__ void moe_combine(Frame& F, int l, const float* xin, float* xout) {
    const bf16* Y = (const bf16*)(F.ws + WS_Y);
    const int* asg_row = (const int*)(F.ws + WS_ROUTE) + 6 * M;
    const float* mod = (const float*)(F.ws + WS_MOD) + (size_t)l * 4 * 6144;
    const float* mod1 = (const float*)(F.ws + WS_MOD) + (size_t)4 * 6144;
    const float* modkv = (const float*)(F.ws + WS_MOD) + (size_t)8 * 6144;
    const float* gq = F.in[4] + D; const float* gkv = F.in[24]; const float* gfin = F.in[38];
    bf16* HQ = (bf16*)(F.ws + WS_HQ); bf16* HK = (bf16*)(F.ws + WS_HK);
    const int gw = blockIdx.x * NWAVES + F.wave, NGW = F.G * NWAVES;
    for (int row = gw; row < M; row += NGW) {
        const int b = row / T; const float* gf = mod + (size_t)b * 6144 + 5120;
        const int r0 = asg_row[2 * row], r1 = asg_row[2 * row + 1];
        const f32x4* xr = (const f32x4*)(xin + (size_t)row * D) + F.lane; f32x4 v[4]; float ss = 0.f;
#pragma unroll
        for (int j = 0; j < 4; ++j) { const int c = 4 * F.lane + 256 * j;
            const v2u y0 = *(const v2u*)(Y + (size_t)r0 * D + c), y1 = *(const v2u*)(Y + (size_t)r1 * D + c); const f32x4 gg = *(const f32x4*)(gf + c);
            const f32x4 ys = {bflo(y0.x) + bflo(y1.x), bfhi(y0.x) + bfhi(y1.x), bflo(y0.y) + bflo(y1.y), bfhi(y0.y) + bfhi(y1.y)};
            v[j] = xr[64 * j] + gg * ys; ss += (v[j].x * v[j].x + v[j].y * v[j].y) + (v[j].z * v[j].z + v[j].w * v[j].w); }
        const float rstd = 1.0f / sqrtf(wave_sum(ss) * (1.f / D) + RMS_EPS);
        if (MODE == 0) {
            const float* shq = mod1 + (size_t)b * 6144; const float* scq = shq + 1024; const float* shk = modkv + (size_t)b * 2048; const float* sck = shk + 1024;
#pragma unroll
            for (int j = 0; j < 4; ++j) { const int c = 4 * F.lane + 256 * j;
                *((f32x4*)(xout + (size_t)row * D) + F.lane + 64 * j) = v[j];
                const f32x4 n = v[j] * rstd;
                const f32x4 hq = n * *(const f32x4*)(gq + c) * (*(const f32x4*)(scq + c) + 1.0f) + *(const f32x4*)(shq + c);
                const f32x4 hk = n * *(const f32x4*)(gkv + c) * (*(const f32x4*)(sck + c) + 1.0f) + *(const f32x4*)(shk + c);
                v2u w; w.x = pk2(hq.x, hq.y); w.y = pk2(hq.z, hq.w); *(v2u*)(HQ + (size_t)row * D + c) = w;
                w.x = pk2(hk.x, hk.y); w.y = pk2(hk.z, hk.w); *(v2u*)(HK + (size_t)row * D + c) = w; }
        } else {
#pragma unroll
            for (int j = 0; j < 4; ++j) { const int c = 4 * F.lane + 256 * j; *((f32x4*)(xout + (size_t)row * D) + F.lane + 64 * j) = v[j] * rstd * *(const f32x4*)(gfin + c); }
        }
    }
}
__device__ __forceinline__ void attn_subln(Frame& F) {
    const bf16* OC = (const bf16*)(F.ws + WS_OC); bf16* ON = (bf16*)(F.ws + WS_ON);
    const float l1 = wave_sum(F.in[27][F.lane] * F.in[28][F.lane]), l2 = wave_sum(F.in[29][F.lane] * F.in[30][F.lane]);
    const float lam = __expf(l1) - __expf(l2) + LAMBDA_INIT1;
    const float* sg = F.in[31] + (F.lane & 7) * 16;
    float gsc[16];
#pragma unroll
    for (int e = 0; e < 16; ++e) gsc[e] = sg[e] * (1.0f - LAMBDA_INIT1);
    const int gw = blockIdx.x * NWAVES + F.wave, NGW = F.G * NWAVES; const int hd = F.lane >> 3, sub = (F.lane & 7) * 16;
    for (int row = gw; row < M; row += NGW) {
        const v4u* p0 = (const v4u*)(OC + (size_t)row * 2048 + (hd * 2) * 128 + sub); const v4u* p1 = (const v4u*)(OC + (size_t)row * 2048 + (hd * 2 + 1) * 128 + sub);
        const v4u a0 = p0[0], a1 = p0[1], b0 = p1[0], b1 = p1[1];
        float d[16];
#define DF(i, A, B) d[2 * (i)] = bflo(A) - lam * bflo(B); d[2 * (i) + 1] = bfhi(A) - lam * bfhi(B)
        DF(0, a0.x, b0.x); DF(1, a0.y, b0.y); DF(2, a0.z, b0.z); DF(3, a0.w, b0.w); DF(4, a1.x, b1.x); DF(5, a1.y, b1.y); DF(6, a1.z, b1.z); DF(7, a1.w, b1.w);
#undef DF
        float ss = 0.f;
#pragma unroll
        for (int e = 0; e < 16; ++e) ss += d[e] * d[e];
        ss += __shfl_xor(ss, 1); ss += __shfl_xor(ss, 2); ss += __shfl_xor(ss, 4);
        const float rstd = 1.0f / sqrtf(ss * (1.f / 128.f) + SUBLN_EPS);
        v4u w0, w1;
        w0.x = pk2(d[0] * rstd * gsc[0], d[1] * rstd * gsc[1]); w0.y = pk2(d[2] * rstd * gsc[2], d[3] * rstd * gsc[3]); w0.z = pk2(d[4] * rstd * gsc[4], d[5] * rstd * gsc[5]); w0.w = pk2(d[6] * rstd * gsc[6], d[7] * rstd * gsc[7]);
        w1.x = pk2(d[8] * rstd * gsc[8], d[9] * rstd * gsc[9]); w1.y = pk2(d[10] * rstd * gsc[10], d[11] * rstd * gsc[11]); w1.z = pk2(d[12] * rstd * gsc[12], d[13] * rstd * gsc[13]); w1.w = pk2(d[14] * rstd * gsc[14], d[15] * rstd * gsc[15]);
        v4u* op = (v4u*)(ON + (size_t)row * D + F.lane * 16); op[0] = w0; op[1] = w1;
    }
}
struct AttnOrder {
    int vcu;
    __device__ __forceinline__ explicit AttnOrder(int grid, int block) : vcu((block % 8) * (grid / 8) + block / 8) {}
    __device__ __forceinline__ bool next(int i, attn_body::AttnUnit& u) const { if (i >= 8) return false; const int s = 2 * (i >> 1) + (vcu & 1); u.bh = vcu >> 1; u.qb = (i & 1) ? s : 15 - s; return true; }
    __device__ __forceinline__ void a_ready(const attn_body::AttnUnit&) const {}
    __device__ __forceinline__ void done(const attn_body::AttnUnit&) const {}
};

constexpr int NPHASE = 22;
#define IN(k) (lo <= (k) && (k) < hi)
#define SEAM(k) do { if (IN(k) && (k) + 1 < hi) xcd_barrier(bar); } while (0)
template <int L> __device__ __forceinline__ void moe_phases(Frame& F, const int lo, const int hi, const XcdBarrier& bar) {
    constexpr int pb = 11 * L;
    LAS unsigned char* ring = F.lds + RING_OFF;
    const LAS int* toff = (const LAS int*)(F.lds + LDSCTL_OFF);
        if (IN(pb + 6)) { F.lane = lane_id(); moe_router(F, L, (const float*)(F.ws + WS_XA)); moe_weights(F, L); } SEAM(pb + 6);
        if (IN(pb + 7)) { F.lane = lane_id(); moe_gather(F, L); } SEAM(pb + 7);
        if (IN(pb + 8)) { F.lane = lane_id();
            moe_toff(F, L);
            pg8::MoeOrder S; S.init(F.ws + WS_XS, F.ws + WS_MOEGU, (size_t)1024 * 1024 * 2, toff, 4, D, F.G, (int)blockIdx.x);
            pg8::EpiGU E{(bf16*)(F.ws + WS_HS)};
            pg8::gemm_phase<pg8::EpiGU, pg8::MoeOrder, true, true>(ring, D, S, E);
        } SEAM(pb + 8);
        if (IN(pb + 9)) { F.lane = lane_id();
            moe_toff(F, L);
            pg8::MoeOrder S; S.init(F.ws + WS_HS, F.ws + WS_MOED, (size_t)1024 * 512 * 2, toff, 4, FF, F.G, (int)blockIdx.x);
            pg8::EpiDown E{(bf16*)(F.ws + WS_Y), (const float*)(F.ws + WS_ROUTE) + 8 * M};
            pg8::gemm_phase<pg8::EpiDown, pg8::MoeOrder, true, true>(ring, FF, S, E);
        } SEAM(pb + 9);
        if (IN(pb + 10)) { F.lane = lane_id();
            moe_combine<L>(F, L, (const float*)(F.ws + WS_XA), F.out);
        } SEAM(pb + 10);
}
#undef IN
#undef SEAM
struct Args { const float* in[39]; float* out; unsigned char* ws; int ph_lo, ph_hi; };
__global__ void __launch_bounds__(NWAVES * 64, 2) trunk_fwd(Args args) {
    extern __shared__ __attribute__((aligned(16))) unsigned char lds[];
    Frame F;
    F.lds = (LAS unsigned char*)lds;
    F.MISC = (volatile LAS unsigned*)(F.lds + MISC_OFF);
    F.tid = threadIdx.x; F.lane = lane_id(); F.wave = __builtin_amdgcn_readfirstlane(F.tid >> 6);
    F.G = gridDim.x; { const int bx = blockIdx.x; F.vcu = (F.G % 8 == 0) ? (bx % 8) * (F.G / 8) + bx / 8 : bx; }
    F.ws = args.ws; F.ctl = (gu32*)(args.ws + WS_CTL); F.in = args.in; F.out = args.out;
    for (int u = F.tid; u < (LDS_BYTES - LDSCTL_OFF) / 4; u += NWAVES * 64) ((LAS unsigned*)(F.lds + LDSCTL_OFF))[u] = 0u;
    __syncthreads();
    const int lo = args.ph_lo, hi = args.ph_hi;
    const bool multi = (hi - lo) > 1;
    XcdBarrier bar; bar.bar = (unsigned*)(F.ctl + CW_BAR); bar.x = 0; bar.st = nullptr;
    if (multi) bar = xcd_barrier_post((unsigned*)(F.ctl + CW_BAR), F.MISC + 8);
#define IN(k) (lo <= (k) && (k) < hi)
#define SEAM(k) do { if (IN(k) && (k) + 1 < hi) xcd_barrier(bar); } while (0)
    LAS unsigned char* ring = F.lds + RING_OFF;
    const LAS int* toff = (const LAS int*)(F.lds + LDSCTL_OFF);

    {
        {
            if (IN(0)) { F.lane = lane_id(); p0_mod(F); p0_weights(F); } SEAM(0);
            if (IN(1)) { F.lane = lane_id(); p1_norm_views(F); } SEAM(1);
            if (IN(2)) { F.lane = lane_id();
                { pg8::BatchOrder S; S.init(F.ws + WS_VIEWS, F.ws + WS_WRKV, (size_t)M * D * 2, (size_t)D * D * 2, M, D, 3, D, F.G, (int)blockIdx.x);
                  pg8::EpiZBf16 E{(bf16*)(F.ws + WS_RKV), (size_t)M * D, 1.0f};
                  pg8::gemm_phase<pg8::EpiZBf16, pg8::BatchOrder, true, true>(ring, D, S, E); }
                { pg8::BatchOrder S; S.init(F.ws + WS_H2, F.ws + WS_WL1, 0, 0, M, 256, 1, 2048, F.G, (int)blockIdx.x);
                  pg8::EpiLora1 E{(bf16*)(F.ws + WS_A2)};
                  pg8::gemm_phase<pg8::EpiLora1, pg8::BatchOrder, true, true>(ring, 2048, S, E); }
            } SEAM(2);
            if (IN(3)) { F.lane = lane_id();
                pg8::BatchOrder S; S.init(F.ws + WS_A2, F.ws + WS_WL2, 0, 0, M, 3072, 1, 256, F.G, (int)blockIdx.x);
                pg8::EpiLora2 E{(float*)(F.ws + WS_LOGW), (bf16*)(F.ws + WS_ASIG), (bf16*)(F.ws + WS_GG), F.in[8], F.in[11]};
                pg8::gemm_phase<pg8::EpiLora2, pg8::BatchOrder, true, true>(ring, 256, S, E);
            } SEAM(3);
            if (IN(4)) { F.lane = lane_id(); p4_scan_seq(F); } SEAM(4);
            if (IN(5)) { F.lane = lane_id();
                pg8::BatchOrder S; S.init(F.ws + WS_YG, F.ws + WS_WO0, 0, 0, M, D, 1, D, F.G, (int)blockIdx.x);
                pg8::EpiResid E{F.in[0], (float*)(F.ws + WS_XA), (const float*)(F.ws + WS_MOD) + 2048};
                pg8::gemm_phase<pg8::EpiResid, pg8::BatchOrder, true, true>(ring, D, S, E);
            } SEAM(5);
        }
        moe_phases<0>(F, lo, hi, bar);
        {
            if (IN(11)) { F.lane = lane_id();
                { pg8::BatchOrder S; S.init(F.ws + WS_HQ, F.ws + WS_WQKV, (size_t)M * D * 2, (size_t)D * D * 2, M, D, 2, D, F.G, (int)blockIdx.x);
                  pg8::EpiZBf16 E{(bf16*)(F.ws + WS_QKV), (size_t)M * D, attn_body::C2};
                  pg8::gemm_phase<pg8::EpiZBf16, pg8::BatchOrder, true, true>(ring, D, S, E); }
                { pg8::BatchOrder S; S.init(F.ws + WS_HK, F.ws + WS_WQKV + (size_t)2 * D * D * 2, 0, 0, M, D, 1, D, F.G, (int)blockIdx.x);
                  pg8::EpiZBf16 E{(bf16*)(F.ws + WS_QKV) + (size_t)2 * M * D, 0, 1.0f};
                  pg8::gemm_phase<pg8::EpiZBf16, pg8::BatchOrder, true, true>(ring, D, S, E); }
            } SEAM(11);
            if (IN(12)) { F.lane = lane_id();
                const attn_body::bf16* Q = (const attn_body::bf16*)(F.ws + WS_QKV); const attn_body::bf16* Kp = Q + (size_t)M * D; const attn_body::bf16* Vp = Kp + (size_t)M * D;
                attn_body::bf16* O = (attn_body::bf16*)(F.ws + WS_OC);
                const AttnOrder S((int)F.G, (int)blockIdx.x); attn_body::AttnUnit u;
                for (int i = 0; S.next(i, u); ++i) {
                    const int b = u.bh >> 5, h = (u.bh >> 2) & 7, c = (u.bh >> 1) & 1, vh = u.bh & 1;
                    attn_body::attn_unit<8>(b, u.qb, Q + (h * 2 + c) * 64, Kp + (h * 2 + c) * 64, Vp + h * 128 + vh * 64, O + (h * 2 + c) * 128 + vh * 64, (char*)lds + RING_OFF);
                }
            } SEAM(12);
            if (IN(13)) { F.lane = lane_id(); attn_subln(F); } SEAM(13);
            if (IN(14)) { F.lane = lane_id();
                pg8::BatchOrder S; S.init(F.ws + WS_ON, F.ws + WS_WO1, 0, 0, M, D, 1, D, F.G, (int)blockIdx.x);
                pg8::EpiResid E{F.out, (float*)(F.ws + WS_XA), (const float*)(F.ws + WS_MOD) + 4 * 6144 + 2048};
                pg8::gemm_phase<pg8::EpiResid, pg8::BatchOrder, true, true>(ring, D, S, E);
            } SEAM(14);
        }
        moe_phases<1>(F, lo, hi, bar);
    }
    if (multi && hi == NPHASE) { if (__hip_atomic_load((gu32*)((unsigned*)(F.ctl + CW_BAR) + XB_TMO), RLX_AGENT) != 0u) {
        const float q = __builtin_nanf(""); for (size_t i = (size_t)blockIdx.x * 512 + F.tid; i < (size_t)M * D; i += (size_t)F.G * 512) F.out[i] = q; } }
#undef IN
#undef SEAM
}

#ifndef N_LAUNCH_MODE
#define N_LAUNCH_MODE 1
#endif
extern "C" void kernel_launch(void* const* d_in, const int* in_sizes, int n_in, void* d_out, int out_size, void* d_ws, size_t ws_size, hipStream_t stream) {
    static int grid = 0;
    if (grid == 0) {
        if (n_in != 39 || in_sizes[0] != M * D || out_size != M * D || ws_size < WS_END) { fprintf(stderr, "kernel_launch: unexpected problem (n_in %d, in0 %d, out %d, ws %zu < %zu); nothing launched\n", n_in, n_in > 0 ? in_sizes[0] : -1, out_size, ws_size, (size_t)WS_END); grid = -1; return; }
        int dev = 0, cus = 0, per_cu = 0;
        if (hipGetDevice(&dev) != hipSuccess || hipDeviceGetAttribute(&cus, hipDeviceAttributeMultiprocessorCount, dev) != hipSuccess) { grid = -1; return; }
        if (hipFuncSetAttribute((const void*)trunk_fwd, hipFuncAttributeMaxDynamicSharedMemorySize, LDS_BYTES) != hipSuccess) { fprintf(stderr, "kernel_launch: hipFuncSetAttribute failed\n"); grid = -1; return; }
        if (hipOccupancyMaxActiveBlocksPerMultiprocessor(&per_cu, (const void*)trunk_fwd, NWAVES * 64, LDS_BYTES) != hipSuccess || per_cu < 1) fprintf(stderr, "kernel_launch: occupancy query reports %d\n", per_cu);
        (void)hipGetLastError();
        grid = cus;
    }
    if (grid < 0) return;
    if (hipMemsetAsync((char*)d_ws + WS_CTL, 0, CTL_ZERO_BYTES, stream) != hipSuccess) return;
    Args a{};
    for (int i = 0; i < 39; ++i) a.in[i] = (const float*)d_in[i];
    a.out = (float*)d_out; a.ws = (unsigned char*)d_ws;
    if (N_LAUNCH_MODE == 1) {
        a.ph_lo = 0; a.ph_hi = NPHASE;
        hipLaunchKernelGGL(trunk_fwd, dim3(grid), dim3(NWAVES * 64), LDS_BYTES, stream, a);
    } else {
        const int ids[20] = {0, 1, 2, 3, 4, 5, 6, 7, 8, 9, 10, 11, 12, 13, 14, 17, 18, 19, 20, 21};
        for (int k = 0; k < 20; ++k) { a.ph_lo = ids[k]; a.ph_hi = ids[k] + 1; hipLaunchKernelGGL(trunk_fwd, dim3(grid), dim3(NWAVES * 64), LDS_BYTES, stream, a); }
    }
}
```

```cpp
#include <hip/hip_runtime.h>
#include <hip/hip_bf16.h>
#include <cstdio>
#include <cstdint>
#include <cmath>

namespace pg8 {
#define PG8_LAS __attribute__((address_space(3)))
typedef unsigned short bf16_t;
typedef short bf16x8 __attribute__((ext_vector_type(8)));
typedef float f32x4 __attribute__((ext_vector_type(4)));
typedef unsigned u32x4 __attribute__((ext_vector_type(4)));
typedef unsigned u32x2 __attribute__((ext_vector_type(2)));
constexpr int BM = 256, BK = 64, HALF = 128, HTB = HALF * BK * 2  , STAGE_BYTES = 8 * HTB, NXCD = 8, WGM = 8;

__host__ __device__ __forceinline__ int lds_byte(int r, int c) { const int st = (r >> 4) * 2 + (c >> 5), rr = r & 15, cc = c & 31, ob = rr * 64 + cc * 2; return st * 1024 + (ob ^ (((ob >> 9) & 1) << 5)); }
__host__ __device__ __forceinline__ void stage_rc(int b, int& R, int& C) { const int st = b / 1024, sb = b % 1024, swz = sb ^ (((sb >> 9) & 1) << 5); R = (st >> 1) * 16 + swz / 64; C = (st & 1) * 32 + (swz % 64) / 2; }
__host__ __device__ __forceinline__ int perm32(int rho) { const int n = rho >> 4, i = rho & 15; return 8 * (i >> 2) + 4 * n + (i & 3); }

struct Unit { int pm, pn, z; };

__device__ __forceinline__ unsigned cvt_pk_bf16(float lo, float hi) { unsigned r; asm("v_cvt_pk_bf16_f32 %0, %1, %2" : "=v"(r) : "v"(lo), "v"(hi)); return r; }

struct BatchOrder {
    const char* A; const char* B; size_t sa, sb, tst; int nM, nN, nwg, tot, G, c;
    __device__ __forceinline__ void init(const void* A_, const void* B_, size_t sa_, size_t sb_, int M, int N, int Z, int K, int G_, int c_) {
        A = (const char*)A_; B = (const char*)B_; sa = sa_; sb = sb_; tst = (size_t)BM * K * 2; nM = M / BM; nN = N / BM; nwg = nM * nN; tot = nwg * Z; G = G_; c = c_; }
    __device__ __forceinline__ bool next(int i, Unit& u) const {
        const int L = i * G + c; if (L >= tot) return false;
        u.z = L / nwg; int wgid = L - u.z * nwg; { const int q = nwg / NXCD, r = nwg % NXCD, xcd = wgid % NXCD, off = wgid / NXCD; wgid = (xcd < r ? xcd * (q + 1) : r * (q + 1) + (xcd - r) * q) + off; }
        const int nig = WGM * nN, gid = wgid / nig, fm = gid * WGM, gsz = (nM - fm) < WGM ? (nM - fm) : WGM;
        u.pm = fm + ((wgid % nig) % gsz); u.pn = (wgid % nig) / gsz; return true;
    }
    __device__ __forceinline__ const char* a_base(const Unit& u) const { return A + (size_t)u.z * sa + (size_t)u.pm * tst; }
    __device__ __forceinline__ const char* b_base(const Unit& u) const { return B + (size_t)u.z * sb + (size_t)u.pn * tst; }
    __device__ __forceinline__ void a_ready(const Unit&) const {}
    __device__ __forceinline__ void done(const Unit&) const {}
};
struct MoeOrder {
    const char* A; const char* B; size_t sbe, tst; const PG8_LAS int* toff; int nNt, tot, G, c;
    __device__ __forceinline__ void init(const void* A_, const void* B_, size_t sbe_, const PG8_LAS int* toff_, int nNt_, int K, int G_, int c_) {
        A = (const char*)A_; B = (const char*)B_; sbe = sbe_; tst = (size_t)BM * K * 2; toff = toff_; nNt = nNt_; tot = toff_[32] * nNt_; G = G_; c = c_; }
    __device__ __forceinline__ bool next(int i, Unit& u) const {
        const int L = i * G + c; if (L >= tot) return false;
        const int tI = L / nNt; u.pm = tI; u.pn = L - tI * nNt; int e = 0;
#pragma unroll
        for (int j = 1; j < 32; ++j) e += (toff[j] <= tI) ? 1 : 0;
        u.z = e; return true;
    }
    __device__ __forceinline__ const char* a_base(const Unit& u) const { return A + (size_t)u.pm * tst; }
    __device__ __forceinline__ const char* b_base(const Unit& u) const { return B + (size_t)u.z * sbe + (size_t)u.pn * tst; }
    __device__ __forceinline__ void a_ready(const Unit&) const {}
    __device__ __forceinline__ void done(const Unit&) const {}
};

__device__ __forceinline__ float sigmoidf_(float x) { return 1.0f / (1.0f + __expf(-x)); }
__device__ __forceinline__ float tanh_fast(float x) { return 1.0f - 2.0f / (__expf(2.0f * x) + 1.0f); }

struct EpiZBf16 {
    static constexpr bool PERM = true, AFTER_DRAIN = false;
    bf16_t* O; size_t zstride; float scale0;
    __device__ __forceinline__ void operator()(const f32x4 (&acc)[2][2][4][2], const Unit& u, int wr, int wc, int fr, int fq) const {
        const int row0 = u.pm * BM + wr * 64 + fr, col0 = u.pn * BM + wc * 32 + 8 * fq; bf16_t* base = O + (size_t)u.z * zstride; const float sc = (u.z == 0) ? scale0 : 1.0f;
#pragma unroll
        for (int ai = 0; ai < 2; ++ai)
#pragma unroll
            for (int m = 0; m < 4; ++m) { bf16_t* rowp = base + (size_t)(row0 + ai * HALF + m * 16) * 1024 + col0;
#pragma unroll
                for (int bj = 0; bj < 2; ++bj) { const f32x4 v0 = acc[ai][bj][m][0] * sc, v1 = acc[ai][bj][m][1] * sc;
                    u32x4 w; w.x = cvt_pk_bf16(v0[0], v0[1]); w.y = cvt_pk_bf16(v0[2], v0[3]); w.z = cvt_pk_bf16(v1[0], v1[1]); w.w = cvt_pk_bf16(v1[2], v1[3]);
                    *(u32x4*)(rowp + bj * HALF) = w; } }
    }
};
struct EpiLora1 {
    static constexpr bool PERM = true, AFTER_DRAIN = false;
    bf16_t* O;
    __device__ __forceinline__ void operator()(const f32x4 (&acc)[2][2][4][2], const Unit& u, int wr, int wc, int fr, int fq) const {
        const int row0 = u.pm * BM + wr * 64 + fr, col0 = wc * 32 + 8 * fq;
#pragma unroll
        for (int ai = 0; ai < 2; ++ai)
#pragma unroll
            for (int m = 0; m < 4; ++m) { bf16_t* rowp = O + (size_t)(row0 + ai * HALF + m * 16) * 256 + col0;
#pragma unroll
                for (int bj = 0; bj < 2; ++bj) { f32x4 v0 = acc[ai][bj][m][0], v1 = acc[ai][bj][m][1];
                    if (bj == 0 && wc < 2) {
#pragma unroll
                        for (int j = 0; j < 4; ++j) { v0[j] = tanh_fast(v0[j]); v1[j] = tanh_fast(v1[j]); } }
                    if (bj == 1) {
#pragma unroll
                        for (int j = 0; j < 4; ++j) { v0[j] = sigmoidf_(v0[j]); v1[j] = sigmoidf_(v1[j]); } }
                    u32x4 w; w.x = cvt_pk_bf16(v0[0], v0[1]); w.y = cvt_pk_bf16(v0[2], v0[3]); w.z = cvt_pk_bf16(v1[0], v1[1]); w.w = cvt_pk_bf16(v1[2], v1[3]);
                    *(u32x4*)(rowp + bj * HALF) = w; } }
    }
};
struct EpiLora2 {
    static constexpr bool PERM = false, AFTER_DRAIN = false;
    float* LW; bf16_t* AS; bf16_t* GG; const float* w0; const float* a0;
    __device__ __forceinline__ void operator()(const f32x4 (&acc)[2][2][4][2], const Unit& u, int wr, int wc, int fr, int fq) const {
        const int sect = u.pn >> 2, row0 = u.pm * BM + wr * 64 + fr, col0 = (u.pn & 3) * BM + wc * 32 + 4 * fq;
#pragma unroll
        for (int ai = 0; ai < 2; ++ai)
#pragma unroll
            for (int m = 0; m < 4; ++m) { const size_t ro = (size_t)(row0 + ai * HALF + m * 16) * 1024;
#pragma unroll
                for (int bj = 0; bj < 2; ++bj)
#pragma unroll
                    for (int n = 0; n < 2; ++n) { const int c = col0 + bj * HALF + n * 16; f32x4 v = acc[ai][bj][m][n];
                        if (sect == 0) { const f32x4 b = *(const f32x4*)(w0 + c);
#pragma unroll
                            for (int j = 0; j < 4; ++j) { const float x = -(v[j] + b[j]); const float sp = fmaxf(x, 0.f) + __logf(1.0f + __expf(-fabsf(x))); v[j] = -__expf(-sp - 0.5f); }
                            *(f32x4*)(LW + ro + c) = v; }
                        else if (sect == 1) { const f32x4 b = *(const f32x4*)(a0 + c);
#pragma unroll
                            for (int j = 0; j < 4; ++j) v[j] = sigmoidf_(v[j] + b[j]);
                            u32x2 w; w.x = cvt_pk_bf16(v[0], v[1]); w.y = cvt_pk_bf16(v[2], v[3]); *(u32x2*)(AS + ro + c) = w; }
                        else { u32x2 w; w.x = cvt_pk_bf16(v[0], v[1]); w.y = cvt_pk_bf16(v[2], v[3]); *(u32x2*)(GG + ro + c) = w; } } }
    }
};
struct EpiResid {
    static constexpr bool PERM = false, AFTER_DRAIN = false;
    const float* xin; float* xout; const float* gate;
    __device__ __forceinline__ void operator()(const f32x4 (&acc)[2][2][4][2], const Unit& u, int wr, int wc, int fr, int fq) const {
        const int row0 = u.pm * BM + wr * 64 + fr, col0 = u.pn * BM + wc * 32 + 4 * fq; const float* gp = gate + (size_t)(u.pm >> 4) * 6144 + col0;
        f32x4 gv[2][2];
#pragma unroll
        for (int bj = 0; bj < 2; ++bj)
#pragma unroll
            for (int n = 0; n < 2; ++n) gv[bj][n] = *(const f32x4*)(gp + bj * HALF + n * 16);
#pragma unroll
        for (int ai = 0; ai < 2; ++ai)
#pragma unroll
            for (int m = 0; m < 4; ++m) { const size_t ro = (size_t)(row0 + ai * HALF + m * 16) * 1024 + col0;
#pragma unroll
                for (int bj = 0; bj < 2; ++bj)
#pragma unroll
                    for (int n = 0; n < 2; ++n) { const f32x4 xi = *(const f32x4*)(xin + ro + bj * HALF + n * 16); *(f32x4*)(xout + ro + bj * HALF + n * 16) = xi + gv[bj][n] * acc[ai][bj][m][n]; } }
    }
};
struct EpiGU {
    static constexpr bool PERM = true, AFTER_DRAIN = false;
    bf16_t* H;
    __device__ __forceinline__ void operator()(const f32x4 (&acc)[2][2][4][2], const Unit& u, int wr, int wc, int fr, int fq) const {
        const int row0 = u.pm * BM + wr * 64 + fr, col0 = u.pn * HALF + wc * 32 + 8 * fq;
#pragma unroll
        for (int ai = 0; ai < 2; ++ai)
#pragma unroll
            for (int m = 0; m < 4; ++m) { float h[8];
#pragma unroll
                for (int n = 0; n < 2; ++n)
#pragma unroll
                    for (int j = 0; j < 4; ++j) { const float g = acc[ai][0][m][n][j], up = acc[ai][1][m][n][j]; h[n * 4 + j] = g * sigmoidf_(g) * up; }
                u32x4 w; w.x = cvt_pk_bf16(h[0], h[1]); w.y = cvt_pk_bf16(h[2], h[3]); w.z = cvt_pk_bf16(h[4], h[5]); w.w = cvt_pk_bf16(h[6], h[7]);
                *(u32x4*)(H + (size_t)(row0 + ai * HALF + m * 16) * 512 + col0) = w; }
    }
};
struct EpiDown {
    static constexpr bool PERM = true, AFTER_DRAIN = false;
    bf16_t* Y; const float* rowgate;
    __device__ __forceinline__ void operator()(const f32x4 (&acc)[2][2][4][2], const Unit& u, int wr, int wc, int fr, int fq) const {
        const int row0 = u.pm * BM + wr * 64 + fr, col0 = u.pn * BM + wc * 32 + 8 * fq;
#pragma unroll
        for (int ai = 0; ai < 2; ++ai)
#pragma unroll
            for (int m = 0; m < 4; ++m) { const int r = row0 + ai * HALF + m * 16; const float gt = rowgate[r]; bf16_t* rowp = Y + (size_t)r * 1024 + col0;
#pragma unroll
                for (int bj = 0; bj < 2; ++bj) { const f32x4 v0 = acc[ai][bj][m][0] * gt, v1 = acc[ai][bj][m][1] * gt;
                    u32x4 w; w.x = cvt_pk_bf16(v0[0], v0[1]); w.y = cvt_pk_bf16(v0[2], v0[3]); w.z = cvt_pk_bf16(v1[0], v1[1]); w.w = cvt_pk_bf16(v1[2], v1[3]);
                    *(u32x4*)(rowp + bj * HALF) = w; } }
    }
};

template <class Epi, class Sched, bool ALIGN_EPI = false, bool SP2 = false>
__device__ __forceinline__ void gemm_phase(PG8_LAS unsigned char* lds, const int K_, const Sched& S, const Epi& E) {
    const int tid = threadIdx.x, wid = __builtin_amdgcn_readfirstlane(tid >> 6), lane = tid & 63, wr = wid >> 2, wc = wid & 3, fr = lane & 15, fq = lane >> 4;
    const int K = K_, nt = K / BK;
    unsigned voffA[2], voffB[2];
#pragma unroll
    for (int i = 0; i < 2; ++i) { int R, C; stage_rc(tid * 16 + i * 8192, R, C); const int Rb = Epi::PERM ? ((R & ~31) + perm32(R & 31)) : R;
        voffA[i] = (unsigned)(R * K + C) * 2u; voffB[i] = (unsigned)(Rb * K + C) * 2u; }
    const size_t kstep = (size_t)(BK * 2);
    const size_t hstep = (size_t)HALF * K * 2;
    const unsigned ldsw = (unsigned)wid * 1024u;
    const int aoff = lds_byte(wr * 64 + fr, fq * 8), boff = lds_byte(wc * 32 + fr, fq * 8);
#define PG8_SA(b, h) (((b) * 2 + (h)) * HTB)
#define PG8_SB(b, h) ((4 + (b) * 2 + (h)) * HTB)
#define PG8_STAGE(bufoff, gbase, voff) do { _Pragma("unroll") for (int _i = 0; _i < 2; ++_i) \
        __builtin_amdgcn_global_load_lds((const unsigned*)((const char*)(gbase) + (voff)[_i]), (PG8_LAS unsigned*)(lds + (bufoff) + ldsw + _i * 8192), 16, 0, 0); } while (0)
#define PG8_LDA(dst, b, h) do { _Pragma("unroll") for (int m = 0; m < 4; ++m) _Pragma("unroll") for (int k = 0; k < 2; ++k) dst[m][k] = *(const PG8_LAS bf16x8*)(lds + PG8_SA(b, h) + aoff + m * 2048 + k * 1024); } while (0)
#define PG8_LDB(dst, b, h) do { _Pragma("unroll") for (int n = 0; n < 2; ++n) _Pragma("unroll") for (int k = 0; k < 2; ++k) dst[n][k] = *(const PG8_LAS bf16x8*)(lds + PG8_SB(b, h) + boff + n * 2048 + k * 1024); } while (0)
#define PG8_MMA(ai, bj, At, Bt) do { __builtin_amdgcn_s_setprio(1); _Pragma("unroll") for (int m = 0; m < 4; ++m) _Pragma("unroll") for (int n = 0; n < 2; ++n) _Pragma("unroll") for (int k = 0; k < 2; ++k) \
        acc[ai][bj][m][n] = __builtin_amdgcn_mfma_f32_16x16x32_bf16(Bt[n][k], At[m][k], acc[ai][bj][m][n], 0, 0, 0); __builtin_amdgcn_s_setprio(0); } while (0)
#define PG8_WAIT_V(n) asm volatile("s_waitcnt vmcnt(" #n ")" ::: "memory")
#define PG8_WAIT_L(n) asm volatile("s_waitcnt lgkmcnt(" #n ")" ::: "memory")
#define PG8_BAR __builtin_amdgcn_s_barrier()
#define PG8_SCHED __builtin_amdgcn_sched_barrier(0)
    Unit cur, nxt; int ui = 0;
    if (!S.next(0, cur)) return;
    f32x4 acc[2][2][4][2];
#pragma unroll
    for (int a = 0; a < 2; ++a)
#pragma unroll
        for (int b = 0; b < 2; ++b)
#pragma unroll
            for (int m = 0; m < 4; ++m)
#pragma unroll
                for (int n = 0; n < 2; ++n) acc[a][b][m][n] = (f32x4){0.f, 0.f, 0.f, 0.f};
    bf16x8 At[4][2], B0[2][2], B1[2][2];
    const char* cA = S.a_base(cur); const char* cB = S.b_base(cur);
    S.a_ready(cur);
    if constexpr (SP2) {
        PG8_STAGE(PG8_SB(0, 0), cB, voffB); PG8_STAGE(PG8_SB(0, 1), cB + hstep, voffB); PG8_STAGE(PG8_SA(0, 0), cA, voffA); PG8_STAGE(PG8_SA(0, 1), cA + hstep, voffA);
        if (wr == 1) PG8_BAR;
        PG8_WAIT_V(2); PG8_BAR;
        PG8_STAGE(PG8_SB(1, 0), cB + kstep, voffB); PG8_STAGE(PG8_SA(1, 0), cA + kstep, voffA); PG8_STAGE(PG8_SB(1, 1), cB + hstep + kstep, voffB);
        PG8_WAIT_V(6); PG8_BAR;
    } else {
        PG8_STAGE(PG8_SB(0, 0), cB, voffB); PG8_STAGE(PG8_SA(0, 0), cA, voffA); PG8_STAGE(PG8_SB(0, 1), cB + hstep, voffB); PG8_STAGE(PG8_SA(0, 1), cA + hstep, voffA);
        if (wr == 1) PG8_BAR;
        PG8_WAIT_V(4); PG8_BAR;
        PG8_STAGE(PG8_SB(1, 0), cB + kstep, voffB); PG8_STAGE(PG8_SA(1, 0), cA + kstep, voffA); PG8_STAGE(PG8_SB(1, 1), cB + hstep + kstep, voffB);
        PG8_WAIT_V(6); PG8_BAR;
    }
    for (;;) {
        const bool has_next = S.next(ui + 1, nxt);
        const char* nA = has_next ? S.a_base(nxt) : cA; const char* nB = has_next ? S.b_base(nxt) : cB;
        for (int t = 0; t < nt; t += 2) {
            const bool last = (t == nt - 2);
            const char* a1 = cA + (size_t)(t + 1) * kstep;
            const char* a2 = last ? nA : cA + (size_t)(t + 2) * kstep; const char* b2 = last ? nB : cB + (size_t)(t + 2) * kstep;
            const char* a3 = a2 + kstep; const char* b3 = b2 + kstep;
            if (last && has_next) S.a_ready(nxt);
            if constexpr (SP2) {
            PG8_LDB(B0, 0, 0); PG8_LDB(B1, 0, 1); PG8_SCHED; PG8_LDA(At, 0, 0); PG8_STAGE(PG8_SA(1, 1), a1 + hstep, voffA);
            PG8_WAIT_V(8); PG8_WAIT_L(0); PG8_BAR; PG8_MMA(0, 0, At, B0); PG8_MMA(0, 1, At, B1); PG8_BAR; PG8_SCHED;
            PG8_LDA(At, 0, 1); PG8_STAGE(PG8_SB(0, 0), b2, voffB); PG8_STAGE(PG8_SB(0, 1), b2 + hstep, voffB); PG8_STAGE(PG8_SA(0, 0), a2, voffA);
            PG8_WAIT_V(8); PG8_WAIT_L(0); PG8_BAR; PG8_MMA(1, 0, At, B0); PG8_MMA(1, 1, At, B1); PG8_BAR; PG8_SCHED;
            PG8_LDB(B0, 1, 0); PG8_LDB(B1, 1, 1); PG8_SCHED; PG8_LDA(At, 1, 0); PG8_STAGE(PG8_SA(0, 1), a2 + hstep, voffA);
            PG8_WAIT_V(8); PG8_WAIT_L(0); PG8_BAR; PG8_MMA(0, 0, At, B0); PG8_MMA(0, 1, At, B1); PG8_BAR; PG8_SCHED;
            PG8_LDA(At, 1, 1); PG8_STAGE(PG8_SB(1, 0), b3, voffB); PG8_STAGE(PG8_SB(1, 1), b3 + hstep, voffB); PG8_STAGE(PG8_SA(1, 0), a3, voffA);
            PG8_WAIT_V(8); PG8_WAIT_L(0); PG8_BAR; PG8_MMA(1, 0, At, B0); PG8_MMA(1, 1, At, B1); PG8_BAR; PG8_SCHED;
            } else {
            PG8_LDB(B0, 0, 0); PG8_SCHED; PG8_LDA(At, 0, 0); PG8_STAGE(PG8_SA(1, 1), a1 + hstep, voffA);
            PG8_WAIT_L(8); PG8_BAR; PG8_WAIT_L(0); PG8_MMA(0, 0, At, B0); PG8_BAR; PG8_SCHED;
            PG8_LDB(B1, 0, 1); PG8_STAGE(PG8_SB(0, 0), b2, voffB);
            PG8_BAR; PG8_WAIT_L(0); PG8_MMA(0, 1, At, B1); PG8_BAR;
            PG8_LDA(At, 0, 1); PG8_STAGE(PG8_SA(0, 0), a2, voffA);
            PG8_BAR; PG8_WAIT_L(0); PG8_MMA(1, 0, At, B0); PG8_BAR; PG8_SCHED;
            PG8_STAGE(PG8_SB(0, 1), b2 + hstep, voffB);
            PG8_WAIT_V(6); PG8_BAR; PG8_MMA(1, 1, At, B1); PG8_BAR;
            PG8_LDB(B0, 1, 0); PG8_SCHED; PG8_LDA(At, 1, 0); PG8_STAGE(PG8_SA(0, 1), a2 + hstep, voffA);
            PG8_WAIT_L(8); PG8_BAR; PG8_WAIT_L(0); PG8_MMA(0, 0, At, B0); PG8_BAR; PG8_SCHED;
            PG8_LDB(B1, 1, 1); PG8_STAGE(PG8_SB(1, 0), b3, voffB);
            PG8_BAR; PG8_WAIT_L(0); PG8_MMA(0, 1, At, B1); PG8_BAR;
            PG8_LDA(At, 1, 1); PG8_STAGE(PG8_SA(1, 0), a3, voffA);
            PG8_BAR; PG8_WAIT_L(0); PG8_MMA(1, 0, At, B0); PG8_BAR; PG8_SCHED;
            PG8_STAGE(PG8_SB(1, 1), b3 + hstep, voffB);
            PG8_WAIT_V(6); PG8_BAR; PG8_MMA(1, 1, At, B1); PG8_BAR;
            }
        }
        if constexpr (ALIGN_EPI) { if (wr == 0) PG8_BAR; }
        if constexpr (!Epi::AFTER_DRAIN) { E(acc, cur, wr, wc, fr, fq); S.done(cur); }
        if (!has_next) break;
#pragma unroll
        for (int a = 0; a < 2; ++a)
#pragma unroll
            for (int b = 0; b < 2; ++b)
#pragma unroll
                for (int m = 0; m < 4; ++m)
#pragma unroll
                    for (int n = 0; n < 2; ++n) acc[a][b][m][n] = (f32x4){0.f, 0.f, 0.f, 0.f};
        cur = nxt; cA = nA; cB = nB; ++ui;
        if constexpr (ALIGN_EPI) { if (wr == 1) PG8_BAR; }
    }
    PG8_WAIT_V(0);
    if constexpr (!ALIGN_EPI) { if (wr == 0) PG8_BAR; }
    PG8_BAR;
    if constexpr (Epi::AFTER_DRAIN) { E.fused(acc, cur, wr, wc, fr, fq, lds, wid, lane); S.done(cur); }
#undef PG8_SA
#undef PG8_SB
#undef PG8_STAGE
#undef PG8_LDA
#undef PG8_LDB
#undef PG8_MMA
#undef PG8_WAIT_V
#undef PG8_WAIT_L
#undef PG8_BAR
#undef PG8_SCHED
}
}

namespace attn_body {
using bf16=__hip_bfloat16;
using bf16x8=__attribute__((ext_vector_type(8)))short;
using s16x4=__attribute__((ext_vector_type(4)))short;
using f32x16=__attribute__((ext_vector_type(16)))float;
using u32x4=__attribute__((ext_vector_type(4)))unsigned;
constexpr int BATCH=4,SEQ=4096,D=64,QP=1024,KP=1024,VP=1024,OP=2048;
constexpr int NW=8,QBLK=32,QB=QBLK*NW,KVBLK=64,NQB=SEQ/QB;
constexpr int ATTN_UNIT_ROWS=QB;
__device__ __forceinline__ int crow(int r,int hi){return (r&3)+8*(r>>2)+4*hi;}
#define SBAR() __builtin_amdgcn_sched_barrier(0)
__device__ __forceinline__ void cmask(f32x16&p0,f32x16&p1,int jb,int qrel,int hi){
  const float NEG=-INFINITY; int kb=64*jb+4*hi;
  #pragma unroll
  for(int r=0;r<16;++r){int kv=kb+(r&3)+8*(r>>2); if(kv>qrel)p0[r]=NEG; if(kv+32>qrel)p1[r]=NEG;}
}

constexpr int NSLOT=3, SLOTB=8192;
constexpr int LDS_K=0, LDS_V=NSLOT*SLOTB, LDS_WS=2*NSLOT*SLOTB, LDS_OST=LDS_WS+NW*64*4, LDS_BYTES=LDS_OST+NW*4096;
constexpr float C2=0.125f*1.4426950408889634f;
__device__ __forceinline__ void glds16(const void*gsrc,unsigned lds_dst){unsigned keep;
  asm volatile("s_mov_b32 %0, m0\n\ts_mov_b32 m0, %2\n\ts_nop 0\n\tglobal_load_lds_dwordx4 %1, off\n\ts_mov_b32 m0, %0":"=&s"(keep):"v"(gsrc),"s"(lds_dst):"memory");}
__device__ __forceinline__ float max3f(float a,float b,float c){float r;asm("v_max3_f32 %0, %1, %2, %3":"=v"(r):"v"(a),"v"(b),"v"(c));return r;}
__device__ __forceinline__ float max2f(float a,float b){float r;asm("v_max_f32_e32 %0, %1, %2":"=v"(r):"v"(a),"v"(b));return r;}
__device__ __forceinline__ float fadd_s(float a,float b){float r;asm("v_add_f32_e32 %0, %1, %2":"=v"(r):"v"(a),"v"(b));return r;}
__device__ __forceinline__ float fsub_s(float a,float b){float r;asm("v_sub_f32_e32 %0, %1, %2":"=v"(r):"v"(a),"v"(b));return r;}
typedef float f32x2_t __attribute__((ext_vector_type(2))); typedef __bf16 bf16x2_t __attribute__((ext_vector_type(2)));
__device__ __forceinline__ unsigned cvtpk_s(float lo,float hi){f32x2_t v={lo,hi};bf16x2_t b=__builtin_convertvector(v,bf16x2_t);return __builtin_bit_cast(unsigned,b);}
#define WAIT_BAR(N) asm volatile("s_waitcnt vmcnt(" #N ") lgkmcnt(0)\n\ts_barrier":::"memory")

__device__ __forceinline__ void qkt(f32x16&p0,f32x16&p1,const char*Kslot,const bf16x8*qr,const f32x16&negm,int r32,int hi){
  const char*kb=Kslot+hi*1024+r32*16;
  #pragma unroll
  for(int d0=0;d0<4;++d0){
    const bf16x8 b0=*reinterpret_cast<const bf16x8*>(kb+d0*2048);
    const bf16x8 b1=*reinterpret_cast<const bf16x8*>(kb+d0*2048+512);
    if(d0==0){p0=__builtin_amdgcn_mfma_f32_32x32x16_bf16(b0,qr[0],negm,0,0,0);p1=__builtin_amdgcn_mfma_f32_32x32x16_bf16(b1,qr[0],negm,0,0,0);}
    else{p0=__builtin_amdgcn_mfma_f32_32x32x16_bf16(b0,qr[d0],p0,0,0,0);p1=__builtin_amdgcn_mfma_f32_32x32x16_bf16(b1,qr[d0],p1,0,0,0);}}
}
typedef __attribute__((address_space(3))) const char* lds_cptr;
typedef short v4i16_t __attribute__((ext_vector_type(4)));
__device__ __forceinline__ void kload8(bf16x8*kf,lds_cptr kp){
  kf[0]=*(const __attribute__((address_space(3))) bf16x8*)(kp);      kf[1]=*(const __attribute__((address_space(3))) bf16x8*)(kp+512);
  kf[2]=*(const __attribute__((address_space(3))) bf16x8*)(kp+2048); kf[3]=*(const __attribute__((address_space(3))) bf16x8*)(kp+2560);
  kf[4]=*(const __attribute__((address_space(3))) bf16x8*)(kp+4096); kf[5]=*(const __attribute__((address_space(3))) bf16x8*)(kp+4608);
  kf[6]=*(const __attribute__((address_space(3))) bf16x8*)(kp+6144); kf[7]=*(const __attribute__((address_space(3))) bf16x8*)(kp+6656);
}
__device__ __forceinline__ void kload2(bf16x8*kf,lds_cptr kp,int j){ kf[2*j]=*(const __attribute__((address_space(3))) bf16x8*)(kp+j*2048); kf[2*j+1]=*(const __attribute__((address_space(3))) bf16x8*)(kp+j*2048+512); }
__device__ __forceinline__ s16x4 vtr(lds_cptr p){ return __builtin_bit_cast(s16x4,__builtin_amdgcn_ds_read_tr16_b64_v4i16((__attribute__((address_space(3))) v4i16_t*)p)); }
__device__ __forceinline__ float rowmax(const f32x16&p0,const f32x16&p1){
  float a=max3f(p0[0],p0[1],p1[0]),b=max3f(p0[2],p0[3],p1[1]);a=max3f(a,p1[2],p1[3]);
  #pragma unroll
  for(int r=4;r<16;r+=4){a=max3f(a,p0[r],p0[r+1]);b=max3f(b,p0[r+2],p0[r+3]);a=max3f(a,p1[r],p1[r+1]);b=max3f(b,p1[r+2],p1[r+3]);}
  const float m=max2f(a,b);
  auto rr=__builtin_amdgcn_permlane32_swap(__float_as_uint(m),__float_as_uint(m),false,false);
  return max2f(__uint_as_float(rr[0]),__uint_as_float(rr[1]));
}
__device__ __forceinline__ void pv(f32x16*o,int vb,bf16x8 pa0,bf16x8 pa1,bf16x8 pa2,bf16x8 pa3){
  #pragma unroll
  for(int d0=0;d0<2;++d0){s16x4 lo[4],hi[4];
    #pragma unroll
    for(int ks=0;ks<4;++ks){
      asm volatile("ds_read_b64_tr_b16 %0,%1 offset:%c2":"=&v"(lo[ks]):"v"(vb),"i"(d0*4096+ks*1024):"memory");
      asm volatile("ds_read_b64_tr_b16 %0,%1 offset:%c2":"=&v"(hi[ks]):"v"(vb),"i"(d0*4096+ks*1024+512):"memory");}
    asm volatile("s_waitcnt lgkmcnt(0)":::"memory");SBAR();
    #define PK(k) (bf16x8){lo[k][0],lo[k][1],lo[k][2],lo[k][3],hi[k][0],hi[k][1],hi[k][2],hi[k][3]}
    o[d0]=__builtin_amdgcn_mfma_f32_32x32x16_bf16(pa0,PK(0),o[d0],0,0,0);
    o[d0]=__builtin_amdgcn_mfma_f32_32x32x16_bf16(pa1,PK(1),o[d0],0,0,0);
    o[d0]=__builtin_amdgcn_mfma_f32_32x32x16_bf16(pa2,PK(2),o[d0],0,0,0);
    o[d0]=__builtin_amdgcn_mfma_f32_32x32x16_bf16(pa3,PK(3),o[d0],0,0,0);
    #undef PK
  }
}

#ifndef ATTN_STORE16
#define ATTN_STORE16(p,v) (*(u32x4*)(p)=(v))
#endif
template<int THRL> __device__ __forceinline__ void attn_unit(int b,int qb,const bf16*Q,const bf16*__restrict__ K,const bf16*__restrict__ V,bf16*O,char*shm){
  const int tid=threadIdx.x,lane=tid&63,r32=lane&31,hi=lane>>5; const int wid=__builtin_amdgcn_readfirstlane(tid>>6);
  const long rowbase=(long)b*SEQ; const int q0=qb*QB;
  const bf16*Qw=Q+(rowbase+q0+wid*QBLK)*QP;
  const bf16*Kh=K+rowbase*KP,*Vh=V+rowbase*VP;
  const unsigned lds0=(unsigned)(uintptr_t)shm;
  float*wsf=(float*)(shm+LDS_WS)+wid*64;
  const bf16*ksrc=Kh+(long)lane*KP+wid*8;
  const bf16*vsrc=Vh+(long)(16*(wid&3)+(lane>>2))*VP+(wid>>2)*32+(lane&3)*8;
  const unsigned kdst=lds0+LDS_K+wid*1024, vdst=lds0+LDS_V+wid*1024;
  #define DMA_K(t,slot) glds16(ksrc+(long)(t)*KVBLK*KP,(unsigned)__builtin_amdgcn_readfirstlane(kdst+(slot)))
  #define DMA_V(t,slot) glds16(vsrc+(long)(t)*KVBLK*VP,(unsigned)__builtin_amdgcn_readfirstlane(vdst+(slot)))
  const int vb0=(int)(lds0+LDS_V)+((lane>>4)&1)*32+(lane&3)*8+(4*hi+((lane&15)>>2))*64;
  const char*Kbase=shm+LDS_K; bf16x8 kf[8];
  const lds_cptr shm3=(lds_cptr)shm; const lds_cptr kp0=shm3+LDS_K+hi*1024+r32*16; const lds_cptr vp0=shm3+LDS_V+((lane>>4)&1)*32+(lane&3)*8+(4*hi+((lane&15)>>2))*64;
  const int NT=(q0+QB)/KVBLK;
  DMA_K(0,0);DMA_V(0,0);DMA_K(1,SLOTB);
  bf16x8 qr[4];
  #pragma unroll
  for(int d0=0;d0<4;++d0)qr[d0]=*reinterpret_cast<const bf16x8*>(&Qw[(long)r32*QP+d0*16+hi*8]);
  float mhat=0.f,l_reg=0.f;f32x16 o[2];o[0]=f32x16{};o[1]=f32x16{};f32x16 negm=f32x16{};asm volatile("":"+v"(negm));
  const int qrel=wid*QBLK+r32;
  #define CMASK(P0,P1,t) do{int jb_=(t)-(NT-4); if(jb_>=0)cmask(P0,P1,jb_,qrel,hi);}while(0)
  bool resc=false;
  #define START(P0,P1) do{ const float rm=rowmax(P0,P1); resc=false; \
    { const float dl=rm; mhat=fadd_s(mhat,dl); \
      _Pragma("unroll") for(int r=0;r<16;++r){P0[r]=fsub_s(P0[r],dl);P1[r]=fsub_s(P1[r],dl);} \
      _Pragma("unroll") for(int r=0;r<16;++r)negm[r]=-mhat; asm volatile("":"+v"(negm)); } \
    _Pragma("unroll") for(int r=0;r<16;++r)P0[r]=__builtin_amdgcn_exp2f(P0[r]); }while(0)
  #define RESC() do{ if(resc){ asm volatile("s_waitcnt lgkmcnt(0)":::"memory"); \
      _Pragma("unroll") for(int d_=0;d_<2;++d_) _Pragma("unroll") for(int r=0;r<16;++r)o[d_][r]*=wsf[crow(r,hi)]; } }while(0)
  f32x16 pA0,pA1,pB0,pB1;
  int sl_prev=0,sl_cur=0,sl_next=SLOTB;
  #define ROT() do{sl_prev=sl_cur;sl_cur=sl_next;sl_next=(sl_next==(NSLOT-1)*SLOTB)?0:sl_next+SLOTB;}while(0)
  DMA_K(2,2*SLOTB);
  WAIT_BAR(3);
  qkt(pA0,pA1,Kbase,qr,negm,r32,hi);asm volatile("s_nop 15\n\ts_nop 7":"+v"(pA0),"+v"(pA1));CMASK(pA0,pA1,0);
  START(pA0,pA1);
  _Pragma("unroll") for(int r=0;r<16;++r)pA1[r]=__builtin_amdgcn_exp2f(pA1[r]);
  WAIT_BAR(0);
  DMA_K(3,0);DMA_V(1,SLOTB);
  ROT();
  kload8(kf,kp0+sl_cur);
  WAIT_BAR(2);
  s16x4 vlo[8],vhi[8]; u32x4 pw0,pw1,pw2,pw3;
  #define PKW(P,B) cvtpk_s(P[B],P[B+1])
  #define PAF(k) __builtin_bit_cast(bf16x8,pw##k)
  #define VFR(i) (bf16x8){vlo[i][0],vlo[i][1],vlo[i][2],vlo[i][3],vhi[i][0],vhi[i][1],vhi[i][2],vhi[i][3]}
  #define PIN(x) asm volatile("":"+v"(x))
  #define MX3(a,b,c) __builtin_fmaxf(__builtin_fmaxf((a),(b)),(c))
  #define GAPA(MF,A0,A1,A2,A3,W0,W1,PW) do{ MF; sacc+=A0; sacc+=A1; sacc+=A2; sacc+=A3; PIN(sacc); W0; W1; PIN(PW); SBAR(); }while(0)
  #define EX(v) __builtin_amdgcn_exp2f(v)
  #define GAPB(MF,X,B) do{ MF; X[B]=EX(X[B]); X[B+1]=EX(X[B+1]); X[B+2]=EX(X[B+2]); X[B+3]=EX(X[B+3]); PIN(X); SBAR(); }while(0)
  #define VRD(i) do{ vlo[i]=vtr(vp_+(((i)>>2)*4096+((i)&3)*1024)); vhi[i]=vtr(vp_+(((i)>>2)*4096+((i)&3)*1024+512)); }while(0)
  #define KRD(G,j) do{ if(G){ kload2(kf,kp0+sl_next,j); SBAR(); } }while(0)
  #define STEP(C0,C1,P0,P1,t,GK,GV,GL) do{ SBAR(); \
    const lds_cptr vp_=vp0+sl_prev; \
    VRD(0); SBAR(); float sacc=(P0[0]+P0[1]); \
    GAPA(C0=__builtin_amdgcn_mfma_f32_32x32x16_bf16(kf[0],qr[0],negm,0,0,0), P0[2],P0[3],P0[4],P0[5],     pw0[0]=PKW(P0,0), pw0[1]=PKW(P0,2), pw0); \
    VRD(4); SBAR(); GAPA(C1=__builtin_amdgcn_mfma_f32_32x32x16_bf16(kf[1],qr[0],negm,0,0,0), P0[6],P0[7],P0[8],P0[9],     pw0[2]=PKW(P0,4), pw0[3]=PKW(P0,6), pw0); \
    VRD(1); SBAR(); GAPA(C0=__builtin_amdgcn_mfma_f32_32x32x16_bf16(kf[2],qr[1],C0,0,0,0),   P0[10],P0[11],P0[12],P0[13], pw1[0]=PKW(P0,8), pw1[1]=PKW(P0,10), pw1); \
    VRD(5); SBAR(); GAPA(C1=__builtin_amdgcn_mfma_f32_32x32x16_bf16(kf[3],qr[1],C1,0,0,0),   P0[14],P0[15],P1[0],P1[1],   pw1[2]=PKW(P0,12),pw1[3]=PKW(P0,14), pw1); \
    VRD(2); SBAR(); GAPA(C0=__builtin_amdgcn_mfma_f32_32x32x16_bf16(kf[4],qr[2],C0,0,0,0),   P1[2],P1[3],P1[4],P1[5],     pw2[0]=PKW(P1,0), pw2[1]=PKW(P1,2), pw2); \
    VRD(6); SBAR(); GAPA(C1=__builtin_amdgcn_mfma_f32_32x32x16_bf16(kf[5],qr[2],C1,0,0,0),   P1[6],P1[7],P1[8],P1[9],     pw2[2]=PKW(P1,4), pw2[3]=PKW(P1,6), pw2); \
    VRD(3); SBAR(); GAPA(C0=__builtin_amdgcn_mfma_f32_32x32x16_bf16(kf[6],qr[3],C0,0,0,0),   P1[10],P1[11],P1[12],P1[13], pw3[0]=PKW(P1,8), pw3[1]=PKW(P1,10), pw3); \
    VRD(7); SBAR(); GAPA(C1=__builtin_amdgcn_mfma_f32_32x32x16_bf16(kf[7],qr[3],C1,0,0,0),   P1[14],P1[15],0.f,0.f,       pw3[2]=PKW(P1,12),pw3[3]=PKW(P1,14), pw3); \
    l_reg+=sacc; \
    if(GK){DMA_K((t)+3,sl_cur);} if(GV){DMA_V((t)+1,sl_next);} \
    CMASK(C0,C1,t); \
    { float a=MX3(C0[0],C0[1],C1[0]),b=MX3(C0[2],C0[3],C1[1]); a=MX3(a,C1[2],C1[3]); \
      _Pragma("unroll") for(int r=4;r<16;r+=4){a=MX3(a,C0[r],C0[r+1]);b=MX3(b,C0[r+2],C0[r+3]);a=MX3(a,C1[r],C1[r+1]);b=MX3(b,C1[r+2],C1[r+3]);} \
      float rm=__builtin_fmaxf(a,b); { auto rr=__builtin_amdgcn_permlane32_swap(__float_as_uint(rm),__float_as_uint(rm),false,false); rm=__builtin_fmaxf(__uint_as_float(rr[0]),__uint_as_float(rr[1])); } \
      resc=false; \
      if(__builtin_expect(__any(rm>(float)THRL),0)){ const float dl=__builtin_fmaxf(rm,0.f); mhat+=dl; \
        _Pragma("unroll") for(int r=0;r<16;++r){C0[r]-=dl;C1[r]-=dl;} \
        _Pragma("unroll") for(int r=0;r<16;++r)negm[r]=-mhat; asm volatile("":"+v"(negm)); \
        const float f=__builtin_amdgcn_exp2f(-dl); l_reg*=f; if(hi==0)wsf[r32]=f; resc=true; } } \
    SBAR(); \
    GAPB(o[0]=__builtin_amdgcn_mfma_f32_32x32x16_bf16(PAF(0),VFR(0),o[0],0,0,0), C0,0); \
    GAPB(o[1]=__builtin_amdgcn_mfma_f32_32x32x16_bf16(PAF(0),VFR(4),o[1],0,0,0), C0,4); \
    KRD(GL,0); GAPB(o[0]=__builtin_amdgcn_mfma_f32_32x32x16_bf16(PAF(1),VFR(1),o[0],0,0,0), C0,8); \
    KRD(GL,1); GAPB(o[1]=__builtin_amdgcn_mfma_f32_32x32x16_bf16(PAF(1),VFR(5),o[1],0,0,0), C0,12); \
    KRD(GL,2); GAPB(o[0]=__builtin_amdgcn_mfma_f32_32x32x16_bf16(PAF(2),VFR(2),o[0],0,0,0), C1,0); \
    KRD(GL,3); GAPB(o[1]=__builtin_amdgcn_mfma_f32_32x32x16_bf16(PAF(2),VFR(6),o[1],0,0,0), C1,4); \
    GAPB(o[0]=__builtin_amdgcn_mfma_f32_32x32x16_bf16(PAF(3),VFR(3),o[0],0,0,0), C1,8); \
    GAPB(o[1]=__builtin_amdgcn_mfma_f32_32x32x16_bf16(PAF(3),VFR(7),o[1],0,0,0), C1,12); \
    }while(0)
  int t=1;
  #undef CMASK
  #define CMASK(P0,P1,t) do{}while(0)
  for(;t+5<NT;t+=2){
    STEP(pB0,pB1,pA0,pA1,t,true,true,true);     WAIT_BAR(2); RESC(); ROT();
    STEP(pA0,pA1,pB0,pB1,t+1,true,true,true);   WAIT_BAR(2); RESC(); ROT();
  }
  #undef CMASK
  #define CMASK(P0,P1,t) do{int jb_=(t)-(NT-4); if(jb_>=0)cmask(P0,P1,jb_,qrel,hi);}while(0)
  #define ENDW(tt) do{ if((tt)+3<NT){WAIT_BAR(2);} else if((tt)+2<NT){WAIT_BAR(1);} else {WAIT_BAR(0);} }while(0)
  for(;t+1<NT;t+=2){
    STEP(pB0,pB1,pA0,pA1,t,(t+3<NT),(t+1<NT),(t+1<NT));       ENDW(t);   RESC(); ROT();
    STEP(pA0,pA1,pB0,pB1,t+1,(t+4<NT),(t+2<NT),(t+2<NT));     ENDW(t+1); RESC(); ROT();
  }
  STEP(pB0,pB1,pA0,pA1,NT-1,false,false,false); RESC();
  { float sacc=pB0[0]+pB0[1]; _Pragma("unroll") for(int r=2;r<16;++r)sacc+=pB0[r]; _Pragma("unroll") for(int r=0;r<16;++r)sacc+=pB1[r]; l_reg+=sacc;
    pw0=(u32x4){PKW(pB0,0),PKW(pB0,2),PKW(pB0,4),PKW(pB0,6)};pw1=(u32x4){PKW(pB0,8),PKW(pB0,10),PKW(pB0,12),PKW(pB0,14)};pw2=(u32x4){PKW(pB1,0),PKW(pB1,2),PKW(pB1,4),PKW(pB1,6)};pw3=(u32x4){PKW(pB1,8),PKW(pB1,10),PKW(pB1,12),PKW(pB1,14)};
    SBAR(); pv(o,vb0+sl_cur,PAF(0),PAF(1),PAF(2),PAF(3)); }
  #undef PKW
  #undef PAF
  #undef VFR
  #undef PIN
  #undef MX3
  #undef GAPA
  #undef GAPB
  #undef EX
  #undef VRD
  #undef KRD
  #undef STEP
  #undef ENDW
  {auto rr=__builtin_amdgcn_permlane32_swap(__float_as_uint(l_reg),__float_as_uint(l_reg),false,false);l_reg=__uint_as_float(rr[0])+__uint_as_float(rr[1]);}
  if(hi==0)wsf[32+r32]=l_reg;asm volatile("s_waitcnt lgkmcnt(0)":::"memory");
  float rli[16];
  #pragma unroll
  for(int r=0;r<16;++r)rli[r]=__builtin_amdgcn_rcpf(wsf[32+crow(r,hi)]);
  bf16*Ow=O+(rowbase+q0+wid*QBLK)*OP;
  { bf16*stg=(bf16*)(shm+LDS_OST)+wid*2048;
    #pragma unroll
    for(int r=0;r<16;++r){const int orow=crow(r,hi);
      #pragma unroll
      for(int d0=0;d0<2;++d0)stg[orow*64+d0*32+r32]=__float2bfloat16(o[d0][r]*rli[r]);}
    asm volatile("s_waitcnt lgkmcnt(0)":::"memory");
    #pragma unroll
    for(int i=0;i<4;++i){const int row=i*8+(lane>>3),ch=lane&7; const u32x4 v=*(const u32x4*)(stg+row*64+ch*8); ATTN_STORE16(Ow+(long)row*OP+ch*8,v);} }
  asm volatile("s_waitcnt lgkmcnt(0)\n\ts_barrier":::"memory");
  #undef DMA_K
  #undef DMA_V
  #undef CMASK
  #undef START
  #undef RESC
  #undef ROT
}
constexpr int ATTN_LDS_BYTES=LDS_BYTES;
struct AttnUnit { int bh; int qb; };
#undef SBAR
#undef WAIT_BAR
}

constexpr int NWAVES = 8;
constexpr int BATCH = 4, T = 4096, D = 1024, M = BATCH * T;
constexpr int NE = 32, FF = 512, NGRP = 4, EPG = 8;
constexpr int MAXROWS = 40960;
constexpr float RMS_EPS = 1e-6f, GN_EPS = 64e-5f, SUBLN_EPS = 1e-5f;
constexpr float LAMBDA_INIT1 = 0.35550906759f;

constexpr size_t MiB = 1u << 20;
constexpr size_t WS_CTL = 0, CTL_ZERO_BYTES = 1 * MiB;
constexpr size_t WS_MOD = 1 * MiB;
constexpr size_t WS_WRKV = 2 * MiB, WS_WL1 = 8 * MiB, WS_WL2 = 9 * MiB, WS_WO0 = 11 * MiB, WS_WQKV = 13 * MiB, WS_WO1 = 19 * MiB;
constexpr size_t WS_ROUTE = 21 * MiB;
constexpr size_t WS_MOEGU = 32 * MiB, WS_MOED = 96 * MiB;
constexpr size_t WS_XA = 128 * MiB;
constexpr size_t WS_R = 192 * MiB;
constexpr size_t WS_VIEWS = WS_R, WS_H2 = WS_R + 96 * MiB, WS_A2 = WS_R + 160 * MiB, WS_RKV = WS_R + 168 * MiB;
constexpr size_t WS_LOGW = WS_R, WS_ASIG = WS_R + 64 * MiB, WS_GG = WS_R + 96 * MiB, WS_YG = WS_R + 128 * MiB;
constexpr size_t WS_H2N = WS_R, WS_XS = WS_R + 32 * MiB, WS_HS = WS_R + 112 * MiB, WS_Y = WS_R + 152 * MiB;
constexpr size_t WS_HQ = WS_R, WS_HK = WS_R + 32 * MiB, WS_QKV = WS_R + 64 * MiB, WS_OC = WS_R + 160 * MiB, WS_ON = WS_R + 224 * MiB;
constexpr size_t WS_QE = 32 * MiB, WS_MCT = 64 * MiB, WS_SC = 96 * MiB, WS_Y0 = 128 * MiB, WS_NC = WS_R + 264 * MiB, WS_RK = WS_R + 296 * MiB;
constexpr size_t WS_END = WS_R + 297 * MiB;
static_assert(WS_RKV + 96 * MiB <= WS_END && WS_Y + 80 * MiB <= WS_END && WS_ON + 32 * MiB <= WS_END, "d_ws map");
constexpr int CW_BAR = 4096;
constexpr int CW_CNT = 8192;

constexpr int RING_OFF = 0, RING_BYTES = 131072;
constexpr int LDSCTL_OFF = RING_BYTES, MISC_OFF = LDSCTL_OFF + 320;
constexpr int LDS_BYTES = 147456;

#define GAS __attribute__((address_space(1)))
#define LAS __attribute__((address_space(3)))
typedef unsigned short bf16;
typedef unsigned v4u __attribute__((ext_vector_type(4)));
typedef unsigned v2u __attribute__((ext_vector_type(2)));
typedef float f32x4 __attribute__((ext_vector_type(4)));
typedef short bf16x8 __attribute__((ext_vector_type(8)));
typedef GAS unsigned gu32;
#define RLX_AGENT __ATOMIC_RELAXED, __HIP_MEMORY_SCOPE_AGENT
#define LDS_WAIT() asm volatile("s_waitcnt lgkmcnt(0)" ::: "memory")
#define VM_WAIT() asm volatile("s_waitcnt vmcnt(0)" ::: "memory")
__device__ __forceinline__ unsigned pk2(float lo, float hi) { return pg8::cvt_pk_bf16(lo, hi); }
__device__ __forceinline__ float bflo(unsigned w) { return __uint_as_float(w << 16); }
__device__ __forceinline__ float bfhi(unsigned w) { return __uint_as_float(w & 0xffff0000u); }

#define XB_TMO      128
#define XB_XCNT(j)  (256  + 64 * (j))
#define XB_XSUB(j)  (1280 + 64 * (j))
#define XB_XGEN(j)  (2304 + 64 * (j))
#define XB_TOP      3328
#define XB_TOPGEN   3392
#define XCD_BAR_WORDS 3456
#define XB_SPIN_CAP (1u << 18)

__device__ __forceinline__ unsigned xb_ld(unsigned* p)              { return __hip_atomic_load(p, __ATOMIC_RELAXED, __HIP_MEMORY_SCOPE_AGENT); }
__device__ __forceinline__ unsigned xb_add(unsigned* p, unsigned v) { return __hip_atomic_fetch_add(p, v, __ATOMIC_RELAXED, __HIP_MEMORY_SCOPE_AGENT); }
__device__ __forceinline__ unsigned xb_xcc_id() { return (unsigned)__builtin_amdgcn_s_getreg((3 << 11) | 20) & 0xFu; }
#define XB_SPIN(cond, bar) do { unsigned _sp = 0; while (cond) { __builtin_amdgcn_s_sleep(1); \
    if ((++_sp & 255u) == 0u) { if (xb_ld(&(bar)[XB_TMO])) break; if (_sp > XB_SPIN_CAP) { atomicAdd(&(bar)[XB_TMO], 1u); break; } } } } while (0)

struct XcdBarrier {
    unsigned* bar; unsigned x;
    volatile LAS unsigned* st;
};

__device__ __forceinline__ XcdBarrier xcd_barrier_post(unsigned* bar, volatile LAS unsigned* st) {
    XcdBarrier b; b.bar = bar; b.x = xb_xcc_id(); b.st = st;
    if (threadIdx.x == 0) (void)xb_add(&bar[XB_XCNT(b.x)], 1u);
    return b;
}
__device__ __forceinline__ void xcd_barrier_complete(unsigned* bar, unsigned x, unsigned& nloc, unsigned& nx) {
    const unsigned G = gridDim.x * gridDim.y * gridDim.z;
    unsigned sum, cnt, mine, sp = 0u;
    for (;;) {
        sum = 0u; cnt = 0u; mine = 0u;
#pragma unroll
        for (unsigned j = 0; j < 16; ++j) { const unsigned c = xb_ld(&bar[XB_XCNT(j)]); sum += c; cnt += (c > 0u) ? 1u : 0u; mine = (j == x) ? c : mine; }
        if (sum == G) break;
        __builtin_amdgcn_s_sleep(1);
        if ((++sp & 255u) == 0u) { if (xb_ld(&bar[XB_TMO])) break; if (sp > XB_SPIN_CAP) { atomicAdd(&bar[XB_TMO], 1u); break; } }
    }
    nloc = mine > 0u ? mine : 1u; nx = cnt > 0u ? cnt : 1u;
}

__device__ __forceinline__ void xcd_barrier(const XcdBarrier& b) {
    asm volatile("s_waitcnt vmcnt(0)" ::: "memory");
    __syncthreads();
    if (threadIdx.x == 0) {
        unsigned* bar = b.bar;
        __builtin_amdgcn_s_waitcnt(0);
        unsigned nloc = b.st[0], nx = b.st[1];
        if (nloc == 0u) { xcd_barrier_complete(bar, b.x, nloc, nx); b.st[0] = nloc; b.st[1] = nx; }
        const unsigned old = xb_add(&bar[XB_XSUB(b.x)], 1u);
        const unsigned gen = old / nloc;
        if (old + 1u == (gen + 1u) * nloc) {
            __builtin_amdgcn_fence(__ATOMIC_RELEASE, "agent");
            asm volatile("s_waitcnt vmcnt(0)" ::: "memory");
            const unsigned og = xb_add(&bar[XB_TOP], 1u);
            const unsigned tg = og / nx;
            if (og + 1u == (tg + 1u) * nx) xb_add(&bar[XB_TOPGEN], 1u);
            else XB_SPIN(xb_ld(&bar[XB_TOPGEN]) == tg, bar);
            __builtin_amdgcn_fence(__ATOMIC_ACQUIRE, "agent");
            xb_add(&bar[XB_XGEN(b.x)], 1u);
            asm volatile("s_waitcnt vmcnt(0)" ::: "memory");
        } else {
            XB_SPIN(xb_ld(&bar[XB_XGEN(b.x)]) == gen, bar);
            __builtin_amdgcn_fence(__ATOMIC_ACQUIRE, "agent");
            asm volatile("s_waitcnt vmcnt(0)" ::: "memory");
        }
    }
    __syncthreads();
}


struct Frame {
    LAS unsigned char* lds;
    volatile LAS unsigned* MISC;
    gu32* ctl;
    unsigned char* ws;
    const float* const* in;
    float* out;
    int tid, lane, wave, vcu, G;
};
__device__ __forceinline__ int lane_id() { int l = threadIdx.x & 63; asm volatile("" : "+v"(l)); return l; }
__device__ __forceinline__ float wave_sum(float v) {
#pragma unroll
    for (int o = 1; o < 64; o <<= 1) v += __shfl_xor(v, o);
    return v;
}
__device__ __forceinline__ void transpose_item(const float* W, int ldw, int k0, int n0, bf16* WT, int ldo, int orow0, int ok0, const float* kscale, LAS float* scr, int lane) {
#pragma unroll 8
    for (int i = 0; i < 32; ++i) { const int kk = 2 * i + (lane >> 5); float v = W[(size_t)(k0 + kk) * ldw + n0 + (lane & 31)]; if (kscale) v *= kscale[k0 + kk]; scr[kk * 33 + (lane & 31)] = v; }
    LDS_WAIT(); asm volatile("" ::: "memory");
    const int c = lane & 7;
#pragma unroll
    for (int j = 0; j < 4; ++j) { const int n = (lane >> 3) + 8 * j; const LAS float* s = scr + (8 * c) * 33 + n;
        v4u o; o.x = pk2(s[0 * 33], s[1 * 33]); o.y = pk2(s[2 * 33], s[3 * 33]); o.z = pk2(s[4 * 33], s[5 * 33]); o.w = pk2(s[6 * 33], s[7 * 33]);
        *(GAS v4u*)(WT + (size_t)(orow0 + n) * ldo + ok0 + k0 + 8 * c) = o; }
    LDS_WAIT(); asm volatile("" ::: "memory");
}
__device__ __forceinline__ void transpose_mat(Frame& F, const float* W, int K, int N, bf16* WT, int ldo, int row_off, int ok0, const float* kscale, int gw, int NGW) {
    LAS float* scr = (LAS float*)(F.lds + RING_OFF + F.wave * 16384);
    const int nblk = N / 32, items = (K / 64) * nblk;
    for (int it = gw; it < items; it += NGW) { const int kb = it / nblk, nb = it % nblk; transpose_item(W, N, 64 * kb, 32 * nb, WT, ldo, row_off + 32 * nb, ok0, kscale, scr, F.lane); }
}

__device__ __forceinline__ void p0_mod(Frame& F) {
    LAS float* cact = (LAS float*)(F.lds + RING_OFF);
    LAS float* red = cact + 4096;
    const float* c = F.in[1];
    for (int i = F.tid; i < 4096; i += 512) { const float v = c[i]; cact[i] = v / (1.0f + __expf(-v)); }
    __syncthreads();
    float* modbase = (float*)(F.ws + WS_MOD);
    for (int it = blockIdx.x; it < 224; it += F.G) {
        const float* W; const float* bias; float* outp; int N, cc;
        if (it < 96) { W = F.in[2]; bias = F.in[3]; outp = modbase; N = 6144; cc = it; }
        else if (it < 192) { W = F.in[2] + (size_t)1024 * 6144; bias = F.in[3] + 6144; outp = modbase + 4 * 6144; N = 6144; cc = it - 96; }
        else { W = F.in[22]; bias = F.in[23]; outp = modbase + 8 * 6144; N = 2048; cc = it - 192; }
        const int kg = F.tid >> 4, cq = F.tid & 15, col = cc * 64 + cq * 4;
        f32x4 a0 = {0, 0, 0, 0}, a1 = a0, a2 = a0, a3 = a0;
#pragma unroll 4
        for (int kk = 0; kk < 32; ++kk) { const int k = kg * 32 + kk; const f32x4 w = *(const f32x4*)(W + (size_t)k * N + col);
            a0 += w * cact[k]; a1 += w * cact[1024 + k]; a2 += w * cact[2048 + k]; a3 += w * cact[3072 + k]; }
        LAS f32x4* rp = (LAS f32x4*)red + (kg * 16 + cq) * 4;
        rp[0] = a0; rp[1] = a1; rp[2] = a2; rp[3] = a3;
        __syncthreads();
        if (F.tid < 256) { const int b = F.tid >> 6, cl = F.tid & 63, cq2 = cl >> 2, j = cl & 3; float s = 0.f;
            for (int g = 0; g < 32; ++g) s += red[((g * 16 + cq2) * 4 + b) * 4 + j];
            outp[(size_t)b * N + cc * 64 + cl] = s + bias[cc * 64 + cl]; }
        __syncthreads();
    }
}
__device__ __forceinline__ void p0_weights(Frame& F) {
    const int gw = F.vcu * NWAVES + F.wave, NGW = F.G * NWAVES;
    bf16* Wrkv = (bf16*)(F.ws + WS_WRKV); bf16* Wl1 = (bf16*)(F.ws + WS_WL1); bf16* Wl2 = (bf16*)(F.ws + WS_WL2);
    bf16* Wo0 = (bf16*)(F.ws + WS_WO0); bf16* Wqkv = (bf16*)(F.ws + WS_WQKV); bf16* Wo1 = (bf16*)(F.ws + WS_WO1);
    for (int z = 0; z < 3; ++z) transpose_mat(F, F.in[7] + (size_t)z * D * D, D, D, Wrkv + (size_t)z * D * D, D, 0, 0, nullptr, gw, NGW);
    transpose_mat(F, F.in[21], D, D, Wo0, D, 0, 0, nullptr, gw, NGW);
    transpose_mat(F, F.in[26], D, D, Wqkv, D, 0, 0, nullptr, gw, NGW);
    transpose_mat(F, F.in[25], D, 2 * D, Wqkv, D, D, 0, nullptr, gw, NGW);
    transpose_mat(F, F.in[32], D, D, Wo1, D, 0, 0, nullptr, gw, NGW);
    const float* mu = F.in[6];
    transpose_mat(F, F.in[9], D, 64, Wl1, 2048, 0, 0, nullptr, gw, NGW);    transpose_mat(F, F.in[9], D, 64, Wl1, 2048, 0, 1024, mu + 3 * D, gw, NGW);
    transpose_mat(F, F.in[12], D, 64, Wl1, 2048, 64, 0, nullptr, gw, NGW);  transpose_mat(F, F.in[12], D, 64, Wl1, 2048, 64, 1024, mu + 4 * D, gw, NGW);
    transpose_mat(F, F.in[14], D, 128, Wl1, 2048, 128, 0, nullptr, gw, NGW); transpose_mat(F, F.in[14], D, 128, Wl1, 2048, 128, 1024, mu + 5 * D, gw, NGW);
    const float* w2 = F.in[10]; const float* a2 = F.in[13]; const float* g2 = F.in[15];
    for (int idx = (blockIdx.x * 512 + F.tid); idx < 3072 * 256; idx += F.G * 512) {
        const int k = idx / 3072, n = idx % 3072; float v = 0.f;
        if (n < 1024) { if (k < 64) v = w2[(size_t)k * 1024 + n]; }
        else if (n < 2048) { if (k >= 64 && k < 128) v = a2[(size_t)(k - 64) * 1024 + (n - 1024)]; }
        else { if (k >= 128) v = g2[(size_t)(k - 128) * 1024 + (n - 2048)]; }
        Wl2[(size_t)n * 256 + k] = (bf16)(pk2(v, 0.f) & 0xffffu);
    }
}
__device__ __forceinline__ void moe_weights(Frame& F, int l) {
    const int gw = F.vcu * NWAVES + F.wave, NGW = F.G * NWAVES;
    LAS float* scr = (LAS float*)(F.lds + RING_OFF + F.wave * 16384);
    bf16* GU = (bf16*)(F.ws + WS_MOEGU); bf16* DW = (bf16*)(F.ws + WS_MOED);
    const float* wg = F.in[35] + (size_t)l * NE * D * FF; const float* wu = F.in[36] + (size_t)l * NE * D * FF; const float* wd = F.in[37] + (size_t)l * NE * FF * D;
    for (int it = gw; it < NE * 768; it += NGW) {
        const int e = it / 768, r = it % 768;
        if (r < 512) { const int up = r >> 8, q = r & 255, kb = q >> 4, nb = q & 15, n0 = 32 * nb;
            const float* W = (up ? wu : wg) + (size_t)e * D * FF;
            transpose_item(W, FF, 64 * kb, n0, GU + (size_t)e * 1024 * 1024, 1024, 256 * (n0 >> 7) + (n0 & 127) + (up ? 128 : 0), 0, nullptr, scr, F.lane); }
        else { const int q = r - 512, kb = q >> 5, nb = q & 31;
            transpose_item(wd + (size_t)e * FF * D, D, 64 * kb, 32 * nb, DW + (size_t)e * 1024 * 512, 512, 32 * nb, 0, nullptr, scr, F.lane); }
    }
}

__device__ __forceinline__ void p1_norm_views(Frame& F) {
    LAS float* hrow = (LAS float*)(F.lds + RING_OFF);
    const float* x = F.in[0]; const float* g = F.in[4]; const float* mu = F.in[6];
    const float* mod = (const float*)(F.ws + WS_MOD);
    bf16* views = (bf16*)(F.ws + WS_VIEWS); bf16* H2 = (bf16*)(F.ws + WS_H2);
    for (int grp = blockIdx.x; grp < M / 8; grp += F.G) {
        const int m0 = grp * 8, b = m0 / T, t0 = m0 % T;
        const float* sh = mod + (size_t)b * 6144; const float* sc = sh + 1024;
        f32x4 hv[4];
        for (int pass = 0; pass < 2; ++pass) {
            if (pass == 1 && F.wave != 0) break;
            const int row = (pass == 0) ? (m0 + F.wave) : (m0 - 1);
            f32x4 v[4];
            if (pass == 1 && t0 == 0) {
#pragma unroll
                for (int j = 0; j < 4; ++j) v[j] = (f32x4){0.f, 0.f, 0.f, 0.f};
            } else {
                const f32x4* xr = (const f32x4*)(x + (size_t)row * D) + F.lane; float ss = 0.f;
#pragma unroll
                for (int j = 0; j < 4; ++j) { v[j] = xr[64 * j]; ss += (v[j].x * v[j].x + v[j].y * v[j].y) + (v[j].z * v[j].z + v[j].w * v[j].w); }
                const float rstd = 1.0f / sqrtf(wave_sum(ss) * (1.f / D) + RMS_EPS);
#pragma unroll
                for (int j = 0; j < 4; ++j) { const int c = 4 * F.lane + 256 * j; const f32x4 gg = *(const f32x4*)(g + c), s1 = *(const f32x4*)(sc + c), s0 = *(const f32x4*)(sh + c);
                    v[j] = v[j] * rstd * gg * (s1 + 1.0f) + s0; }
            }
            LAS f32x4* hp = (LAS f32x4*)(hrow + ((pass == 0) ? (F.wave + 1) : 0) * 1024) + F.lane;
#pragma unroll
            for (int j = 0; j < 4; ++j) { hp[64 * j] = v[j]; if (pass == 0) hv[j] = v[j]; }
        }
        __syncthreads();
        {
            const int row = m0 + F.wave;
            const LAS f32x4* pp = (const LAS f32x4*)(hrow + F.wave * 1024) + F.lane;
#pragma unroll
            for (int j = 0; j < 4; ++j) { const int c = 4 * F.lane + 256 * j; const f32x4 xx = pp[64 * j] - hv[j];
#pragma unroll
                for (int i = 0; i < 3; ++i) { const f32x4 mm = *(const f32x4*)(mu + i * D + c); const f32x4 o = hv[j] + xx * mm;
                    v2u w; w.x = pk2(o.x, o.y); w.y = pk2(o.z, o.w); *(v2u*)(views + ((size_t)i * M + row) * D + c) = w; }
                v2u w; w.x = pk2(hv[j].x, hv[j].y); w.y = pk2(hv[j].z, hv[j].w); *(v2u*)(H2 + (size_t)row * 2048 + c) = w;
                w.x = pk2(xx.x, xx.y); w.y = pk2(xx.z, xx.w); *(v2u*)(H2 + (size_t)row * 2048 + 1024 + c) = w; }
        }
        __syncthreads();
    }
}

__device__ __forceinline__ void p4_scan_seq(Frame& F) {
    constexpr int TS = 32;
    LAS float* sA = (LAS float*)(F.lds + RING_OFF);
    LAS float* sW = sA + TS * 64; LAS float* sB = sW + TS * 64; LAS float* sK = sB + TS * 64; LAS float* sR = sK + TS * 64; LAS float* sV = sR + TS * 64;
    LAS float* sY = sV + TS * 64; LAS float* sRK = sY + TS * 64;
    const bf16* Rb = (const bf16*)(F.ws + WS_RKV); const bf16* Kb = Rb + (size_t)M * D; const bf16* Vb = Kb + (size_t)M * D;
    const float* LW = (const float*)(F.ws + WS_LOGW); const bf16* AS = (const bf16*)(F.ws + WS_ASIG); const bf16* GG = (const bf16*)(F.ws + WS_GG);
    bf16* YG = (bf16*)(F.ws + WS_YG);
    const float* k_k = F.in[16]; const float* k_a = F.in[17]; const float* r_k = F.in[18]; const float* gn_g = F.in[19]; const float* gn_b = F.in[20];
    for (int bh = blockIdx.x; bh < BATCH * 16; bh += F.G) {
        const int b = bh >> 4, h = bh & 15;
        const int i = F.tid >> 3, q = F.tid & 7;
        const int st = F.tid >> 4, d4 = (F.tid & 15) * 4;
        const int cg = h * 64 + d4;
        const f32x4 kkv = *(const f32x4*)(k_k + cg), kav = *(const f32x4*)(k_a + cg), rkv = *(const f32x4*)(r_k + cg), gng = *(const f32x4*)(gn_g + cg), gnb = *(const f32x4*)(gn_b + cg);
        float s[8];
#pragma unroll
        for (int j = 0; j < 8; ++j) s[j] = 0.f;
        for (int t0 = 0; t0 < T; t0 += TS) {
            const size_t ro = ((size_t)b * T + t0 + st) * D + cg;
            {
                const v2u rr = *(const v2u*)(Rb + ro), kk2 = *(const v2u*)(Kb + ro), vv = *(const v2u*)(Vb + ro), aa = *(const v2u*)(AS + ro); const f32x4 lw = *(const f32x4*)(LW + ro);
                const f32x4 r4 = {bflo(rr.x), bfhi(rr.x), bflo(rr.y), bfhi(rr.y)}, k4 = {bflo(kk2.x), bfhi(kk2.x), bflo(kk2.y), bfhi(kk2.y)};
                const f32x4 v4 = {bflo(vv.x), bfhi(vv.x), bflo(vv.y), bfhi(vv.y)}, a4 = {bflo(aa.x), bfhi(aa.x), bflo(aa.y), bfhi(aa.y)};
                const f32x4 kr = k4 * kkv; float ss = (kr.x * kr.x + kr.y * kr.y) + (kr.z * kr.z + kr.w * kr.w);
                ss += __shfl_xor(ss, 1); ss += __shfl_xor(ss, 2); ss += __shfl_xor(ss, 4); ss += __shfl_xor(ss, 8);
                const float inv = 1.0f / fmaxf(sqrtf(ss), 1e-12f);
                const f32x4 kkn = kr * inv; const f32x4 km = k4 * ((a4 - 1.0f) * kav + 1.0f);
                const f32x4 rk4 = r4 * km * rkv; float rs = (rk4.x + rk4.y) + (rk4.z + rk4.w);
                rs += __shfl_xor(rs, 1); rs += __shfl_xor(rs, 2); rs += __shfl_xor(rs, 4); rs += __shfl_xor(rs, 8);
                f32x4 wv; wv.x = __expf(lw.x); wv.y = __expf(lw.y); wv.z = __expf(lw.z); wv.w = __expf(lw.w);
                *(LAS f32x4*)(sA + st * 64 + d4) = -kkn; *(LAS f32x4*)(sW + st * 64 + d4) = wv; *(LAS f32x4*)(sB + st * 64 + d4) = kkn * a4;
                *(LAS f32x4*)(sK + st * 64 + d4) = km; *(LAS f32x4*)(sR + st * 64 + d4) = r4; *(LAS f32x4*)(sV + st * 64 + d4) = v4;
                if ((F.tid & 15) == 0) sRK[st] = rs;
            }
            __syncthreads();
            for (int t = 0; t < TS; ++t) {
                const LAS f32x4* pa = (const LAS f32x4*)(sA + t * 64 + q * 8); const LAS f32x4* pw = (const LAS f32x4*)(sW + t * 64 + q * 8); const LAS f32x4* pb = (const LAS f32x4*)(sB + t * 64 + q * 8);
                const LAS f32x4* pk = (const LAS f32x4*)(sK + t * 64 + q * 8); const LAS f32x4* pr = (const LAS f32x4*)(sR + t * 64 + q * 8);
                const f32x4 a0 = pa[0], a1 = pa[1], w0 = pw[0], w1 = pw[1], b0 = pb[0], b1 = pb[1], k0 = pk[0], k1 = pk[1], r0 = pr[0], r1 = pr[1];
                const float vi = sV[t * 64 + i];
                float sa = (s[0] * a0.x + s[1] * a0.y) + (s[2] * a0.z + s[3] * a0.w) + (s[4] * a1.x + s[5] * a1.y) + (s[6] * a1.z + s[7] * a1.w);
                sa += __shfl_xor(sa, 1); sa += __shfl_xor(sa, 2); sa += __shfl_xor(sa, 4);
                s[0] = s[0] * w0.x + sa * b0.x + vi * k0.x; s[1] = s[1] * w0.y + sa * b0.y + vi * k0.y; s[2] = s[2] * w0.z + sa * b0.z + vi * k0.z; s[3] = s[3] * w0.w + sa * b0.w + vi * k0.w;
                s[4] = s[4] * w1.x + sa * b1.x + vi * k1.x; s[5] = s[5] * w1.y + sa * b1.y + vi * k1.y; s[6] = s[6] * w1.z + sa * b1.z + vi * k1.z; s[7] = s[7] * w1.w + sa * b1.w + vi * k1.w;
                float y = (s[0] * r0.x + s[1] * r0.y) + (s[2] * r0.z + s[3] * r0.w) + (s[4] * r1.x + s[5] * r1.y) + (s[6] * r1.z + s[7] * r1.w);
                y += __shfl_xor(y, 1); y += __shfl_xor(y, 2); y += __shfl_xor(y, 4);
                if (q == 0) sY[t * 64 + i] = y;
            }
            __syncthreads();
            {
                const f32x4 y4 = *(const LAS f32x4*)(sY + st * 64 + d4); const f32x4 v4 = *(const LAS f32x4*)(sV + st * 64 + d4);
                float sm = (y4.x + y4.y) + (y4.z + y4.w);
                sm += __shfl_xor(sm, 1); sm += __shfl_xor(sm, 2); sm += __shfl_xor(sm, 4); sm += __shfl_xor(sm, 8);
                const float mean = sm * (1.f / 64.f); const f32x4 dv = y4 - mean;
                float vs = (dv.x * dv.x + dv.y * dv.y) + (dv.z * dv.z + dv.w * dv.w);
                vs += __shfl_xor(vs, 1); vs += __shfl_xor(vs, 2); vs += __shfl_xor(vs, 4); vs += __shfl_xor(vs, 8);
                const float rstd = 1.0f / sqrtf(vs * (1.f / 64.f) + GN_EPS);
                const v2u gg = *(const v2u*)(GG + ro); const f32x4 g4 = {bflo(gg.x), bfhi(gg.x), bflo(gg.y), bfhi(gg.y)};
                const f32x4 o = (dv * rstd * gng + gnb + v4 * sRK[st]) * g4;
                v2u w; w.x = pk2(o.x, o.y); w.y = pk2(o.z, o.w); *(v2u*)(YG + ro) = w;
            }
            __syncthreads();
        }
    }
}

__device__ __forceinline__ void moe_router(Frame& F, int l, const float* xin) {
    const float* g = F.in[5] + (size_t)l * D; const float* wrg = F.in[33] + (size_t)l * D * NGRP; const float* wre = F.in[34] + (size_t)l * D * NE;
    const float* mod = (const float*)(F.ws + WS_MOD) + (size_t)l * 4 * 6144;
    bf16* H2N = (bf16*)(F.ws + WS_H2N);
    int* asg_e = (int*)(F.ws + WS_ROUTE); int* asg_pos = asg_e + 2 * M; float* asg_gate = (float*)(asg_pos + 2 * M);
    unsigned* cnt = (unsigned*)F.ctl + CW_CNT + 64 * l;
    const int gw = blockIdx.x * NWAVES + F.wave, NGW = F.G * NWAVES;
    for (int row = gw; row < M; row += NGW) {
        const int b = row / T; const float* sh = mod + (size_t)b * 6144 + 3072; const float* sc = sh + 1024;
        const f32x4* xr = (const f32x4*)(xin + (size_t)row * D) + F.lane; f32x4 v[4]; float ss = 0.f;
#pragma unroll
        for (int j = 0; j < 4; ++j) { v[j] = xr[64 * j]; ss += (v[j].x * v[j].x + v[j].y * v[j].y) + (v[j].z * v[j].z + v[j].w * v[j].w); }
        const float rstd = 1.0f / sqrtf(wave_sum(ss) * (1.f / D) + RMS_EPS);
        float acc[36];
#pragma unroll
        for (int o = 0; o < 36; ++o) acc[o] = 0.f;
#pragma unroll
        for (int j = 0; j < 4; ++j) { const int c = 4 * F.lane + 256 * j; const f32x4 gg = *(const f32x4*)(g + c), s1 = *(const f32x4*)(sc + c), s0 = *(const f32x4*)(sh + c);
            v[j] = v[j] * rstd * gg * (s1 + 1.0f) + s0;
            v2u w; w.x = pk2(v[j].x, v[j].y); w.y = pk2(v[j].z, v[j].w); *(v2u*)(H2N + (size_t)row * D + c) = w; }
        const float* wel = wre + (size_t)F.lane * 128; const float* wgl = wrg + (size_t)F.lane * 16;
        asm volatile("" : "+v"(wel), "+v"(wgl));
#pragma unroll
        for (int j = 0; j < 4; ++j) { const float* wej = wel + (size_t)j * 256 * 32; const float* wgj = wgl + (size_t)j * 256 * 4;
#pragma unroll
            for (int e = 0; e < 4; ++e) { const float hvv = v[j][e];
                const f32x4 wg4 = *(const f32x4*)(wgj + e * 4);
                acc[0] += hvv * wg4.x; acc[1] += hvv * wg4.y; acc[2] += hvv * wg4.z; acc[3] += hvv * wg4.w;
#pragma unroll
                for (int q = 0; q < 8; ++q) { const f32x4 we = *(const f32x4*)(wej + e * 32 + q * 4);
                    acc[4 + q * 4 + 0] += hvv * we.x; acc[4 + q * 4 + 1] += hvv * we.y; acc[4 + q * 4 + 2] += hvv * we.z; acc[4 + q * 4 + 3] += hvv * we.w; } } }
#pragma unroll
        for (int o = 0; o < 36; ++o) acc[o] = wave_sum(acc[o]);
        int gi = 0; float gm = acc[0];
#pragma unroll
        for (int j = 1; j < 4; ++j) if (acc[j] > gm) { gm = acc[j]; gi = j; }
        float gs = 0.f;
#pragma unroll
        for (int j = 0; j < 4; ++j) gs += __expf(acc[j] - gm);
        const float ggate = 1.0f / gs;
        float el[8];
#pragma unroll
        for (int j = 0; j < 8; ++j) el[j] = (gi == 0) ? acc[4 + j] : (gi == 1) ? acc[12 + j] : (gi == 2) ? acc[20 + j] : acc[28 + j];
        int i1 = 0; float v1 = el[0];
#pragma unroll
        for (int j = 1; j < 8; ++j) if (el[j] > v1) { v1 = el[j]; i1 = j; }
        int i2 = -1; float v2 = -INFINITY;
#pragma unroll
        for (int j = 0; j < 8; ++j) if (j != i1 && el[j] > v2) { v2 = el[j]; i2 = j; }
        const float e2 = __expf(v2 - v1), p1 = 1.0f / (1.0f + e2), p2 = e2 * p1;
        if (F.lane == 0) { const int ea = gi * 8 + i1, eb = gi * 8 + i2;
            const unsigned pa = atomicAdd(cnt + ea, 1u), pb = atomicAdd(cnt + eb, 1u);
            asg_e[2 * row] = ea; asg_e[2 * row + 1] = eb; asg_pos[2 * row] = (int)pa; asg_pos[2 * row + 1] = (int)pb;
            asg_gate[2 * row] = ggate * p1; asg_gate[2 * row + 1] = ggate * p2; }
    }
}
__device__ __forceinline__ void moe_toff(Frame& F, int l) {
    LAS int* toff = (LAS int*)(F.lds + LDSCTL_OFF);
    if (F.tid == 0) { const unsigned* cnt = (const unsigned*)F.ctl + CW_CNT + 64 * l; int acc = 0;
        for (int e = 0; e < 32; ++e) { toff[e] = acc; acc += (int)((__hip_atomic_load(cnt + e, RLX_AGENT) + 255u) >> 8); }
        toff[32] = acc; }
    __syncthreads();
}
__device__ __forceinline__ void moe_gather(Frame& F, int l) {
    moe_toff(F, l);
    const LAS int* toff = (const LAS int*)(F.lds + LDSCTL_OFF);
    const bf16* H2N = (const bf16*)(F.ws + WS_H2N); bf16* XS = (bf16*)(F.ws + WS_XS);
    const int* asg_e = (const int*)(F.ws + WS_ROUTE); const int* asg_pos = asg_e + 2 * M; const float* asg_gate = (const float*)(asg_pos + 2 * M);
    int* asg_row = (int*)(asg_gate + 2 * M); float* rowgate = (float*)(asg_row + 2 * M);
    const int gw = blockIdx.x * NWAVES + F.wave, NGW = F.G * NWAVES;
    for (int a = gw; a < 2 * M; a += NGW) {
        const int tok = a >> 1, e = asg_e[a], pos = asg_pos[a]; const int row = toff[e] * 256 + pos;
        const v4u* src = (const v4u*)(H2N + (size_t)tok * D) + F.lane; v4u* dst = (v4u*)(XS + (size_t)row * D) + F.lane;
        const v4u x0 = src[0], x1 = src[64]; dst[0] = x0; dst[64] = x1;
        if (F.lane == 0) { rowgate[row] = asg_gate[a]; asg_row[a] = row; }
    }
}
template <int MODE> __device__ __forceinline__ void moe_combine(Frame& F, int l, const float* xin, float* xout) {
    const bf16* Y = (const bf16*)(F.ws + WS_Y);
    const int* asg_row = (const int*)(F.ws + WS_ROUTE) + 6 * M;
    const float* mod = (const float*)(F.ws + WS_MOD) + (size_t)l * 4 * 6144;
    const float* mod1 = (const float*)(F.ws + WS_MOD) + (size_t)4 * 6144;
    const float* modkv = (const float*)(F.ws + WS_MOD) + (size_t)8 * 6144;
    const float* gq = F.in[4] + D; const float* gkv = F.in[24]; const float* gfin = F.in[38];
    bf16* HQ = (bf16*)(F.ws + WS_HQ); bf16* HK = (bf16*)(F.ws + WS_HK);
    const int gw = blockIdx.x * NWAVES + F.wave, NGW = F.G * NWAVES;
    for (int row = gw; row < M; row += NGW) {
        const int b = row / T; const float* gf = mod + (size_t)b * 6144 + 5120;
        const int r0 = asg_row[2 * row], r1 = asg_row[2 * row + 1];
        const f32x4* xr = (const f32x4*)(xin + (size_t)row * D) + F.lane; f32x4 v[4]; float ss = 0.f;
#pragma unroll
        for (int j = 0; j < 4; ++j) { const int c = 4 * F.lane + 256 * j;
            const v2u y0 = *(const v2u*)(Y + (size_t)r0 * D + c), y1 = *(const v2u*)(Y + (size_t)r1 * D + c); const f32x4 gg = *(const f32x4*)(gf + c);
            const f32x4 ys = {bflo(y0.x) + bflo(y1.x), bfhi(y0.x) + bfhi(y1.x), bflo(y0.y) + bflo(y1.y), bfhi(y0.y) + bfhi(y1.y)};
            v[j] = xr[64 * j] + gg * ys; ss += (v[j].x * v[j].x + v[j].y * v[j].y) + (v[j].z * v[j].z + v[j].w * v[j].w); }
        const float rstd = 1.0f / sqrtf(wave_sum(ss) * (1.f / D) + RMS_EPS);
        if (MODE == 0) {
            const float* shq = mod1 + (size_t)b * 6144; const float* scq = shq + 1024; const float* shk = modkv + (size_t)b * 2048; const float* sck = shk + 1024;
#pragma unroll
            for (int j = 0; j < 4; ++j) { const int c = 4 * F.lane + 256 * j;
                *((f32x4*)(xout + (size_t)row * D) + F.lane + 64 * j) = v[j];
                const f32x4 n = v[j] * rstd;
                const f32x4 hq = n * *(const f32x4*)(gq + c) * (*(const f32x4*)(scq + c) + 1.0f) + *(const f32x4*)(shq + c);
                const f32x4 hk = n * *(const f32x4*)(gkv + c) * (*(const f32x4*)(sck + c) + 1.0f) + *(const f32x4*)(shk + c);
                v2u w; w.x = pk2(hq.x, hq.y); w.y = pk2(hq.z, hq.w); *(v2u*)(HQ + (size_t)row * D + c) = w;
                w.x = pk2(hk.x, hk.y); w.y = pk2(hk.z, hk.w); *(v2u*)(HK + (size_t)row * D + c) = w; }
        } else {
#pragma unroll
            for (int j = 0; j < 4; ++j) { const int c = 4 * F.lane + 256 * j; *((f32x4*)(xout + (size_t)row * D) + F.lane + 64 * j) = v[j] * rstd * *(const f32x4*)(gfin + c); }
        }
    }
}
__device__ __forceinline__ void attn_subln(Frame& F) {
    const bf16* OC = (const bf16*)(F.ws + WS_OC); bf16* ON = (bf16*)(F.ws + WS_ON);
    const float l1 = wave_sum(F.in[27][F.lane] * F.in[28][F.lane]), l2 = wave_sum(F.in[29][F.lane] * F.in[30][F.lane]);
    const float lam = __expf(l1) - __expf(l2) + LAMBDA_INIT1;
    const float* sg = F.in[31] + (F.lane & 7) * 16;
    float gsc[16];
#pragma unroll
    for (int e = 0; e < 16; ++e) gsc[e] = sg[e] * (1.0f - LAMBDA_INIT1);
    const int gw = blockIdx.x * NWAVES + F.wave, NGW = F.G * NWAVES; const int hd = F.lane >> 3, sub = (F.lane & 7) * 16;
    for (int row = gw; row < M; row += NGW) {
        const v4u* p0 = (const v4u*)(OC + (size_t)row * 2048 + (hd * 2) * 128 + sub); const v4u* p1 = (const v4u*)(OC + (size_t)row * 2048 + (hd * 2 + 1) * 128 + sub);
        const v4u a0 = p0[0], a1 = p0[1], b0 = p1[0], b1 = p1[1];
        float d[16];
#define DF(i, A, B) d[2 * (i)] = bflo(A) - lam * bflo(B); d[2 * (i) + 1] = bfhi(A) - lam * bfhi(B)
        DF(0, a0.x, b0.x); DF(1, a0.y, b0.y); DF(2, a0.z, b0.z); DF(3, a0.w, b0.w); DF(4, a1.x, b1.x); DF(5, a1.y, b1.y); DF(6, a1.z, b1.z); DF(7, a1.w, b1.w);
#undef DF
        float ss = 0.f;
#pragma unroll
        for (int e = 0; e < 16; ++e) ss += d[e] * d[e];
        ss += __shfl_xor(ss, 1); ss += __shfl_xor(ss, 2); ss += __shfl_xor(ss, 4);
        const float rstd = 1.0f / sqrtf(ss * (1.f / 128.f) + SUBLN_EPS);
        v4u w0, w1;
        w0.x = pk2(d[0] * rstd * gsc[0], d[1] * rstd * gsc[1]); w0.y = pk2(d[2] * rstd * gsc[2], d[3] * rstd * gsc[3]); w0.z = pk2(d[4] * rstd * gsc[4], d[5] * rstd * gsc[5]); w0.w = pk2(d[6] * rstd * gsc[6], d[7] * rstd * gsc[7]);
        w1.x = pk2(d[8] * rstd * gsc[8], d[9] * rstd * gsc[9]); w1.y = pk2(d[10] * rstd * gsc[10], d[11] * rstd * gsc[11]); w1.z = pk2(d[12] * rstd * gsc[12], d[13] * rstd * gsc[13]); w1.w = pk2(d[14] * rstd * gsc[14], d[15] * rstd * gsc[15]);
        v4u* op = (v4u*)(ON + (size_t)row * D + F.lane * 16); op[0] = w0; op[1] = w1;
    }
}
struct AttnOrder {
    int vcu;
    __device__ __forceinline__ explicit AttnOrder(int grid, int block) : vcu((block % 8) * (grid / 8) + block / 8) {}
    __device__ __forceinline__ bool next(int i, attn_body::AttnUnit& u) const { if (i >= 8) return false; const int s = 2 * (i >> 1) + (vcu & 1); u.bh = vcu >> 1; u.qb = (i & 1) ? s : 15 - s; return true; }
    __device__ __forceinline__ void a_ready(const attn_body::AttnUnit&) const {}
    __device__ __forceinline__ void done(const attn_body::AttnUnit&) const {}
};

typedef float f32x16 __attribute__((ext_vector_type(16)));
typedef float f32x2_t __attribute__((ext_vector_type(2))); typedef __bf16 bf16x2_t __attribute__((ext_vector_type(2)));
__device__ __forceinline__ unsigned cvtpk(float lo, float hi) { f32x2_t v = {lo, hi}; bf16x2_t b = __builtin_convertvector(v, bf16x2_t); return __builtin_bit_cast(unsigned, b); }
#define MMA32(a, b, c) __builtin_amdgcn_mfma_f32_32x32x16_bf16((a), (b), (c), 0, 0, 0)
constexpr int SC_TS = 72, SC_TB = 64 * SC_TS * 2;
constexpr int SL_A = 0, SL_B = 1, SL_K = 2, SL_R = 3, SL_BH = 4, SL_KH = 5, SL_VT = 6, SL_ARB = 7, SL_ARK = 8;
constexpr int SC_RHS = 9 * SC_TB;
constexpr int SC_AAB = 0, SC_AABS = 68;
constexpr int SC_LBUF = 7 * SC_TB, SC_SEG = SC_LBUF + 16384;
constexpr int SC_GEND = SC_RHS + 32768;
static_assert(SC_GEND + 256 <= RING_BYTES && SC_SEG + 2048 <= 9 * SC_TB && 64 * SC_AABS * 4 <= 2 * SC_TB, "scan LDS map");

__device__ __forceinline__ void tile_mma2(f32x16 (&acc)[2], const LAS unsigned char* TA, const LAS unsigned char* TBp, int mt, int r32, int hi) {
#pragma unroll
    for (int ks = 0; ks < 4; ++ks) {
        const bf16x8 a = *(const LAS bf16x8*)(TA + ((32 * mt + r32) * SC_TS + 16 * ks + 8 * hi) * 2);
        const bf16x8 b0 = *(const LAS bf16x8*)(TBp + ((r32) * SC_TS + 16 * ks + 8 * hi) * 2);
        const bf16x8 b1 = *(const LAS bf16x8*)(TBp + ((32 + r32) * SC_TS + 16 * ks + 8 * hi) * 2);
        acc[0] = MMA32(a, b0, acc[0]); acc[1] = MMA32(a, b1, acc[1]);
    }
}
__device__ __forceinline__ void p4a_chunks(Frame& F) {
    LAS unsigned char* L = F.lds + RING_OFF;
    const bf16* Rb = (const bf16*)(F.ws + WS_RKV); const bf16* Kb = Rb + (size_t)M * D; const bf16* Vb = Kb + (size_t)M * D;
    const float* LW = (const float*)(F.ws + WS_LOGW); const bf16* AS = (const bf16*)(F.ws + WS_ASIG);
    bf16* QE = (bf16*)(F.ws + WS_QE); bf16* MCT = (bf16*)(F.ws + WS_MCT); bf16* NC = (bf16*)(F.ws + WS_NC); float* Y0 = (float*)(F.ws + WS_Y0); float* RK = (float*)(F.ws + WS_RK);
    const float* k_k = F.in[16]; const float* k_a = F.in[17]; const float* r_k = F.in[18];
    const int tid = F.tid, lane = F.lane, w = F.wave, r32 = lane & 31, hi = lane >> 5;
    const int t = tid >> 3, d8 = (tid & 7) * 8;
    LAS float* Lbuf = (LAS float*)(L + SC_LBUF); LAS float* Seg = (LAS float*)(L + SC_SEG); LAS float* RHS = (LAS float*)(L + SC_RHS); LAS float* Gend = (LAS float*)(L + SC_GEND);
    LAS float* AAB = (LAS float*)(L + SC_AAB);
    for (int cu = blockIdx.x; cu < BATCH * 16 * 64; cu += F.G) {
        const int bh = cu >> 6, c = cu & 63, b = bh >> 4, h = bh & 15;
        const size_t ro = ((size_t)b * T + c * 64 + t) * D + h * 64 + d8;
        const v4u r8 = *(const v4u*)(Rb + ro), k8 = *(const v4u*)(Kb + ro), v8 = *(const v4u*)(Vb + ro), a8 = *(const v4u*)(AS + ro);
        const f32x4 lw0 = *(const f32x4*)(LW + ro), lw1 = *(const f32x4*)(LW + ro + 4);
        *(LAS f32x4*)(Lbuf + t * 64 + d8) = lw0; *(LAS f32x4*)(Lbuf + t * 64 + d8 + 4) = lw1;
        __syncthreads();
        { const int d = tid & 63, seg = tid >> 6; float run = 0.f;
#pragma unroll
          for (int i = 0; i < 8; ++i) { run += Lbuf[(seg * 8 + i) * 64 + d]; Lbuf[(seg * 8 + i) * 64 + d] = run; }
          Seg[seg * 64 + d] = run; }
        __syncthreads();
        {
            float Lt[8], Le[8];
            { const f32x4 p0 = *(const LAS f32x4*)(Lbuf + t * 64 + d8), p1 = *(const LAS f32x4*)(Lbuf + t * 64 + d8 + 4);
              Lt[0] = p0.x; Lt[1] = p0.y; Lt[2] = p0.z; Lt[3] = p0.w; Lt[4] = p1.x; Lt[5] = p1.y; Lt[6] = p1.z; Lt[7] = p1.w; }
#pragma unroll
            for (int e = 0; e < 8; ++e) Le[e] = 0.f;
            const int myseg = t >> 3;
#pragma unroll
            for (int s = 0; s < 8; ++s) { const f32x4 q0 = *(const LAS f32x4*)(Seg + s * 64 + d8), q1 = *(const LAS f32x4*)(Seg + s * 64 + d8 + 4);
                const float sv[8] = {q0.x, q0.y, q0.z, q0.w, q1.x, q1.y, q1.z, q1.w};
#pragma unroll
                for (int e = 0; e < 8; ++e) { Le[e] += sv[e]; Lt[e] += (s < myseg) ? sv[e] : 0.f; } }
            const float lwv[8] = {lw0.x, lw0.y, lw0.z, lw0.w, lw1.x, lw1.y, lw1.z, lw1.w};
            const unsigned rw[4] = {r8.x, r8.y, r8.z, r8.w}, kw[4] = {k8.x, k8.y, k8.z, k8.w}, vw[4] = {v8.x, v8.y, v8.z, v8.w}, aw[4] = {a8.x, a8.y, a8.z, a8.w};
            float rr[8], kk[8], vv[8], aa[8];
#pragma unroll
            for (int e = 0; e < 4; ++e) { rr[2 * e] = bflo(rw[e]); rr[2 * e + 1] = bfhi(rw[e]); kk[2 * e] = bflo(kw[e]); kk[2 * e + 1] = bfhi(kw[e]);
                vv[2 * e] = bflo(vw[e]); vv[2 * e + 1] = bfhi(vw[e]); aa[2 * e] = bflo(aw[e]); aa[2 * e + 1] = bfhi(aw[e]); }
            const f32x4 kk0 = *(const f32x4*)(k_k + h * 64 + d8), kk1 = *(const f32x4*)(k_k + h * 64 + d8 + 4), ka0 = *(const f32x4*)(k_a + h * 64 + d8), ka1 = *(const f32x4*)(k_a + h * 64 + d8 + 4);
            const f32x4 rk0 = *(const f32x4*)(r_k + h * 64 + d8), rk1 = *(const f32x4*)(r_k + h * 64 + d8 + 4);
            const float kkv[8] = {kk0.x, kk0.y, kk0.z, kk0.w, kk1.x, kk1.y, kk1.z, kk1.w}, kav[8] = {ka0.x, ka0.y, ka0.z, ka0.w, ka1.x, ka1.y, ka1.z, ka1.w}, rkv[8] = {rk0.x, rk0.y, rk0.z, rk0.w, rk1.x, rk1.y, rk1.z, rk1.w};
            float kr[8], ss = 0.f, rs = 0.f, km[8];
#pragma unroll
            for (int e = 0; e < 8; ++e) { kr[e] = kk[e] * kkv[e]; ss += kr[e] * kr[e]; km[e] = kk[e] * (1.0f + (aa[e] - 1.0f) * kav[e]); rs += rr[e] * km[e] * rkv[e]; }
            ss += __shfl_xor(ss, 1); ss += __shfl_xor(ss, 2); ss += __shfl_xor(ss, 4);
            rs += __shfl_xor(rs, 1); rs += __shfl_xor(rs, 2); rs += __shfl_xor(rs, 4);
            const float inv = 1.0f / fmaxf(sqrtf(ss), 1e-12f);
            if ((tid & 7) == 0) RK[(size_t)cu * 64 + t] = rs;
            float At[8], Bt[8], Kt[8], Rt[8], Bh[8], Kh[8];
#pragma unroll
            for (int e = 0; e < 8; ++e) { const float kn = kr[e] * inv, av = -kn, bv = kn * aa[e];
                const float g = __expf(Lt[e]), gi = __expf(-Lt[e]), gp = __expf(Lt[e] - lwv[e]), ge = __expf(Le[e] - Lt[e]);
                At[e] = av * gp; Bt[e] = bv * gi; Kt[e] = km[e] * gi; Rt[e] = rr[e] * g; Bh[e] = bv * ge; Kh[e] = km[e] * ge;
                if (t == 63) Gend[d8 + e] = g; }
            const int ob = (t * SC_TS + d8) * 2;
            { v4u o; o.x = cvtpk(At[0], At[1]); o.y = cvtpk(At[2], At[3]); o.z = cvtpk(At[4], At[5]); o.w = cvtpk(At[6], At[7]); *(LAS v4u*)(L + SL_A * SC_TB + ob) = o; }
            { v4u o; o.x = cvtpk(Bt[0], Bt[1]); o.y = cvtpk(Bt[2], Bt[3]); o.z = cvtpk(Bt[4], Bt[5]); o.w = cvtpk(Bt[6], Bt[7]); *(LAS v4u*)(L + SL_B * SC_TB + ob) = o; }
            { v4u o; o.x = cvtpk(Kt[0], Kt[1]); o.y = cvtpk(Kt[2], Kt[3]); o.z = cvtpk(Kt[4], Kt[5]); o.w = cvtpk(Kt[6], Kt[7]); *(LAS v4u*)(L + SL_K * SC_TB + ob) = o; }
            { v4u o; o.x = cvtpk(Rt[0], Rt[1]); o.y = cvtpk(Rt[2], Rt[3]); o.z = cvtpk(Rt[4], Rt[5]); o.w = cvtpk(Rt[6], Rt[7]); *(LAS v4u*)(L + SL_R * SC_TB + ob) = o; }
            *(LAS f32x4*)(RHS + t * 128 + d8) = (f32x4){At[0], At[1], At[2], At[3]}; *(LAS f32x4*)(RHS + t * 128 + d8 + 4) = (f32x4){At[4], At[5], At[6], At[7]};
            LAS unsigned short* bhT = (LAS unsigned short*)(L + SL_BH * SC_TB); LAS unsigned short* khT = (LAS unsigned short*)(L + SL_KH * SC_TB); LAS unsigned short* vT = (LAS unsigned short*)(L + SL_VT * SC_TB);
#pragma unroll
            for (int e = 0; e < 8; ++e) { bhT[(d8 + e) * SC_TS + t] = (unsigned short)(cvtpk(Bh[e], 0.f) & 0xffffu); khT[(d8 + e) * SC_TS + t] = (unsigned short)(cvtpk(Kh[e], 0.f) & 0xffffu); }
#pragma unroll
            for (int e = 0; e < 4; ++e) { vT[(d8 + 2 * e) * SC_TS + t] = (unsigned short)(vw[e] & 0xffffu); vT[(d8 + 2 * e + 1) * SC_TS + t] = (unsigned short)(vw[e] >> 16); }
        }
        __syncthreads();
        const int p = w >> 1, mt = w & 1;
        f32x16 acc[2];
#pragma unroll
        for (int i = 0; i < 16; ++i) { acc[0][i] = 0.f; acc[1][i] = 0.f; }
        tile_mma2(acc, L + ((p & 1) ? SL_K : SL_B) * SC_TB, L + ((p & 2) ? SL_R : SL_A) * SC_TB, mt, r32, hi);
        __syncthreads();
#pragma unroll
        for (int nt = 0; nt < 2; ++nt) { const int s = 32 * nt + r32;
#pragma unroll
            for (int rg = 0; rg < 4; ++rg) { const int j0 = 32 * mt + 8 * rg + 4 * hi; float v[4];
#pragma unroll
                for (int e = 0; e < 4; ++e) { const bool keep = (p < 2) ? (j0 + e < s) : (j0 + e <= s); v[e] = keep ? acc[nt][4 * rg + e] : 0.f; }
                if (p == 0) *(LAS f32x4*)(AAB + s * SC_AABS + j0) = (f32x4){v[0], v[1], v[2], v[3]};
                else { v2u o; o.x = cvtpk(v[0], v[1]); o.y = cvtpk(v[2], v[3]); *(LAS v2u*)(L + ((p == 1) ? SL_K : (p == 2) ? SL_ARB : SL_ARK) * SC_TB + (s * SC_TS + j0) * 2) = o; } } }
        __syncthreads();
#pragma unroll
        for (int i = 0; i < 16; ++i) { acc[0][i] = 0.f; acc[1][i] = 0.f; }
        if (w < 4) {
            tile_mma2(acc, L + SL_K * SC_TB, L + SL_VT * SC_TB, w & 1, r32, hi);
            if (w < 2) {
#pragma unroll
                for (int nt = 0; nt < 2; ++nt)
#pragma unroll
                    for (int reg = 0; reg < 16; ++reg) RHS[(32 * (w & 1) + (reg & 3) + 8 * (reg >> 2) + 4 * hi) * 128 + 64 + 32 * nt + r32] = acc[nt][reg];
            }
        } else if (w < 6) tile_mma2(acc, L + SL_VT * SC_TB, L + SL_ARK * SC_TB, w & 1, r32, hi);
        else tile_mma2(acc, L + SL_KH * SC_TB, L + SL_VT * SC_TB, w & 1, r32, hi);
        __syncthreads();
        float x[64];
        if (w < 2) {
#pragma unroll
            for (int s = 0; s < 64; ++s) x[s] = 0.f;
#pragma unroll
            for (int s = 0; s < 64; ++s) { float a = RHS[s * 128 + tid];
#pragma unroll
                for (int j4 = 0; j4 < (s + 3) / 4; ++j4) { const f32x4 q = *(const LAS f32x4*)(AAB + s * SC_AABS + 4 * j4);
                    a += q.x * x[4 * j4]; a += q.y * x[4 * j4 + 1]; a += q.z * x[4 * j4 + 2]; a += q.w * x[4 * j4 + 3]; }
                x[s] = a; }
        }
        __syncthreads();
        if (w < 2) { LAS unsigned char* xt = L + SC_RHS + (tid >> 6) * SC_TB + (tid & 63) * SC_TS * 2;
#pragma unroll
            for (int q = 0; q < 8; ++q) { v4u o; o.x = cvtpk(x[8 * q], x[8 * q + 1]); o.y = cvtpk(x[8 * q + 2], x[8 * q + 3]); o.z = cvtpk(x[8 * q + 4], x[8 * q + 5]); o.w = cvtpk(x[8 * q + 6], x[8 * q + 7]);
                *(LAS v4u*)(xt + q * 16) = o; } }
        __syncthreads();
        const LAS unsigned char* WMT = L + SC_RHS; const LAS unsigned char* U0T = L + SC_RHS + SC_TB;
        if (w < 4) {
#pragma unroll
            for (int i = 0; i < 16; ++i) { acc[0][i] = 0.f; acc[1][i] = 0.f; } }
        if (w < 2) {
            tile_mma2(acc, WMT, L + SL_ARB * SC_TB, w & 1, r32, hi);
            bf16* qo = QE + (size_t)cu * 4096;
#pragma unroll
            for (int nt = 0; nt < 2; ++nt) { const int tt = 32 * nt + r32;
#pragma unroll
                for (int rg = 0; rg < 4; ++rg) { const int d0 = 32 * (w & 1) + 8 * rg + 4 * hi; const v2u rt = *(const LAS v2u*)(L + SL_R * SC_TB + (tt * SC_TS + d0) * 2);
                    v2u o; o.x = cvtpk(acc[nt][4 * rg] + bflo(rt.x), acc[nt][4 * rg + 1] + bfhi(rt.x)); o.y = cvtpk(acc[nt][4 * rg + 2] + bflo(rt.y), acc[nt][4 * rg + 3] + bfhi(rt.y));
                    *(v2u*)(qo + tt * 64 + d0) = o; } }
        } else if (w < 4) {
            tile_mma2(acc, WMT, L + SL_BH * SC_TB, w & 1, r32, hi);
            bf16* mo = MCT + (size_t)cu * 4096;
#pragma unroll
            for (int nt = 0; nt < 2; ++nt) { const int dp = 32 * nt + r32; const float gc = Gend[dp];
#pragma unroll
                for (int rg = 0; rg < 4; ++rg) { const int d0 = 32 * (w & 1) + 8 * rg + 4 * hi; float v[4];
#pragma unroll
                    for (int e = 0; e < 4; ++e) v[e] = acc[nt][4 * rg + e] + ((d0 + e == dp) ? gc : 0.f);
                    v2u o; o.x = cvtpk(v[0], v[1]); o.y = cvtpk(v[2], v[3]); *(v2u*)(mo + dp * 64 + d0) = o; } }
        } else if (w < 6) {
            tile_mma2(acc, U0T, L + SL_ARB * SC_TB, w & 1, r32, hi);
            float* yo = Y0 + (size_t)cu * 4096;
#pragma unroll
            for (int nt = 0; nt < 2; ++nt) { const int tt = 32 * nt + r32;
#pragma unroll
                for (int rg = 0; rg < 4; ++rg) { const int i0 = 32 * (w & 1) + 8 * rg + 4 * hi; *(f32x4*)(yo + tt * 64 + i0) = (f32x4){acc[nt][4 * rg], acc[nt][4 * rg + 1], acc[nt][4 * rg + 2], acc[nt][4 * rg + 3]}; } }
        } else {
            tile_mma2(acc, L + SL_BH * SC_TB, U0T, w & 1, r32, hi);
            bf16* no = NC + (size_t)cu * 4096;
#pragma unroll
            for (int nt = 0; nt < 2; ++nt) { const int ii = 32 * nt + r32;
#pragma unroll
                for (int rg = 0; rg < 4; ++rg) { const int d0 = 32 * (w & 1) + 8 * rg + 4 * hi; v2u o; o.x = cvtpk(acc[nt][4 * rg], acc[nt][4 * rg + 1]); o.y = cvtpk(acc[nt][4 * rg + 2], acc[nt][4 * rg + 3]);
                    *(v2u*)(no + ii * 64 + d0) = o; } }
        }
        __syncthreads();
    }
}
__device__ __forceinline__ void p4b_state(Frame& F) {
    if (F.wave != 0) return;
    const bf16* MCT = (const bf16*)(F.ws + WS_MCT); const bf16* NC = (const bf16*)(F.ws + WS_NC); bf16* SCB = (bf16*)(F.ws + WS_SC);
    const int lane = F.lane, il = lane & 15, g = lane >> 4;
    for (int unit = blockIdx.x; unit < BATCH * 16 * 4; unit += F.G) {
        const int bh = unit >> 2, ig = (unit & 3) * 16 + il;
        f32x4 acc[4];
#pragma unroll
        for (int m = 0; m < 4; ++m) acc[m] = (f32x4){0.f, 0.f, 0.f, 0.f};
        v2u af[4][2][2]; v2u nf[4];
        {   const bf16* mc = MCT + (size_t)(bh * 64) * 4096; const bf16* nc = NC + (size_t)(bh * 64) * 4096;
#pragma unroll
            for (int m = 0; m < 4; ++m) { nf[m] = *(const v2u*)(nc + ig * 64 + 16 * m + 4 * g);
#pragma unroll
                for (int ks = 0; ks < 2; ++ks) { af[m][ks][0] = *(const v2u*)(mc + (16 * m + il) * 64 + 32 * ks + 4 * g); af[m][ks][1] = *(const v2u*)(mc + (16 * m + il) * 64 + 32 * ks + 16 + 4 * g); } } }
        for (int c = 0; c < 64; ++c) {
            const size_t cu = (size_t)bh * 64 + c;
            unsigned pk[4][2];
#pragma unroll
            for (int m = 0; m < 4; ++m) { pk[m][0] = cvtpk(acc[m][0], acc[m][1]); pk[m][1] = cvtpk(acc[m][2], acc[m][3]);
                v2u o; o.x = pk[m][0]; o.y = pk[m][1]; *(v2u*)(SCB + cu * 4096 + ig * 64 + 16 * m + 4 * g) = o; }
            const v4u b0 = {pk[0][0], pk[0][1], pk[1][0], pk[1][1]}, b1 = {pk[2][0], pk[2][1], pk[3][0], pk[3][1]};
            v2u ca[4][2][2], cn[4];
#pragma unroll
            for (int m = 0; m < 4; ++m) { cn[m] = nf[m];
#pragma unroll
                for (int ks = 0; ks < 2; ++ks) { ca[m][ks][0] = af[m][ks][0]; ca[m][ks][1] = af[m][ks][1]; } }
            if (c + 1 < 64) { const bf16* mc = MCT + (cu + 1) * 4096; const bf16* nc = NC + (cu + 1) * 4096;
#pragma unroll
                for (int m = 0; m < 4; ++m) { nf[m] = *(const v2u*)(nc + ig * 64 + 16 * m + 4 * g);
#pragma unroll
                    for (int ks = 0; ks < 2; ++ks) { af[m][ks][0] = *(const v2u*)(mc + (16 * m + il) * 64 + 32 * ks + 4 * g); af[m][ks][1] = *(const v2u*)(mc + (16 * m + il) * 64 + 32 * ks + 16 + 4 * g); } } }
#pragma unroll
            for (int m = 0; m < 4; ++m) {
                f32x4 ci = {bflo(cn[m].x), bfhi(cn[m].x), bflo(cn[m].y), bfhi(cn[m].y)};
                const v4u a0 = {ca[m][0][0].x, ca[m][0][0].y, ca[m][0][1].x, ca[m][0][1].y}, a1 = {ca[m][1][0].x, ca[m][1][0].y, ca[m][1][1].x, ca[m][1][1].y};
                ci = __builtin_amdgcn_mfma_f32_16x16x32_bf16(__builtin_bit_cast(bf16x8, a0), __builtin_bit_cast(bf16x8, b0), ci, 0, 0, 0);
                acc[m] = __builtin_amdgcn_mfma_f32_16x16x32_bf16(__builtin_bit_cast(bf16x8, a1), __builtin_bit_cast(bf16x8, b1), ci, 0, 0, 0);
            }
        }
    }
}
__device__ __forceinline__ void p4c_out(Frame& F) {
    LAS float* stage = (LAS float*)(F.lds + RING_OFF);
    const bf16* QE = (const bf16*)(F.ws + WS_QE); const bf16* SCB = (const bf16*)(F.ws + WS_SC); const float* Y0 = (const float*)(F.ws + WS_Y0); const float* RK = (const float*)(F.ws + WS_RK);
    const bf16* Vb = (const bf16*)(F.ws + WS_RKV) + (size_t)2 * M * D; const bf16* GG = (const bf16*)(F.ws + WS_GG); bf16* YG = (bf16*)(F.ws + WS_YG);
    const float* gn_g = F.in[19]; const float* gn_b = F.in[20];
    const int lane = F.lane, w = F.wave, r32 = lane & 31, hi = lane >> 5, us = w >> 1, nt = w & 1;
    for (int grp = blockIdx.x; grp < BATCH * 16 * 64 / 4; grp += F.G) {
        const int cu = grp * 4 + us, bh = cu >> 6, c = cu & 63, b = bh >> 4, h = bh & 15;
        const bf16* sc = SCB + (size_t)cu * 4096; const bf16* qe = QE + (size_t)cu * 4096; const float* y0 = Y0 + (size_t)cu * 4096;
        const int tt = 32 * nt + r32;
        f32x16 acc[2];
#pragma unroll
        for (int mt = 0; mt < 2; ++mt)
#pragma unroll
            for (int rg = 0; rg < 4; ++rg) { const f32x4 q = *(const f32x4*)(y0 + tt * 64 + 32 * mt + 8 * rg + 4 * hi); acc[mt][4 * rg] = q.x; acc[mt][4 * rg + 1] = q.y; acc[mt][4 * rg + 2] = q.z; acc[mt][4 * rg + 3] = q.w; }
#pragma unroll
        for (int ks = 0; ks < 4; ++ks) { const bf16x8 bq = *(const bf16x8*)(qe + tt * 64 + 16 * ks + 8 * hi);
            const bf16x8 a0 = *(const bf16x8*)(sc + r32 * 64 + 16 * ks + 8 * hi), a1 = *(const bf16x8*)(sc + (32 + r32) * 64 + 16 * ks + 8 * hi);
            acc[0] = MMA32(a0, bq, acc[0]); acc[1] = MMA32(a1, bq, acc[1]); }
        float sm = 0.f;
#pragma unroll
        for (int i = 0; i < 16; ++i) sm += acc[0][i] + acc[1][i];
        sm += __shfl_xor(sm, 32); const float mean = sm * (1.f / 64.f);
        float vs = 0.f;
#pragma unroll
        for (int i = 0; i < 16; ++i) { const float d0 = acc[0][i] - mean, d1 = acc[1][i] - mean; vs += d0 * d0 + d1 * d1; }
        vs += __shfl_xor(vs, 32); const float rstd = 1.0f / sqrtf(vs * (1.f / 64.f) + GN_EPS);
        LAS float* st = stage + us * (64 * 68);
#pragma unroll
        for (int mt = 0; mt < 2; ++mt)
#pragma unroll
            for (int rg = 0; rg < 4; ++rg) *(LAS f32x4*)(st + tt * 68 + 32 * mt + 8 * rg + 4 * hi) = (f32x4){(acc[mt][4 * rg] - mean) * rstd, (acc[mt][4 * rg + 1] - mean) * rstd, (acc[mt][4 * rg + 2] - mean) * rstd, (acc[mt][4 * rg + 3] - mean) * rstd};
        __syncthreads();
        {   const int i8 = (lane & 7) * 8; const int cg = h * 64 + i8;
            const f32x4 g0 = *(const f32x4*)(gn_g + cg), g1 = *(const f32x4*)(gn_g + cg + 4), b0 = *(const f32x4*)(gn_b + cg), b1 = *(const f32x4*)(gn_b + cg + 4);
#pragma unroll
            for (int it = 0; it < 4; ++it) { const int t2 = 32 * nt + it * 8 + (lane >> 3); const size_t ro = ((size_t)b * T + c * 64 + t2) * D + cg;
                const f32x4 y0v = *(const LAS f32x4*)(st + t2 * 68 + i8), y1v = *(const LAS f32x4*)(st + t2 * 68 + i8 + 4);
                const v4u vv = *(const v4u*)(Vb + ro), gg = *(const v4u*)(GG + ro); const float rk = RK[(size_t)cu * 64 + t2];
                float o[8];
                o[0] = (y0v.x * g0.x + b0.x + rk * bflo(vv.x)) * bflo(gg.x); o[1] = (y0v.y * g0.y + b0.y + rk * bfhi(vv.x)) * bfhi(gg.x);
                o[2] = (y0v.z * g0.z + b0.z + rk * bflo(vv.y)) * bflo(gg.y); o[3] = (y0v.w * g0.w + b0.w + rk * bfhi(vv.y)) * bfhi(gg.y);
                o[4] = (y1v.x * g1.x + b1.x + rk * bflo(vv.z)) * bflo(gg.z); o[5] = (y1v.y * g1.y + b1.y + rk * bfhi(vv.z)) * bfhi(gg.z);
                o[6] = (y1v.z * g1.z + b1.z + rk * bflo(vv.w)) * bflo(gg.w); o[7] = (y1v.w * g1.w + b1.w + rk * bfhi(vv.w)) * bfhi(gg.w);
                v4u ov; ov.x = cvtpk(o[0], o[1]); ov.y = cvtpk(o[2], o[3]); ov.z = cvtpk(o[4], o[5]); ov.w = cvtpk(o[6], o[7]); *(v4u*)(YG + ro) = ov; }
        }
        __syncthreads();
    }
}

constexpr int NPHASE = 22;
#define IN(k) (lo <= (k) && (k) < hi)
#define SEAM(k) do { if (IN(k) && (k) + 1 < hi) xcd_barrier(bar); } while (0)
template <int L> __device__ __forceinline__ void moe_phases(Frame& F, const int lo, const int hi, const XcdBarrier& bar) {
    constexpr int pb = 11 * L;
    LAS unsigned char* ring = F.lds + RING_OFF;
    const LAS int* toff = (const LAS int*)(F.lds + LDSCTL_OFF);
        if (IN(pb + 6)) { F.lane = lane_id(); moe_router(F, L, (const float*)(F.ws + WS_XA)); moe_weights(F, L); } SEAM(pb + 6);
        if (IN(pb + 7)) { F.lane = lane_id(); moe_gather(F, L); } SEAM(pb + 7);
        if (IN(pb + 8)) { F.lane = lane_id();
            moe_toff(F, L);
            pg8::MoeOrder S; S.init(F.ws + WS_XS, F.ws + WS_MOEGU, (size_t)1024 * 1024 * 2, toff, 4, D, F.G, (int)blockIdx.x);
            pg8::EpiGU E{(bf16*)(F.ws + WS_HS)};
            pg8::gemm_phase<pg8::EpiGU, pg8::MoeOrder, true, true>(ring, D, S, E);
        } SEAM(pb + 8);
        if (IN(pb + 9)) { F.lane = lane_id();
            moe_toff(F, L);
            pg8::MoeOrder S; S.init(F.ws + WS_HS, F.ws + WS_MOED, (size_t)1024 * 512 * 2, toff, 4, FF, F.G, (int)blockIdx.x);
            pg8::EpiDown E{(bf16*)(F.ws + WS_Y), (const float*)(F.ws + WS_ROUTE) + 8 * M};
            pg8::gemm_phase<pg8::EpiDown, pg8::MoeOrder, true, true>(ring, FF, S, E);
        } SEAM(pb + 9);
        if (IN(pb + 10)) { F.lane = lane_id();
            moe_combine<L>(F, L, (const float*)(F.ws + WS_XA), F.out);
        } SEAM(pb + 10);
}
#undef IN
#undef SEAM
struct Args { const float* in[39]; float* out; unsigned char* ws; int ph_lo, ph_hi; };
__global__ void __launch_bounds__(NWAVES * 64, 2) trunk_fwd(Args args) {
    extern __shared__ __attribute__((aligned(16))) unsigned char lds[];
    Frame F;
    F.lds = (LAS unsigned char*)lds;
    F.MISC = (volatile LAS unsigned*)(F.lds + MISC_OFF);
    F.tid = threadIdx.x; F.lane = lane_id(); F.wave = __builtin_amdgcn_readfirstlane(F.tid >> 6);
    F.G = gridDim.x; { const int bx = blockIdx.x; F.vcu = (F.G % 8 == 0) ? (bx % 8) * (F.G / 8) + bx / 8 : bx; }
    F.ws = args.ws; F.ctl = (gu32*)(args.ws + WS_CTL); F.in = args.in; F.out = args.out;
    for (int u = F.tid; u < (LDS_BYTES - LDSCTL_OFF) / 4; u += NWAVES * 64) ((LAS unsigned*)(F.lds + LDSCTL_OFF))[u] = 0u;
    __syncthreads();
    const int lo = args.ph_lo, hi = args.ph_hi;
    const bool multi = (hi - lo) > 1;
    XcdBarrier bar; bar.bar = (unsigned*)(F.ctl + CW_BAR); bar.x = 0; bar.st = nullptr;
    if (multi) bar = xcd_barrier_post((unsigned*)(F.ctl + CW_BAR), F.MISC + 8);
#define IN(k) (lo <= (k) && (k) < hi)
#define SEAM(k) do { if (IN(k) && (k) + 1 < hi) xcd_barrier(bar); } while (0)
    LAS unsigned char* ring = F.lds + RING_OFF;
    const LAS int* toff = (const LAS int*)(F.lds + LDSCTL_OFF);

    {
        {
            if (IN(0)) { F.lane = lane_id(); p0_mod(F); p0_weights(F); } SEAM(0);
            if (IN(1)) { F.lane = lane_id(); p1_norm_views(F); } SEAM(1);
            if (IN(2)) { F.lane = lane_id();
                { pg8::BatchOrder S; S.init(F.ws + WS_VIEWS, F.ws + WS_WRKV, (size_t)M * D * 2, (size_t)D * D * 2, M, D, 3, D, F.G, (int)blockIdx.x);
                  pg8::EpiZBf16 E{(bf16*)(F.ws + WS_RKV), (size_t)M * D, 1.0f};
                  pg8::gemm_phase<pg8::EpiZBf16, pg8::BatchOrder, true, true>(ring, D, S, E); }
                { pg8::BatchOrder S; S.init(F.ws + WS_H2, F.ws + WS_WL1, 0, 0, M, 256, 1, 2048, F.G, (int)blockIdx.x);
                  pg8::EpiLora1 E{(bf16*)(F.ws + WS_A2)};
                  pg8::gemm_phase<pg8::EpiLora1, pg8::BatchOrder, true, true>(ring, 2048, S, E); }
            } SEAM(2);
            if (IN(3)) { F.lane = lane_id();
                pg8::BatchOrder S; S.init(F.ws + WS_A2, F.ws + WS_WL2, 0, 0, M, 3072, 1, 256, F.G, (int)blockIdx.x);
                pg8::EpiLora2 E{(float*)(F.ws + WS_LOGW), (bf16*)(F.ws + WS_ASIG), (bf16*)(F.ws + WS_GG), F.in[8], F.in[11]};
                pg8::gemm_phase<pg8::EpiLora2, pg8::BatchOrder, true, true>(ring, 256, S, E);
            } SEAM(3);
#if defined(SCAN_SEQ)
            if (IN(4)) { F.lane = lane_id(); p4_scan_seq(F); } SEAM(4);
#else
            if (IN(4)) { F.lane = lane_id(); p4a_chunks(F); xcd_barrier(bar); F.lane = lane_id(); p4b_state(F); xcd_barrier(bar); F.lane = lane_id(); p4c_out(F); } SEAM(4);
#endif
            if (IN(5)) { F.lane = lane_id();
                pg8::BatchOrder S; S.init(F.ws + WS_YG, F.ws + WS_WO0, 0, 0, M, D, 1, D, F.G, (int)blockIdx.x);
                pg8::EpiResid E{F.in[0], (float*)(F.ws + WS_XA), (const float*)(F.ws + WS_MOD) + 2048};
                pg8::gemm_phase<pg8::EpiResid, pg8::BatchOrder, true, true>(ring, D, S, E);
            } SEAM(5);
        }
        moe_phases<0>(F, lo, hi, bar);
        {
            if (IN(11)) { F.lane = lane_id();
                { pg8::BatchOrder S; S.init(F.ws + WS_HQ, F.ws + WS_WQKV, (size_t)M * D * 2, (size_t)D * D * 2, M, D, 2, D, F.G, (int)blockIdx.x);
                  pg8::EpiZBf16 E{(bf16*)(F.ws + WS_QKV), (size_t)M * D, attn_body::C2};
                  pg8::gemm_phase<pg8::EpiZBf16, pg8::BatchOrder, true, true>(ring, D, S, E); }
                { pg8::BatchOrder S; S.init(F.ws + WS_HK, F.ws + WS_WQKV + (size_t)2 * D * D * 2, 0, 0, M, D, 1, D, F.G, (int)blockIdx.x);
                  pg8::EpiZBf16 E{(bf16*)(F.ws + WS_QKV) + (size_t)2 * M * D, 0, 1.0f};
                  pg8::gemm_phase<pg8::EpiZBf16, pg8::BatchOrder, true, true>(ring, D, S, E); }
            } SEAM(11);
            if (IN(12)) { F.lane = lane_id();
                const attn_body::bf16* Q = (const attn_body::bf16*)(F.ws + WS_QKV); const attn_body::bf16* Kp = Q + (size_t)M * D; const attn_body::bf16* Vp = Kp + (size_t)M * D;
                attn_body::bf16* O = (attn_body::bf16*)(F.ws + WS_OC);
                const AttnOrder S((int)F.G, (int)blockIdx.x); attn_body::AttnUnit u;
                for (int i = 0; S.next(i, u); ++i) {
                    const int b = u.bh >> 5, h = (u.bh >> 2) & 7, c = (u.bh >> 1) & 1, vh = u.bh & 1;
                    attn_body::attn_unit<8>(b, u.qb, Q + (h * 2 + c) * 64, Kp + (h * 2 + c) * 64, Vp + h * 128 + vh * 64, O + (h * 2 + c) * 128 + vh * 64, (char*)lds + RING_OFF);
                }
            } SEAM(12);
            if (IN(13)) { F.lane = lane_id(); attn_subln(F); } SEAM(13);
            if (IN(14)) { F.lane = lane_id();
                pg8::BatchOrder S; S.init(F.ws + WS_ON, F.ws + WS_WO1, 0, 0, M, D, 1, D, F.G, (int)blockIdx.x);
                pg8::EpiResid E{F.out, (float*)(F.ws + WS_XA), (const float*)(F.ws + WS_MOD) + 4 * 6144 + 2048};
                pg8::gemm_phase<pg8::EpiResid, pg8::BatchOrder, true, true>(ring, D, S, E);
            } SEAM(14);
        }
        moe_phases<1>(F, lo, hi, bar);
    }
    if (multi && hi == NPHASE) { if (__hip_atomic_load((gu32*)((unsigned*)(F.ctl + CW_BAR) + XB_TMO), RLX_AGENT) != 0u) {
        const float q = __builtin_nanf(""); for (size_t i = (size_t)blockIdx.x * 512 + F.tid; i < (size_t)M * D; i += (size_t)F.G * 512) F.out[i] = q; } }
#undef IN
#undef SEAM
}

#ifndef N_LAUNCH_MODE
#define N_LAUNCH_MODE 1
#endif
extern "C" void kernel_launch(void* const* d_in, const int* in_sizes, int n_in, void* d_out, int out_size, void* d_ws, size_t ws_size, hipStream_t stream) {
    static int grid = 0;
    if (grid == 0) {
        if (n_in != 39 || in_sizes[0] != M * D || out_size != M * D || ws_size < WS_END) { fprintf(stderr, "kernel_launch: unexpected problem (n_in %d, in0 %d, out %d, ws %zu < %zu); nothing launched\n", n_in, n_in > 0 ? in_sizes[0] : -1, out_size, ws_size, (size_t)WS_END); grid = -1; return; }
        int dev = 0, cus = 0, per_cu = 0;
        if (hipGetDevice(&dev) != hipSuccess || hipDeviceGetAttribute(&cus, hipDeviceAttributeMultiprocessorCount, dev) != hipSuccess) { grid = -1; return; }
        if (hipFuncSetAttribute((const void*)trunk_fwd, hipFuncAttributeMaxDynamicSharedMemorySize, LDS_BYTES) != hipSuccess) { fprintf(stderr, "kernel_launch: hipFuncSetAttribute failed\n"); grid = -1; return; }
        if (hipOccupancyMaxActiveBlocksPerMultiprocessor(&per_cu, (const void*)trunk_fwd, NWAVES * 64, LDS_BYTES) != hipSuccess || per_cu < 1) fprintf(stderr, "kernel_launch: occupancy query reports %d\n", per_cu);
        (void)hipGetLastError();
        grid = cus;
    }
    if (grid < 0) return;
    if (hipMemsetAsync((char*)d_ws + WS_CTL, 0, CTL_ZERO_BYTES, stream) != hipSuccess) return;
    Args a{};
    for (int i = 0; i < 39; ++i) a.in[i] = (const float*)d_in[i];
    a.out = (float*)d_out; a.ws = (unsigned char*)d_ws;
    if (N_LAUNCH_MODE == 1) {
        a.ph_lo = 0; a.ph_hi = NPHASE;
        hipLaunchKernelGGL(trunk_fwd, dim3(grid), dim3(NWAVES * 64), LDS_BYTES, stream, a);
    } else {
        const int ids[20] = {0, 1, 2, 3, 4, 5, 6, 7, 8, 9, 10, 11, 12, 13, 14, 17, 18, 19, 20, 21};
        for (int k = 0; k < 20; ++k) { a.ph_lo = ids[k]; a.ph_hi = ids[k] + 1; hipLaunchKernelGGL(trunk_fwd, dim3(grid), dim3(NWAVES * 64), LDS_BYTES, stream, a); }
    }
}
```

```cpp
#include <hip/hip_runtime.h>
#include <hip/hip_bf16.h>
#include <cstdio>
#include <cstdint>
#include <cmath>

namespace pg8 {
#define PG8_LAS __attribute__((address_space(3)))
typedef unsigned short bf16_t;
typedef short bf16x8 __attribute__((ext_vector_type(8)));
typedef float f32x4 __attribute__((ext_vector_type(4)));
typedef unsigned u32x4 __attribute__((ext_vector_type(4)));
typedef unsigned u32x2 __attribute__((ext_vector_type(2)));
constexpr int BM = 256, BK = 64, HALF = 128, HTB = HALF * BK * 2  , STAGE_BYTES = 8 * HTB, NXCD = 8, WGM = 8;

__host__ __device__ __forceinline__ int lds_byte(int r, int c) { const int st = (r >> 4) * 2 + (c >> 5), rr = r & 15, cc = c & 31, ob = rr * 64 + cc * 2; return st * 1024 + (ob ^ (((ob >> 9) & 1) << 5)); }
__host__ __device__ __forceinline__ void stage_rc(int b, int& R, int& C) { const int st = b / 1024, sb = b % 1024, swz = sb ^ (((sb >> 9) & 1) << 5); R = (st >> 1) * 16 + swz / 64; C = (st & 1) * 32 + (swz % 64) / 2; }
__host__ __device__ __forceinline__ int perm32(int rho) { const int n = rho >> 4, i = rho & 15; return 8 * (i >> 2) + 4 * n + (i & 3); }

struct Unit { int pm, pn, z; };

__device__ __forceinline__ unsigned cvt_pk_bf16(float lo, float hi) { unsigned r; asm("v_cvt_pk_bf16_f32 %0, %1, %2" : "=v"(r) : "v"(lo), "v"(hi)); return r; }

struct BatchOrder {
    const char* A; const char* B; size_t sa, sb, tst; int nM, nN, nwg, tot, G, c;
    __device__ __forceinline__ void init(const void* A_, const void* B_, size_t sa_, size_t sb_, int M, int N, int Z, int K, int G_, int c_) {
        A = (const char*)A_; B = (const char*)B_; sa = sa_; sb = sb_; tst = (size_t)BM * K * 2; nM = M / BM; nN = N / BM; nwg = nM * nN; tot = nwg * Z; G = G_; c = c_; }
    __device__ __forceinline__ bool next(int i, Unit& u) const {
        const int L = i * G + c; if (L >= tot) return false;
        u.z = L / nwg; int wgid = L - u.z * nwg; { const int q = nwg / NXCD, r = nwg % NXCD, xcd = wgid % NXCD, off = wgid / NXCD; wgid = (xcd < r ? xcd * (q + 1) : r * (q + 1) + (xcd - r) * q) + off; }
        const int nig = WGM * nN, gid = wgid / nig, fm = gid * WGM, gsz = (nM - fm) < WGM ? (nM - fm) : WGM;
        u.pm = fm + ((wgid % nig) % gsz); u.pn = (wgid % nig) / gsz; return true;
    }
    __device__ __forceinline__ const char* a_base(const Unit& u) const { return A + (size_t)u.z * sa + (size_t)u.pm * tst; }
    __device__ __forceinline__ const char* b_base(const Unit& u) const { return B + (size_t)u.z * sb + (size_t)u.pn * tst; }
    __device__ __forceinline__ void a_ready(const Unit&) const {}
    __device__ __forceinline__ void done(const Unit&) const {}
};
struct MoeOrder {
    const char* A; const char* B; size_t sbe, tst; const PG8_LAS int* toff; int nNt, tot, G, c;
    __device__ __forceinline__ void init(const void* A_, const void* B_, size_t sbe_, const PG8_LAS int* toff_, int nNt_, int K, int G_, int c_) {
        A = (const char*)A_; B = (const char*)B_; sbe = sbe_; tst = (size_t)BM * K * 2; toff = toff_; nNt = nNt_; tot = toff_[32] * nNt_; G = G_; c = c_; }
    __device__ __forceinline__ bool next(int i, Unit& u) const {
        const int L = i * G + c; if (L >= tot) return false;
        const int tI = L / nNt; u.pm = tI; u.pn = L - tI * nNt; int e = 0;
#pragma unroll
        for (int j = 1; j < 32; ++j) e += (toff[j] <= tI) ? 1 : 0;
        u.z = e; return true;
    }
    __device__ __forceinline__ const char* a_base(const Unit& u) const { return A + (size_t)u.pm * tst; }
    __device__ __forceinline__ const char* b_base(const Unit& u) const { return B + (size_t)u.z * sbe + (size_t)u.pn * tst; }
    __device__ __forceinline__ void a_ready(const Unit&) const {}
    __device__ __forceinline__ void done(const Unit&) const {}
};

__device__ __forceinline__ float sigmoidf_(float x) { return 1.0f / (1.0f + __expf(-x)); }
__device__ __forceinline__ float tanh_fast(float x) { return 1.0f - 2.0f / (__expf(2.0f * x) + 1.0f); }

struct EpiZBf16 {
    static constexpr bool PERM = true, AFTER_DRAIN = false;
    bf16_t* O; size_t zstride; float scale0;
    __device__ __forceinline__ void operator()(const f32x4 (&acc)[2][2][4][2], const Unit& u, int wr, int wc, int fr, int fq) const {
        const int row0 = u.pm * BM + wr * 64 + fr, col0 = u.pn * BM + wc * 32 + 8 * fq; bf16_t* base = O + (size_t)u.z * zstride; const float sc = (u.z == 0) ? scale0 : 1.0f;
#pragma unroll
        for (int ai = 0; ai < 2; ++ai)
#pragma unroll
            for (int m = 0; m < 4; ++m) { bf16_t* rowp = base + (size_t)(row0 + ai * HALF + m * 16) * 1024 + col0;
#pragma unroll
                for (int bj = 0; bj < 2; ++bj) { const f32x4 v0 = acc[ai][bj][m][0] * sc, v1 = acc[ai][bj][m][1] * sc;
                    u32x4 w; w.x = cvt_pk_bf16(v0[0], v0[1]); w.y = cvt_pk_bf16(v0[2], v0[3]); w.z = cvt_pk_bf16(v1[0], v1[1]); w.w = cvt_pk_bf16(v1[2], v1[3]);
                    *(u32x4*)(rowp + bj * HALF) = w; } }
    }
};
struct EpiLora1 {
    static constexpr bool PERM = true, AFTER_DRAIN = false;
    bf16_t* O;
    __device__ __forceinline__ void operator()(const f32x4 (&acc)[2][2][4][2], const Unit& u, int wr, int wc, int fr, int fq) const {
        const int row0 = u.pm * BM + wr * 64 + fr, col0 = wc * 32 + 8 * fq;
#pragma unroll
        for (int ai = 0; ai < 2; ++ai)
#pragma unroll
            for (int m = 0; m < 4; ++m) { bf16_t* rowp = O + (size_t)(row0 + ai * HALF + m * 16) * 256 + col0;
#pragma unroll
                for (int bj = 0; bj < 2; ++bj) { f32x4 v0 = acc[ai][bj][m][0], v1 = acc[ai][bj][m][1];
                    if (bj == 0 && wc < 2) {
#pragma unroll
                        for (int j = 0; j < 4; ++j) { v0[j] = tanh_fast(v0[j]); v1[j] = tanh_fast(v1[j]); } }
                    if (bj == 1) {
#pragma unroll
                        for (int j = 0; j < 4; ++j) { v0[j] = sigmoidf_(v0[j]); v1[j] = sigmoidf_(v1[j]); } }
                    u32x4 w; w.x = cvt_pk_bf16(v0[0], v0[1]); w.y = cvt_pk_bf16(v0[2], v0[3]); w.z = cvt_pk_bf16(v1[0], v1[1]); w.w = cvt_pk_bf16(v1[2], v1[3]);
                    *(u32x4*)(rowp + bj * HALF) = w; } }
    }
};
struct EpiLora2 {
    static constexpr bool PERM = false, AFTER_DRAIN = false;
    float* LW; bf16_t* AS; bf16_t* GG; const float* w0; const float* a0;
    __device__ __forceinline__ void operator()(const f32x4 (&acc)[2][2][4][2], const Unit& u, int wr, int wc, int fr, int fq) const {
        const int sect = u.pn >> 2, row0 = u.pm * BM + wr * 64 + fr, col0 = (u.pn & 3) * BM + wc * 32 + 4 * fq;
#pragma unroll
        for (int ai = 0; ai < 2; ++ai)
#pragma unroll
            for (int m = 0; m < 4; ++m) { const size_t ro = (size_t)(row0 + ai * HALF + m * 16) * 1024;
#pragma unroll
                for (int bj = 0; bj < 2; ++bj)
#pragma unroll
                    for (int n = 0; n < 2; ++n) { const int c = col0 + bj * HALF + n * 16; f32x4 v = acc[ai][bj][m][n];
                        if (sect == 0) { const f32x4 b = *(const f32x4*)(w0 + c);
#pragma unroll
                            for (int j = 0; j < 4; ++j) { const float x = -(v[j] + b[j]); const float sp = fmaxf(x, 0.f) + __logf(1.0f + __expf(-fabsf(x))); v[j] = -__expf(-sp - 0.5f); }
                            *(f32x4*)(LW + ro + c) = v; }
                        else if (sect == 1) { const f32x4 b = *(const f32x4*)(a0 + c);
#pragma unroll
                            for (int j = 0; j < 4; ++j) v[j] = sigmoidf_(v[j] + b[j]);
                            u32x2 w; w.x = cvt_pk_bf16(v[0], v[1]); w.y = cvt_pk_bf16(v[2], v[3]); *(u32x2*)(AS + ro + c) = w; }
                        else { u32x2 w; w.x = cvt_pk_bf16(v[0], v[1]); w.y = cvt_pk_bf16(v[2], v[3]); *(u32x2*)(GG + ro + c) = w; } } }
    }
};
struct EpiResid {
    static constexpr bool PERM = false, AFTER_DRAIN = false;
    const float* xin; float* xout; const float* gate;
    __device__ __forceinline__ void operator()(const f32x4 (&acc)[2][2][4][2], const Unit& u, int wr, int wc, int fr, int fq) const {
        const int row0 = u.pm * BM + wr * 64 + fr, col0 = u.pn * BM + wc * 32 + 4 * fq; const float* gp = gate + (size_t)(u.pm >> 4) * 6144 + col0;
        f32x4 gv[2][2];
#pragma unroll
        for (int bj = 0; bj < 2; ++bj)
#pragma unroll
            for (int n = 0; n < 2; ++n) gv[bj][n] = *(const f32x4*)(gp + bj * HALF + n * 16);
#pragma unroll
        for (int ai = 0; ai < 2; ++ai)
#pragma unroll
            for (int m = 0; m < 4; ++m) { const size_t ro = (size_t)(row0 + ai * HALF + m * 16) * 1024 + col0;
#pragma unroll
                for (int bj = 0; bj < 2; ++bj)
#pragma unroll
                    for (int n = 0; n < 2; ++n) { const f32x4 xi = *(const f32x4*)(xin + ro + bj * HALF + n * 16); *(f32x4*)(xout + ro + bj * HALF + n * 16) = xi + gv[bj][n] * acc[ai][bj][m][n]; } }
    }
};
struct EpiGU {
    static constexpr bool PERM = true, AFTER_DRAIN = false;
    bf16_t* H;
    __device__ __forceinline__ void operator()(const f32x4 (&acc)[2][2][4][2], const Unit& u, int wr, int wc, int fr, int fq) const {
        const int row0 = u.pm * BM + wr * 64 + fr, col0 = u.pn * HALF + wc * 32 + 8 * fq;
#pragma unroll
        for (int ai = 0; ai < 2; ++ai)
#pragma unroll
            for (int m = 0; m < 4; ++m) { float h[8];
#pragma unroll
                for (int n = 0; n < 2; ++n)
#pragma unroll
                    for (int j = 0; j < 4; ++j) { const float g = acc[ai][0][m][n][j], up = acc[ai][1][m][n][j]; h[n * 4 + j] = g * sigmoidf_(g) * up; }
                u32x4 w; w.x = cvt_pk_bf16(h[0], h[1]); w.y = cvt_pk_bf16(h[2], h[3]); w.z = cvt_pk_bf16(h[4], h[5]); w.w = cvt_pk_bf16(h[6], h[7]);
                *(u32x4*)(H + (size_t)(row0 + ai * HALF + m * 16) * 512 + col0) = w; }
    }
};
struct EpiDown {
    static constexpr bool PERM = true, AFTER_DRAIN = false;
    bf16_t* Y; const float* rowgate;
    __device__ __forceinline__ void operator()(const f32x4 (&acc)[2][2][4][2], const Unit& u, int wr, int wc, int fr, int fq) const {
        const int row0 = u.pm * BM + wr * 64 + fr, col0 = u.pn * BM + wc * 32 + 8 * fq;
#pragma unroll
        for (int ai = 0; ai < 2; ++ai)
#pragma unroll
            for (int m = 0; m < 4; ++m) { const int r = row0 + ai * HALF + m * 16; const float gt = rowgate[r]; bf16_t* rowp = Y + (size_t)r * 1024 + col0;
#pragma unroll
                for (int bj = 0; bj < 2; ++bj) { const f32x4 v0 = acc[ai][bj][m][0] * gt, v1 = acc[ai][bj][m][1] * gt;
                    u32x4 w; w.x = cvt_pk_bf16(v0[0], v0[1]); w.y = cvt_pk_bf16(v0[2], v0[3]); w.z = cvt_pk_bf16(v1[0], v1[1]); w.w = cvt_pk_bf16(v1[2], v1[3]);
                    *(u32x4*)(rowp + bj * HALF) = w; } }
    }
};

template <class Epi, class Sched, bool ALIGN_EPI = false, bool SP2 = false>
__device__ __forceinline__ void gemm_phase(PG8_LAS unsigned char* lds, const int K_, const Sched& S, const Epi& E) {
    const int tid = threadIdx.x, wid = __builtin_amdgcn_readfirstlane(tid >> 6), lane = tid & 63, wr = wid >> 2, wc = wid & 3, fr = lane & 15, fq = lane >> 4;
    const int K = K_, nt = K / BK;
    unsigned voffA[2], voffB[2];
#pragma unroll
    for (int i = 0; i < 2; ++i) { int R, C; stage_rc(tid * 16 + i * 8192, R, C); const int Rb = Epi::PERM ? ((R & ~31) + perm32(R & 31)) : R;
        voffA[i] = (unsigned)(R * K + C) * 2u; voffB[i] = (unsigned)(Rb * K + C) * 2u; }
    const size_t kstep = (size_t)(BK * 2);
    const size_t hstep = (size_t)HALF * K * 2;
    const unsigned ldsw = (unsigned)wid * 1024u;
    const int aoff = lds_byte(wr * 64 + fr, fq * 8), boff = lds_byte(wc * 32 + fr, fq * 8);
#define PG8_SA(b, h) (((b) * 2 + (h)) * HTB)
#define PG8_SB(b, h) ((4 + (b) * 2 + (h)) * HTB)
#define PG8_STAGE(bufoff, gbase, voff) do { _Pragma("unroll") for (int _i = 0; _i < 2; ++_i) \
        __builtin_amdgcn_global_load_lds((const unsigned*)((const char*)(gbase) + (voff)[_i]), (PG8_LAS unsigned*)(lds + (bufoff) + ldsw + _i * 8192), 16, 0, 0); } while (0)
#define PG8_LDA(dst, b, h) do { _Pragma("unroll") for (int m = 0; m < 4; ++m) _Pragma("unroll") for (int k = 0; k < 2; ++k) dst[m][k] = *(const PG8_LAS bf16x8*)(lds + PG8_SA(b, h) + aoff + m * 2048 + k * 1024); } while (0)
#define PG8_LDB(dst, b, h) do { _Pragma("unroll") for (int n = 0; n < 2; ++n) _Pragma("unroll") for (int k = 0; k < 2; ++k) dst[n][k] = *(const PG8_LAS bf16x8*)(lds + PG8_SB(b, h) + boff + n * 2048 + k * 1024); } while (0)
#define PG8_MMA(ai, bj, At, Bt) do { __builtin_amdgcn_s_setprio(1); _Pragma("unroll") for (int m = 0; m < 4; ++m) _Pragma("unroll") for (int n = 0; n < 2; ++n) _Pragma("unroll") for (int k = 0; k < 2; ++k) \
        acc[ai][bj][m][n] = __builtin_amdgcn_mfma_f32_16x16x32_bf16(Bt[n][k], At[m][k], acc[ai][bj][m][n], 0, 0, 0); __builtin_amdgcn_s_setprio(0); } while (0)
#define PG8_WAIT_V(n) asm volatile("s_waitcnt vmcnt(" #n ")" ::: "memory")
#define PG8_WAIT_L(n) asm volatile("s_waitcnt lgkmcnt(" #n ")" ::: "memory")
#define PG8_BAR __builtin_amdgcn_s_barrier()
#define PG8_SCHED __builtin_amdgcn_sched_barrier(0)
    Unit cur, nxt; int ui = 0;
    if (!S.next(0, cur)) return;
    f32x4 acc[2][2][4][2];
#pragma unroll
    for (int a = 0; a < 2; ++a)
#pragma unroll
        for (int b = 0; b < 2; ++b)
#pragma unroll
            for (int m = 0; m < 4; ++m)
#pragma unroll
                for (int n = 0; n < 2; ++n) acc[a][b][m][n] = (f32x4){0.f, 0.f, 0.f, 0.f};
    bf16x8 At[4][2], B0[2][2], B1[2][2];
    const char* cA = S.a_base(cur); const char* cB = S.b_base(cur);
    S.a_ready(cur);
    if constexpr (SP2) {
        PG8_STAGE(PG8_SB(0, 0), cB, voffB); PG8_STAGE(PG8_SB(0, 1), cB + hstep, voffB); PG8_STAGE(PG8_SA(0, 0), cA, voffA); PG8_STAGE(PG8_SA(0, 1), cA + hstep, voffA);
        if (wr == 1) PG8_BAR;
        PG8_WAIT_V(2); PG8_BAR;
        PG8_STAGE(PG8_SB(1, 0), cB + kstep, voffB); PG8_STAGE(PG8_SA(1, 0), cA + kstep, voffA); PG8_STAGE(PG8_SB(1, 1), cB + hstep + kstep, voffB);
        PG8_WAIT_V(6); PG8_BAR;
    } else {
        PG8_STAGE(PG8_SB(0, 0), cB, voffB); PG8_STAGE(PG8_SA(0, 0), cA, voffA); PG8_STAGE(PG8_SB(0, 1), cB + hstep, voffB); PG8_STAGE(PG8_SA(0, 1), cA + hstep, voffA);
        if (wr == 1) PG8_BAR;
        PG8_WAIT_V(4); PG8_BAR;
        PG8_STAGE(PG8_SB(1, 0), cB + kstep, voffB); PG8_STAGE(PG8_SA(1, 0), cA + kstep, voffA); PG8_STAGE(PG8_SB(1, 1), cB + hstep + kstep, voffB);
        PG8_WAIT_V(6); PG8_BAR;
    }
    for (;;) {
        const bool has_next = S.next(ui + 1, nxt);
        const char* nA = has_next ? S.a_base(nxt) : cA; const char* nB = has_next ? S.b_base(nxt) : cB;
        for (int t = 0; t < nt; t += 2) {
            const bool last = (t == nt - 2);
            const char* a1 = cA + (size_t)(t + 1) * kstep;
            const char* a2 = last ? nA : cA + (size_t)(t + 2) * kstep; const char* b2 = last ? nB : cB + (size_t)(t + 2) * kstep;
            const char* a3 = a2 + kstep; const char* b3 = b2 + kstep;
            if (last && has_next) S.a_ready(nxt);
            if constexpr (SP2) {
            PG8_LDB(B0, 0, 0); PG8_LDB(B1, 0, 1); PG8_SCHED; PG8_LDA(At, 0, 0); PG8_STAGE(PG8_SA(1, 1), a1 + hstep, voffA);
            PG8_WAIT_V(8); PG8_WAIT_L(0); PG8_BAR; PG8_MMA(0, 0, At, B0); PG8_MMA(0, 1, At, B1); PG8_BAR; PG8_SCHED;
            PG8_LDA(At, 0, 1); PG8_STAGE(PG8_SB(0, 0), b2, voffB); PG8_STAGE(PG8_SB(0, 1), b2 + hstep, voffB); PG8_STAGE(PG8_SA(0, 0), a2, voffA);
            PG8_WAIT_V(8); PG8_WAIT_L(0); PG8_BAR; PG8_MMA(1, 0, At, B0); PG8_MMA(1, 1, At, B1); PG8_BAR; PG8_SCHED;
            PG8_LDB(B0, 1, 0); PG8_LDB(B1, 1, 1); PG8_SCHED; PG8_LDA(At, 1, 0); PG8_STAGE(PG8_SA(0, 1), a2 + hstep, voffA);
            PG8_WAIT_V(8); PG8_WAIT_L(0); PG8_BAR; PG8_MMA(0, 0, At, B0); PG8_MMA(0, 1, At, B1); PG8_BAR; PG8_SCHED;
            PG8_LDA(At, 1, 1); PG8_STAGE(PG8_SB(1, 0), b3, voffB); PG8_STAGE(PG8_SB(1, 1), b3 + hstep, voffB); PG8_STAGE(PG8_SA(1, 0), a3, voffA);
            PG8_WAIT_V(8); PG8_WAIT_L(0); PG8_BAR; PG8_MMA(1, 0, At, B0); PG8_MMA(1, 1, At, B1); PG8_BAR; PG8_SCHED;
            } else {
            PG8_LDB(B0, 0, 0); PG8_SCHED; PG8_LDA(At, 0, 0); PG8_STAGE(PG8_SA(1, 1), a1 + hstep, voffA);
            PG8_WAIT_L(8); PG8_BAR; PG8_WAIT_L(0); PG8_MMA(0, 0, At, B0); PG8_BAR; PG8_SCHED;
            PG8_LDB(B1, 0, 1); PG8_STAGE(PG8_SB(0, 0), b2, voffB);
            PG8_BAR; PG8_WAIT_L(0); PG8_MMA(0, 1, At, B1); PG8_BAR;
            PG8_LDA(At, 0, 1); PG8_STAGE(PG8_SA(0, 0), a2, voffA);
            PG8_BAR; PG8_WAIT_L(0); PG8_MMA(1, 0, At, B0); PG8_BAR; PG8_SCHED;
            PG8_STAGE(PG8_SB(0, 1), b2 + hstep, voffB);
            PG8_WAIT_V(6); PG8_BAR; PG8_MMA(1, 1, At, B1); PG8_BAR;
            PG8_LDB(B0, 1, 0); PG8_SCHED; PG8_LDA(At, 1, 0); PG8_STAGE(PG8_SA(0, 1), a2 + hstep, voffA);
            PG8_WAIT_L(8); PG8_BAR; PG8_WAIT_L(0); PG8_MMA(0, 0, At, B0); PG8_BAR; PG8_SCHED;
            PG8_LDB(B1, 1, 1); PG8_STAGE(PG8_SB(1, 0), b3, voffB);
            PG8_BAR; PG8_WAIT_L(0); PG8_MMA(0, 1, At, B1); PG8_BAR;
            PG8_LDA(At, 1, 1); PG8_STAGE(PG8_SA(1, 0), a3, voffA);
            PG8_BAR; PG8_WAIT_L(0); PG8_MMA(1, 0, At, B0); PG8_BAR; PG8_SCHED;
            PG8_STAGE(PG8_SB(1, 1), b3 + hstep, voffB);
            PG8_WAIT_V(6); PG8_BAR; PG8_MMA(1, 1, At, B1); PG8_BAR;
            }
        }
        if constexpr (ALIGN_EPI) { if (wr == 0) PG8_BAR; }
        if constexpr (!Epi::AFTER_DRAIN) { E(acc, cur, wr, wc, fr, fq); S.done(cur); }
        if (!has_next) break;
#pragma unroll
        for (int a = 0; a < 2; ++a)
#pragma unroll
            for (int b = 0; b < 2; ++b)
#pragma unroll
                for (int m = 0; m < 4; ++m)
#pragma unroll
                    for (int n = 0; n < 2; ++n) acc[a][b][m][n] = (f32x4){0.f, 0.f, 0.f, 0.f};
        cur = nxt; cA = nA; cB = nB; ++ui;
        if constexpr (ALIGN_EPI) { if (wr == 1) PG8_BAR; }
    }
    PG8_WAIT_V(0);
    if constexpr (!ALIGN_EPI) { if (wr == 0) PG8_BAR; }
    PG8_BAR;
    if constexpr (Epi::AFTER_DRAIN) { E.fused(acc, cur, wr, wc, fr, fq, lds, wid, lane); S.done(cur); }
#undef PG8_SA
#undef PG8_SB
#undef PG8_STAGE
#undef PG8_LDA
#undef PG8_LDB
#undef PG8_MMA
#undef PG8_WAIT_V
#undef PG8_WAIT_L
#undef PG8_BAR
#undef PG8_SCHED
}
}

namespace attn_body {
using bf16=__hip_bfloat16;
using bf16x8=__attribute__((ext_vector_type(8)))short;
using s16x4=__attribute__((ext_vector_type(4)))short;
using f32x16=__attribute__((ext_vector_type(16)))float;
using u32x4=__attribute__((ext_vector_type(4)))unsigned;
constexpr int BATCH=4,SEQ=4096,D=64,QP=1024,KP=1024,VP=1024,OP=2048;
constexpr int NW=8,QBLK=32,QB=QBLK*NW,KVBLK=64,NQB=SEQ/QB;
constexpr int ATTN_UNIT_ROWS=QB;
__device__ __forceinline__ int crow(int r,int hi){return (r&3)+8*(r>>2)+4*hi;}
#define SBAR() __builtin_amdgcn_sched_barrier(0)
__device__ __forceinline__ void cmask(f32x16&p0,f32x16&p1,int jb,int qrel,int hi){
  const float NEG=-INFINITY; int kb=64*jb+4*hi;
  #pragma unroll
  for(int r=0;r<16;++r){int kv=kb+(r&3)+8*(r>>2); if(kv>qrel)p0[r]=NEG; if(kv+32>qrel)p1[r]=NEG;}
}

constexpr int NSLOT=3, SLOTB=8192;
constexpr int LDS_K=0, LDS_V=NSLOT*SLOTB, LDS_WS=2*NSLOT*SLOTB, LDS_OST=LDS_WS+NW*64*4, LDS_BYTES=LDS_OST+NW*4096;
constexpr float C2=0.125f*1.4426950408889634f;
__device__ __forceinline__ void glds16(const void*gsrc,unsigned lds_dst){unsigned keep;
  asm volatile("s_mov_b32 %0, m0\n\ts_mov_b32 m0, %2\n\ts_nop 0\n\tglobal_load_lds_dwordx4 %1, off\n\ts_mov_b32 m0, %0":"=&s"(keep):"v"(gsrc),"s"(lds_dst):"memory");}
__device__ __forceinline__ float max3f(float a,float b,float c){float r;asm("v_max3_f32 %0, %1, %2, %3":"=v"(r):"v"(a),"v"(b),"v"(c));return r;}
__device__ __forceinline__ float max2f(float a,float b){float r;asm("v_max_f32_e32 %0, %1, %2":"=v"(r):"v"(a),"v"(b));return r;}
__device__ __forceinline__ float fadd_s(float a,float b){float r;asm("v_add_f32_e32 %0, %1, %2":"=v"(r):"v"(a),"v"(b));return r;}
__device__ __forceinline__ float fsub_s(float a,float b){float r;asm("v_sub_f32_e32 %0, %1, %2":"=v"(r):"v"(a),"v"(b));return r;}
typedef float f32x2_t __attribute__((ext_vector_type(2))); typedef __bf16 bf16x2_t __attribute__((ext_vector_type(2)));
__device__ __forceinline__ unsigned cvtpk_s(float lo,float hi){f32x2_t v={lo,hi};bf16x2_t b=__builtin_convertvector(v,bf16x2_t);return __builtin_bit_cast(unsigned,b);}
#define WAIT_BAR(N) asm volatile("s_waitcnt vmcnt(" #N ") lgkmcnt(0)\n\ts_barrier":::"memory")

__device__ __forceinline__ void qkt(f32x16&p0,f32x16&p1,const char*Kslot,const bf16x8*qr,const f32x16&negm,int r32,int hi){
  const char*kb=Kslot+hi*1024+r32*16;
  #pragma unroll
  for(int d0=0;d0<4;++d0){
    const bf16x8 b0=*reinterpret_cast<const bf16x8*>(kb+d0*2048);
    const bf16x8 b1=*reinterpret_cast<const bf16x8*>(kb+d0*2048+512);
    if(d0==0){p0=__builtin_amdgcn_mfma_f32_32x32x16_bf16(b0,qr[0],negm,0,0,0);p1=__builtin_amdgcn_mfma_f32_32x32x16_bf16(b1,qr[0],negm,0,0,0);}
    else{p0=__builtin_amdgcn_mfma_f32_32x32x16_bf16(b0,qr[d0],p0,0,0,0);p1=__builtin_amdgcn_mfma_f32_32x32x16_bf16(b1,qr[d0],p1,0,0,0);}}
}
typedef __attribute__((address_space(3))) const char* lds_cptr;
typedef short v4i16_t __attribute__((ext_vector_type(4)));
__device__ __forceinline__ void kload8(bf16x8*kf,lds_cptr kp){
  kf[0]=*(const __attribute__((address_space(3))) bf16x8*)(kp);      kf[1]=*(const __attribute__((address_space(3))) bf16x8*)(kp+512);
  kf[2]=*(const __attribute__((address_space(3))) bf16x8*)(kp+2048); kf[3]=*(const __attribute__((address_space(3))) bf16x8*)(kp+2560);
  kf[4]=*(const __attribute__((address_space(3))) bf16x8*)(kp+4096); kf[5]=*(const __attribute__((address_space(3))) bf16x8*)(kp+4608);
  kf[6]=*(const __attribute__((address_space(3))) bf16x8*)(kp+6144); kf[7]=*(const __attribute__((address_space(3))) bf16x8*)(kp+6656);
}
__device__ __forceinline__ void kload2(bf16x8*kf,lds_cptr kp,int j){ kf[2*j]=*(const __attribute__((address_space(3))) bf16x8*)(kp+j*2048); kf[2*j+1]=*(const __attribute__((address_space(3))) bf16x8*)(kp+j*2048+512); }
__device__ __forceinline__ s16x4 vtr(lds_cptr p){ return __builtin_bit_cast(s16x4,__builtin_amdgcn_ds_read_tr16_b64_v4i16((__attribute__((address_space(3))) v4i16_t*)p)); }
__device__ __forceinline__ float rowmax(const f32x16&p0,const f32x16&p1){
  float a=max3f(p0[0],p0[1],p1[0]),b=max3f(p0[2],p0[3],p1[1]);a=max3f(a,p1[2],p1[3]);
  #pragma unroll
  for(int r=4;r<16;r+=4){a=max3f(a,p0[r],p0[r+1]);b=max3f(b,p0[r+2],p0[r+3]);a=max3f(a,p1[r],p1[r+1]);b=max3f(b,p1[r+2],p1[r+3]);}
  const float m=max2f(a,b);
  auto rr=__builtin_amdgcn_permlane32_swap(__float_as_uint(m),__float_as_uint(m),false,false);
  return max2f(__uint_as_float(rr[0]),__uint_as_float(rr[1]));
}
__device__ __forceinline__ void pv(f32x16*o,int vb,bf16x8 pa0,bf16x8 pa1,bf16x8 pa2,bf16x8 pa3){
  #pragma unroll
  for(int d0=0;d0<2;++d0){s16x4 lo[4],hi[4];
    #pragma unroll
    for(int ks=0;ks<4;++ks){
      asm volatile("ds_read_b64_tr_b16 %0,%1 offset:%c2":"=&v"(lo[ks]):"v"(vb),"i"(d0*4096+ks*1024):"memory");
      asm volatile("ds_read_b64_tr_b16 %0,%1 offset:%c2":"=&v"(hi[ks]):"v"(vb),"i"(d0*4096+ks*1024+512):"memory");}
    asm volatile("s_waitcnt lgkmcnt(0)":::"memory");SBAR();
    #define PK(k) (bf16x8){lo[k][0],lo[k][1],lo[k][2],lo[k][3],hi[k][0],hi[k][1],hi[k][2],hi[k][3]}
    o[d0]=__builtin_amdgcn_mfma_f32_32x32x16_bf16(pa0,PK(0),o[d0],0,0,0);
    o[d0]=__builtin_amdgcn_mfma_f32_32x32x16_bf16(pa1,PK(1),o[d0],0,0,0);
    o[d0]=__builtin_amdgcn_mfma_f32_32x32x16_bf16(pa2,PK(2),o[d0],0,0,0);
    o[d0]=__builtin_amdgcn_mfma_f32_32x32x16_bf16(pa3,PK(3),o[d0],0,0,0);
    #undef PK
  }
}

#ifndef ATTN_STORE16
#define ATTN_STORE16(p,v) (*(u32x4*)(p)=(v))
#endif
template<int THRL> __device__ __forceinline__ void attn_unit(int b,int qb,const bf16*Q,const bf16*__restrict__ K,const bf16*__restrict__ V,bf16*O,char*shm){
  const int tid=threadIdx.x,lane=tid&63,r32=lane&31,hi=lane>>5; const int wid=__builtin_amdgcn_readfirstlane(tid>>6);
  const long rowbase=(long)b*SEQ; const int q0=qb*QB;
  const bf16*Qw=Q+(rowbase+q0+wid*QBLK)*QP;
  const bf16*Kh=K+rowbase*KP,*Vh=V+rowbase*VP;
  const unsigned lds0=(unsigned)(uintptr_t)shm;
  float*wsf=(float*)(shm+LDS_WS)+wid*64;
  const bf16*ksrc=Kh+(long)lane*KP+wid*8;
  const bf16*vsrc=Vh+(long)(16*(wid&3)+(lane>>2))*VP+(wid>>2)*32+(lane&3)*8;
  const unsigned kdst=lds0+LDS_K+wid*1024, vdst=lds0+LDS_V+wid*1024;
  #define DMA_K(t,slot) glds16(ksrc+(long)(t)*KVBLK*KP,(unsigned)__builtin_amdgcn_readfirstlane(kdst+(slot)))
  #define DMA_V(t,slot) glds16(vsrc+(long)(t)*KVBLK*VP,(unsigned)__builtin_amdgcn_readfirstlane(vdst+(slot)))
  const int vb0=(int)(lds0+LDS_V)+((lane>>4)&1)*32+(lane&3)*8+(4*hi+((lane&15)>>2))*64;
  const char*Kbase=shm+LDS_K; bf16x8 kf[8];
  const lds_cptr shm3=(lds_cptr)shm; const lds_cptr kp0=shm3+LDS_K+hi*1024+r32*16; const lds_cptr vp0=shm3+LDS_V+((lane>>4)&1)*32+(lane&3)*8+(4*hi+((lane&15)>>2))*64;
  const int NT=(q0+QB)/KVBLK;
  DMA_K(0,0);DMA_V(0,0);DMA_K(1,SLOTB);
  bf16x8 qr[4];
  #pragma unroll
  for(int d0=0;d0<4;++d0)qr[d0]=*reinterpret_cast<const bf16x8*>(&Qw[(long)r32*QP+d0*16+hi*8]);
  float mhat=0.f,l_reg=0.f;f32x16 o[2];o[0]=f32x16{};o[1]=f32x16{};f32x16 negm=f32x16{};asm volatile("":"+v"(negm));
  const int qrel=wid*QBLK+r32;
  #define CMASK(P0,P1,t) do{int jb_=(t)-(NT-4); if(jb_>=0)cmask(P0,P1,jb_,qrel,hi);}while(0)
  bool resc=false;
  #define START(P0,P1) do{ const float rm=rowmax(P0,P1); resc=false; \
    { const float dl=rm; mhat=fadd_s(mhat,dl); \
      _Pragma("unroll") for(int r=0;r<16;++r){P0[r]=fsub_s(P0[r],dl);P1[r]=fsub_s(P1[r],dl);} \
      _Pragma("unroll") for(int r=0;r<16;++r)negm[r]=-mhat; asm volatile("":"+v"(negm)); } \
    _Pragma("unroll") for(int r=0;r<16;++r)P0[r]=__builtin_amdgcn_exp2f(P0[r]); }while(0)
  #define RESC() do{ if(resc){ asm volatile("s_waitcnt lgkmcnt(0)":::"memory"); \
      _Pragma("unroll") for(int d_=0;d_<2;++d_) _Pragma("unroll") for(int r=0;r<16;++r)o[d_][r]*=wsf[crow(r,hi)]; } }while(0)
  f32x16 pA0,pA1,pB0,pB1;
  int sl_prev=0,sl_cur=0,sl_next=SLOTB;
  #define ROT() do{sl_prev=sl_cur;sl_cur=sl_next;sl_next=(sl_next==(NSLOT-1)*SLOTB)?0:sl_next+SLOTB;}while(0)
  DMA_K(2,2*SLOTB);
  WAIT_BAR(3);
  qkt(pA0,pA1,Kbase,qr,negm,r32,hi);asm volatile("s_nop 15\n\ts_nop 7":"+v"(pA0),"+v"(pA1));CMASK(pA0,pA1,0);
  START(pA0,pA1);
  _Pragma("unroll") for(int r=0;r<16;++r)pA1[r]=__builtin_amdgcn_exp2f(pA1[r]);
  WAIT_BAR(0);
  DMA_K(3,0);DMA_V(1,SLOTB);
  ROT();
  kload8(kf,kp0+sl_cur);
  WAIT_BAR(2);
  s16x4 vlo[8],vhi[8]; u32x4 pw0,pw1,pw2,pw3;
  #define PKW(P,B) cvtpk_s(P[B],P[B+1])
  #define PAF(k) __builtin_bit_cast(bf16x8,pw##k)
  #define VFR(i) (bf16x8){vlo[i][0],vlo[i][1],vlo[i][2],vlo[i][3],vhi[i][0],vhi[i][1],vhi[i][2],vhi[i][3]}
  #define PIN(x) asm volatile("":"+v"(x))
  #define MX3(a,b,c) __builtin_fmaxf(__builtin_fmaxf((a),(b)),(c))
  #define GAPA(MF,A0,A1,A2,A3,W0,W1,PW) do{ MF; sacc+=A0; sacc+=A1; sacc+=A2; sacc+=A3; PIN(sacc); W0; W1; PIN(PW); SBAR(); }while(0)
  #define EX(v) __builtin_amdgcn_exp2f(v)
  #define GAPB(MF,X,B) do{ MF; X[B]=EX(X[B]); X[B+1]=EX(X[B+1]); X[B+2]=EX(X[B+2]); X[B+3]=EX(X[B+3]); PIN(X); SBAR(); }while(0)
  #define VRD(i) do{ vlo[i]=vtr(vp_+(((i)>>2)*4096+((i)&3)*1024)); vhi[i]=vtr(vp_+(((i)>>2)*4096+((i)&3)*1024+512)); }while(0)
  #define KRD(G,j) do{ if(G){ kload2(kf,kp0+sl_next,j); SBAR(); } }while(0)
  #define STEP(C0,C1,P0,P1,t,GK,GV,GL) do{ SBAR(); \
    const lds_cptr vp_=vp0+sl_prev; \
    VRD(0); SBAR(); float sacc=(P0[0]+P0[1]); \
    GAPA(C0=__builtin_amdgcn_mfma_f32_32x32x16_bf16(kf[0],qr[0],negm,0,0,0), P0[2],P0[3],P0[4],P0[5],     pw0[0]=PKW(P0,0), pw0[1]=PKW(P0,2), pw0); \
    VRD(4); SBAR(); GAPA(C1=__builtin_amdgcn_mfma_f32_32x32x16_bf16(kf[1],qr[0],negm,0,0,0), P0[6],P0[7],P0[8],P0[9],     pw0[2]=PKW(P0,4), pw0[3]=PKW(P0,6), pw0); \
    VRD(1); SBAR(); GAPA(C0=__builtin_amdgcn_mfma_f32_32x32x16_bf16(kf[2],qr[1],C0,0,0,0),   P0[10],P0[11],P0[12],P0[13], pw1[0]=PKW(P0,8), pw1[1]=PKW(P0,10), pw1); \
    VRD(5); SBAR(); GAPA(C1=__builtin_amdgcn_mfma_f32_32x32x16_bf16(kf[3],qr[1],C1,0,0,0),   P0[14],P0[15],P1[0],P1[1],   pw1[2]=PKW(P0,12),pw1[3]=PKW(P0,14), pw1); \
    VRD(2); SBAR(); GAPA(C0=__builtin_amdgcn_mfma_f32_32x32x16_bf16(kf[4],qr[2],C0,0,0,0),   P1[2],P1[3],P1[4],P1[5],     pw2[0]=PKW(P1,0), pw2[1]=PKW(P1,2), pw2); \
    VRD(6); SBAR(); GAPA(C1=__builtin_amdgcn_mfma_f32_32x32x16_bf16(kf[5],qr[2],C1,0,0,0),   P1[6],P1[7],P1[8],P1[9],     pw2[2]=PKW(P1,4), pw2[3]=PKW(P1,6), pw2); \
    VRD(3); SBAR(); GAPA(C0=__builtin_amdgcn_mfma_f32_32x32x16_bf16(kf[6],qr[3],C0,0,0,0),   P1[10],P1[11],P1[12],P1[13], pw3[0]=PKW(P1,8), pw3[1]=PKW(P1,10), pw3); \
    VRD(7); SBAR(); GAPA(C1=__builtin_amdgcn_mfma_f32_32x32x16_bf16(kf[7],qr[3],C1,0,0,0),   P1[14],P1[15],0.f,0.f,       pw3[2]=PKW(P1,12),pw3[3]=PKW(P1,14), pw3); \
    l_reg+=sacc; \
    if(GK){DMA_K((t)+3,sl_cur);} if(GV){DMA_V((t)+1,sl_next);} \
    CMASK(C0,C1,t); \
    { float a=MX3(C0[0],C0[1],C1[0]),b=MX3(C0[2],C0[3],C1[1]); a=MX3(a,C1[2],C1[3]); \
      _Pragma("unroll") for(int r=4;r<16;r+=4){a=MX3(a,C0[r],C0[r+1]);b=MX3(b,C0[r+2],C0[r+3]);a=MX3(a,C1[r],C1[r+1]);b=MX3(b,C1[r+2],C1[r+3]);} \
      float rm=__builtin_fmaxf(a,b); { auto rr=__builtin_amdgcn_permlane32_swap(__float_as_uint(rm),__float_as_uint(rm),false,false); rm=__builtin_fmaxf(__uint_as_float(rr[0]),__uint_as_float(rr[1])); } \
      resc=false; \
      if(__builtin_expect(__any(rm>(float)THRL),0)){ const float dl=__builtin_fmaxf(rm,0.f); mhat+=dl; \
        _Pragma("unroll") for(int r=0;r<16;++r){C0[r]-=dl;C1[r]-=dl;} \
        _Pragma("unroll") for(int r=0;r<16;++r)negm[r]=-mhat; asm volatile("":"+v"(negm)); \
        const float f=__builtin_amdgcn_exp2f(-dl); l_reg*=f; if(hi==0)wsf[r32]=f; resc=true; } } \
    SBAR(); \
    GAPB(o[0]=__builtin_amdgcn_mfma_f32_32x32x16_bf16(PAF(0),VFR(0),o[0],0,0,0), C0,0); \
    GAPB(o[1]=__builtin_amdgcn_mfma_f32_32x32x16_bf16(PAF(0),VFR(4),o[1],0,0,0), C0,4); \
    KRD(GL,0); GAPB(o[0]=__builtin_amdgcn_mfma_f32_32x32x16_bf16(PAF(1),VFR(1),o[0],0,0,0), C0,8); \
    KRD(GL,1); GAPB(o[1]=__builtin_amdgcn_mfma_f32_32x32x16_bf16(PAF(1),VFR(5),o[1],0,0,0), C0,12); \
    KRD(GL,2); GAPB(o[0]=__builtin_amdgcn_mfma_f32_32x32x16_bf16(PAF(2),VFR(2),o[0],0,0,0), C1,0); \
    KRD(GL,3); GAPB(o[1]=__builtin_amdgcn_mfma_f32_32x32x16_bf16(PAF(2),VFR(6),o[1],0,0,0), C1,4); \
    GAPB(o[0]=__builtin_amdgcn_mfma_f32_32x32x16_bf16(PAF(3),VFR(3),o[0],0,0,0), C1,8); \
    GAPB(o[1]=__builtin_amdgcn_mfma_f32_32x32x16_bf16(PAF(3),VFR(7),o[1],0,0,0), C1,12); \
    }while(0)
  int t=1;
  #undef CMASK
  #define CMASK(P0,P1,t) do{}while(0)
  for(;t+5<NT;t+=2){
    STEP(pB0,pB1,pA0,pA1,t,true,true,true);     WAIT_BAR(2); RESC(); ROT();
    STEP(pA0,pA1,pB0,pB1,t+1,true,true,true);   WAIT_BAR(2); RESC(); ROT();
  }
  #undef CMASK
  #define CMASK(P0,P1,t) do{int jb_=(t)-(NT-4); if(jb_>=0)cmask(P0,P1,jb_,qrel,hi);}while(0)
  #define ENDW(tt) do{ if((tt)+3<NT){WAIT_BAR(2);} else if((tt)+2<NT){WAIT_BAR(1);} else {WAIT_BAR(0);} }while(0)
  for(;t+1<NT;t+=2){
    STEP(pB0,pB1,pA0,pA1,t,(t+3<NT),(t+1<NT),(t+1<NT));       ENDW(t);   RESC(); ROT();
    STEP(pA0,pA1,pB0,pB1,t+1,(t+4<NT),(t+2<NT),(t+2<NT));     ENDW(t+1); RESC(); ROT();
  }
  STEP(pB0,pB1,pA0,pA1,NT-1,false,false,false); RESC();
  { float sacc=pB0[0]+pB0[1]; _Pragma("unroll") for(int r=2;r<16;++r)sacc+=pB0[r]; _Pragma("unroll") for(int r=0;r<16;++r)sacc+=pB1[r]; l_reg+=sacc;
    pw0=(u32x4){PKW(pB0,0),PKW(pB0,2),PKW(pB0,4),PKW(pB0,6)};pw1=(u32x4){PKW(pB0,8),PKW(pB0,10),PKW(pB0,12),PKW(pB0,14)};pw2=(u32x4){PKW(pB1,0),PKW(pB1,2),PKW(pB1,4),PKW(pB1,6)};pw3=(u32x4){PKW(pB1,8),PKW(pB1,10),PKW(pB1,12),PKW(pB1,14)};
    SBAR(); pv(o,vb0+sl_cur,PAF(0),PAF(1),PAF(2),PAF(3)); }
  #undef PKW
  #undef PAF
  #undef VFR
  #undef PIN
  #undef MX3
  #undef GAPA
  #undef GAPB
  #undef EX
  #undef VRD
  #undef KRD
  #undef STEP
  #undef ENDW
  {auto rr=__builtin_amdgcn_permlane32_swap(__float_as_uint(l_reg),__float_as_uint(l_reg),false,false);l_reg=__uint_as_float(rr[0])+__uint_as_float(rr[1]);}
  if(hi==0)wsf[32+r32]=l_reg;asm volatile("s_waitcnt lgkmcnt(0)":::"memory");
  float rli[16];
  #pragma unroll
  for(int r=0;r<16;++r)rli[r]=__builtin_amdgcn_rcpf(wsf[32+crow(r,hi)]);
  bf16*Ow=O+(rowbase+q0+wid*QBLK)*OP;
  { bf16*stg=(bf16*)(shm+LDS_OST)+wid*2048;
    #pragma unroll
    for(int r=0;r<16;++r){const int orow=crow(r,hi);
      #pragma unroll
      for(int d0=0;d0<2;++d0)stg[orow*64+d0*32+r32]=__float2bfloat16(o[d0][r]*rli[r]);}
    asm volatile("s_waitcnt lgkmcnt(0)":::"memory");
    #pragma unroll
    for(int i=0;i<4;++i){const int row=i*8+(lane>>3),ch=lane&7; const u32x4 v=*(const u32x4*)(stg+row*64+ch*8); ATTN_STORE16(Ow+(long)row*OP+ch*8,v);} }
  asm volatile("s_waitcnt lgkmcnt(0)\n\ts_barrier":::"memory");
  #undef DMA_K
  #undef DMA_V
  #undef CMASK
  #undef START
  #undef RESC
  #undef ROT
}
constexpr int ATTN_LDS_BYTES=LDS_BYTES;
struct AttnUnit { int bh; int qb; };
#undef SBAR
#undef WAIT_BAR
}

constexpr int NWAVES = 8;
constexpr int BATCH = 4, T = 4096, D = 1024, M = BATCH * T;
constexpr int NE = 32, FF = 512, NGRP = 4, EPG = 8;
constexpr int MAXROWS = 40960;
constexpr float RMS_EPS = 1e-6f, GN_EPS = 64e-5f, SUBLN_EPS = 1e-5f;
constexpr float LAMBDA_INIT1 = 0.35550906759f;

constexpr size_t MiB = 1u << 20;
constexpr size_t WS_CTL = 0, CTL_ZERO_BYTES = 1 * MiB;
constexpr size_t WS_MOD = 1 * MiB;
constexpr size_t WS_WRKV = 2 * MiB, WS_WL1 = 8 * MiB, WS_WL2 = 9 * MiB, WS_WO0 = 11 * MiB, WS_WQKV = 13 * MiB, WS_WO1 = 19 * MiB;
constexpr size_t WS_ROUTE = 21 * MiB;
constexpr size_t WS_MOEGU = 32 * MiB, WS_MOED = 96 * MiB;
constexpr size_t WS_XA = 128 * MiB;
constexpr size_t WS_R = 192 * MiB;
constexpr size_t WS_VIEWS = WS_R, WS_H2 = WS_R + 96 * MiB, WS_A2 = WS_R + 160 * MiB, WS_RKV = WS_R + 168 * MiB;
constexpr size_t WS_LOGW = WS_R, WS_ASIG = WS_R + 64 * MiB, WS_GG = WS_R + 96 * MiB, WS_YG = WS_R + 128 * MiB;
constexpr size_t WS_H2N = WS_R, WS_XS = WS_R + 32 * MiB, WS_HS = WS_R + 112 * MiB, WS_Y = WS_R + 152 * MiB;
constexpr size_t WS_HQ = WS_R, WS_HK = WS_R + 32 * MiB, WS_QKV = WS_R + 64 * MiB, WS_OC = WS_R + 160 * MiB, WS_ON = WS_R + 224 * MiB;
constexpr size_t WS_QE = 32 * MiB, WS_MCT = 64 * MiB, WS_SC = 96 * MiB, WS_Y0 = 128 * MiB, WS_NC = WS_R + 264 * MiB, WS_RK = WS_R + 296 * MiB;
constexpr size_t WS_END = WS_R + 297 * MiB;
static_assert(WS_RKV + 96 * MiB <= WS_END && WS_Y + 80 * MiB <= WS_END && WS_ON + 32 * MiB <= WS_END, "d_ws map");
constexpr int CW_BAR = 4096;
constexpr int CW_CNT = 8192;

constexpr int RING_OFF = 0, RING_BYTES = 131072;
constexpr int LDSCTL_OFF = 146944, MISC_OFF = LDSCTL_OFF + 320;
constexpr int LDS_BYTES = 147456;

#define GAS __attribute__((address_space(1)))
#define LAS __attribute__((address_space(3)))
typedef unsigned short bf16;
typedef unsigned v4u __attribute__((ext_vector_type(4)));
typedef unsigned v2u __attribute__((ext_vector_type(2)));
typedef float f32x4 __attribute__((ext_vector_type(4)));
typedef short bf16x8 __attribute__((ext_vector_type(8)));
typedef GAS unsigned gu32;
#define RLX_AGENT __ATOMIC_RELAXED, __HIP_MEMORY_SCOPE_AGENT
#define LDS_WAIT() asm volatile("s_waitcnt lgkmcnt(0)" ::: "memory")
#define VM_WAIT() asm volatile("s_waitcnt vmcnt(0)" ::: "memory")
__device__ __forceinline__ unsigned pk2(float lo, float hi) { return pg8::cvt_pk_bf16(lo, hi); }
__device__ __forceinline__ float bflo(unsigned w) { return __uint_as_float(w << 16); }
__device__ __forceinline__ float bfhi(unsigned w) { return __uint_as_float(w & 0xffff0000u); }

#define XB_TMO      128
#define XB_XCNT(j)  (256  + 64 * (j))
#define XB_XSUB(j)  (1280 + 64 * (j))
#define XB_XGEN(j)  (2304 + 64 * (j))
#define XB_TOP      3328
#define XB_TOPGEN   3392
#define XCD_BAR_WORDS 3456
#define XB_SPIN_CAP (1u << 18)

__device__ __forceinline__ unsigned xb_ld(unsigned* p)              { return __hip_atomic_load(p, __ATOMIC_RELAXED, __HIP_MEMORY_SCOPE_AGENT); }
__device__ __forceinline__ unsigned xb_add(unsigned* p, unsigned v) { return __hip_atomic_fetch_add(p, v, __ATOMIC_RELAXED, __HIP_MEMORY_SCOPE_AGENT); }
__device__ __forceinline__ unsigned xb_xcc_id() { return (unsigned)__builtin_amdgcn_s_getreg((3 << 11) | 20) & 0xFu; }
#define XB_SPIN(cond, bar) do { unsigned _sp = 0; while (cond) { __builtin_amdgcn_s_sleep(1); \
    if ((++_sp & 255u) == 0u) { if (xb_ld(&(bar)[XB_TMO])) break; if (_sp > XB_SPIN_CAP) { atomicAdd(&(bar)[XB_TMO], 1u); break; } } } } while (0)

struct XcdBarrier {
    unsigned* bar; unsigned x;
    volatile LAS unsigned* st;
};

__device__ __forceinline__ XcdBarrier xcd_barrier_post(unsigned* bar, volatile LAS unsigned* st) {
    XcdBarrier b; b.bar = bar; b.x = xb_xcc_id(); b.st = st;
    if (threadIdx.x == 0) (void)xb_add(&bar[XB_XCNT(b.x)], 1u);
    return b;
}
__device__ __forceinline__ void xcd_barrier_complete(unsigned* bar, unsigned x, unsigned& nloc, unsigned& nx) {
    const unsigned G = gridDim.x * gridDim.y * gridDim.z;
    unsigned sum, cnt, mine, sp = 0u;
    for (;;) {
        sum = 0u; cnt = 0u; mine = 0u;
#pragma unroll
        for (unsigned j = 0; j < 16; ++j) { const unsigned c = xb_ld(&bar[XB_XCNT(j)]); sum += c; cnt += (c > 0u) ? 1u : 0u; mine = (j == x) ? c : mine; }
        if (sum == G) break;
        __builtin_amdgcn_s_sleep(1);
        if ((++sp & 255u) == 0u) { if (xb_ld(&bar[XB_TMO])) break; if (sp > XB_SPIN_CAP) { atomicAdd(&bar[XB_TMO], 1u); break; } }
    }
    nloc = mine > 0u ? mine : 1u; nx = cnt > 0u ? cnt : 1u;
}

__device__ __forceinline__ void xcd_barrier(const XcdBarrier& b) {
    asm volatile("s_waitcnt vmcnt(0)" ::: "memory");
    __syncthreads();
    if (threadIdx.x == 0) {
        unsigned* bar = b.bar;
        __builtin_amdgcn_s_waitcnt(0);
        unsigned nloc = b.st[0], nx = b.st[1];
        if (nloc == 0u) { xcd_barrier_complete(bar, b.x, nloc, nx); b.st[0] = nloc; b.st[1] = nx; }
        const unsigned old = xb_add(&bar[XB_XSUB(b.x)], 1u);
        const unsigned gen = old / nloc;
        if (old + 1u == (gen + 1u) * nloc) {
            __builtin_amdgcn_fence(__ATOMIC_RELEASE, "agent");
            asm volatile("s_waitcnt vmcnt(0)" ::: "memory");
            const unsigned og = xb_add(&bar[XB_TOP], 1u);
            const unsigned tg = og / nx;
            if (og + 1u == (tg + 1u) * nx) xb_add(&bar[XB_TOPGEN], 1u);
            else XB_SPIN(xb_ld(&bar[XB_TOPGEN]) == tg, bar);
            __builtin_amdgcn_fence(__ATOMIC_ACQUIRE, "agent");
            xb_add(&bar[XB_XGEN(b.x)], 1u);
            asm volatile("s_waitcnt vmcnt(0)" ::: "memory");
        } else {
            XB_SPIN(xb_ld(&bar[XB_XGEN(b.x)]) == gen, bar);
            __builtin_amdgcn_fence(__ATOMIC_ACQUIRE, "agent");
            asm volatile("s_waitcnt vmcnt(0)" ::: "memory");
        }
    }
    __syncthreads();
}


struct Frame {
    LAS unsigned char* lds;
    volatile LAS unsigned* MISC;
    gu32* ctl;
    unsigned char* ws;
    const float* const* in;
    float* out;
    int tid, lane, wave, vcu, G;
};
__device__ __forceinline__ int lane_id() { int l = threadIdx.x & 63; asm volatile("" : "+v"(l)); return l; }
__device__ __forceinline__ float wave_sum(float v) {
#pragma unroll
    for (int o = 1; o < 64; o <<= 1) v += __shfl_xor(v, o);
    return v;
}
__device__ __forceinline__ void transpose_item(const float* W, int ldw, int k0, int n0, bf16* WT, int ldo, int orow0, int ok0, const float* kscale, LAS float* scr, int lane) {
#pragma unroll 8
    for (int i = 0; i < 32; ++i) { const int kk = 2 * i + (lane >> 5); float v = W[(size_t)(k0 + kk) * ldw + n0 + (lane & 31)]; if (kscale) v *= kscale[k0 + kk]; scr[kk * 33 + (lane & 31)] = v; }
    LDS_WAIT(); asm volatile("" ::: "memory");
    const int c = lane & 7;
#pragma unroll
    for (int j = 0; j < 4; ++j) { const int n = (lane >> 3) + 8 * j; const LAS float* s = scr + (8 * c) * 33 + n;
        v4u o; o.x = pk2(s[0 * 33], s[1 * 33]); o.y = pk2(s[2 * 33], s[3 * 33]); o.z = pk2(s[4 * 33], s[5 * 33]); o.w = pk2(s[6 * 33], s[7 * 33]);
        *(GAS v4u*)(WT + (size_t)(orow0 + n) * ldo + ok0 + k0 + 8 * c) = o; }
    LDS_WAIT(); asm volatile("" ::: "memory");
}
__device__ __forceinline__ void transpose_mat(Frame& F, const float* W, int K, int N, bf16* WT, int ldo, int row_off, int ok0, const float* kscale, int gw, int NGW) {
    LAS float* scr = (LAS float*)(F.lds + RING_OFF + F.wave * 16384);
    const int nblk = N / 32, items = (K / 64) * nblk;
    for (int it = gw; it < items; it += NGW) { const int kb = it / nblk, nb = it % nblk; transpose_item(W, N, 64 * kb, 32 * nb, WT, ldo, row_off + 32 * nb, ok0, kscale, scr, F.lane); }
}

__device__ __forceinline__ void p0_mod(Frame& F) {
    LAS float* cact = (LAS float*)(F.lds + RING_OFF);
    LAS float* red = cact + 4096;
    const float* c = F.in[1];
    for (int i = F.tid; i < 4096; i += 512) { const float v = c[i]; cact[i] = v / (1.0f + __expf(-v)); }
    __syncthreads();
    float* modbase = (float*)(F.ws + WS_MOD);
    for (int it = blockIdx.x; it < 224; it += F.G) {
        const float* W; const float* bias; float* outp; int N, cc;
        if (it < 96) { W = F.in[2]; bias = F.in[3]; outp = modbase; N = 6144; cc = it; }
        else if (it < 192) { W = F.in[2] + (size_t)1024 * 6144; bias = F.in[3] + 6144; outp = modbase + 4 * 6144; N = 6144; cc = it - 96; }
        else { W = F.in[22]; bias = F.in[23]; outp = modbase + 8 * 6144; N = 2048; cc = it - 192; }
        const int kg = F.tid >> 4, cq = F.tid & 15, col = cc * 64 + cq * 4;
        f32x4 a0 = {0, 0, 0, 0}, a1 = a0, a2 = a0, a3 = a0;
#pragma unroll 4
        for (int kk = 0; kk < 32; ++kk) { const int k = kg * 32 + kk; const f32x4 w = *(const f32x4*)(W + (size_t)k * N + col);
            a0 += w * cact[k]; a1 += w * cact[1024 + k]; a2 += w * cact[2048 + k]; a3 += w * cact[3072 + k]; }
        LAS f32x4* rp = (LAS f32x4*)red + (kg * 16 + cq) * 4;
        rp[0] = a0; rp[1] = a1; rp[2] = a2; rp[3] = a3;
        __syncthreads();
        if (F.tid < 256) { const int b = F.tid >> 6, cl = F.tid & 63, cq2 = cl >> 2, j = cl & 3; float s = 0.f;
            for (int g = 0; g < 32; ++g) s += red[((g * 16 + cq2) * 4 + b) * 4 + j];
            outp[(size_t)b * N + cc * 64 + cl] = s + bias[cc * 64 + cl]; }
        __syncthreads();
    }
}
__device__ __forceinline__ void p0_weights(Frame& F) {
    const int gw = F.vcu * NWAVES + F.wave, NGW = F.G * NWAVES;
    bf16* Wrkv = (bf16*)(F.ws + WS_WRKV); bf16* Wl1 = (bf16*)(F.ws + WS_WL1); bf16* Wl2 = (bf16*)(F.ws + WS_WL2);
    bf16* Wo0 = (bf16*)(F.ws + WS_WO0); bf16* Wqkv = (bf16*)(F.ws + WS_WQKV); bf16* Wo1 = (bf16*)(F.ws + WS_WO1);
    for (int z = 0; z < 3; ++z) transpose_mat(F, F.in[7] + (size_t)z * D * D, D, D, Wrkv + (size_t)z * D * D, D, 0, 0, nullptr, gw, NGW);
    transpose_mat(F, F.in[21], D, D, Wo0, D, 0, 0, nullptr, gw, NGW);
    transpose_mat(F, F.in[26], D, D, Wqkv, D, 0, 0, nullptr, gw, NGW);
    transpose_mat(F, F.in[25], D, 2 * D, Wqkv, D, D, 0, nullptr, gw, NGW);
    transpose_mat(F, F.in[32], D, D, Wo1, D, 0, 0, nullptr, gw, NGW);
    const float* mu = F.in[6];
    transpose_mat(F, F.in[9], D, 64, Wl1, 2048, 0, 0, nullptr, gw, NGW);    transpose_mat(F, F.in[9], D, 64, Wl1, 2048, 0, 1024, mu + 3 * D, gw, NGW);
    transpose_mat(F, F.in[12], D, 64, Wl1, 2048, 64, 0, nullptr, gw, NGW);  transpose_mat(F, F.in[12], D, 64, Wl1, 2048, 64, 1024, mu + 4 * D, gw, NGW);
    transpose_mat(F, F.in[14], D, 128, Wl1, 2048, 128, 0, nullptr, gw, NGW); transpose_mat(F, F.in[14], D, 128, Wl1, 2048, 128, 1024, mu + 5 * D, gw, NGW);
    const float* w2 = F.in[10]; const float* a2 = F.in[13]; const float* g2 = F.in[15];
    for (int idx = (blockIdx.x * 512 + F.tid); idx < 3072 * 256; idx += F.G * 512) {
        const int k = idx / 3072, n = idx % 3072; float v = 0.f;
        if (n < 1024) { if (k < 64) v = w2[(size_t)k * 1024 + n]; }
        else if (n < 2048) { if (k >= 64 && k < 128) v = a2[(size_t)(k - 64) * 1024 + (n - 1024)]; }
        else { if (k >= 128) v = g2[(size_t)(k - 128) * 1024 + (n - 2048)]; }
        Wl2[(size_t)n * 256 + k] = (bf16)(pk2(v, 0.f) & 0xffffu);
    }
}
__device__ __forceinline__ void moe_weights(Frame& F, int l) {
    const int gw = F.vcu * NWAVES + F.wave, NGW = F.G * NWAVES;
    LAS float* scr = (LAS float*)(F.lds + RING_OFF + F.wave * 16384);
    bf16* GU = (bf16*)(F.ws + WS_MOEGU); bf16* DW = (bf16*)(F.ws + WS_MOED);
    const float* wg = F.in[35] + (size_t)l * NE * D * FF; const float* wu = F.in[36] + (size_t)l * NE * D * FF; const float* wd = F.in[37] + (size_t)l * NE * FF * D;
    for (int it = gw; it < NE * 768; it += NGW) {
        const int e = it / 768, r = it % 768;
        if (r < 512) { const int up = r >> 8, q = r & 255, kb = q >> 4, nb = q & 15, n0 = 32 * nb;
            const float* W = (up ? wu : wg) + (size_t)e * D * FF;
            transpose_item(W, FF, 64 * kb, n0, GU + (size_t)e * 1024 * 1024, 1024, 256 * (n0 >> 7) + (n0 & 127) + (up ? 128 : 0), 0, nullptr, scr, F.lane); }
        else { const int q = r - 512, kb = q >> 5, nb = q & 31;
            transpose_item(wd + (size_t)e * FF * D, D, 64 * kb, 32 * nb, DW + (size_t)e * 1024 * 512, 512, 32 * nb, 0, nullptr, scr, F.lane); }
    }
}

__device__ __forceinline__ void p1_norm_views(Frame& F) {
    LAS float* hrow = (LAS float*)(F.lds + RING_OFF);
    const float* x = F.in[0]; const float* g = F.in[4]; const float* mu = F.in[6];
    const float* mod = (const float*)(F.ws + WS_MOD);
    bf16* views = (bf16*)(F.ws + WS_VIEWS); bf16* H2 = (bf16*)(F.ws + WS_H2);
    for (int grp = blockIdx.x; grp < M / 8; grp += F.G) {
        const int m0 = grp * 8, b = m0 / T, t0 = m0 % T;
        const float* sh = mod + (size_t)b * 6144; const float* sc = sh + 1024;
        f32x4 hv[4];
        for (int pass = 0; pass < 2; ++pass) {
            if (pass == 1 && F.wave != 0) break;
            const int row = (pass == 0) ? (m0 + F.wave) : (m0 - 1);
            f32x4 v[4];
            if (pass == 1 && t0 == 0) {
#pragma unroll
                for (int j = 0; j < 4; ++j) v[j] = (f32x4){0.f, 0.f, 0.f, 0.f};
            } else {
                const f32x4* xr = (const f32x4*)(x + (size_t)row * D) + F.lane; float ss = 0.f;
#pragma unroll
                for (int j = 0; j < 4; ++j) { v[j] = xr[64 * j]; ss += (v[j].x * v[j].x + v[j].y * v[j].y) + (v[j].z * v[j].z + v[j].w * v[j].w); }
                const float rstd = 1.0f / sqrtf(wave_sum(ss) * (1.f / D) + RMS_EPS);
#pragma unroll
                for (int j = 0; j < 4; ++j) { const int c = 4 * F.lane + 256 * j; const f32x4 gg = *(const f32x4*)(g + c), s1 = *(const f32x4*)(sc + c), s0 = *(const f32x4*)(sh + c);
                    v[j] = v[j] * rstd * gg * (s1 + 1.0f) + s0; }
            }
            LAS f32x4* hp = (LAS f32x4*)(hrow + ((pass == 0) ? (F.wave + 1) : 0) * 1024) + F.lane;
#pragma unroll
            for (int j = 0; j < 4; ++j) { hp[64 * j] = v[j]; if (pass == 0) hv[j] = v[j]; }
        }
        __syncthreads();
        {
            const int row = m0 + F.wave;
            const LAS f32x4* pp = (const LAS f32x4*)(hrow + F.wave * 1024) + F.lane;
#pragma unroll
            for (int j = 0; j < 4; ++j) { const int c = 4 * F.lane + 256 * j; const f32x4 xx = pp[64 * j] - hv[j];
#pragma unroll
                for (int i = 0; i < 3; ++i) { const f32x4 mm = *(const f32x4*)(mu + i * D + c); const f32x4 o = hv[j] + xx * mm;
                    v2u w; w.x = pk2(o.x, o.y); w.y = pk2(o.z, o.w); *(v2u*)(views + ((size_t)i * M + row) * D + c) = w; }
                v2u w; w.x = pk2(hv[j].x, hv[j].y); w.y = pk2(hv[j].z, hv[j].w); *(v2u*)(H2 + (size_t)row * 2048 + c) = w;
                w.x = pk2(xx.x, xx.y); w.y = pk2(xx.z, xx.w); *(v2u*)(H2 + (size_t)row * 2048 + 1024 + c) = w; }
        }
        __syncthreads();
    }
}

__device__ __forceinline__ void p4_scan_seq(Frame& F) {
    constexpr int TS = 32;
    LAS float* sA = (LAS float*)(F.lds + RING_OFF);
    LAS float* sW = sA + TS * 64; LAS float* sB = sW + TS * 64; LAS float* sK = sB + TS * 64; LAS float* sR = sK + TS * 64; LAS float* sV = sR + TS * 64;
    LAS float* sY = sV + TS * 64; LAS float* sRK = sY + TS * 64;
    const bf16* Rb = (const bf16*)(F.ws + WS_RKV); const bf16* Kb = Rb + (size_t)M * D; const bf16* Vb = Kb + (size_t)M * D;
    const float* LW = (const float*)(F.ws + WS_LOGW); const bf16* AS = (const bf16*)(F.ws + WS_ASIG); const bf16* GG = (const bf16*)(F.ws + WS_GG);
    bf16* YG = (bf16*)(F.ws + WS_YG);
    const float* k_k = F.in[16]; const float* k_a = F.in[17]; const float* r_k = F.in[18]; const float* gn_g = F.in[19]; const float* gn_b = F.in[20];
    for (int bh = blockIdx.x; bh < BATCH * 16; bh += F.G) {
        const int b = bh >> 4, h = bh & 15;
        const int i = F.tid >> 3, q = F.tid & 7;
        const int st = F.tid >> 4, d4 = (F.tid & 15) * 4;
        const int cg = h * 64 + d4;
        const f32x4 kkv = *(const f32x4*)(k_k + cg), kav = *(const f32x4*)(k_a + cg), rkv = *(const f32x4*)(r_k + cg), gng = *(const f32x4*)(gn_g + cg), gnb = *(const f32x4*)(gn_b + cg);
        float s[8];
#pragma unroll
        for (int j = 0; j < 8; ++j) s[j] = 0.f;
        for (int t0 = 0; t0 < T; t0 += TS) {
            const size_t ro = ((size_t)b * T + t0 + st) * D + cg;
            {
                const v2u rr = *(const v2u*)(Rb + ro), kk2 = *(const v2u*)(Kb + ro), vv = *(const v2u*)(Vb + ro), aa = *(const v2u*)(AS + ro); const f32x4 lw = *(const f32x4*)(LW + ro);
                const f32x4 r4 = {bflo(rr.x), bfhi(rr.x), bflo(rr.y), bfhi(rr.y)}, k4 = {bflo(kk2.x), bfhi(kk2.x), bflo(kk2.y), bfhi(kk2.y)};
                const f32x4 v4 = {bflo(vv.x), bfhi(vv.x), bflo(vv.y), bfhi(vv.y)}, a4 = {bflo(aa.x), bfhi(aa.x), bflo(aa.y), bfhi(aa.y)};
                const f32x4 kr = k4 * kkv; float ss = (kr.x * kr.x + kr.y * kr.y) + (kr.z * kr.z + kr.w * kr.w);
                ss += __shfl_xor(ss, 1); ss += __shfl_xor(ss, 2); ss += __shfl_xor(ss, 4); ss += __shfl_xor(ss, 8);
                const float inv = 1.0f / fmaxf(sqrtf(ss), 1e-12f);
                const f32x4 kkn = kr * inv; const f32x4 km = k4 * ((a4 - 1.0f) * kav + 1.0f);
                const f32x4 rk4 = r4 * km * rkv; float rs = (rk4.x + rk4.y) + (rk4.z + rk4.w);
                rs += __shfl_xor(rs, 1); rs += __shfl_xor(rs, 2); rs += __shfl_xor(rs, 4); rs += __shfl_xor(rs, 8);
                f32x4 wv; wv.x = __expf(lw.x); wv.y = __expf(lw.y); wv.z = __expf(lw.z); wv.w = __expf(lw.w);
                *(LAS f32x4*)(sA + st * 64 + d4) = -kkn; *(LAS f32x4*)(sW + st * 64 + d4) = wv; *(LAS f32x4*)(sB + st * 64 + d4) = kkn * a4;
                *(LAS f32x4*)(sK + st * 64 + d4) = km; *(LAS f32x4*)(sR + st * 64 + d4) = r4; *(LAS f32x4*)(sV + st * 64 + d4) = v4;
                if ((F.tid & 15) == 0) sRK[st] = rs;
            }
            __syncthreads();
            for (int t = 0; t < TS; ++t) {
                const LAS f32x4* pa = (const LAS f32x4*)(sA + t * 64 + q * 8); const LAS f32x4* pw = (const LAS f32x4*)(sW + t * 64 + q * 8); const LAS f32x4* pb = (const LAS f32x4*)(sB + t * 64 + q * 8);
                const LAS f32x4* pk = (const LAS f32x4*)(sK + t * 64 + q * 8); const LAS f32x4* pr = (const LAS f32x4*)(sR + t * 64 + q * 8);
                const f32x4 a0 = pa[0], a1 = pa[1], w0 = pw[0], w1 = pw[1], b0 = pb[0], b1 = pb[1], k0 = pk[0], k1 = pk[1], r0 = pr[0], r1 = pr[1];
                const float vi = sV[t * 64 + i];
                float sa = (s[0] * a0.x + s[1] * a0.y) + (s[2] * a0.z + s[3] * a0.w) + (s[4] * a1.x + s[5] * a1.y) + (s[6] * a1.z + s[7] * a1.w);
                sa += __shfl_xor(sa, 1); sa += __shfl_xor(sa, 2); sa += __shfl_xor(sa, 4);
                s[0] = s[0] * w0.x + sa * b0.x + vi * k0.x; s[1] = s[1] * w0.y + sa * b0.y + vi * k0.y; s[2] = s[2] * w0.z + sa * b0.z + vi * k0.z; s[3] = s[3] * w0.w + sa * b0.w + vi * k0.w;
                s[4] = s[4] * w1.x + sa * b1.x + vi * k1.x; s[5] = s[5] * w1.y + sa * b1.y + vi * k1.y; s[6] = s[6] * w1.z + sa * b1.z + vi * k1.z; s[7] = s[7] * w1.w + sa * b1.w + vi * k1.w;
                float y = (s[0] * r0.x + s[1] * r0.y) + (s[2] * r0.z + s[3] * r0.w) + (s[4] * r1.x + s[5] * r1.y) + (s[6] * r1.z + s[7] * r1.w);
                y += __shfl_xor(y, 1); y += __shfl_xor(y, 2); y += __shfl_xor(y, 4);
                if (q == 0) sY[t * 64 + i] = y;
            }
            __syncthreads();
            {
                const f32x4 y4 = *(const LAS f32x4*)(sY + st * 64 + d4); const f32x4 v4 = *(const LAS f32x4*)(sV + st * 64 + d4);
                float sm = (y4.x + y4.y) + (y4.z + y4.w);
                sm += __shfl_xor(sm, 1); sm += __shfl_xor(sm, 2); sm += __shfl_xor(sm, 4); sm += __shfl_xor(sm, 8);
                const float mean = sm * (1.f / 64.f); const f32x4 dv = y4 - mean;
                float vs = (dv.x * dv.x + dv.y * dv.y) + (dv.z * dv.z + dv.w * dv.w);
                vs += __shfl_xor(vs, 1); vs += __shfl_xor(vs, 2); vs += __shfl_xor(vs, 4); vs += __shfl_xor(vs, 8);
                const float rstd = 1.0f / sqrtf(vs * (1.f / 64.f) + GN_EPS);
                const v2u gg = *(const v2u*)(GG + ro); const f32x4 g4 = {bflo(gg.x), bfhi(gg.x), bflo(gg.y), bfhi(gg.y)};
                const f32x4 o = (dv * rstd * gng + gnb + v4 * sRK[st]) * g4;
                v2u w; w.x = pk2(o.x, o.y); w.y = pk2(o.z, o.w); *(v2u*)(YG + ro) = w;
            }
            __syncthreads();
        }
    }
}

constexpr int RT_HS = 1028;
__device__ __forceinline__ void moe_router(Frame& F, int l, const float* xin, int cnt_off) {
    const float* g = F.in[5] + (size_t)l * D; const float* wrg = F.in[33] + (size_t)l * D * NGRP; const float* wre = F.in[34] + (size_t)l * D * NE;
    const float* mod = (const float*)(F.ws + WS_MOD) + (size_t)l * 4 * 6144;
    bf16* H2N = (bf16*)(F.ws + WS_H2N);
    int* asg_e = (int*)(F.ws + WS_ROUTE); int* asg_pos = asg_e + 2 * M; float* asg_gate = (float*)(asg_pos + 2 * M);
    unsigned* cnt = (unsigned*)F.ctl + CW_CNT + 64 * l + cnt_off;
    LAS float* hs = (LAS float*)(F.lds + RING_OFF);
    LAS float* part = hs + 16 * RT_HS;
    LAS float* lgs = part + 8 * 768;
    const int lane = F.lane, w = F.wave, n16 = lane & 15, g4 = lane >> 4;
    float wreg[3][32];
    {   const int kb = 128 * w + 32 * g4;
        const float* pg = wrg + (size_t)kb * 4 + (n16 & 3); const float* pe0 = wre + (size_t)kb * 32 + ((n16 + 28) & 31); const float* pe1 = wre + (size_t)kb * 32 + 12 + n16; const float* pe2 = wre + (size_t)kb * 32 + 28 + (n16 & 3);
#pragma unroll
        for (int ks = 0; ks < 32; ++ks) { const float a = pg[ks * 4], bq = pe0[ks * 32], cq = pe2[ks * 32];
            wreg[0][ks] = (n16 < 4) ? a : bq; wreg[1][ks] = pe1[ks * 32]; wreg[2][ks] = (n16 < 4) ? cq : 0.f; } }
    const int ti_n = (M / 16 - (int)blockIdx.x + F.G - 1) / F.G;
    for (int ti = 0; ti < ti_n; ++ti) { const int tile = blockIdx.x + ti * F.G;
#pragma unroll 1
        for (int rr = 0; rr < 2; ++rr) { const int rl = 2 * w + rr, row = tile * 16 + rl;
            const int b = row / T; const float* sh = mod + (size_t)b * 6144 + 3072; const float* sc = sh + 1024;
            const f32x4* xr = (const f32x4*)(xin + (size_t)row * D) + lane; f32x4 v[4]; float ss = 0.f;
#pragma unroll
            for (int j = 0; j < 4; ++j) { v[j] = xr[64 * j]; ss += (v[j].x * v[j].x + v[j].y * v[j].y) + (v[j].z * v[j].z + v[j].w * v[j].w); }
            const float rstd = 1.0f / sqrtf(wave_sum(ss) * (1.f / D) + RMS_EPS);
#pragma unroll
            for (int j = 0; j < 4; ++j) { const int c = 4 * lane + 256 * j; const f32x4 gg = *(const f32x4*)(g + c), s1 = *(const f32x4*)(sc + c), s0 = *(const f32x4*)(sh + c);
                v[j] = v[j] * rstd * gg * (s1 + 1.0f) + s0;
                v2u wv; wv.x = pk2(v[j].x, v[j].y); wv.y = pk2(v[j].z, v[j].w); *(v2u*)(H2N + (size_t)row * D + c) = wv;
                *(LAS f32x4*)(hs + rl * RT_HS + c) = v[j]; } }
        __syncthreads();
        f32x4 acc[3];
#pragma unroll
        for (int nt = 0; nt < 3; ++nt) acc[nt] = (f32x4){0.f, 0.f, 0.f, 0.f};
#pragma unroll
        for (int q = 0; q < 8; ++q) { const f32x4 a4 = *(const LAS f32x4*)(hs + n16 * RT_HS + 128 * w + 32 * g4 + 4 * q);
#pragma unroll
            for (int e = 0; e < 4; ++e)
#pragma unroll
                for (int nt = 0; nt < 3; ++nt) acc[nt] = __builtin_amdgcn_mfma_f32_16x16x4f32(a4[e], wreg[nt][4 * q + e], acc[nt], 0, 0, 0); }
#pragma unroll
        for (int nt = 0; nt < 3; ++nt)
#pragma unroll
            for (int reg = 0; reg < 4; ++reg) part[(w * 16 + 4 * g4 + reg) * 48 + 16 * nt + n16] = acc[nt][reg];
        __syncthreads();
        for (int o = F.tid; o < 768; o += 512) { float s = 0.f;
#pragma unroll
            for (int ww = 0; ww < 8; ++ww) s += part[ww * 768 + o];
            lgs[ti * 768 + o] = s; }
    }
    __syncthreads();
    for (int rloc = F.tid; rloc < 16 * ti_n; rloc += 512) {
        const int row = (blockIdx.x + (rloc >> 4) * F.G) * 16 + (rloc & 15);
        float lg[36];
#pragma unroll
        for (int q = 0; q < 9; ++q) { const f32x4 pv = *(const LAS f32x4*)(lgs + rloc * 48 + 4 * q); lg[4 * q] = pv.x; lg[4 * q + 1] = pv.y; lg[4 * q + 2] = pv.z; lg[4 * q + 3] = pv.w; }
        int gi = 0; float gm = lg[0];
#pragma unroll
        for (int j = 1; j < 4; ++j) if (lg[j] > gm) { gm = lg[j]; gi = j; }
        float gs = 0.f;
#pragma unroll
        for (int j = 0; j < 4; ++j) gs += __expf(lg[j] - gm);
        const float ggate = 1.0f / gs;
        float el[8];
#pragma unroll
        for (int j = 0; j < 8; ++j) el[j] = (gi == 0) ? lg[4 + j] : (gi == 1) ? lg[12 + j] : (gi == 2) ? lg[20 + j] : lg[28 + j];
        int i1 = 0; float v1 = el[0];
#pragma unroll
        for (int j = 1; j < 8; ++j) if (el[j] > v1) { v1 = el[j]; i1 = j; }
        int i2 = -1; float v2 = -INFINITY;
#pragma unroll
        for (int j = 0; j < 8; ++j) if (j != i1 && el[j] > v2) { v2 = el[j]; i2 = j; }
        const float e2 = __expf(v2 - v1), p1 = 1.0f / (1.0f + e2), p2 = e2 * p1;
        const int ea = gi * 8 + i1, eb = gi * 8 + i2;
        const unsigned pa = atomicAdd(cnt + ea, 1u), pb = atomicAdd(cnt + eb, 1u);
        asg_e[2 * row] = ea; asg_e[2 * row + 1] = eb; asg_pos[2 * row] = (int)pa; asg_pos[2 * row + 1] = (int)pb;
        asg_gate[2 * row] = ggate * p1; asg_gate[2 * row + 1] = ggate * p2;
    }
    __syncthreads();
}
__device__ __forceinline__ void moe_toff(Frame& F, int l) {
    LAS int* toff = (LAS int*)(F.lds + LDSCTL_OFF);
    if (F.tid == 0) { const unsigned* cnt = (const unsigned*)F.ctl + CW_CNT + 64 * l; int acc = 0;
        for (int e = 0; e < 32; ++e) { toff[e] = acc; acc += (int)((__hip_atomic_load(cnt + e, RLX_AGENT) + 255u) >> 8); }
        toff[32] = acc; }
    __syncthreads();
}
__device__ __forceinline__ void moe_gather(Frame& F, int l) {
    moe_toff(F, l);
    const LAS int* toff = (const LAS int*)(F.lds + LDSCTL_OFF);
    const bf16* H2N = (const bf16*)(F.ws + WS_H2N); bf16* XS = (bf16*)(F.ws + WS_XS);
    const int* asg_e = (const int*)(F.ws + WS_ROUTE); const int* asg_pos = asg_e + 2 * M; const float* asg_gate = (const float*)(asg_pos + 2 * M);
    int* asg_row = (int*)(asg_gate + 2 * M); float* rowgate = (float*)(asg_row + 2 * M);
    const int gw = blockIdx.x * NWAVES + F.wave, NGW = F.G * NWAVES;
    for (int a = gw; a < 2 * M; a += NGW) {
        const int tok = a >> 1, e = asg_e[a], pos = asg_pos[a]; const int row = toff[e] * 256 + pos;
        const v4u* src = (const v4u*)(H2N + (size_t)tok * D) + F.lane; v4u* dst = (v4u*)(XS + (size_t)row * D) + F.lane;
        const v4u x0 = src[0], x1 = src[64]; dst[0] = x0; dst[64] = x1;
        if (F.lane == 0) { rowgate[row] = asg_gate[a]; asg_row[a] = row; }
    }
}
template <int MODE> __device__ __forceinline__ void moe_combine(Frame& F, int l, const float* xin, float* xout) {
    const bf16* Y = (const bf16*)(F.ws + WS_Y);
    const int* asg_row = (const int*)(F.ws + WS_ROUTE) + 6 * M;
    const float* mod = (const float*)(F.ws + WS_MOD) + (size_t)l * 4 * 6144;
    const float* mod1 = (const float*)(F.ws + WS_MOD) + (size_t)4 * 6144;
    const float* modkv = (const float*)(F.ws + WS_MOD) + (size_t)8 * 6144;
    const float* gq = F.in[4] + D; const float* gkv = F.in[24]; const float* gfin = F.in[38];
    bf16* HQ = (bf16*)(F.ws + WS_HQ); bf16* HK = (bf16*)(F.ws + WS_HK);
    const int gw = blockIdx.x * NWAVES + F.wave, NGW = F.G * NWAVES;
    for (int row = gw; row < M; row += NGW) {
        const int b = row / T; const float* gf = mod + (size_t)b * 6144 + 5120;
        const int r0 = asg_row[2 * row], r1 = asg_row[2 * row + 1];
        const f32x4* xr = (const f32x4*)(xin + (size_t)row * D) + F.lane; f32x4 v[4]; float ss = 0.f;
#pragma unroll
        for (int j = 0; j < 4; ++j) { const int c = 4 * F.lane + 256 * j;
            const v2u y0 = *(const v2u*)(Y + (size_t)r0 * D + c), y1 = *(const v2u*)(Y + (size_t)r1 * D + c); const f32x4 gg = *(const f32x4*)(gf + c);
            const f32x4 ys = {bflo(y0.x) + bflo(y1.x), bfhi(y0.x) + bfhi(y1.x), bflo(y0.y) + bflo(y1.y), bfhi(y0.y) + bfhi(y1.y)};
            v[j] = xr[64 * j] + gg * ys; ss += (v[j].x * v[j].x + v[j].y * v[j].y) + (v[j].z * v[j].z + v[j].w * v[j].w); }
        const float rstd = 1.0f / sqrtf(wave_sum(ss) * (1.f / D) + RMS_EPS);
        if (MODE == 0) {
            const float* shq = mod1 + (size_t)b * 6144; const float* scq = shq + 1024; const float* shk = modkv + (size_t)b * 2048; const float* sck = shk + 1024;
#pragma unroll
            for (int j = 0; j < 4; ++j) { const int c = 4 * F.lane + 256 * j;
                *((f32x4*)(xout + (size_t)row * D) + F.lane + 64 * j) = v[j];
                const f32x4 n = v[j] * rstd;
                const f32x4 hq = n * *(const f32x4*)(gq + c) * (*(const f32x4*)(scq + c) + 1.0f) + *(const f32x4*)(shq + c);
                const f32x4 hk = n * *(const f32x4*)(gkv + c) * (*(const f32x4*)(sck + c) + 1.0f) + *(const f32x4*)(shk + c);
                v2u w; w.x = pk2(hq.x, hq.y); w.y = pk2(hq.z, hq.w); *(v2u*)(HQ + (size_t)row * D + c) = w;
                w.x = pk2(hk.x, hk.y); w.y = pk2(hk.z, hk.w); *(v2u*)(HK + (size_t)row * D + c) = w; }
        } else {
#pragma unroll
            for (int j = 0; j < 4; ++j) { const int c = 4 * F.lane + 256 * j; *((f32x4*)(xout + (size_t)row * D) + F.lane + 64 * j) = v[j] * rstd * *(const f32x4*)(gfin + c); }
        }
    }
}
__device__ __forceinline__ void attn_subln(Frame& F) {
    const bf16* OC = (const bf16*)(F.ws + WS_OC); bf16* ON = (bf16*)(F.ws + WS_ON);
    const float l1 = wave_sum(F.in[27][F.lane] * F.in[28][F.lane]), l2 = wave_sum(F.in[29][F.lane] * F.in[30][F.lane]);
    const float lam = __expf(l1) - __expf(l2) + LAMBDA_INIT1;
    const float* sg = F.in[31] + (F.lane & 7) * 16;
    float gsc[16];
#pragma unroll
    for (int e = 0; e < 16; ++e) gsc[e] = sg[e] * (1.0f - LAMBDA_INIT1);
    const int gw = blockIdx.x * NWAVES + F.wave, NGW = F.G * NWAVES; const int hd = F.lane >> 3, sub = (F.lane & 7) * 16;
    for (int row = gw; row < M; row += NGW) {
        const v4u* p0 = (const v4u*)(OC + (size_t)row * 2048 + (hd * 2) * 128 + sub); const v4u* p1 = (const v4u*)(OC + (size_t)row * 2048 + (hd * 2 + 1) * 128 + sub);
        const v4u a0 = p0[0], a1 = p0[1], b0 = p1[0], b1 = p1[1];
        float d[16];
#define DF(i, A, B) d[2 * (i)] = bflo(A) - lam * bflo(B); d[2 * (i) + 1] = bfhi(A) - lam * bfhi(B)
        DF(0, a0.x, b0.x); DF(1, a0.y, b0.y); DF(2, a0.z, b0.z); DF(3, a0.w, b0.w); DF(4, a1.x, b1.x); DF(5, a1.y, b1.y); DF(6, a1.z, b1.z); DF(7, a1.w, b1.w);
#undef DF
        float ss = 0.f;
#pragma unroll
        for (int e = 0; e < 16; ++e) ss += d[e] * d[e];
        ss += __shfl_xor(ss, 1); ss += __shfl_xor(ss, 2); ss += __shfl_xor(ss, 4);
        const float rstd = 1.0f / sqrtf(ss * (1.f / 128.f) + SUBLN_EPS);
        v4u w0, w1;
        w0.x = pk2(d[0] * rstd * gsc[0], d[1] * rstd * gsc[1]); w0.y = pk2(d[2] * rstd * gsc[2], d[3] * rstd * gsc[3]); w0.z = pk2(d[4] * rstd * gsc[4], d[5] * rstd * gsc[5]); w0.w = pk2(d[6] * rstd * gsc[6], d[7] * rstd * gsc[7]);
        w1.x = pk2(d[8] * rstd * gsc[8], d[9] * rstd * gsc[9]); w1.y = pk2(d[10] * rstd * gsc[10], d[11] * rstd * gsc[11]); w1.z = pk2(d[12] * rstd * gsc[12], d[13] * rstd * gsc[13]); w1.w = pk2(d[14] * rstd * gsc[14], d[15] * rstd * gsc[15]);
        v4u* op = (v4u*)(ON + (size_t)row * D + F.lane * 16); op[0] = w0; op[1] = w1;
    }
}
struct AttnOrder {
    int vcu;
    __device__ __forceinline__ explicit AttnOrder(int grid, int block) : vcu((block % 8) * (grid / 8) + block / 8) {}
    __device__ __forceinline__ bool next(int i, attn_body::AttnUnit& u) const { if (i >= 8) return false; const int s = 2 * (i >> 1) + (vcu & 1); u.bh = vcu >> 1; u.qb = (i & 1) ? s : 15 - s; return true; }
    __device__ __forceinline__ void a_ready(const attn_body::AttnUnit&) const {}
    __device__ __forceinline__ void done(const attn_body::AttnUnit&) const {}
};

typedef float f32x16 __attribute__((ext_vector_type(16)));
typedef float f32x2_t __attribute__((ext_vector_type(2))); typedef __bf16 bf16x2_t __attribute__((ext_vector_type(2)));
__device__ __forceinline__ unsigned cvtpk(float lo, float hi) { f32x2_t v = {lo, hi}; bf16x2_t b = __builtin_convertvector(v, bf16x2_t); return __builtin_bit_cast(unsigned, b); }
#define MMA32(a, b, c) __builtin_amdgcn_mfma_f32_32x32x16_bf16((a), (b), (c), 0, 0, 0)
constexpr int SC_TS = 72, SC_TB = 64 * SC_TS * 2;
constexpr int SL_A = 0, SL_B = 1, SL_K = 2, SL_R = 3, SL_BH = 4, SL_KH = 5, SL_VT = 6, SL_ARB = 7, SL_ARK = 8;
constexpr int SC_RHS = 9 * SC_TB;
constexpr int SC_XT0 = SC_RHS + 32768, SC_XT1 = SC_XT0 + SC_TB;
constexpr int SC_GEND = SC_XT1 + SC_TB;
constexpr int SC_AD = 1 * SC_TB, SC_ADS = 20;
constexpr int SC_TBB = SC_AD + 4 * 16 * SC_ADS * 4;
constexpr int SC_LBUF = 7 * SC_TB, SC_SEG = SC_LBUF + 16384;
static_assert(SC_GEND + 256 <= LDSCTL_OFF && SC_SEG + 2048 <= 9 * SC_TB && SC_TBB + 2048 <= 2 * SC_TB, "scan LDS map");

__device__ __forceinline__ void tile_mma2(f32x16 (&acc)[2], const LAS unsigned char* TA, const LAS unsigned char* TBp, int mt, int r32, int hi) {
#pragma unroll
    for (int ks = 0; ks < 4; ++ks) {
        const bf16x8 a = *(const LAS bf16x8*)(TA + ((32 * mt + r32) * SC_TS + 16 * ks + 8 * hi) * 2);
        const bf16x8 b0 = *(const LAS bf16x8*)(TBp + ((r32) * SC_TS + 16 * ks + 8 * hi) * 2);
        const bf16x8 b1 = *(const LAS bf16x8*)(TBp + ((32 + r32) * SC_TS + 16 * ks + 8 * hi) * 2);
        acc[0] = MMA32(a, b0, acc[0]); acc[1] = MMA32(a, b1, acc[1]);
    }
}
__device__ __forceinline__ void p4a_chunks(Frame& F) {
    LAS unsigned char* L = F.lds + RING_OFF;
    const bf16* Rb = (const bf16*)(F.ws + WS_RKV); const bf16* Kb = Rb + (size_t)M * D; const bf16* Vb = Kb + (size_t)M * D;
    const float* LW = (const float*)(F.ws + WS_LOGW); const bf16* AS = (const bf16*)(F.ws + WS_ASIG);
    bf16* QE = (bf16*)(F.ws + WS_QE); bf16* MCT = (bf16*)(F.ws + WS_MCT); bf16* NC = (bf16*)(F.ws + WS_NC); float* Y0 = (float*)(F.ws + WS_Y0); float* RK = (float*)(F.ws + WS_RK);
    const float* k_k = F.in[16]; const float* k_a = F.in[17]; const float* r_k = F.in[18];
    const int tid = F.tid, lane = F.lane, w = F.wave, r32 = lane & 31, hi = lane >> 5;
    const int t = tid >> 3, d8 = (tid & 7) * 8;
    LAS float* Lbuf = (LAS float*)(L + SC_LBUF); LAS float* Seg = (LAS float*)(L + SC_SEG); LAS float* RHS = (LAS float*)(L + SC_RHS); LAS float* Gend = (LAS float*)(L + SC_GEND);
    LAS float* AD = (LAS float*)(L + SC_AD);
    for (int cu = blockIdx.x; cu < BATCH * 16 * 64; cu += F.G) {
        const int bh = cu >> 6, c = cu & 63, b = bh >> 4, h = bh & 15;
        const size_t ro = ((size_t)b * T + c * 64 + t) * D + h * 64 + d8;
        const v4u r8 = *(const v4u*)(Rb + ro), k8 = *(const v4u*)(Kb + ro), v8 = *(const v4u*)(Vb + ro), a8 = *(const v4u*)(AS + ro);
        const f32x4 lw0 = *(const f32x4*)(LW + ro), lw1 = *(const f32x4*)(LW + ro + 4);
        *(LAS f32x4*)(Lbuf + t * 64 + d8) = lw0; *(LAS f32x4*)(Lbuf + t * 64 + d8 + 4) = lw1;
        __syncthreads();
        { const int d = tid & 63, seg = tid >> 6; float run = 0.f;
#pragma unroll
          for (int i = 0; i < 8; ++i) { run += Lbuf[(seg * 8 + i) * 64 + d]; Lbuf[(seg * 8 + i) * 64 + d] = run; }
          Seg[seg * 64 + d] = run; }
        __syncthreads();
        {
            float Lt[8], Le[8];
            { const f32x4 p0 = *(const LAS f32x4*)(Lbuf + t * 64 + d8), p1 = *(const LAS f32x4*)(Lbuf + t * 64 + d8 + 4);
              Lt[0] = p0.x; Lt[1] = p0.y; Lt[2] = p0.z; Lt[3] = p0.w; Lt[4] = p1.x; Lt[5] = p1.y; Lt[6] = p1.z; Lt[7] = p1.w; }
#pragma unroll
            for (int e = 0; e < 8; ++e) Le[e] = 0.f;
            const int myseg = t >> 3;
#pragma unroll
            for (int s = 0; s < 8; ++s) { const f32x4 q0 = *(const LAS f32x4*)(Seg + s * 64 + d8), q1 = *(const LAS f32x4*)(Seg + s * 64 + d8 + 4);
                const float sv[8] = {q0.x, q0.y, q0.z, q0.w, q1.x, q1.y, q1.z, q1.w};
#pragma unroll
                for (int e = 0; e < 8; ++e) { Le[e] += sv[e]; Lt[e] += (s < myseg) ? sv[e] : 0.f; } }
            const float lwv[8] = {lw0.x, lw0.y, lw0.z, lw0.w, lw1.x, lw1.y, lw1.z, lw1.w};
            const unsigned rw[4] = {r8.x, r8.y, r8.z, r8.w}, kw[4] = {k8.x, k8.y, k8.z, k8.w}, vw[4] = {v8.x, v8.y, v8.z, v8.w}, aw[4] = {a8.x, a8.y, a8.z, a8.w};
            float rr[8], kk[8], vv[8], aa[8];
#pragma unroll
            for (int e = 0; e < 4; ++e) { rr[2 * e] = bflo(rw[e]); rr[2 * e + 1] = bfhi(rw[e]); kk[2 * e] = bflo(kw[e]); kk[2 * e + 1] = bfhi(kw[e]);
                vv[2 * e] = bflo(vw[e]); vv[2 * e + 1] = bfhi(vw[e]); aa[2 * e] = bflo(aw[e]); aa[2 * e + 1] = bfhi(aw[e]); }
            const f32x4 kk0 = *(const f32x4*)(k_k + h * 64 + d8), kk1 = *(const f32x4*)(k_k + h * 64 + d8 + 4), ka0 = *(const f32x4*)(k_a + h * 64 + d8), ka1 = *(const f32x4*)(k_a + h * 64 + d8 + 4);
            const f32x4 rk0 = *(const f32x4*)(r_k + h * 64 + d8), rk1 = *(const f32x4*)(r_k + h * 64 + d8 + 4);
            const float kkv[8] = {kk0.x, kk0.y, kk0.z, kk0.w, kk1.x, kk1.y, kk1.z, kk1.w}, kav[8] = {ka0.x, ka0.y, ka0.z, ka0.w, ka1.x, ka1.y, ka1.z, ka1.w}, rkv[8] = {rk0.x, rk0.y, rk0.z, rk0.w, rk1.x, rk1.y, rk1.z, rk1.w};
            float kr[8], ss = 0.f, rs = 0.f, km[8];
#pragma unroll
            for (int e = 0; e < 8; ++e) { kr[e] = kk[e] * kkv[e]; ss += kr[e] * kr[e]; km[e] = kk[e] * (1.0f + (aa[e] - 1.0f) * kav[e]); rs += rr[e] * km[e] * rkv[e]; }
            ss += __shfl_xor(ss, 1); ss += __shfl_xor(ss, 2); ss += __shfl_xor(ss, 4);
            rs += __shfl_xor(rs, 1); rs += __shfl_xor(rs, 2); rs += __shfl_xor(rs, 4);
            const float inv = 1.0f / fmaxf(sqrtf(ss), 1e-12f);
            if ((tid & 7) == 0) RK[(size_t)cu * 64 + t] = rs;
            float At[8], Bt[8], Kt[8], Rt[8], Bh[8], Kh[8];
#pragma unroll
            for (int e = 0; e < 8; ++e) { const float kn = kr[e] * inv, av = -kn, bv = kn * aa[e];
                const float g = __expf(Lt[e]), gi = __expf(-Lt[e]), gp = __expf(Lt[e] - lwv[e]), ge = __expf(Le[e] - Lt[e]);
                At[e] = av * gp; Bt[e] = bv * gi; Kt[e] = km[e] * gi; Rt[e] = rr[e] * g; Bh[e] = bv * ge; Kh[e] = km[e] * ge;
                if (t == 63) Gend[d8 + e] = g; }
            const int ob = (t * SC_TS + d8) * 2;
            { v4u o; o.x = cvtpk(At[0], At[1]); o.y = cvtpk(At[2], At[3]); o.z = cvtpk(At[4], At[5]); o.w = cvtpk(At[6], At[7]); *(LAS v4u*)(L + SL_A * SC_TB + ob) = o; }
            { v4u o; o.x = cvtpk(Bt[0], Bt[1]); o.y = cvtpk(Bt[2], Bt[3]); o.z = cvtpk(Bt[4], Bt[5]); o.w = cvtpk(Bt[6], Bt[7]); *(LAS v4u*)(L + SL_B * SC_TB + ob) = o; }
            { v4u o; o.x = cvtpk(Kt[0], Kt[1]); o.y = cvtpk(Kt[2], Kt[3]); o.z = cvtpk(Kt[4], Kt[5]); o.w = cvtpk(Kt[6], Kt[7]); *(LAS v4u*)(L + SL_K * SC_TB + ob) = o; }
            { v4u o; o.x = cvtpk(Rt[0], Rt[1]); o.y = cvtpk(Rt[2], Rt[3]); o.z = cvtpk(Rt[4], Rt[5]); o.w = cvtpk(Rt[6], Rt[7]); *(LAS v4u*)(L + SL_R * SC_TB + ob) = o; }
            *(LAS f32x4*)(RHS + t * 128 + d8) = (f32x4){At[0], At[1], At[2], At[3]}; *(LAS f32x4*)(RHS + t * 128 + d8 + 4) = (f32x4){At[4], At[5], At[6], At[7]};
            LAS unsigned short* bhT = (LAS unsigned short*)(L + SL_BH * SC_TB); LAS unsigned short* khT = (LAS unsigned short*)(L + SL_KH * SC_TB); LAS unsigned short* vT = (LAS unsigned short*)(L + SL_VT * SC_TB);
#pragma unroll
            for (int e = 0; e < 8; ++e) { bhT[(d8 + e) * SC_TS + t] = (unsigned short)(cvtpk(Bh[e], 0.f) & 0xffffu); khT[(d8 + e) * SC_TS + t] = (unsigned short)(cvtpk(Kh[e], 0.f) & 0xffffu); }
#pragma unroll
            for (int e = 0; e < 4; ++e) { vT[(d8 + 2 * e) * SC_TS + t] = (unsigned short)(vw[e] & 0xffffu); vT[(d8 + 2 * e + 1) * SC_TS + t] = (unsigned short)(vw[e] >> 16); }
        }
        __syncthreads();
        const int p = w >> 1, mt = w & 1;
        f32x16 acc[2];
#pragma unroll
        for (int i = 0; i < 16; ++i) { acc[0][i] = 0.f; acc[1][i] = 0.f; }
        tile_mma2(acc, L + ((p & 1) ? SL_K : SL_B) * SC_TB, L + ((p & 2) ? SL_R : SL_A) * SC_TB, mt, r32, hi);
        __syncthreads();
#pragma unroll
        for (int nt = 0; nt < 2; ++nt) { const int s = 32 * nt + r32;
#pragma unroll
            for (int rg = 0; rg < 4; ++rg) { const int j0 = 32 * mt + 8 * rg + 4 * hi; float v[4];
#pragma unroll
                for (int e = 0; e < 4; ++e) { const bool keep = (p < 2) ? (j0 + e < s) : (j0 + e <= s); v[e] = keep ? acc[nt][4 * rg + e] : 0.f; }
                if (p == 0 && (s >> 4) == (j0 >> 4)) *(LAS f32x4*)(AD + ((s >> 4) * 16 + (s & 15)) * SC_ADS + (j0 & 15)) = (f32x4){v[0], v[1], v[2], v[3]};
                { v2u o; o.x = cvtpk(v[0], v[1]); o.y = cvtpk(v[2], v[3]); *(LAS v2u*)(L + ((p == 0) ? SL_A : (p == 1) ? SL_K : (p == 2) ? SL_ARB : SL_ARK) * SC_TB + (s * SC_TS + j0) * 2) = o; } } }
        __syncthreads();
#pragma unroll
        for (int i = 0; i < 16; ++i) { acc[0][i] = 0.f; acc[1][i] = 0.f; }
        if (w < 2) {
            tile_mma2(acc, L + SL_K * SC_TB, L + SL_VT * SC_TB, w & 1, r32, hi);
#pragma unroll
            for (int nt = 0; nt < 2; ++nt)
#pragma unroll
                for (int reg = 0; reg < 16; ++reg) RHS[(32 * (w & 1) + (reg & 3) + 8 * (reg >> 2) + 4 * hi) * 128 + 64 + 32 * nt + r32] = acc[nt][reg];
        } else if (w == 2) {
            const int bb = lane >> 4, cc = lane & 15; const LAS float* ad = AD + bb * 16 * SC_ADS; float tt[16];
#pragma unroll
            for (int s = 0; s < 16; ++s) tt[s] = 0.f;
#pragma unroll
            for (int s = 0; s < 16; ++s) { float a = (s == cc) ? 1.0f : 0.0f;
#pragma unroll
                for (int j4 = 0; j4 < (s + 3) / 4; ++j4) { const f32x4 q = *(const LAS f32x4*)(ad + s * SC_ADS + 4 * j4);
                    a += q.x * tt[4 * j4]; a += q.y * tt[4 * j4 + 1]; a += q.z * tt[4 * j4 + 2]; a += q.w * tt[4 * j4 + 3]; }
                tt[s] = a; }
            LAS unsigned short* tb = (LAS unsigned short*)(L + SC_TBB) + bb * 256 + cc;
#pragma unroll
            for (int s = 0; s < 16; ++s) tb[s * 16] = (unsigned short)(cvtpk(tt[s], 0.f) & 0xffffu);
        } else if (w == 3) {
            LAS v4u* z = (LAS v4u*)(L + SC_XT0) + lane;
#pragma unroll
            for (int q = 0; q < 18; ++q) z[q * 64] = (v4u){0u, 0u, 0u, 0u};
        } else if (w < 6) tile_mma2(acc, L + SL_VT * SC_TB, L + SL_ARK * SC_TB, w & 1, r32, hi);
        else tile_mma2(acc, L + SL_KH * SC_TB, L + SL_VT * SC_TB, w & 1, r32, hi);
        __syncthreads();
        {   const int cl = lane & 15, g = lane >> 4; LAS unsigned char* xt = L + SC_XT0 + (w >> 2) * SC_TB + ((16 * (w & 3) + cl) * SC_TS) * 2;
#pragma unroll
            for (int bb = 0; bb < 4; ++bb) {
                f32x4 rp;
#pragma unroll
                for (int reg = 0; reg < 4; ++reg) rp[reg] = RHS[(16 * bb + 4 * g + reg) * 128 + 16 * w + cl];
#pragma unroll
                for (int ks = 0; ks < 2; ++ks) { const bf16x8 af = *(const LAS bf16x8*)(L + SL_A * SC_TB + ((16 * bb + cl) * SC_TS + 32 * ks + 8 * g) * 2);
                    const bf16x8 bf = *(const LAS bf16x8*)(xt + (32 * ks + 8 * g) * 2);
                    rp = __builtin_amdgcn_mfma_f32_16x16x32_bf16(af, bf, rp, 0, 0, 0); }
                const v2u tq = *(const LAS v2u*)(L + SC_TBB + ((bb * 16 + cl) * 16 + 4 * g) * 2);
                const v4u a2 = {tq.x, tq.y, 0u, 0u}, b2 = {cvtpk(rp[0], rp[1]), cvtpk(rp[2], rp[3]), 0u, 0u};
                const f32x4 xb = __builtin_amdgcn_mfma_f32_16x16x32_bf16(__builtin_bit_cast(bf16x8, a2), __builtin_bit_cast(bf16x8, b2), (f32x4){0.f, 0.f, 0.f, 0.f}, 0, 0, 0);
                v2u o; o.x = cvtpk(xb[0], xb[1]); o.y = cvtpk(xb[2], xb[3]); *(LAS v2u*)(xt + (16 * bb + 4 * g) * 2) = o;
                asm volatile("s_waitcnt lgkmcnt(0)" ::: "memory");
            } }
        __syncthreads();
        const LAS unsigned char* WMT = L + SC_XT0; const LAS unsigned char* U0T = L + SC_XT1;
        if (w < 4) {
#pragma unroll
            for (int i = 0; i < 16; ++i) { acc[0][i] = 0.f; acc[1][i] = 0.f; } }
        if (w < 2) {
            tile_mma2(acc, WMT, L + SL_ARB * SC_TB, w & 1, r32, hi);
            bf16* qo = QE + (size_t)cu * 4096;
#pragma unroll
            for (int nt = 0; nt < 2; ++nt) { const int tt = 32 * nt + r32;
#pragma unroll
                for (int rg = 0; rg < 4; ++rg) { const int d0 = 32 * (w & 1) + 8 * rg + 4 * hi; const v2u rt = *(const LAS v2u*)(L + SL_R * SC_TB + (tt * SC_TS + d0) * 2);
                    v2u o; o.x = cvtpk(acc[nt][4 * rg] + bflo(rt.x), acc[nt][4 * rg + 1] + bfhi(rt.x)); o.y = cvtpk(acc[nt][4 * rg + 2] + bflo(rt.y), acc[nt][4 * rg + 3] + bfhi(rt.y));
                    *(v2u*)(qo + tt * 64 + d0) = o; } }
        } else if (w < 4) {
            tile_mma2(acc, WMT, L + SL_BH * SC_TB, w & 1, r32, hi);
            bf16* mo = MCT + (size_t)cu * 4096;
#pragma unroll
            for (int nt = 0; nt < 2; ++nt) { const int dp = 32 * nt + r32; const float gc = Gend[dp];
#pragma unroll
                for (int rg = 0; rg < 4; ++rg) { const int d0 = 32 * (w & 1) + 8 * rg + 4 * hi; float v[4];
#pragma unroll
                    for (int e = 0; e < 4; ++e) v[e] = acc[nt][4 * rg + e] + ((d0 + e == dp) ? gc : 0.f);
                    v2u o; o.x = cvtpk(v[0], v[1]); o.y = cvtpk(v[2], v[3]); *(v2u*)(mo + dp * 64 + d0) = o; } }
        } else if (w < 6) {
            tile_mma2(acc, U0T, L + SL_ARB * SC_TB, w & 1, r32, hi);
            float* yo = Y0 + (size_t)cu * 4096;
#pragma unroll
            for (int nt = 0; nt < 2; ++nt) { const int tt = 32 * nt + r32;
#pragma unroll
                for (int rg = 0; rg < 4; ++rg) { const int i0 = 32 * (w & 1) + 8 * rg + 4 * hi; *(f32x4*)(yo + tt * 64 + i0) = (f32x4){acc[nt][4 * rg], acc[nt][4 * rg + 1], acc[nt][4 * rg + 2], acc[nt][4 * rg + 3]}; } }
        } else {
            tile_mma2(acc, L + SL_BH * SC_TB, U0T, w & 1, r32, hi);
            bf16* no = NC + (size_t)cu * 4096;
#pragma unroll
            for (int nt = 0; nt < 2; ++nt) { const int ii = 32 * nt + r32;
#pragma unroll
                for (int rg = 0; rg < 4; ++rg) { const int d0 = 32 * (w & 1) + 8 * rg + 4 * hi; v2u o; o.x = cvtpk(acc[nt][4 * rg], acc[nt][4 * rg + 1]); o.y = cvtpk(acc[nt][4 * rg + 2], acc[nt][4 * rg + 3]);
                    *(v2u*)(no + ii * 64 + d0) = o; } }
        }
        __syncthreads();
    }
}
__device__ __forceinline__ void p4b_state(Frame& F) {
    if (F.wave != 0) return;
    const bf16* MCT = (const bf16*)(F.ws + WS_MCT); const bf16* NC = (const bf16*)(F.ws + WS_NC); bf16* SCB = (bf16*)(F.ws + WS_SC);
    const int lane = F.lane, il = lane & 15, g = lane >> 4;
    for (int unit = blockIdx.x; unit < BATCH * 16 * 4; unit += F.G) {
        const int bh = unit >> 2, ig = (unit & 3) * 16 + il;
        f32x4 acc[4];
#pragma unroll
        for (int m = 0; m < 4; ++m) acc[m] = (f32x4){0.f, 0.f, 0.f, 0.f};
        v2u af[4][2][2]; v2u nf[4];
        {   const bf16* mc = MCT + (size_t)(bh * 64) * 4096; const bf16* nc = NC + (size_t)(bh * 64) * 4096;
#pragma unroll
            for (int m = 0; m < 4; ++m) { nf[m] = *(const v2u*)(nc + ig * 64 + 16 * m + 4 * g);
#pragma unroll
                for (int ks = 0; ks < 2; ++ks) { af[m][ks][0] = *(const v2u*)(mc + (16 * m + il) * 64 + 32 * ks + 4 * g); af[m][ks][1] = *(const v2u*)(mc + (16 * m + il) * 64 + 32 * ks + 16 + 4 * g); } } }
        for (int c = 0; c < 64; ++c) {
            const size_t cu = (size_t)bh * 64 + c;
            unsigned pk[4][2];
#pragma unroll
            for (int m = 0; m < 4; ++m) { pk[m][0] = cvtpk(acc[m][0], acc[m][1]); pk[m][1] = cvtpk(acc[m][2], acc[m][3]);
                v2u o; o.x = pk[m][0]; o.y = pk[m][1]; *(v2u*)(SCB + cu * 4096 + ig * 64 + 16 * m + 4 * g) = o; }
            const v4u b0 = {pk[0][0], pk[0][1], pk[1][0], pk[1][1]}, b1 = {pk[2][0], pk[2][1], pk[3][0], pk[3][1]};
            v2u ca[4][2][2], cn[4];
#pragma unroll
            for (int m = 0; m < 4; ++m) { cn[m] = nf[m];
#pragma unroll
                for (int ks = 0; ks < 2; ++ks) { ca[m][ks][0] = af[m][ks][0]; ca[m][ks][1] = af[m][ks][1]; } }
            if (c + 1 < 64) { const bf16* mc = MCT + (cu + 1) * 4096; const bf16* nc = NC + (cu + 1) * 4096;
#pragma unroll
                for (int m = 0; m < 4; ++m) { nf[m] = *(const v2u*)(nc + ig * 64 + 16 * m + 4 * g);
#pragma unroll
                    for (int ks = 0; ks < 2; ++ks) { af[m][ks][0] = *(const v2u*)(mc + (16 * m + il) * 64 + 32 * ks + 4 * g); af[m][ks][1] = *(const v2u*)(mc + (16 * m + il) * 64 + 32 * ks + 16 + 4 * g); } } }
#pragma unroll
            for (int m = 0; m < 4; ++m) {
                f32x4 ci = {bflo(cn[m].x), bfhi(cn[m].x), bflo(cn[m].y), bfhi(cn[m].y)};
                const v4u a0 = {ca[m][0][0].x, ca[m][0][0].y, ca[m][0][1].x, ca[m][0][1].y}, a1 = {ca[m][1][0].x, ca[m][1][0].y, ca[m][1][1].x, ca[m][1][1].y};
                ci = __builtin_amdgcn_mfma_f32_16x16x32_bf16(__builtin_bit_cast(bf16x8, a0), __builtin_bit_cast(bf16x8, b0), ci, 0, 0, 0);
                acc[m] = __builtin_amdgcn_mfma_f32_16x16x32_bf16(__builtin_bit_cast(bf16x8, a1), __builtin_bit_cast(bf16x8, b1), ci, 0, 0, 0);
            }
        }
    }
}
__device__ __forceinline__ void p4c_out(Frame& F) {
    LAS float* stage = (LAS float*)(F.lds + RING_OFF);
    const bf16* QE = (const bf16*)(F.ws + WS_QE); const bf16* SCB = (const bf16*)(F.ws + WS_SC); const float* Y0 = (const float*)(F.ws + WS_Y0); const float* RK = (const float*)(F.ws + WS_RK);
    const bf16* Vb = (const bf16*)(F.ws + WS_RKV) + (size_t)2 * M * D; const bf16* GG = (const bf16*)(F.ws + WS_GG); bf16* YG = (bf16*)(F.ws + WS_YG);
    const float* gn_g = F.in[19]; const float* gn_b = F.in[20];
    const int lane = F.lane, w = F.wave, r32 = lane & 31, hi = lane >> 5, us = w >> 1, nt = w & 1;
    for (int grp = blockIdx.x; grp < BATCH * 16 * 64 / 4; grp += F.G) {
        const int cu = grp * 4 + us, bh = cu >> 6, c = cu & 63, b = bh >> 4, h = bh & 15;
        const bf16* sc = SCB + (size_t)cu * 4096; const bf16* qe = QE + (size_t)cu * 4096; const float* y0 = Y0 + (size_t)cu * 4096;
        const int tt = 32 * nt + r32;
        f32x16 acc[2];
#pragma unroll
        for (int mt = 0; mt < 2; ++mt)
#pragma unroll
            for (int rg = 0; rg < 4; ++rg) { const f32x4 q = *(const f32x4*)(y0 + tt * 64 + 32 * mt + 8 * rg + 4 * hi); acc[mt][4 * rg] = q.x; acc[mt][4 * rg + 1] = q.y; acc[mt][4 * rg + 2] = q.z; acc[mt][4 * rg + 3] = q.w; }
#pragma unroll
        for (int ks = 0; ks < 4; ++ks) { const bf16x8 bq = *(const bf16x8*)(qe + tt * 64 + 16 * ks + 8 * hi);
            const bf16x8 a0 = *(const bf16x8*)(sc + r32 * 64 + 16 * ks + 8 * hi), a1 = *(const bf16x8*)(sc + (32 + r32) * 64 + 16 * ks + 8 * hi);
            acc[0] = MMA32(a0, bq, acc[0]); acc[1] = MMA32(a1, bq, acc[1]); }
        float sm = 0.f;
#pragma unroll
        for (int i = 0; i < 16; ++i) sm += acc[0][i] + acc[1][i];
        sm += __shfl_xor(sm, 32); const float mean = sm * (1.f / 64.f);
        float vs = 0.f;
#pragma unroll
        for (int i = 0; i < 16; ++i) { const float d0 = acc[0][i] - mean, d1 = acc[1][i] - mean; vs += d0 * d0 + d1 * d1; }
        vs += __shfl_xor(vs, 32); const float rstd = 1.0f / sqrtf(vs * (1.f / 64.f) + GN_EPS);
        LAS float* st = stage + us * (64 * 68);
#pragma unroll
        for (int mt = 0; mt < 2; ++mt)
#pragma unroll
            for (int rg = 0; rg < 4; ++rg) *(LAS f32x4*)(st + tt * 68 + 32 * mt + 8 * rg + 4 * hi) = (f32x4){(acc[mt][4 * rg] - mean) * rstd, (acc[mt][4 * rg + 1] - mean) * rstd, (acc[mt][4 * rg + 2] - mean) * rstd, (acc[mt][4 * rg + 3] - mean) * rstd};
        __syncthreads();
        {   const int i8 = (lane & 7) * 8; const int cg = h * 64 + i8;
            const f32x4 g0 = *(const f32x4*)(gn_g + cg), g1 = *(const f32x4*)(gn_g + cg + 4), b0 = *(const f32x4*)(gn_b + cg), b1 = *(const f32x4*)(gn_b + cg + 4);
#pragma unroll
            for (int it = 0; it < 4; ++it) { const int t2 = 32 * nt + it * 8 + (lane >> 3); const size_t ro = ((size_t)b * T + c * 64 + t2) * D + cg;
                const f32x4 y0v = *(const LAS f32x4*)(st + t2 * 68 + i8), y1v = *(const LAS f32x4*)(st + t2 * 68 + i8 + 4);
                const v4u vv = *(const v4u*)(Vb + ro), gg = *(const v4u*)(GG + ro); const float rk = RK[(size_t)cu * 64 + t2];
                float o[8];
                o[0] = (y0v.x * g0.x + b0.x + rk * bflo(vv.x)) * bflo(gg.x); o[1] = (y0v.y * g0.y + b0.y + rk * bfhi(vv.x)) * bfhi(gg.x);
                o[2] = (y0v.z * g0.z + b0.z + rk * bflo(vv.y)) * bflo(gg.y); o[3] = (y0v.w * g0.w + b0.w + rk * bfhi(vv.y)) * bfhi(gg.y);
                o[4] = (y1v.x * g1.x + b1.x + rk * bflo(vv.z)) * bflo(gg.z); o[5] = (y1v.y * g1.y + b1.y + rk * bfhi(vv.z)) * bfhi(gg.z);
                o[6] = (y1v.z * g1.z + b1.z + rk * bflo(vv.w)) * bflo(gg.w); o[7] = (y1v.w * g1.w + b1.w + rk * bfhi(vv.w)) * bfhi(gg.w);
                v4u ov; ov.x = cvtpk(o[0], o[1]); ov.y = cvtpk(o[2], o[3]); ov.z = cvtpk(o[4], o[5]); ov.w = cvtpk(o[6], o[7]); *(v4u*)(YG + ro) = ov; }
        }
        __syncthreads();
    }
}

constexpr int NPHASE = 22;
#ifndef PROBE_PHASE
#define PROBE_PHASE (-1)
#endif
#define PROBE(k, ...) do { __VA_ARGS__; if (PROBE_PHASE == (k)) { xcd_barrier(bar); __VA_ARGS__; } } while (0)
#define IN(k) (lo <= (k) && (k) < hi)
#define SEAM(k) do { if (IN(k) && (k) + 1 < hi) xcd_barrier(bar); } while (0)
template <int L> __device__ __forceinline__ void moe_phases(Frame& F, const int lo, const int hi, const XcdBarrier& bar) {
    constexpr int pb = 11 * L;
    LAS unsigned char* ring = F.lds + RING_OFF;
    const LAS int* toff = (const LAS int*)(F.lds + LDSCTL_OFF);
        if (IN(pb + 6)) { F.lane = lane_id(); if (PROBE_PHASE == 100 + pb) { moe_router(F, L, (const float*)(F.ws + WS_XA), 32); xcd_barrier(bar); F.lane = lane_id(); }
            moe_router(F, L, (const float*)(F.ws + WS_XA), 0); PROBE(pb + 6, F.lane = lane_id(); moe_weights(F, L); ); } SEAM(pb + 6);
        if (IN(pb + 7)) { PROBE(pb + 7, F.lane = lane_id(); moe_gather(F, L); ); } SEAM(pb + 7);
        if (IN(pb + 8)) { PROBE(pb + 8, F.lane = lane_id();
            moe_toff(F, L);
            pg8::MoeOrder S; S.init(F.ws + WS_XS, F.ws + WS_MOEGU, (size_t)1024 * 1024 * 2, toff, 4, D, F.G, (int)blockIdx.x);
            pg8::EpiGU E{(bf16*)(F.ws + WS_HS)};
            pg8::gemm_phase<pg8::EpiGU, pg8::MoeOrder, true, true>(ring, D, S, E);
        ); } SEAM(pb + 8);
        if (IN(pb + 9)) { PROBE(pb + 9, F.lane = lane_id();
            moe_toff(F, L);
            pg8::MoeOrder S; S.init(F.ws + WS_HS, F.ws + WS_MOED, (size_t)1024 * 512 * 2, toff, 4, FF, F.G, (int)blockIdx.x);
            pg8::EpiDown E{(bf16*)(F.ws + WS_Y), (const float*)(F.ws + WS_ROUTE) + 8 * M};
            pg8::gemm_phase<pg8::EpiDown, pg8::MoeOrder, true, true>(ring, FF, S, E);
        ); } SEAM(pb + 9);
        if (IN(pb + 10)) { PROBE(pb + 10, F.lane = lane_id();
            moe_combine<L>(F, L, (const float*)(F.ws + WS_XA), F.out);
        ); } SEAM(pb + 10);
}
#undef IN
#undef SEAM
struct Args { const float* in[39]; float* out; unsigned char* ws; int ph_lo, ph_hi; };
__global__ void __launch_bounds__(NWAVES * 64, 2) trunk_fwd(Args args) {
    extern __shared__ __attribute__((aligned(16))) unsigned char lds[];
    Frame F;
    F.lds = (LAS unsigned char*)lds;
    F.MISC = (volatile LAS unsigned*)(F.lds + MISC_OFF);
    F.tid = threadIdx.x; F.lane = lane_id(); F.wave = __builtin_amdgcn_readfirstlane(F.tid >> 6);
    F.G = gridDim.x; { const int bx = blockIdx.x; F.vcu = (F.G % 8 == 0) ? (bx % 8) * (F.G / 8) + bx / 8 : bx; }
    F.ws = args.ws; F.ctl = (gu32*)(args.ws + WS_CTL); F.in = args.in; F.out = args.out;
    for (int u = F.tid; u < (LDS_BYTES - LDSCTL_OFF) / 4; u += NWAVES * 64) ((LAS unsigned*)(F.lds + LDSCTL_OFF))[u] = 0u;
    __syncthreads();
    const int lo = args.ph_lo, hi = args.ph_hi;
    const bool multi = (hi - lo) > 1;
    XcdBarrier bar; bar.bar = (unsigned*)(F.ctl + CW_BAR); bar.x = 0; bar.st = nullptr;
    if (multi) bar = xcd_barrier_post((unsigned*)(F.ctl + CW_BAR), F.MISC + 8);
#define IN(k) (lo <= (k) && (k) < hi)
#define SEAM(k) do { if (IN(k) && (k) + 1 < hi) xcd_barrier(bar); } while (0)
    LAS unsigned char* ring = F.lds + RING_OFF;
    const LAS int* toff = (const LAS int*)(F.lds + LDSCTL_OFF);

    {
        {
            if (IN(0)) { PROBE(0, F.lane = lane_id(); p0_mod(F); p0_weights(F); ); } SEAM(0);
            if (IN(1)) { PROBE(1, F.lane = lane_id(); p1_norm_views(F); ); } SEAM(1);
            if (IN(2)) { PROBE(2, F.lane = lane_id();
                { pg8::BatchOrder S; S.init(F.ws + WS_VIEWS, F.ws + WS_WRKV, (size_t)M * D * 2, (size_t)D * D * 2, M, D, 3, D, F.G, (int)blockIdx.x);
                  pg8::EpiZBf16 E{(bf16*)(F.ws + WS_RKV), (size_t)M * D, 1.0f};
                  pg8::gemm_phase<pg8::EpiZBf16, pg8::BatchOrder, true, true>(ring, D, S, E); }
                { pg8::BatchOrder S; S.init(F.ws + WS_H2, F.ws + WS_WL1, 0, 0, M, 256, 1, 2048, F.G, (int)blockIdx.x);
                  pg8::EpiLora1 E{(bf16*)(F.ws + WS_A2)};
                  pg8::gemm_phase<pg8::EpiLora1, pg8::BatchOrder, true, true>(ring, 2048, S, E); }
            ); } SEAM(2);
            if (IN(3)) { PROBE(3, F.lane = lane_id();
                pg8::BatchOrder S; S.init(F.ws + WS_A2, F.ws + WS_WL2, 0, 0, M, 3072, 1, 256, F.G, (int)blockIdx.x);
                pg8::EpiLora2 E{(float*)(F.ws + WS_LOGW), (bf16*)(F.ws + WS_ASIG), (bf16*)(F.ws + WS_GG), F.in[8], F.in[11]};
                pg8::gemm_phase<pg8::EpiLora2, pg8::BatchOrder, true, true>(ring, 256, S, E);
            ); } SEAM(3);
#if defined(SCAN_SEQ)
            if (IN(4)) { PROBE(4, F.lane = lane_id(); p4_scan_seq(F); ); } SEAM(4);
#else
            if (IN(4)) { PROBE(40, F.lane = lane_id(); p4a_chunks(F); ); xcd_barrier(bar); PROBE(41, F.lane = lane_id(); p4b_state(F); ); xcd_barrier(bar); PROBE(42, F.lane = lane_id(); p4c_out(F); ); } SEAM(4);
#endif
            if (IN(5)) { PROBE(5, F.lane = lane_id();
                pg8::BatchOrder S; S.init(F.ws + WS_YG, F.ws + WS_WO0, 0, 0, M, D, 1, D, F.G, (int)blockIdx.x);
                pg8::EpiResid E{F.in[0], (float*)(F.ws + WS_XA), (const float*)(F.ws + WS_MOD) + 2048};
                pg8::gemm_phase<pg8::EpiResid, pg8::BatchOrder, true, true>(ring, D, S, E);
            ); } SEAM(5);
        }
        moe_phases<0>(F, lo, hi, bar);
        {
            if (IN(11)) { PROBE(11, F.lane = lane_id();
                { pg8::BatchOrder S; S.init(F.ws + WS_HQ, F.ws + WS_WQKV, (size_t)M * D * 2, (size_t)D * D * 2, M, D, 2, D, F.G, (int)blockIdx.x);
                  pg8::EpiZBf16 E{(bf16*)(F.ws + WS_QKV), (size_t)M * D, attn_body::C2};
                  pg8::gemm_phase<pg8::EpiZBf16, pg8::BatchOrder, true, true>(ring, D, S, E); }
                { pg8::BatchOrder S; S.init(F.ws + WS_HK, F.ws + WS_WQKV + (size_t)2 * D * D * 2, 0, 0, M, D, 1, D, F.G, (int)blockIdx.x);
                  pg8::EpiZBf16 E{(bf16*)(F.ws + WS_QKV) + (size_t)2 * M * D, 0, 1.0f};
                  pg8::gemm_phase<pg8::EpiZBf16, pg8::BatchOrder, true, true>(ring, D, S, E); }
            ); } SEAM(11);
            if (IN(12)) { PROBE(12, F.lane = lane_id();
                const attn_body::bf16* Q = (const attn_body::bf16*)(F.ws + WS_QKV); const attn_body::bf16* Kp = Q + (size_t)M * D; const attn_body::bf16* Vp = Kp + (size_t)M * D;
                attn_body::bf16* O = (attn_body::bf16*)(F.ws + WS_OC);
                const AttnOrder S((int)F.G, (int)blockIdx.x); attn_body::AttnUnit u;
                for (int i = 0; S.next(i, u); ++i) {
                    const int b = u.bh >> 5, h = (u.bh >> 2) & 7, c = (u.bh >> 1) & 1, vh = u.bh & 1;
                    attn_body::attn_unit<8>(b, u.qb, Q + (h * 2 + c) * 64, Kp + (h * 2 + c) * 64, Vp + h * 128 + vh * 64, O + (h * 2 + c) * 128 + vh * 64, (char*)lds + RING_OFF);
                }
            ); } SEAM(12);
            if (IN(13)) { PROBE(13, F.lane = lane_id(); attn_subln(F); ); } SEAM(13);
            if (IN(14)) { PROBE(14, F.lane = lane_id();
                pg8::BatchOrder S; S.init(F.ws + WS_ON, F.ws + WS_WO1, 0, 0, M, D, 1, D, F.G, (int)blockIdx.x);
                pg8::EpiResid E{F.out, (float*)(F.ws + WS_XA), (const float*)(F.ws + WS_MOD) + 4 * 6144 + 2048};
                pg8::gemm_phase<pg8::EpiResid, pg8::BatchOrder, true, true>(ring, D, S, E);
            ); } SEAM(14);
        }
        moe_phases<1>(F, lo, hi, bar);
    }
    if (multi && hi == NPHASE) { if (__hip_atomic_load((gu32*)((unsigned*)(F.ctl + CW_BAR) + XB_TMO), RLX_AGENT) != 0u) {
        const float q = __builtin_nanf(""); for (size_t i = (size_t)blockIdx.x * 512 + F.tid; i < (size_t)M * D; i += (size_t)F.G * 512) F.out[i] = q; } }
#undef IN
#undef SEAM
}

#ifndef N_LAUNCH_MODE
#define N_LAUNCH_MODE 1
#endif
extern "C" void kernel_launch(void* const* d_in, const int* in_sizes, int n_in, void* d_out, int out_size, void* d_ws, size_t ws_size, hipStream_t stream) {
    static int grid = 0;
    if (grid == 0) {
        if (n_in != 39 || in_sizes[0] != M * D || out_size != M * D || ws_size < WS_END) { fprintf(stderr, "kernel_launch: unexpected problem (n_in %d, in0 %d, out %d, ws %zu < %zu); nothing launched\n", n_in, n_in > 0 ? in_sizes[0] : -1, out_size, ws_size, (size_t)WS_END); grid = -1; return; }
        int dev = 0, cus = 0, per_cu = 0;
        if (hipGetDevice(&dev) != hipSuccess || hipDeviceGetAttribute(&cus, hipDeviceAttributeMultiprocessorCount, dev) != hipSuccess) { grid = -1; return; }
        if (hipFuncSetAttribute((const void*)trunk_fwd, hipFuncAttributeMaxDynamicSharedMemorySize, LDS_BYTES) != hipSuccess) { fprintf(stderr, "kernel_launch: hipFuncSetAttribute failed\n"); grid = -1; return; }
        if (hipOccupancyMaxActiveBlocksPerMultiprocessor(&per_cu, (const void*)trunk_fwd, NWAVES * 64, LDS_BYTES) != hipSuccess || per_cu < 1) fprintf(stderr, "kernel_launch: occupancy query reports %d\n", per_cu);
        (void)hipGetLastError();
        grid = cus;
    }
    if (grid < 0) return;
    if (hipMemsetAsync((char*)d_ws + WS_CTL, 0, CTL_ZERO_BYTES, stream) != hipSuccess) return;
    Args a{};
    for (int i = 0; i < 39; ++i) a.in[i] = (const float*)d_in[i];
    a.out = (float*)d_out; a.ws = (unsigned char*)d_ws;
    if (N_LAUNCH_MODE == 1) {
        a.ph_lo = 0; a.ph_hi = NPHASE;
        hipLaunchKernelGGL(trunk_fwd, dim3(grid), dim3(NWAVES * 64), LDS_BYTES, stream, a);
    } else {
        const int ids[20] = {0, 1, 2, 3, 4, 5, 6, 7, 8, 9, 10, 11, 12, 13, 14, 17, 18, 19, 20, 21};
        for (int k = 0; k < 20; ++k) { a.ph_lo = ids[k]; a.ph_hi = ids[k] + 1; hipLaunchKernelGGL(trunk_fwd, dim3(grid), dim3(NWAVES * 64), LDS_BYTES, stream, a); }
    }
}
```

```cpp
#include <hip/hip_runtime.h>
#include <hip/hip_bf16.h>
#include <cstdio>
#include <cstdint>
#include <cmath>

namespace pg8 {
#define PG8_LAS __attribute__((address_space(3)))
typedef unsigned short bf16_t;
typedef short bf16x8 __attribute__((ext_vector_type(8)));
typedef float f32x4 __attribute__((ext_vector_type(4)));
typedef unsigned u32x4 __attribute__((ext_vector_type(4)));
typedef unsigned u32x2 __attribute__((ext_vector_type(2)));
constexpr int BM = 256, BK = 64, HALF = 128, HTB = HALF * BK * 2  , STAGE_BYTES = 8 * HTB, NXCD = 8, WGM = 8;

__host__ __device__ __forceinline__ int lds_byte(int r, int c) { const int st = (r >> 4) * 2 + (c >> 5), rr = r & 15, cc = c & 31, ob = rr * 64 + cc * 2; return st * 1024 + (ob ^ (((ob >> 9) & 1) << 5)); }
__host__ __device__ __forceinline__ void stage_rc(int b, int& R, int& C) { const int st = b / 1024, sb = b % 1024, swz = sb ^ (((sb >> 9) & 1) << 5); R = (st >> 1) * 16 + swz / 64; C = (st & 1) * 32 + (swz % 64) / 2; }
__host__ __device__ __forceinline__ int perm32(int rho) { const int n = rho >> 4, i = rho & 15; return 8 * (i >> 2) + 4 * n + (i & 3); }

struct Unit { int pm, pn, z; };

__device__ __forceinline__ unsigned cvt_pk_bf16(float lo, float hi) { unsigned r; asm("v_cvt_pk_bf16_f32 %0, %1, %2" : "=v"(r) : "v"(lo), "v"(hi)); return r; }

struct BatchOrder {
    const char* A; const char* B; size_t sa, sb, tst; int nM, nN, nwg, tot, G, c;
    __device__ __forceinline__ void init(const void* A_, const void* B_, size_t sa_, size_t sb_, int M, int N, int Z, int K, int G_, int c_) {
        A = (const char*)A_; B = (const char*)B_; sa = sa_; sb = sb_; tst = (size_t)BM * K * 2; nM = M / BM; nN = N / BM; nwg = nM * nN; tot = nwg * Z; G = G_; c = c_; }
    __device__ __forceinline__ bool next(int i, Unit& u) const {
        const int L = i * G + c; if (L >= tot) return false;
        u.z = L / nwg; int wgid = L - u.z * nwg; { const int q = nwg / NXCD, r = nwg % NXCD, xcd = wgid % NXCD, off = wgid / NXCD; wgid = (xcd < r ? xcd * (q + 1) : r * (q + 1) + (xcd - r) * q) + off; }
        const int nig = WGM * nN, gid = wgid / nig, fm = gid * WGM, gsz = (nM - fm) < WGM ? (nM - fm) : WGM;
        u.pm = fm + ((wgid % nig) % gsz); u.pn = (wgid % nig) / gsz; return true;
    }
    __device__ __forceinline__ const char* a_base(const Unit& u) const { return A + (size_t)u.z * sa + (size_t)u.pm * tst; }
    __device__ __forceinline__ const char* b_base(const Unit& u) const { return B + (size_t)u.z * sb + (size_t)u.pn * tst; }
    __device__ __forceinline__ void a_ready(const Unit&) const {}
    __device__ __forceinline__ void done(const Unit&) const {}
};
constexpr int MOE_CAP = 16384;
struct MoeOrder {
    const char* A; const char* B; size_t sbe, tst; const PG8_LAS int* toff; const PG8_LAS int* cnt; const int* rowtok; int nNt, tot, G, c, K;
    __device__ __forceinline__ void init(const void* A_, const void* B_, size_t sbe_, const PG8_LAS int* toff_, const PG8_LAS int* cnt_, const int* rowtok_, int nNt_, int K_, int G_, int c_) {
        A = (const char*)A_; B = (const char*)B_; sbe = sbe_; tst = (size_t)BM * K_ * 2; toff = toff_; cnt = cnt_; rowtok = rowtok_; nNt = nNt_; tot = __builtin_amdgcn_readfirstlane(toff_[32]) * nNt_; G = G_; c = c_; K = K_; }
    __device__ __forceinline__ bool next(int i, Unit& u) const {
        const int L = i * G + c; if (L >= tot) return false;
        const int tI = L / nNt; u.pm = tI; u.pn = L - tI * nNt; int e = 0;
#pragma unroll
        for (int j = 1; j < 32; ++j) e += (toff[j] <= tI) ? 1 : 0;
        u.z = __builtin_amdgcn_readfirstlane(e); return true;
    }
    __device__ __forceinline__ const char* a_base(const Unit& u) const { return rowtok ? A : A + (size_t)u.pm * tst; }
    __device__ __forceinline__ const char* b_base(const Unit& u) const { return B + (size_t)u.z * sbe + (size_t)u.pn * tst; }
    __device__ __forceinline__ unsigned a_goff(const Unit& u, int half, int R, int C) const {
        const int pos = 256 * (u.pm - toff[u.z]) + 128 * half + R; const int tok = (pos < cnt[u.z]) ? rowtok[(size_t)u.z * MOE_CAP + pos] : 0;
        return (unsigned)(tok * K + C) * 2u; }
    __device__ __forceinline__ void a_ready(const Unit&) const {}
    __device__ __forceinline__ void done(const Unit&) const {}
};

__device__ __forceinline__ float sigmoidf_(float x) { return 1.0f / (1.0f + __expf(-x)); }
__device__ __forceinline__ float tanh_fast(float x) { return 1.0f - 2.0f / (__expf(2.0f * x) + 1.0f); }

struct EpiZBf16 {
    static constexpr bool PERM = true, AFTER_DRAIN = false;
    bf16_t* O; size_t zstride; float scale0;
    __device__ __forceinline__ void operator()(const f32x4 (&acc)[2][2][4][2], const Unit& u, int wr, int wc, int fr, int fq) const {
        const int row0 = u.pm * BM + wr * 64 + fr, col0 = u.pn * BM + wc * 32 + 8 * fq; bf16_t* base = O + (size_t)u.z * zstride; const float sc = (u.z == 0) ? scale0 : 1.0f;
#pragma unroll
        for (int ai = 0; ai < 2; ++ai)
#pragma unroll
            for (int m = 0; m < 4; ++m) { bf16_t* rowp = base + (size_t)(row0 + ai * HALF + m * 16) * 1024 + col0;
#pragma unroll
                for (int bj = 0; bj < 2; ++bj) { const f32x4 v0 = acc[ai][bj][m][0] * sc, v1 = acc[ai][bj][m][1] * sc;
                    u32x4 w; w.x = cvt_pk_bf16(v0[0], v0[1]); w.y = cvt_pk_bf16(v0[2], v0[3]); w.z = cvt_pk_bf16(v1[0], v1[1]); w.w = cvt_pk_bf16(v1[2], v1[3]);
                    *(u32x4*)(rowp + bj * HALF) = w; } }
    }
};
struct EpiLora1 {
    static constexpr bool PERM = true, AFTER_DRAIN = false;
    bf16_t* O;
    __device__ __forceinline__ void operator()(const f32x4 (&acc)[2][2][4][2], const Unit& u, int wr, int wc, int fr, int fq) const {
        const int row0 = u.pm * BM + wr * 64 + fr, col0 = wc * 32 + 8 * fq;
#pragma unroll
        for (int ai = 0; ai < 2; ++ai)
#pragma unroll
            for (int m = 0; m < 4; ++m) { bf16_t* rowp = O + (size_t)(row0 + ai * HALF + m * 16) * 256 + col0;
#pragma unroll
                for (int bj = 0; bj < 2; ++bj) { f32x4 v0 = acc[ai][bj][m][0], v1 = acc[ai][bj][m][1];
                    if (bj == 0 && wc < 2) {
#pragma unroll
                        for (int j = 0; j < 4; ++j) { v0[j] = tanh_fast(v0[j]); v1[j] = tanh_fast(v1[j]); } }
                    if (bj == 1) {
#pragma unroll
                        for (int j = 0; j < 4; ++j) { v0[j] = sigmoidf_(v0[j]); v1[j] = sigmoidf_(v1[j]); } }
                    u32x4 w; w.x = cvt_pk_bf16(v0[0], v0[1]); w.y = cvt_pk_bf16(v0[2], v0[3]); w.z = cvt_pk_bf16(v1[0], v1[1]); w.w = cvt_pk_bf16(v1[2], v1[3]);
                    *(u32x4*)(rowp + bj * HALF) = w; } }
    }
};
struct EpiLora2 {
    static constexpr bool PERM = false, AFTER_DRAIN = false;
    float* LW; bf16_t* AS; bf16_t* GG; const float* w0; const float* a0;
    __device__ __forceinline__ void operator()(const f32x4 (&acc)[2][2][4][2], const Unit& u, int wr, int wc, int fr, int fq) const {
        const int sect = u.pn >> 2, row0 = u.pm * BM + wr * 64 + fr, col0 = (u.pn & 3) * BM + wc * 32 + 4 * fq;
        if (sect == 0) {
#pragma unroll
            for (int bj = 0; bj < 2; ++bj)
#pragma unroll
                for (int n = 0; n < 2; ++n) { const int c = col0 + bj * HALF + n * 16; const f32x4 b = *(const f32x4*)(w0 + c);
#pragma unroll
                    for (int ai = 0; ai < 2; ++ai)
#pragma unroll
                        for (int m = 0; m < 4; ++m) { f32x4 v = acc[ai][bj][m][n] + b;
#pragma unroll
                            for (int j = 0; j < 4; ++j) v[j] = -0.60653065971f * sigmoidf_(v[j]);
                            *(f32x4*)(LW + (size_t)(row0 + ai * HALF + m * 16) * 1024 + c) = v; } }
        } else if (sect == 1) {
#pragma unroll
            for (int bj = 0; bj < 2; ++bj)
#pragma unroll
                for (int n = 0; n < 2; ++n) { const int c = col0 + bj * HALF + n * 16; const f32x4 b = *(const f32x4*)(a0 + c);
#pragma unroll
                    for (int ai = 0; ai < 2; ++ai)
#pragma unroll
                        for (int m = 0; m < 4; ++m) { f32x4 v = acc[ai][bj][m][n] + b;
#pragma unroll
                            for (int j = 0; j < 4; ++j) v[j] = sigmoidf_(v[j]);
                            u32x2 w; w.x = cvt_pk_bf16(v[0], v[1]); w.y = cvt_pk_bf16(v[2], v[3]); *(u32x2*)(AS + (size_t)(row0 + ai * HALF + m * 16) * 1024 + c) = w; } }
        } else {
#pragma unroll
            for (int bj = 0; bj < 2; ++bj)
#pragma unroll
                for (int n = 0; n < 2; ++n) { const int c = col0 + bj * HALF + n * 16;
#pragma unroll
                    for (int ai = 0; ai < 2; ++ai)
#pragma unroll
                        for (int m = 0; m < 4; ++m) { const f32x4 v = acc[ai][bj][m][n] * 1.0f;
                            u32x2 w; w.x = cvt_pk_bf16(v[0], v[1]); w.y = cvt_pk_bf16(v[2], v[3]); *(u32x2*)(GG + (size_t)(row0 + ai * HALF + m * 16) * 1024 + c) = w; } }
        }
    }
};
struct EpiResid {
    static constexpr bool PERM = false, AFTER_DRAIN = false;
    const float* xin; float* xout; const float* gate;
    __device__ __forceinline__ void operator()(const f32x4 (&acc)[2][2][4][2], const Unit& u, int wr, int wc, int fr, int fq) const {
        const int row0 = u.pm * BM + wr * 64 + fr, col0 = u.pn * BM + wc * 32 + 4 * fq; const float* gp = gate + (size_t)(u.pm >> 4) * 6144 + col0;
        f32x4 gv[2][2];
#pragma unroll
        for (int bj = 0; bj < 2; ++bj)
#pragma unroll
            for (int n = 0; n < 2; ++n) gv[bj][n] = *(const f32x4*)(gp + bj * HALF + n * 16);
#pragma unroll
        for (int ai = 0; ai < 2; ++ai)
#pragma unroll
            for (int m = 0; m < 4; ++m) { const size_t ro = (size_t)(row0 + ai * HALF + m * 16) * 1024 + col0;
#pragma unroll
                for (int bj = 0; bj < 2; ++bj)
#pragma unroll
                    for (int n = 0; n < 2; ++n) { const f32x4 xi = *(const f32x4*)(xin + ro + bj * HALF + n * 16); *(f32x4*)(xout + ro + bj * HALF + n * 16) = xi + gv[bj][n] * acc[ai][bj][m][n]; } }
    }
};
struct EpiGU {
    static constexpr bool PERM = true, AFTER_DRAIN = false;
    bf16_t* H;
    __device__ __forceinline__ void operator()(const f32x4 (&acc)[2][2][4][2], const Unit& u, int wr, int wc, int fr, int fq) const {
        const int row0 = u.pm * BM + wr * 64 + fr, col0 = u.pn * HALF + wc * 32 + 8 * fq;
#pragma unroll
        for (int ai = 0; ai < 2; ++ai)
#pragma unroll
            for (int m = 0; m < 4; ++m) { float h[8];
#pragma unroll
                for (int n = 0; n < 2; ++n)
#pragma unroll
                    for (int j = 0; j < 4; ++j) { const float g = acc[ai][0][m][n][j], up = acc[ai][1][m][n][j]; h[n * 4 + j] = g * sigmoidf_(g) * up; }
                u32x4 w; w.x = cvt_pk_bf16(h[0], h[1]); w.y = cvt_pk_bf16(h[2], h[3]); w.z = cvt_pk_bf16(h[4], h[5]); w.w = cvt_pk_bf16(h[6], h[7]);
                *(u32x4*)(H + (size_t)(row0 + ai * HALF + m * 16) * 512 + col0) = w; }
    }
};
struct EpiDown {
    static constexpr bool PERM = true, AFTER_DRAIN = false;
    bf16_t* Y; const float* rowgate; const PG8_LAS int* toff;
    __device__ __forceinline__ void operator()(const f32x4 (&acc)[2][2][4][2], const Unit& u, int wr, int wc, int fr, int fq) const {
        const int rl0 = wr * 64 + fr, col0 = u.pn * BM + wc * 32 + 8 * fq; const float* gp = rowgate + (size_t)u.z * MOE_CAP + 256 * (u.pm - toff[u.z]);
#pragma unroll
        for (int ai = 0; ai < 2; ++ai)
#pragma unroll
            for (int m = 0; m < 4; ++m) { const int rl = rl0 + ai * HALF + m * 16; const float gt = gp[rl]; bf16_t* rowp = Y + (size_t)(u.pm * BM + rl) * 1024 + col0;
#pragma unroll
                for (int bj = 0; bj < 2; ++bj) { const f32x4 v0 = acc[ai][bj][m][0] * gt, v1 = acc[ai][bj][m][1] * gt;
                    u32x4 w; w.x = cvt_pk_bf16(v0[0], v0[1]); w.y = cvt_pk_bf16(v0[2], v0[3]); w.z = cvt_pk_bf16(v1[0], v1[1]); w.w = cvt_pk_bf16(v1[2], v1[3]);
                    *(u32x4*)(rowp + bj * HALF) = w; } }
    }
};

template <class Epi, class Sched, bool ALIGN_EPI = false, bool SP2 = false>
__device__ __forceinline__ void gemm_phase(PG8_LAS unsigned char* lds, const int K_, const Sched& S, const Epi& E, const int tid_, const int wid_) {
    const int tid = tid_, wid = wid_, lane = tid & 63, wr = wid >> 2, wc = wid & 3, fr = lane & 15, fq = lane >> 4;
    const int K = K_, nt = K / BK;
    unsigned voffA[2], voffB[2];
#pragma unroll
    for (int i = 0; i < 2; ++i) { int R, C; stage_rc(tid * 16 + i * 8192, R, C); const int Rb = Epi::PERM ? ((R & ~31) + perm32(R & 31)) : R;
        voffA[i] = (unsigned)(R * K + C) * 2u; voffB[i] = (unsigned)(Rb * K + C) * 2u; }
    const size_t kstep = (size_t)(BK * 2);
    const size_t hstep = (size_t)HALF * K * 2;
    const unsigned ldsw = (unsigned)wid * 1024u;
    const int aoff = lds_byte(wr * 64 + fr, fq * 8), boff = lds_byte(wc * 32 + fr, fq * 8);
#define PG8_SA(b, h) (((b) * 2 + (h)) * HTB)
#define PG8_SB(b, h) ((4 + (b) * 2 + (h)) * HTB)
#define PG8_STAGE(bufoff, gbase, voff) do { _Pragma("unroll") for (int _i = 0; _i < 2; ++_i) \
        __builtin_amdgcn_global_load_lds((const unsigned*)((const char*)(gbase) + (voff)[_i]), (PG8_LAS unsigned*)(lds + (bufoff) + ldsw + _i * 8192), 16, 0, 0); } while (0)
#define PG8_LDA(dst, b, h) do { _Pragma("unroll") for (int m = 0; m < 4; ++m) _Pragma("unroll") for (int k = 0; k < 2; ++k) dst[m][k] = *(const PG8_LAS bf16x8*)(lds + PG8_SA(b, h) + aoff + m * 2048 + k * 1024); } while (0)
#define PG8_LDB(dst, b, h) do { _Pragma("unroll") for (int n = 0; n < 2; ++n) _Pragma("unroll") for (int k = 0; k < 2; ++k) dst[n][k] = *(const PG8_LAS bf16x8*)(lds + PG8_SB(b, h) + boff + n * 2048 + k * 1024); } while (0)
#define PG8_MMA(ai, bj, At, Bt) do { __builtin_amdgcn_s_setprio(1); _Pragma("unroll") for (int m = 0; m < 4; ++m) _Pragma("unroll") for (int n = 0; n < 2; ++n) _Pragma("unroll") for (int k = 0; k < 2; ++k) \
        acc[ai][bj][m][n] = __builtin_amdgcn_mfma_f32_16x16x32_bf16(Bt[n][k], At[m][k], acc[ai][bj][m][n], 0, 0, 0); __builtin_amdgcn_s_setprio(0); } while (0)
#define PG8_WAIT_V(n) asm volatile("s_waitcnt vmcnt(" #n ")" ::: "memory")
#define PG8_WAIT_L(n) asm volatile("s_waitcnt lgkmcnt(" #n ")" ::: "memory")
#define PG8_BAR __builtin_amdgcn_s_barrier()
#define PG8_SCHED __builtin_amdgcn_sched_barrier(0)
    Unit cur, nxt; int ui = 0;
    if (!S.next(0, cur)) return;
    f32x4 acc[2][2][4][2];
#pragma unroll
    for (int a = 0; a < 2; ++a)
#pragma unroll
        for (int b = 0; b < 2; ++b)
#pragma unroll
            for (int m = 0; m < 4; ++m)
#pragma unroll
                for (int n = 0; n < 2; ++n) acc[a][b][m][n] = (f32x4){0.f, 0.f, 0.f, 0.f};
    bf16x8 At[4][2], B0[2][2], B1[2][2];
    const char* cA = S.a_base(cur); const char* cB = S.b_base(cur);
    S.a_ready(cur);
    if constexpr (SP2) {
        PG8_STAGE(PG8_SB(0, 0), cB, voffB); PG8_STAGE(PG8_SB(0, 1), cB + hstep, voffB); PG8_STAGE(PG8_SA(0, 0), cA, voffA); PG8_STAGE(PG8_SA(0, 1), cA + hstep, voffA);
        if (wr == 1) PG8_BAR;
        PG8_WAIT_V(2); PG8_BAR;
        PG8_STAGE(PG8_SB(1, 0), cB + kstep, voffB); PG8_STAGE(PG8_SA(1, 0), cA + kstep, voffA); PG8_STAGE(PG8_SB(1, 1), cB + hstep + kstep, voffB);
        PG8_WAIT_V(6); PG8_BAR;
    } else {
        PG8_STAGE(PG8_SB(0, 0), cB, voffB); PG8_STAGE(PG8_SA(0, 0), cA, voffA); PG8_STAGE(PG8_SB(0, 1), cB + hstep, voffB); PG8_STAGE(PG8_SA(0, 1), cA + hstep, voffA);
        if (wr == 1) PG8_BAR;
        PG8_WAIT_V(4); PG8_BAR;
        PG8_STAGE(PG8_SB(1, 0), cB + kstep, voffB); PG8_STAGE(PG8_SA(1, 0), cA + kstep, voffA); PG8_STAGE(PG8_SB(1, 1), cB + hstep + kstep, voffB);
        PG8_WAIT_V(6); PG8_BAR;
    }
    for (;;) {
        const bool has_next = S.next(ui + 1, nxt);
        const char* nA = has_next ? S.a_base(nxt) : cA; const char* nB = has_next ? S.b_base(nxt) : cB;
        for (int t = 0; t < nt; t += 2) {
            const bool last = (t == nt - 2);
            const char* a1 = cA + (size_t)(t + 1) * kstep;
            const char* a2 = last ? nA : cA + (size_t)(t + 2) * kstep; const char* b2 = last ? nB : cB + (size_t)(t + 2) * kstep;
            const char* a3 = a2 + kstep; const char* b3 = b2 + kstep;
            if (last && has_next) S.a_ready(nxt);
            if constexpr (SP2) {
            PG8_LDB(B0, 0, 0); PG8_LDB(B1, 0, 1); PG8_SCHED; PG8_LDA(At, 0, 0); PG8_STAGE(PG8_SA(1, 1), a1 + hstep, voffA);
            PG8_WAIT_V(8); PG8_WAIT_L(0); PG8_BAR; PG8_MMA(0, 0, At, B0); PG8_MMA(0, 1, At, B1); PG8_BAR; PG8_SCHED;
            PG8_LDA(At, 0, 1); PG8_STAGE(PG8_SB(0, 0), b2, voffB); PG8_STAGE(PG8_SB(0, 1), b2 + hstep, voffB); PG8_STAGE(PG8_SA(0, 0), a2, voffA);
            PG8_WAIT_V(8); PG8_WAIT_L(0); PG8_BAR; PG8_MMA(1, 0, At, B0); PG8_MMA(1, 1, At, B1); PG8_BAR; PG8_SCHED;
            PG8_LDB(B0, 1, 0); PG8_LDB(B1, 1, 1); PG8_SCHED; PG8_LDA(At, 1, 0); PG8_STAGE(PG8_SA(0, 1), a2 + hstep, voffA);
            PG8_WAIT_V(8); PG8_WAIT_L(0); PG8_BAR; PG8_MMA(0, 0, At, B0); PG8_MMA(0, 1, At, B1); PG8_BAR; PG8_SCHED;
            PG8_LDA(At, 1, 1); PG8_STAGE(PG8_SB(1, 0), b3, voffB); PG8_STAGE(PG8_SB(1, 1), b3 + hstep, voffB); PG8_STAGE(PG8_SA(1, 0), a3, voffA);
            PG8_WAIT_V(8); PG8_WAIT_L(0); PG8_BAR; PG8_MMA(1, 0, At, B0); PG8_MMA(1, 1, At, B1); PG8_BAR; PG8_SCHED;
            } else {
            PG8_LDB(B0, 0, 0); PG8_SCHED; PG8_LDA(At, 0, 0); PG8_STAGE(PG8_SA(1, 1), a1 + hstep, voffA);
            PG8_WAIT_L(8); PG8_BAR; PG8_WAIT_L(0); PG8_MMA(0, 0, At, B0); PG8_BAR; PG8_SCHED;
            PG8_LDB(B1, 0, 1); PG8_STAGE(PG8_SB(0, 0), b2, voffB);
            PG8_BAR; PG8_WAIT_L(0); PG8_MMA(0, 1, At, B1); PG8_BAR;
            PG8_LDA(At, 0, 1); PG8_STAGE(PG8_SA(0, 0), a2, voffA);
            PG8_BAR; PG8_WAIT_L(0); PG8_MMA(1, 0, At, B0); PG8_BAR; PG8_SCHED;
            PG8_STAGE(PG8_SB(0, 1), b2 + hstep, voffB);
            PG8_WAIT_V(6); PG8_BAR; PG8_MMA(1, 1, At, B1); PG8_BAR;
            PG8_LDB(B0, 1, 0); PG8_SCHED; PG8_LDA(At, 1, 0); PG8_STAGE(PG8_SA(0, 1), a2 + hstep, voffA);
            PG8_WAIT_L(8); PG8_BAR; PG8_WAIT_L(0); PG8_MMA(0, 0, At, B0); PG8_BAR; PG8_SCHED;
            PG8_LDB(B1, 1, 1); PG8_STAGE(PG8_SB(1, 0), b3, voffB);
            PG8_BAR; PG8_WAIT_L(0); PG8_MMA(0, 1, At, B1); PG8_BAR;
            PG8_LDA(At, 1, 1); PG8_STAGE(PG8_SA(1, 0), a3, voffA);
            PG8_BAR; PG8_WAIT_L(0); PG8_MMA(1, 0, At, B0); PG8_BAR; PG8_SCHED;
            PG8_STAGE(PG8_SB(1, 1), b3 + hstep, voffB);
            PG8_WAIT_V(6); PG8_BAR; PG8_MMA(1, 1, At, B1); PG8_BAR;
            }
        }
        if constexpr (ALIGN_EPI) { if (wr == 0) PG8_BAR; }
        if constexpr (!Epi::AFTER_DRAIN) { E(acc, cur, wr, wc, fr, fq); S.done(cur); }
        if (!has_next) break;
#pragma unroll
        for (int a = 0; a < 2; ++a)
#pragma unroll
            for (int b = 0; b < 2; ++b)
#pragma unroll
                for (int m = 0; m < 4; ++m)
#pragma unroll
                    for (int n = 0; n < 2; ++n) acc[a][b][m][n] = (f32x4){0.f, 0.f, 0.f, 0.f};
        cur = nxt; cA = nA; cB = nB; ++ui;
        if constexpr (ALIGN_EPI) { if (wr == 1) PG8_BAR; }
    }
    PG8_WAIT_V(0);
    if constexpr (!ALIGN_EPI) { if (wr == 0) PG8_BAR; }
    PG8_BAR;
    if constexpr (Epi::AFTER_DRAIN) { E.fused(acc, cur, wr, wc, fr, fq, lds, wid, lane); S.done(cur); }
#undef PG8_SA
#undef PG8_SB
#undef PG8_STAGE
#undef PG8_LDA
#undef PG8_LDB
#undef PG8_MMA
#undef PG8_WAIT_V
#undef PG8_WAIT_L
#undef PG8_BAR
#undef PG8_SCHED
}

template <class Epi, class Sched>
__device__ __forceinline__ void gemm_phase_gather(PG8_LAS unsigned char* lds, const int K_, const Sched& S, const Epi& E, const int tid_, const int wid_) {
    const int tid = tid_, wid = wid_, lane = tid & 63, wr = wid >> 2, wc = wid & 3, fr = lane & 15, fq = lane >> 4;
    const int K = K_, nt = K / BK;
    constexpr bool ALIGN_EPI = true, SP2 = true;
    unsigned voffA[2], voffB[2]; int Rg[2], Cg[2];
#pragma unroll
    for (int i = 0; i < 2; ++i) { int R, C; stage_rc(tid * 16 + i * 8192, R, C); const int Rb = Epi::PERM ? ((R & ~31) + perm32(R & 31)) : R;
        voffA[i] = 0u; Rg[i] = R; Cg[i] = C; voffB[i] = (unsigned)(Rb * K + C) * 2u; }
    unsigned va0[2], va1[2], nva0[2], nva1[2];
#define PG8_GOFF(dst0, dst1, U) do { _Pragma("unroll") for (int _i = 0; _i < 2; ++_i) { dst0[_i] = S.a_goff(U, 0, Rg[_i], Cg[_i]); dst1[_i] = S.a_goff(U, 1, Rg[_i], Cg[_i]); } } while (0)
#define PG8_SEL(last_, nv, v) { (last_) ? nv[0] : v[0], (last_) ? nv[1] : v[1] }
    const size_t kstep = (size_t)(BK * 2);
    const size_t hstep = (size_t)HALF * K * 2;
    const unsigned ldsw = (unsigned)wid * 1024u;
    const int aoff = lds_byte(wr * 64 + fr, fq * 8), boff = lds_byte(wc * 32 + fr, fq * 8);
#define PG8_SA(b, h) (((b) * 2 + (h)) * HTB)
#define PG8_SB(b, h) ((4 + (b) * 2 + (h)) * HTB)
#define PG8_STAGE(bufoff, gbase, voff) do { _Pragma("unroll") for (int _i = 0; _i < 2; ++_i) \
        __builtin_amdgcn_global_load_lds((const unsigned*)((const char*)(gbase) + (voff)[_i]), (PG8_LAS unsigned*)(lds + (bufoff) + ldsw + _i * 8192), 16, 0, 0); } while (0)
#define PG8_LDA(dst, b, h) do { _Pragma("unroll") for (int m = 0; m < 4; ++m) _Pragma("unroll") for (int k = 0; k < 2; ++k) dst[m][k] = *(const PG8_LAS bf16x8*)(lds + PG8_SA(b, h) + aoff + m * 2048 + k * 1024); } while (0)
#define PG8_LDB(dst, b, h) do { _Pragma("unroll") for (int n = 0; n < 2; ++n) _Pragma("unroll") for (int k = 0; k < 2; ++k) dst[n][k] = *(const PG8_LAS bf16x8*)(lds + PG8_SB(b, h) + boff + n * 2048 + k * 1024); } while (0)
#define PG8_MMA(ai, bj, At, Bt) do { __builtin_amdgcn_s_setprio(1); _Pragma("unroll") for (int m = 0; m < 4; ++m) _Pragma("unroll") for (int n = 0; n < 2; ++n) _Pragma("unroll") for (int k = 0; k < 2; ++k) \
        acc[ai][bj][m][n] = __builtin_amdgcn_mfma_f32_16x16x32_bf16(Bt[n][k], At[m][k], acc[ai][bj][m][n], 0, 0, 0); __builtin_amdgcn_s_setprio(0); } while (0)
#define PG8_WAIT_V(n) asm volatile("s_waitcnt vmcnt(" #n ")" ::: "memory")
#define PG8_WAIT_L(n) asm volatile("s_waitcnt lgkmcnt(" #n ")" ::: "memory")
#define PG8_BAR __builtin_amdgcn_s_barrier()
#define PG8_SCHED __builtin_amdgcn_sched_barrier(0)
    Unit cur, nxt; int ui = 0;
    if (!S.next(0, cur)) return;
    f32x4 acc[2][2][4][2];
#pragma unroll
    for (int a = 0; a < 2; ++a)
#pragma unroll
        for (int b = 0; b < 2; ++b)
#pragma unroll
            for (int m = 0; m < 4; ++m)
#pragma unroll
                for (int n = 0; n < 2; ++n) acc[a][b][m][n] = (f32x4){0.f, 0.f, 0.f, 0.f};
    bf16x8 At[4][2], B0[2][2], B1[2][2];
    const char* cA = S.a_base(cur); const char* cB = S.b_base(cur);
    S.a_ready(cur);
    if constexpr (SP2) {
        PG8_GOFF(va0, va1, cur);
        PG8_STAGE(PG8_SB(0, 0), cB, voffB); PG8_STAGE(PG8_SB(0, 1), cB + hstep, voffB); PG8_STAGE(PG8_SA(0, 0), cA, va0); PG8_STAGE(PG8_SA(0, 1), cA, va1);
        if (wr == 1) PG8_BAR;
        PG8_WAIT_V(2); PG8_BAR;
        PG8_STAGE(PG8_SB(1, 0), cB + kstep, voffB); PG8_STAGE(PG8_SA(1, 0), cA + kstep, va0); PG8_STAGE(PG8_SB(1, 1), cB + hstep + kstep, voffB);
        PG8_WAIT_V(6); PG8_BAR;
    } else {
        PG8_STAGE(PG8_SB(0, 0), cB, voffB); PG8_STAGE(PG8_SA(0, 0), cA, voffA); PG8_STAGE(PG8_SB(0, 1), cB + hstep, voffB); PG8_STAGE(PG8_SA(0, 1), cA + hstep, voffA);
        if (wr == 1) PG8_BAR;
        PG8_WAIT_V(4); PG8_BAR;
        PG8_STAGE(PG8_SB(1, 0), cB + kstep, voffB); PG8_STAGE(PG8_SA(1, 0), cA + kstep, voffA); PG8_STAGE(PG8_SB(1, 1), cB + hstep + kstep, voffB);
        PG8_WAIT_V(6); PG8_BAR;
    }
    for (;;) {
        const bool has_next = S.next(ui + 1, nxt);
        if (has_next) PG8_GOFF(nva0, nva1, nxt); else { nva0[0] = va0[0]; nva0[1] = va0[1]; nva1[0] = va1[0]; nva1[1] = va1[1]; }
        const char* nA = has_next ? S.a_base(nxt) : cA; const char* nB = has_next ? S.b_base(nxt) : cB;
        for (int t = 0; t < nt; t += 2) {
            const bool last = (t == nt - 2);
            const char* a1 = cA + (size_t)(t + 1) * kstep;
            const char* a2 = last ? nA : cA + (size_t)(t + 2) * kstep; const char* b2 = last ? nB : cB + (size_t)(t + 2) * kstep;
            const char* a3 = a2 + kstep; const char* b3 = b2 + kstep;
            if (last && has_next) S.a_ready(nxt);
            if constexpr (SP2) {
            PG8_LDB(B0, 0, 0); PG8_LDB(B1, 0, 1); PG8_SCHED; PG8_LDA(At, 0, 0); PG8_STAGE(PG8_SA(1, 1), a1, va1);
            PG8_WAIT_V(8); PG8_WAIT_L(0); PG8_BAR; PG8_MMA(0, 0, At, B0); PG8_MMA(0, 1, At, B1); PG8_BAR; PG8_SCHED;
            PG8_LDA(At, 0, 1); PG8_STAGE(PG8_SB(0, 0), b2, voffB); PG8_STAGE(PG8_SB(0, 1), b2 + hstep, voffB); { const unsigned sv[2] = PG8_SEL(last, nva0, va0); PG8_STAGE(PG8_SA(0, 0), a2, sv); }
            PG8_WAIT_V(8); PG8_WAIT_L(0); PG8_BAR; PG8_MMA(1, 0, At, B0); PG8_MMA(1, 1, At, B1); PG8_BAR; PG8_SCHED;
            PG8_LDB(B0, 1, 0); PG8_LDB(B1, 1, 1); PG8_SCHED; PG8_LDA(At, 1, 0); { const unsigned sv[2] = PG8_SEL(last, nva1, va1); PG8_STAGE(PG8_SA(0, 1), a2, sv); }
            PG8_WAIT_V(8); PG8_WAIT_L(0); PG8_BAR; PG8_MMA(0, 0, At, B0); PG8_MMA(0, 1, At, B1); PG8_BAR; PG8_SCHED;
            PG8_LDA(At, 1, 1); PG8_STAGE(PG8_SB(1, 0), b3, voffB); PG8_STAGE(PG8_SB(1, 1), b3 + hstep, voffB); { const unsigned sv[2] = PG8_SEL(last, nva0, va0); PG8_STAGE(PG8_SA(1, 0), a3, sv); }
            PG8_WAIT_V(8); PG8_WAIT_L(0); PG8_BAR; PG8_MMA(1, 0, At, B0); PG8_MMA(1, 1, At, B1); PG8_BAR; PG8_SCHED;
            } else {
            PG8_LDB(B0, 0, 0); PG8_SCHED; PG8_LDA(At, 0, 0); PG8_STAGE(PG8_SA(1, 1), a1 + hstep, voffA);
            PG8_WAIT_L(8); PG8_BAR; PG8_WAIT_L(0); PG8_MMA(0, 0, At, B0); PG8_BAR; PG8_SCHED;
            PG8_LDB(B1, 0, 1); PG8_STAGE(PG8_SB(0, 0), b2, voffB);
            PG8_BAR; PG8_WAIT_L(0); PG8_MMA(0, 1, At, B1); PG8_BAR;
            PG8_LDA(At, 0, 1); PG8_STAGE(PG8_SA(0, 0), a2, voffA);
            PG8_BAR; PG8_WAIT_L(0); PG8_MMA(1, 0, At, B0); PG8_BAR; PG8_SCHED;
            PG8_STAGE(PG8_SB(0, 1), b2 + hstep, voffB);
            PG8_WAIT_V(6); PG8_BAR; PG8_MMA(1, 1, At, B1); PG8_BAR;
            PG8_LDB(B0, 1, 0); PG8_SCHED; PG8_LDA(At, 1, 0); PG8_STAGE(PG8_SA(0, 1), a2 + hstep, voffA);
            PG8_WAIT_L(8); PG8_BAR; PG8_WAIT_L(0); PG8_MMA(0, 0, At, B0); PG8_BAR; PG8_SCHED;
            PG8_LDB(B1, 1, 1); PG8_STAGE(PG8_SB(1, 0), b3, voffB);
            PG8_BAR; PG8_WAIT_L(0); PG8_MMA(0, 1, At, B1); PG8_BAR;
            PG8_LDA(At, 1, 1); PG8_STAGE(PG8_SA(1, 0), a3, voffA);
            PG8_BAR; PG8_WAIT_L(0); PG8_MMA(1, 0, At, B0); PG8_BAR; PG8_SCHED;
            PG8_STAGE(PG8_SB(1, 1), b3 + hstep, voffB);
            PG8_WAIT_V(6); PG8_BAR; PG8_MMA(1, 1, At, B1); PG8_BAR;
            }
        }
        if constexpr (ALIGN_EPI) { if (wr == 0) PG8_BAR; }
        if constexpr (!Epi::AFTER_DRAIN) { E(acc, cur, wr, wc, fr, fq); S.done(cur); }
        if (!has_next) break;
#pragma unroll
        for (int a = 0; a < 2; ++a)
#pragma unroll
            for (int b = 0; b < 2; ++b)
#pragma unroll
                for (int m = 0; m < 4; ++m)
#pragma unroll
                    for (int n = 0; n < 2; ++n) acc[a][b][m][n] = (f32x4){0.f, 0.f, 0.f, 0.f};
        cur = nxt; cA = nA; cB = nB; ++ui; va0[0] = nva0[0]; va0[1] = nva0[1]; va1[0] = nva1[0]; va1[1] = nva1[1];
        if constexpr (ALIGN_EPI) { if (wr == 1) PG8_BAR; }
    }
    PG8_WAIT_V(0);
    if constexpr (!ALIGN_EPI) { if (wr == 0) PG8_BAR; }
    PG8_BAR;
    if constexpr (Epi::AFTER_DRAIN) { E.fused(acc, cur, wr, wc, fr, fq, lds, wid, lane); S.done(cur); }
#undef PG8_SA
#undef PG8_SB
#undef PG8_STAGE
#undef PG8_LDA
#undef PG8_LDB
#undef PG8_MMA
#undef PG8_WAIT_V
#undef PG8_WAIT_L
#undef PG8_BAR
#undef PG8_SCHED
#undef PG8_GOFF
#undef PG8_SEL
}
}

namespace attn_body {
using bf16=__hip_bfloat16;
using bf16x8=__attribute__((ext_vector_type(8)))short;
using s16x4=__attribute__((ext_vector_type(4)))short;
using f32x16=__attribute__((ext_vector_type(16)))float;
using u32x4=__attribute__((ext_vector_type(4)))unsigned;
constexpr int BATCH=4,SEQ=4096,D=64,QP=1024,KP=1024,VP=1024,OP=2048;
constexpr int NW=8,QBLK=32,QB=QBLK*NW,KVBLK=64,NQB=SEQ/QB;
constexpr int ATTN_UNIT_ROWS=QB;
__device__ __forceinline__ int crow(int r,int hi){return (r&3)+8*(r>>2)+4*hi;}
#define SBAR() __builtin_amdgcn_sched_barrier(0)
__device__ __forceinline__ void cmask(f32x16&p0,f32x16&p1,int jb,int qrel,int hi){
  const float NEG=-INFINITY; int kb=64*jb+4*hi;
  #pragma unroll
  for(int r=0;r<16;++r){int kv=kb+(r&3)+8*(r>>2); if(kv>qrel)p0[r]=NEG; if(kv+32>qrel)p1[r]=NEG;}
}

constexpr int NSLOT=3, SLOTB=8192;
constexpr int LDS_K=0, LDS_V=NSLOT*SLOTB, LDS_WS=2*NSLOT*SLOTB, LDS_OST=LDS_WS+NW*64*4, LDS_BYTES=LDS_OST+NW*4096;
constexpr float C2=0.125f*1.4426950408889634f;
__device__ __forceinline__ void glds16(const void*gsrc,unsigned lds_dst){unsigned keep;
  asm volatile("s_mov_b32 %0, m0\n\ts_mov_b32 m0, %2\n\ts_nop 0\n\tglobal_load_lds_dwordx4 %1, off\n\ts_mov_b32 m0, %0":"=&s"(keep):"v"(gsrc),"s"(lds_dst):"memory");}
__device__ __forceinline__ float max3f(float a,float b,float c){float r;asm("v_max3_f32 %0, %1, %2, %3":"=v"(r):"v"(a),"v"(b),"v"(c));return r;}
__device__ __forceinline__ float max2f(float a,float b){float r;asm("v_max_f32_e32 %0, %1, %2":"=v"(r):"v"(a),"v"(b));return r;}
__device__ __forceinline__ float fadd_s(float a,float b){float r;asm("v_add_f32_e32 %0, %1, %2":"=v"(r):"v"(a),"v"(b));return r;}
__device__ __forceinline__ float fsub_s(float a,float b){float r;asm("v_sub_f32_e32 %0, %1, %2":"=v"(r):"v"(a),"v"(b));return r;}
typedef float f32x2_t __attribute__((ext_vector_type(2))); typedef __bf16 bf16x2_t __attribute__((ext_vector_type(2)));
__device__ __forceinline__ unsigned cvtpk_s(float lo,float hi){f32x2_t v={lo,hi};bf16x2_t b=__builtin_convertvector(v,bf16x2_t);return __builtin_bit_cast(unsigned,b);}
#define WAIT_BAR(N) asm volatile("s_waitcnt vmcnt(" #N ") lgkmcnt(0)\n\ts_barrier":::"memory")

__device__ __forceinline__ void qkt(f32x16&p0,f32x16&p1,const char*Kslot,const bf16x8*qr,const f32x16&negm,int r32,int hi){
  const char*kb=Kslot+hi*1024+r32*16;
  #pragma unroll
  for(int d0=0;d0<4;++d0){
    const bf16x8 b0=*reinterpret_cast<const bf16x8*>(kb+d0*2048);
    const bf16x8 b1=*reinterpret_cast<const bf16x8*>(kb+d0*2048+512);
    if(d0==0){p0=__builtin_amdgcn_mfma_f32_32x32x16_bf16(b0,qr[0],negm,0,0,0);p1=__builtin_amdgcn_mfma_f32_32x32x16_bf16(b1,qr[0],negm,0,0,0);}
    else{p0=__builtin_amdgcn_mfma_f32_32x32x16_bf16(b0,qr[d0],p0,0,0,0);p1=__builtin_amdgcn_mfma_f32_32x32x16_bf16(b1,qr[d0],p1,0,0,0);}}
}
typedef __attribute__((address_space(3))) const char* lds_cptr;
typedef short v4i16_t __attribute__((ext_vector_type(4)));
__device__ __forceinline__ void kload8(bf16x8*kf,lds_cptr kp){
  kf[0]=*(const __attribute__((address_space(3))) bf16x8*)(kp);      kf[1]=*(const __attribute__((address_space(3))) bf16x8*)(kp+512);
  kf[2]=*(const __attribute__((address_space(3))) bf16x8*)(kp+2048); kf[3]=*(const __attribute__((address_space(3))) bf16x8*)(kp+2560);
  kf[4]=*(const __attribute__((address_space(3))) bf16x8*)(kp+4096); kf[5]=*(const __attribute__((address_space(3))) bf16x8*)(kp+4608);
  kf[6]=*(const __attribute__((address_space(3))) bf16x8*)(kp+6144); kf[7]=*(const __attribute__((address_space(3))) bf16x8*)(kp+6656);
}
__device__ __forceinline__ void kload2(bf16x8*kf,lds_cptr kp,int j){ kf[2*j]=*(const __attribute__((address_space(3))) bf16x8*)(kp+j*2048); kf[2*j+1]=*(const __attribute__((address_space(3))) bf16x8*)(kp+j*2048+512); }
__device__ __forceinline__ s16x4 vtr(lds_cptr p){ return __builtin_bit_cast(s16x4,__builtin_amdgcn_ds_read_tr16_b64_v4i16((__attribute__((address_space(3))) v4i16_t*)p)); }
__device__ __forceinline__ float rowmax(const f32x16&p0,const f32x16&p1){
  float a=max3f(p0[0],p0[1],p1[0]),b=max3f(p0[2],p0[3],p1[1]);a=max3f(a,p1[2],p1[3]);
  #pragma unroll
  for(int r=4;r<16;r+=4){a=max3f(a,p0[r],p0[r+1]);b=max3f(b,p0[r+2],p0[r+3]);a=max3f(a,p1[r],p1[r+1]);b=max3f(b,p1[r+2],p1[r+3]);}
  const float m=max2f(a,b);
  auto rr=__builtin_amdgcn_permlane32_swap(__float_as_uint(m),__float_as_uint(m),false,false);
  return max2f(__uint_as_float(rr[0]),__uint_as_float(rr[1]));
}
__device__ __forceinline__ void pv(f32x16*o,int vb,bf16x8 pa0,bf16x8 pa1,bf16x8 pa2,bf16x8 pa3){
  #pragma unroll
  for(int d0=0;d0<2;++d0){s16x4 lo[4],hi[4];
    #pragma unroll
    for(int ks=0;ks<4;++ks){
      asm volatile("ds_read_b64_tr_b16 %0,%1 offset:%c2":"=&v"(lo[ks]):"v"(vb),"i"(d0*4096+ks*1024):"memory");
      asm volatile("ds_read_b64_tr_b16 %0,%1 offset:%c2":"=&v"(hi[ks]):"v"(vb),"i"(d0*4096+ks*1024+512):"memory");}
    asm volatile("s_waitcnt lgkmcnt(0)":::"memory");SBAR();
    #define PK(k) (bf16x8){lo[k][0],lo[k][1],lo[k][2],lo[k][3],hi[k][0],hi[k][1],hi[k][2],hi[k][3]}
    o[d0]=__builtin_amdgcn_mfma_f32_32x32x16_bf16(pa0,PK(0),o[d0],0,0,0);
    o[d0]=__builtin_amdgcn_mfma_f32_32x32x16_bf16(pa1,PK(1),o[d0],0,0,0);
    o[d0]=__builtin_amdgcn_mfma_f32_32x32x16_bf16(pa2,PK(2),o[d0],0,0,0);
    o[d0]=__builtin_amdgcn_mfma_f32_32x32x16_bf16(pa3,PK(3),o[d0],0,0,0);
    #undef PK
  }
}

#ifndef ATTN_STORE16
#define ATTN_STORE16(p,v) (*(u32x4*)(p)=(v))
#endif
template<int THRL> __device__ __forceinline__ void attn_unit(int b,int qb,const bf16*Q,const bf16*__restrict__ K,const bf16*__restrict__ V,bf16*O,char*shm,const int tid_,const int wid_){
  const int tid=tid_,lane=tid&63,r32=lane&31,hi=lane>>5; const int wid=wid_;
  const long rowbase=(long)b*SEQ; const int q0=qb*QB;
  const bf16*Qw=Q+(rowbase+q0+wid*QBLK)*QP;
  const bf16*Kh=K+rowbase*KP,*Vh=V+rowbase*VP;
  const unsigned lds0=(unsigned)(uintptr_t)shm;
  float*wsf=(float*)(shm+LDS_WS)+wid*64;
  const bf16*ksrc=Kh+(long)lane*KP+wid*8;
  const bf16*vsrc=Vh+(long)(16*(wid&3)+(lane>>2))*VP+(wid>>2)*32+(lane&3)*8;
  const unsigned kdst=lds0+LDS_K+wid*1024, vdst=lds0+LDS_V+wid*1024;
  #define DMA_K(t,slot) glds16(ksrc+(long)(t)*KVBLK*KP,(unsigned)__builtin_amdgcn_readfirstlane(kdst+(slot)))
  #define DMA_V(t,slot) glds16(vsrc+(long)(t)*KVBLK*VP,(unsigned)__builtin_amdgcn_readfirstlane(vdst+(slot)))
  const int vb0=(int)(lds0+LDS_V)+((lane>>4)&1)*32+(lane&3)*8+(4*hi+((lane&15)>>2))*64;
  const char*Kbase=shm+LDS_K; bf16x8 kf[8];
  const lds_cptr shm3=(lds_cptr)shm; const lds_cptr kp0=shm3+LDS_K+hi*1024+r32*16; const lds_cptr vp0=shm3+LDS_V+((lane>>4)&1)*32+(lane&3)*8+(4*hi+((lane&15)>>2))*64;
  const int NT=(q0+QB)/KVBLK;
  DMA_K(0,0);DMA_V(0,0);DMA_K(1,SLOTB);
  bf16x8 qr[4];
  #pragma unroll
  for(int d0=0;d0<4;++d0)qr[d0]=*reinterpret_cast<const bf16x8*>(&Qw[(long)r32*QP+d0*16+hi*8]);
  float mhat=0.f,l_reg=0.f;f32x16 o[2];o[0]=f32x16{};o[1]=f32x16{};f32x16 negm=f32x16{};asm volatile("":"+v"(negm));
  const int qrel=wid*QBLK+r32;
  #define CMASK(P0,P1,t) do{int jb_=(t)-(NT-4); if(jb_>=0)cmask(P0,P1,jb_,qrel,hi);}while(0)
  bool resc=false;
  #define START(P0,P1) do{ const float rm=rowmax(P0,P1); resc=false; \
    { const float dl=rm; mhat=fadd_s(mhat,dl); \
      _Pragma("unroll") for(int r=0;r<16;++r){P0[r]=fsub_s(P0[r],dl);P1[r]=fsub_s(P1[r],dl);} \
      _Pragma("unroll") for(int r=0;r<16;++r)negm[r]=-mhat; asm volatile("":"+v"(negm)); } \
    _Pragma("unroll") for(int r=0;r<16;++r)P0[r]=__builtin_amdgcn_exp2f(P0[r]); }while(0)
  #define RESC() do{ if(resc){ asm volatile("s_waitcnt lgkmcnt(0)":::"memory"); \
      _Pragma("unroll") for(int d_=0;d_<2;++d_) _Pragma("unroll") for(int r=0;r<16;++r)o[d_][r]*=wsf[crow(r,hi)]; } }while(0)
  f32x16 pA0,pA1,pB0,pB1;
  int sl_prev=0,sl_cur=0,sl_next=SLOTB;
  #define ROT() do{sl_prev=sl_cur;sl_cur=sl_next;sl_next=(sl_next==(NSLOT-1)*SLOTB)?0:sl_next+SLOTB;}while(0)
  DMA_K(2,2*SLOTB);
  WAIT_BAR(3);
  qkt(pA0,pA1,Kbase,qr,negm,r32,hi);asm volatile("s_nop 15\n\ts_nop 7":"+v"(pA0),"+v"(pA1));CMASK(pA0,pA1,0);
  START(pA0,pA1);
  _Pragma("unroll") for(int r=0;r<16;++r)pA1[r]=__builtin_amdgcn_exp2f(pA1[r]);
  WAIT_BAR(0);
  DMA_K(3,0);DMA_V(1,SLOTB);
  ROT();
  kload8(kf,kp0+sl_cur);
  WAIT_BAR(2);
  s16x4 vlo[8],vhi[8]; u32x4 pw0,pw1,pw2,pw3;
  #define PKW(P,B) cvtpk_s(P[B],P[B+1])
  #define PAF(k) __builtin_bit_cast(bf16x8,pw##k)
  #define VFR(i) (bf16x8){vlo[i][0],vlo[i][1],vlo[i][2],vlo[i][3],vhi[i][0],vhi[i][1],vhi[i][2],vhi[i][3]}
  #define PIN(x) asm volatile("":"+v"(x))
  #define MX3(a,b,c) __builtin_fmaxf(__builtin_fmaxf((a),(b)),(c))
  #define GAPA(MF,A0,A1,A2,A3,W0,W1,PW) do{ MF; sacc+=A0; sacc+=A1; sacc+=A2; sacc+=A3; PIN(sacc); W0; W1; PIN(PW); SBAR(); }while(0)
  #define EX(v) __builtin_amdgcn_exp2f(v)
  #define GAPB(MF,X,B) do{ MF; X[B]=EX(X[B]); X[B+1]=EX(X[B+1]); X[B+2]=EX(X[B+2]); X[B+3]=EX(X[B+3]); PIN(X); SBAR(); }while(0)
  #define VRD(i) do{ vlo[i]=vtr(vp_+(((i)>>2)*4096+((i)&3)*1024)); vhi[i]=vtr(vp_+(((i)>>2)*4096+((i)&3)*1024+512)); }while(0)
  #define KRD(G,j) do{ if(G){ kload2(kf,kp0+sl_next,j); SBAR(); } }while(0)
  #define STEP(C0,C1,P0,P1,t,GK,GV,GL) do{ SBAR(); \
    const lds_cptr vp_=vp0+sl_prev; \
    VRD(0); SBAR(); float sacc=(P0[0]+P0[1]); \
    GAPA(C0=__builtin_amdgcn_mfma_f32_32x32x16_bf16(kf[0],qr[0],negm,0,0,0), P0[2],P0[3],P0[4],P0[5],     pw0[0]=PKW(P0,0), pw0[1]=PKW(P0,2), pw0); \
    VRD(4); SBAR(); GAPA(C1=__builtin_amdgcn_mfma_f32_32x32x16_bf16(kf[1],qr[0],negm,0,0,0), P0[6],P0[7],P0[8],P0[9],     pw0[2]=PKW(P0,4), pw0[3]=PKW(P0,6), pw0); \
    VRD(1); SBAR(); GAPA(C0=__builtin_amdgcn_mfma_f32_32x32x16_bf16(kf[2],qr[1],C0,0,0,0),   P0[10],P0[11],P0[12],P0[13], pw1[0]=PKW(P0,8), pw1[1]=PKW(P0,10), pw1); \
    VRD(5); SBAR(); GAPA(C1=__builtin_amdgcn_mfma_f32_32x32x16_bf16(kf[3],qr[1],C1,0,0,0),   P0[14],P0[15],P1[0],P1[1],   pw1[2]=PKW(P0,12),pw1[3]=PKW(P0,14), pw1); \
    VRD(2); SBAR(); GAPA(C0=__builtin_amdgcn_mfma_f32_32x32x16_bf16(kf[4],qr[2],C0,0,0,0),   P1[2],P1[3],P1[4],P1[5],     pw2[0]=PKW(P1,0), pw2[1]=PKW(P1,2), pw2); \
    VRD(6); SBAR(); GAPA(C1=__builtin_amdgcn_mfma_f32_32x32x16_bf16(kf[5],qr[2],C1,0,0,0),   P1[6],P1[7],P1[8],P1[9],     pw2[2]=PKW(P1,4), pw2[3]=PKW(P1,6), pw2); \
    VRD(3); SBAR(); GAPA(C0=__builtin_amdgcn_mfma_f32_32x32x16_bf16(kf[6],qr[3],C0,0,0,0),   P1[10],P1[11],P1[12],P1[13], pw3[0]=PKW(P1,8), pw3[1]=PKW(P1,10), pw3); \
    VRD(7); SBAR(); GAPA(C1=__builtin_amdgcn_mfma_f32_32x32x16_bf16(kf[7],qr[3],C1,0,0,0),   P1[14],P1[15],0.f,0.f,       pw3[2]=PKW(P1,12),pw3[3]=PKW(P1,14), pw3); \
    l_reg+=sacc; \
    if(GK){DMA_K((t)+3,sl_cur);} if(GV){DMA_V((t)+1,sl_next);} \
    CMASK(C0,C1,t); \
    { float a=MX3(C0[0],C0[1],C1[0]),b=MX3(C0[2],C0[3],C1[1]); a=MX3(a,C1[2],C1[3]); \
      _Pragma("unroll") for(int r=4;r<16;r+=4){a=MX3(a,C0[r],C0[r+1]);b=MX3(b,C0[r+2],C0[r+3]);a=MX3(a,C1[r],C1[r+1]);b=MX3(b,C1[r+2],C1[r+3]);} \
      float rm=__builtin_fmaxf(a,b); { auto rr=__builtin_amdgcn_permlane32_swap(__float_as_uint(rm),__float_as_uint(rm),false,false); rm=__builtin_fmaxf(__uint_as_float(rr[0]),__uint_as_float(rr[1])); } \
      resc=false; \
      if(__builtin_expect(__any(rm>(float)THRL),0)){ const float dl=__builtin_fmaxf(rm,0.f); mhat+=dl; \
        _Pragma("unroll") for(int r=0;r<16;++r){C0[r]-=dl;C1[r]-=dl;} \
        _Pragma("unroll") for(int r=0;r<16;++r)negm[r]=-mhat; asm volatile("":"+v"(negm)); \
        const float f=__builtin_amdgcn_exp2f(-dl); l_reg*=f; if(hi==0)wsf[r32]=f; resc=true; } } \
    SBAR(); \
    GAPB(o[0]=__builtin_amdgcn_mfma_f32_32x32x16_bf16(PAF(0),VFR(0),o[0],0,0,0), C0,0); \
    GAPB(o[1]=__builtin_amdgcn_mfma_f32_32x32x16_bf16(PAF(0),VFR(4),o[1],0,0,0), C0,4); \
    KRD(GL,0); GAPB(o[0]=__builtin_amdgcn_mfma_f32_32x32x16_bf16(PAF(1),VFR(1),o[0],0,0,0), C0,8); \
    KRD(GL,1); GAPB(o[1]=__builtin_amdgcn_mfma_f32_32x32x16_bf16(PAF(1),VFR(5),o[1],0,0,0), C0,12); \
    KRD(GL,2); GAPB(o[0]=__builtin_amdgcn_mfma_f32_32x32x16_bf16(PAF(2),VFR(2),o[0],0,0,0), C1,0); \
    KRD(GL,3); GAPB(o[1]=__builtin_amdgcn_mfma_f32_32x32x16_bf16(PAF(2),VFR(6),o[1],0,0,0), C1,4); \
    GAPB(o[0]=__builtin_amdgcn_mfma_f32_32x32x16_bf16(PAF(3),VFR(3),o[0],0,0,0), C1,8); \
    GAPB(o[1]=__builtin_amdgcn_mfma_f32_32x32x16_bf16(PAF(3),VFR(7),o[1],0,0,0), C1,12); \
    }while(0)
  int t=1;
  #undef CMASK
  #define CMASK(P0,P1,t) do{}while(0)
  for(;t+5<NT;t+=2){
    STEP(pB0,pB1,pA0,pA1,t,true,true,true);     WAIT_BAR(2); RESC(); ROT();
    STEP(pA0,pA1,pB0,pB1,t+1,true,true,true);   WAIT_BAR(2); RESC(); ROT();
  }
  #undef CMASK
  #define CMASK(P0,P1,t) do{int jb_=(t)-(NT-4); if(jb_>=0)cmask(P0,P1,jb_,qrel,hi);}while(0)
  #define ENDW(tt) do{ if((tt)+3<NT){WAIT_BAR(2);} else if((tt)+2<NT){WAIT_BAR(1);} else {WAIT_BAR(0);} }while(0)
  for(;t+1<NT;t+=2){
    STEP(pB0,pB1,pA0,pA1,t,(t+3<NT),(t+1<NT),(t+1<NT));       ENDW(t);   RESC(); ROT();
    STEP(pA0,pA1,pB0,pB1,t+1,(t+4<NT),(t+2<NT),(t+2<NT));     ENDW(t+1); RESC(); ROT();
  }
  STEP(pB0,pB1,pA0,pA1,NT-1,false,false,false); RESC();
  { float sacc=pB0[0]+pB0[1]; _Pragma("unroll") for(int r=2;r<16;++r)sacc+=pB0[r]; _Pragma("unroll") for(int r=0;r<16;++r)sacc+=pB1[r]; l_reg+=sacc;
    pw0=(u32x4){PKW(pB0,0),PKW(pB0,2),PKW(pB0,4),PKW(pB0,6)};pw1=(u32x4){PKW(pB0,8),PKW(pB0,10),PKW(pB0,12),PKW(pB0,14)};pw2=(u32x4){PKW(pB1,0),PKW(pB1,2),PKW(pB1,4),PKW(pB1,6)};pw3=(u32x4){PKW(pB1,8),PKW(pB1,10),PKW(pB1,12),PKW(pB1,14)};
    SBAR(); pv(o,vb0+sl_cur,PAF(0),PAF(1),PAF(2),PAF(3)); }
  #undef PKW
  #undef PAF
  #undef VFR
  #undef PIN
  #undef MX3
  #undef GAPA
  #undef GAPB
  #undef EX
  #undef VRD
  #undef KRD
  #undef STEP
  #undef ENDW
  {auto rr=__builtin_amdgcn_permlane32_swap(__float_as_uint(l_reg),__float_as_uint(l_reg),false,false);l_reg=__uint_as_float(rr[0])+__uint_as_float(rr[1]);}
  if(hi==0)wsf[32+r32]=l_reg;asm volatile("s_waitcnt lgkmcnt(0)":::"memory");
  float rli[16];
  #pragma unroll
  for(int r=0;r<16;++r)rli[r]=__builtin_amdgcn_rcpf(wsf[32+crow(r,hi)]);
  bf16*Ow=O+(rowbase+q0+wid*QBLK)*OP;
  { bf16*stg=(bf16*)(shm+LDS_OST)+wid*2048;
    #pragma unroll
    for(int r=0;r<16;++r){const int orow=crow(r,hi);
      #pragma unroll
      for(int d0=0;d0<2;++d0)stg[orow*64+d0*32+r32]=__float2bfloat16(o[d0][r]*rli[r]);}
    asm volatile("s_waitcnt lgkmcnt(0)":::"memory");
    #pragma unroll
    for(int i=0;i<4;++i){const int row=i*8+(lane>>3),ch=lane&7; const u32x4 v=*(const u32x4*)(stg+row*64+ch*8); ATTN_STORE16(Ow+(long)row*OP+ch*8,v);} }
  asm volatile("s_waitcnt lgkmcnt(0)\n\ts_barrier":::"memory");
  #undef DMA_K
  #undef DMA_V
  #undef CMASK
  #undef START
  #undef RESC
  #undef ROT
}
constexpr int ATTN_LDS_BYTES=LDS_BYTES;
struct AttnUnit { int bh; int qb; };
#undef SBAR
#undef WAIT_BAR
}

#ifndef PROBE_PHASE
#define PROBE_PHASE (-1)
#endif

constexpr int NWAVES = 8;
constexpr int BATCH = 4, T = 4096, D = 1024, M = BATCH * T;
constexpr int NE = 32, FF = 512, NGRP = 4, EPG = 8;
constexpr int MAXROWS = 40960;
constexpr float RMS_EPS = 1e-6f, GN_EPS = 64e-5f, SUBLN_EPS = 1e-5f;
constexpr float LAMBDA_INIT1 = 0.35550906759f;

constexpr size_t MiB = 1u << 20;
constexpr size_t WS_CTL = 0, CTL_ZERO_BYTES = 1 * MiB;
constexpr size_t WS_MOD = 1 * MiB;
constexpr size_t WS_WRKV = 2 * MiB, WS_WL1 = 8 * MiB, WS_WL2 = 9 * MiB, WS_WO0 = 11 * MiB, WS_WQKV = 13 * MiB, WS_WO1 = 19 * MiB;
constexpr size_t WS_ROWTOK = 22 * MiB, WS_ROWGATE = 24 * MiB;
constexpr size_t WS_ROUTE = 21 * MiB;
constexpr size_t WS_MOEGU = 32 * MiB, WS_MOED = 96 * MiB;
constexpr size_t WS_XA = 128 * MiB;
constexpr size_t WS_R = 192 * MiB;
constexpr size_t WS_VIEWS = WS_R, WS_H2 = WS_R + 96 * MiB, WS_A2 = WS_R + 160 * MiB, WS_RKV = WS_R + 168 * MiB;
constexpr size_t WS_LOGW = WS_R, WS_ASIG = WS_R + 64 * MiB, WS_GG = WS_R + 96 * MiB, WS_YG = WS_R + 128 * MiB;
constexpr size_t WS_H2N = WS_R, WS_XS = WS_R + 32 * MiB, WS_HS = WS_R + 112 * MiB, WS_Y = WS_R + 152 * MiB;
constexpr size_t WS_HQ = WS_R, WS_HK = WS_R + 32 * MiB, WS_QKV = WS_R + 64 * MiB, WS_OC = WS_R + 160 * MiB, WS_ON = WS_R + 224 * MiB;
constexpr size_t WS_QE = 32 * MiB, WS_MCT = 64 * MiB, WS_SC = 96 * MiB, WS_Y0 = 128 * MiB, WS_NC = WS_R + 264 * MiB, WS_RK = WS_R + 296 * MiB;
constexpr size_t WS_END = WS_R + 297 * MiB;
static_assert(WS_RKV + 96 * MiB <= WS_END && WS_Y + 80 * MiB <= WS_END && WS_ON + 32 * MiB <= WS_END, "d_ws map");
constexpr int CW_BAR = 4096;
constexpr int CW_CNT = 8192;

constexpr int RING_OFF = 0, RING_BYTES = 131072;
constexpr int LDSCTL_OFF = 146944, MISC_OFF = LDSCTL_OFF + 320;
constexpr int LDS_BYTES = 147456;

#define GAS __attribute__((address_space(1)))
#define LAS __attribute__((address_space(3)))
typedef unsigned short bf16;
typedef unsigned v4u __attribute__((ext_vector_type(4)));
typedef unsigned v2u __attribute__((ext_vector_type(2)));
typedef float f32x4 __attribute__((ext_vector_type(4)));
typedef short bf16x8 __attribute__((ext_vector_type(8)));
typedef GAS unsigned gu32;
#define RLX_AGENT __ATOMIC_RELAXED, __HIP_MEMORY_SCOPE_AGENT
#define LDS_WAIT() asm volatile("s_waitcnt lgkmcnt(0)" ::: "memory")
#define VM_WAIT() asm volatile("s_waitcnt vmcnt(0)" ::: "memory")
__device__ __forceinline__ unsigned pk2(float lo, float hi) { return pg8::cvt_pk_bf16(lo, hi); }
__device__ __forceinline__ float bflo(unsigned w) { return __uint_as_float(w << 16); }
__device__ __forceinline__ float bfhi(unsigned w) { return __uint_as_float(w & 0xffff0000u); }

#define XB_TMO      128
#define XB_XCNT(j)  (256  + 64 * (j))
#define XB_XSUB(j)  (1280 + 64 * (j))
#define XB_XGEN(j)  (2304 + 64 * (j))
#define XB_TOP      3328
#define XB_TOPGEN   3392
#define XCD_BAR_WORDS 3456
#define XB_SPIN_CAP (1u << 18)

__device__ __forceinline__ unsigned xb_ld(unsigned* p)              { return __hip_atomic_load(p, __ATOMIC_RELAXED, __HIP_MEMORY_SCOPE_AGENT); }
__device__ __forceinline__ unsigned xb_add(unsigned* p, unsigned v) { return __hip_atomic_fetch_add(p, v, __ATOMIC_RELAXED, __HIP_MEMORY_SCOPE_AGENT); }
__device__ __forceinline__ unsigned xb_xcc_id() { return (unsigned)__builtin_amdgcn_s_getreg((3 << 11) | 20) & 0xFu; }
#define XB_SPIN(cond, bar) do { unsigned _sp = 0; while (cond) { __builtin_amdgcn_s_sleep(1); \
    if ((++_sp & 255u) == 0u) { if (xb_ld(&(bar)[XB_TMO])) break; if (_sp > XB_SPIN_CAP) { atomicAdd(&(bar)[XB_TMO], 1u); break; } } } } while (0)

__device__ __forceinline__ int xb_lane() { int l; asm volatile("v_mbcnt_lo_u32_b32 %0, -1, 0\n\tv_mbcnt_hi_u32_b32 %0, -1, %0" : "=v"(l)); return l; }
struct XcdBarrier {
    unsigned* bar; unsigned x; int wave;
    volatile LAS unsigned* st;
};

__device__ __forceinline__ XcdBarrier xcd_barrier_post(unsigned* bar, volatile LAS unsigned* st) {
    XcdBarrier b; b.bar = bar; b.x = xb_xcc_id(); b.st = st; b.wave = __builtin_amdgcn_readfirstlane(threadIdx.x >> 6);
    if (threadIdx.x == 0) (void)xb_add(&bar[XB_XCNT(b.x)], 1u);
    return b;
}
__device__ __forceinline__ void xcd_barrier_complete(unsigned* bar, unsigned x, unsigned& nloc, unsigned& nx) {
    const unsigned G = gridDim.x * gridDim.y * gridDim.z;
    unsigned sum, cnt, mine, sp = 0u;
    for (;;) {
        sum = 0u; cnt = 0u; mine = 0u;
#pragma unroll
        for (unsigned j = 0; j < 16; ++j) { const unsigned c = xb_ld(&bar[XB_XCNT(j)]); sum += c; cnt += (c > 0u) ? 1u : 0u; mine = (j == x) ? c : mine; }
        if (sum == G) break;
        __builtin_amdgcn_s_sleep(1);
        if ((++sp & 255u) == 0u) { if (xb_ld(&bar[XB_TMO])) break; if (sp > XB_SPIN_CAP) { atomicAdd(&bar[XB_TMO], 1u); break; } }
    }
    nloc = mine > 0u ? mine : 1u; nx = cnt > 0u ? cnt : 1u;
}

__device__ __forceinline__ void xcd_barrier(const XcdBarrier& b) {
    asm volatile("s_waitcnt vmcnt(0)" ::: "memory");
    __syncthreads();
    if (b.wave == 0 && xb_lane() == 0) {
        unsigned* bar = b.bar;
        __builtin_amdgcn_s_waitcnt(0);
        unsigned nloc = b.st[0], nx = b.st[1];
        if (nloc == 0u) { xcd_barrier_complete(bar, b.x, nloc, nx); b.st[0] = nloc; b.st[1] = nx; }
        const unsigned old = xb_add(&bar[XB_XSUB(b.x)], 1u);
        const unsigned gen = old / nloc;
        if (old + 1u == (gen + 1u) * nloc) {
            __builtin_amdgcn_fence(__ATOMIC_RELEASE, "agent");
            asm volatile("s_waitcnt vmcnt(0)" ::: "memory");
            const unsigned og = xb_add(&bar[XB_TOP], 1u);
            const unsigned tg = og / nx;
            if (og + 1u == (tg + 1u) * nx) xb_add(&bar[XB_TOPGEN], 1u);
            else XB_SPIN(xb_ld(&bar[XB_TOPGEN]) == tg, bar);
            __builtin_amdgcn_fence(__ATOMIC_ACQUIRE, "agent");
            xb_add(&bar[XB_XGEN(b.x)], 1u);
            asm volatile("s_waitcnt vmcnt(0)" ::: "memory");
        } else {
            XB_SPIN(xb_ld(&bar[XB_XGEN(b.x)]) == gen, bar);
            __builtin_amdgcn_fence(__ATOMIC_ACQUIRE, "agent");
            asm volatile("s_waitcnt vmcnt(0)" ::: "memory");
        }
    }
    __syncthreads();
}


struct Frame {
    LAS unsigned char* lds;
    volatile LAS unsigned* MISC;
    gu32* ctl;
    unsigned char* ws;
    const float* const* in;
    float* out;
    int tid, lane, wave, vcu, G;
};
__device__ __forceinline__ int lane_id() { int l; asm volatile("v_mbcnt_lo_u32_b32 %0, -1, 0\n\tv_mbcnt_hi_u32_b32 %0, -1, %0" : "=v"(l)); return l; }
__device__ __forceinline__ float wave_sum(float v) {
#pragma unroll
    for (int o = 1; o < 64; o <<= 1) v += __shfl_xor(v, o);
    return v;
}
__device__ __forceinline__ void transpose_item(const float* W, int ldw, int k0, int n0, bf16* WT, int ldo, int orow0, int ok0, const float* kscale, LAS float* scr, int lane) {
#pragma unroll 8
    for (int i = 0; i < 32; ++i) { const int kk = 2 * i + (lane >> 5); float v = W[(size_t)(k0 + kk) * ldw + n0 + (lane & 31)]; if (kscale) v *= kscale[k0 + kk]; scr[kk * 33 + (lane & 31)] = v; }
    LDS_WAIT(); asm volatile("" ::: "memory");
    const int c = lane & 7;
#pragma unroll
    for (int j = 0; j < 4; ++j) { const int n = (lane >> 3) + 8 * j; const LAS float* s = scr + (8 * c) * 33 + n;
        v4u o; o.x = pk2(s[0 * 33], s[1 * 33]); o.y = pk2(s[2 * 33], s[3 * 33]); o.z = pk2(s[4 * 33], s[5 * 33]); o.w = pk2(s[6 * 33], s[7 * 33]);
        *(GAS v4u*)(WT + (size_t)(orow0 + n) * ldo + ok0 + k0 + 8 * c) = o; }
    LDS_WAIT(); asm volatile("" ::: "memory");
}
__device__ __forceinline__ void transpose_mat(Frame& F, const float* W, int K, int N, bf16* WT, int ldo, int row_off, int ok0, const float* kscale, int gw, int NGW) {
    LAS float* scr = (LAS float*)(F.lds + RING_OFF + F.wave * 16384);
    const int nblk = N / 32, items = (K / 64) * nblk;
    for (int it = gw; it < items; it += NGW) { const int kb = it / nblk, nb = it % nblk; transpose_item(W, N, 64 * kb, 32 * nb, WT, ldo, row_off + 32 * nb, ok0, kscale, scr, F.lane); }
}

__device__ __forceinline__ void p0_mod(Frame& F) {
    LAS float* cact = (LAS float*)(F.lds + RING_OFF);
    LAS float* red = cact + 4096;
    const float* c = F.in[1];
    for (int i = F.tid; i < 4096; i += 512) { const float v = c[i]; cact[i] = v / (1.0f + __expf(-v)); }
    __syncthreads();
    float* modbase = (float*)(F.ws + WS_MOD);
    for (int it = blockIdx.x; it < 224; it += F.G) {
        const float* W; const float* bias; float* outp; int N, cc;
        if (it < 96) { W = F.in[2]; bias = F.in[3]; outp = modbase; N = 6144; cc = it; }
        else if (it < 192) { W = F.in[2] + (size_t)1024 * 6144; bias = F.in[3] + 6144; outp = modbase + 4 * 6144; N = 6144; cc = it - 96; }
        else { W = F.in[22]; bias = F.in[23]; outp = modbase + 8 * 6144; N = 2048; cc = it - 192; }
        const int kg = F.tid >> 4, cq = F.tid & 15, col = cc * 64 + cq * 4;
        f32x4 a0 = {0, 0, 0, 0}, a1 = a0, a2 = a0, a3 = a0;
#pragma unroll 4
        for (int kk = 0; kk < 32; ++kk) { const int k = kg * 32 + kk; const f32x4 w = *(const f32x4*)(W + (size_t)k * N + col);
            a0 += w * cact[k]; a1 += w * cact[1024 + k]; a2 += w * cact[2048 + k]; a3 += w * cact[3072 + k]; }
        LAS f32x4* rp = (LAS f32x4*)red + (kg * 16 + cq) * 4;
        rp[0] = a0; rp[1] = a1; rp[2] = a2; rp[3] = a3;
        __syncthreads();
        if (F.tid < 256) { const int b = F.tid >> 6, cl = F.tid & 63, cq2 = cl >> 2, j = cl & 3; float s = 0.f;
            for (int g = 0; g < 32; ++g) s += red[((g * 16 + cq2) * 4 + b) * 4 + j];
            outp[(size_t)b * N + cc * 64 + cl] = s + bias[cc * 64 + cl]; }
        __syncthreads();
    }
}
__device__ __forceinline__ void p0_weights(Frame& F) {
    const int gw = F.vcu * NWAVES + F.wave, NGW = F.G * NWAVES;
    bf16* Wrkv = (bf16*)(F.ws + WS_WRKV); bf16* Wl1 = (bf16*)(F.ws + WS_WL1); bf16* Wl2 = (bf16*)(F.ws + WS_WL2);
    bf16* Wo0 = (bf16*)(F.ws + WS_WO0); bf16* Wqkv = (bf16*)(F.ws + WS_WQKV); bf16* Wo1 = (bf16*)(F.ws + WS_WO1);
    for (int z = 0; z < 3; ++z) transpose_mat(F, F.in[7] + (size_t)z * D * D, D, D, Wrkv + (size_t)z * D * D, D, 0, 0, nullptr, gw, NGW);
    transpose_mat(F, F.in[21], D, D, Wo0, D, 0, 0, nullptr, gw, NGW);
    transpose_mat(F, F.in[26], D, D, Wqkv, D, 0, 0, nullptr, gw, NGW);
    transpose_mat(F, F.in[25], D, 2 * D, Wqkv, D, D, 0, nullptr, gw, NGW);
    transpose_mat(F, F.in[32], D, D, Wo1, D, 0, 0, nullptr, gw, NGW);
    const float* mu = F.in[6];
    transpose_mat(F, F.in[9], D, 64, Wl1, 2048, 0, 0, nullptr, gw, NGW);    transpose_mat(F, F.in[9], D, 64, Wl1, 2048, 0, 1024, mu + 3 * D, gw, NGW);
    transpose_mat(F, F.in[12], D, 64, Wl1, 2048, 64, 0, nullptr, gw, NGW);  transpose_mat(F, F.in[12], D, 64, Wl1, 2048, 64, 1024, mu + 4 * D, gw, NGW);
    transpose_mat(F, F.in[14], D, 128, Wl1, 2048, 128, 0, nullptr, gw, NGW); transpose_mat(F, F.in[14], D, 128, Wl1, 2048, 128, 1024, mu + 5 * D, gw, NGW);
    const float* w2 = F.in[10]; const float* a2 = F.in[13]; const float* g2 = F.in[15];
    for (int idx = (blockIdx.x * 512 + F.tid); idx < 3072 * 256; idx += F.G * 512) {
        const int k = idx / 3072, n = idx % 3072; float v = 0.f;
        if (n < 1024) { if (k < 64) v = w2[(size_t)k * 1024 + n]; }
        else if (n < 2048) { if (k >= 64 && k < 128) v = a2[(size_t)(k - 64) * 1024 + (n - 1024)]; }
        else { if (k >= 128) v = g2[(size_t)(k - 128) * 1024 + (n - 2048)]; }
        Wl2[(size_t)n * 256 + k] = (bf16)(pk2(v, 0.f) & 0xffffu);
    }
}
__device__ __forceinline__ void moe_weights(Frame& F, int l) {
    const int gw = F.vcu * NWAVES + F.wave, NGW = F.G * NWAVES;
    LAS float* scr = (LAS float*)(F.lds + RING_OFF + F.wave * 16384);
    bf16* GU = (bf16*)(F.ws + WS_MOEGU); bf16* DW = (bf16*)(F.ws + WS_MOED);
    const float* wg = F.in[35] + (size_t)l * NE * D * FF; const float* wu = F.in[36] + (size_t)l * NE * D * FF; const float* wd = F.in[37] + (size_t)l * NE * FF * D;
    for (int it = gw; it < NE * 768; it += NGW) {
        const int e = it / 768, r = it % 768;
        if (r < 512) { const int up = r >> 8, q = r & 255, kb = q >> 4, nb = q & 15, n0 = 32 * nb;
            const float* W = (up ? wu : wg) + (size_t)e * D * FF;
            transpose_item(W, FF, 64 * kb, n0, GU + (size_t)e * 1024 * 1024, 1024, 256 * (n0 >> 7) + (n0 & 127) + (up ? 128 : 0), 0, nullptr, scr, F.lane); }
        else { const int q = r - 512, kb = q >> 5, nb = q & 31;
            transpose_item(wd + (size_t)e * FF * D, D, 64 * kb, 32 * nb, DW + (size_t)e * 1024 * 512, 512, 32 * nb, 0, nullptr, scr, F.lane); }
    }
}

__device__ __forceinline__ void p1_norm_views(Frame& F) {
    LAS float* hrow = (LAS float*)(F.lds + RING_OFF);
    const float* x = F.in[0]; const float* g = F.in[4]; const float* mu = F.in[6];
    const float* mod = (const float*)(F.ws + WS_MOD);
    bf16* views = (bf16*)(F.ws + WS_VIEWS); bf16* H2 = (bf16*)(F.ws + WS_H2);
    for (int grp = blockIdx.x; grp < M / 8; grp += F.G) {
        const int m0 = grp * 8, b = m0 / T, t0 = m0 % T;
        const float* sh = mod + (size_t)b * 6144; const float* sc = sh + 1024;
        f32x4 hv[4];
        for (int pass = 0; pass < 2; ++pass) {
            if (pass == 1 && F.wave != 0) break;
            const int row = (pass == 0) ? (m0 + F.wave) : (m0 - 1);
            f32x4 v[4];
            if (pass == 1 && t0 == 0) {
#pragma unroll
                for (int j = 0; j < 4; ++j) v[j] = (f32x4){0.f, 0.f, 0.f, 0.f};
            } else {
                const f32x4* xr = (const f32x4*)(x + (size_t)row * D) + F.lane; float ss = 0.f;
#pragma unroll
                for (int j = 0; j < 4; ++j) { v[j] = xr[64 * j]; ss += (v[j].x * v[j].x + v[j].y * v[j].y) + (v[j].z * v[j].z + v[j].w * v[j].w); }
                const float rstd = 1.0f / sqrtf(wave_sum(ss) * (1.f / D) + RMS_EPS);
#pragma unroll
                for (int j = 0; j < 4; ++j) { const int c = 4 * F.lane + 256 * j; const f32x4 gg = *(const f32x4*)(g + c), s1 = *(const f32x4*)(sc + c), s0 = *(const f32x4*)(sh + c);
                    v[j] = v[j] * rstd * gg * (s1 + 1.0f) + s0; }
            }
            LAS f32x4* hp = (LAS f32x4*)(hrow + ((pass == 0) ? (F.wave + 1) : 0) * 1024) + F.lane;
#pragma unroll
            for (int j = 0; j < 4; ++j) { hp[64 * j] = v[j]; if (pass == 0) hv[j] = v[j]; }
        }
        __syncthreads();
        {
            const int row = m0 + F.wave;
            const LAS f32x4* pp = (const LAS f32x4*)(hrow + F.wave * 1024) + F.lane;
#pragma unroll
            for (int j = 0; j < 4; ++j) { const int c = 4 * F.lane + 256 * j; const f32x4 xx = pp[64 * j] - hv[j];
#pragma unroll
                for (int i = 0; i < 3; ++i) { const f32x4 mm = *(const f32x4*)(mu + i * D + c); const f32x4 o = hv[j] + xx * mm;
                    v2u w; w.x = pk2(o.x, o.y); w.y = pk2(o.z, o.w); *(v2u*)(views + ((size_t)i * M + row) * D + c) = w; }
                v2u w; w.x = pk2(hv[j].x, hv[j].y); w.y = pk2(hv[j].z, hv[j].w); *(v2u*)(H2 + (size_t)row * 2048 + c) = w;
                w.x = pk2(xx.x, xx.y); w.y = pk2(xx.z, xx.w); *(v2u*)(H2 + (size_t)row * 2048 + 1024 + c) = w; }
        }
        __syncthreads();
    }
}

__device__ __forceinline__ void p4_scan_seq(Frame& F) {
    constexpr int TS = 32;
    LAS float* sA = (LAS float*)(F.lds + RING_OFF);
    LAS float* sW = sA + TS * 64; LAS float* sB = sW + TS * 64; LAS float* sK = sB + TS * 64; LAS float* sR = sK + TS * 64; LAS float* sV = sR + TS * 64;
    LAS float* sY = sV + TS * 64; LAS float* sRK = sY + TS * 64;
    const bf16* Rb = (const bf16*)(F.ws + WS_RKV); const bf16* Kb = Rb + (size_t)M * D; const bf16* Vb = Kb + (size_t)M * D;
    const float* LW = (const float*)(F.ws + WS_LOGW); const bf16* AS = (const bf16*)(F.ws + WS_ASIG); const bf16* GG = (const bf16*)(F.ws + WS_GG);
    bf16* YG = (bf16*)(F.ws + WS_YG);
    const float* k_k = F.in[16]; const float* k_a = F.in[17]; const float* r_k = F.in[18]; const float* gn_g = F.in[19]; const float* gn_b = F.in[20];
    for (int bh = blockIdx.x; bh < BATCH * 16; bh += F.G) {
        const int b = bh >> 4, h = bh & 15;
        const int i = F.tid >> 3, q = F.tid & 7;
        const int st = F.tid >> 4, d4 = (F.tid & 15) * 4;
        const int cg = h * 64 + d4;
        const f32x4 kkv = *(const f32x4*)(k_k + cg), kav = *(const f32x4*)(k_a + cg), rkv = *(const f32x4*)(r_k + cg), gng = *(const f32x4*)(gn_g + cg), gnb = *(const f32x4*)(gn_b + cg);
        float s[8];
#pragma unroll
        for (int j = 0; j < 8; ++j) s[j] = 0.f;
        for (int t0 = 0; t0 < T; t0 += TS) {
            const size_t ro = ((size_t)b * T + t0 + st) * D + cg;
            {
                const v2u rr = *(const v2u*)(Rb + ro), kk2 = *(const v2u*)(Kb + ro), vv = *(const v2u*)(Vb + ro), aa = *(const v2u*)(AS + ro); const f32x4 lw = *(const f32x4*)(LW + ro);
                const f32x4 r4 = {bflo(rr.x), bfhi(rr.x), bflo(rr.y), bfhi(rr.y)}, k4 = {bflo(kk2.x), bfhi(kk2.x), bflo(kk2.y), bfhi(kk2.y)};
                const f32x4 v4 = {bflo(vv.x), bfhi(vv.x), bflo(vv.y), bfhi(vv.y)}, a4 = {bflo(aa.x), bfhi(aa.x), bflo(aa.y), bfhi(aa.y)};
                const f32x4 kr = k4 * kkv; float ss = (kr.x * kr.x + kr.y * kr.y) + (kr.z * kr.z + kr.w * kr.w);
                ss += __shfl_xor(ss, 1); ss += __shfl_xor(ss, 2); ss += __shfl_xor(ss, 4); ss += __shfl_xor(ss, 8);
                const float inv = 1.0f / fmaxf(sqrtf(ss), 1e-12f);
                const f32x4 kkn = kr * inv; const f32x4 km = k4 * ((a4 - 1.0f) * kav + 1.0f);
                const f32x4 rk4 = r4 * km * rkv; float rs = (rk4.x + rk4.y) + (rk4.z + rk4.w);
                rs += __shfl_xor(rs, 1); rs += __shfl_xor(rs, 2); rs += __shfl_xor(rs, 4); rs += __shfl_xor(rs, 8);
                f32x4 wv; wv.x = __expf(lw.x); wv.y = __expf(lw.y); wv.z = __expf(lw.z); wv.w = __expf(lw.w);
                *(LAS f32x4*)(sA + st * 64 + d4) = -kkn; *(LAS f32x4*)(sW + st * 64 + d4) = wv; *(LAS f32x4*)(sB + st * 64 + d4) = kkn * a4;
                *(LAS f32x4*)(sK + st * 64 + d4) = km; *(LAS f32x4*)(sR + st * 64 + d4) = r4; *(LAS f32x4*)(sV + st * 64 + d4) = v4;
                if ((F.tid & 15) == 0) sRK[st] = rs;
            }
            __syncthreads();
            for (int t = 0; t < TS; ++t) {
                const LAS f32x4* pa = (const LAS f32x4*)(sA + t * 64 + q * 8); const LAS f32x4* pw = (const LAS f32x4*)(sW + t * 64 + q * 8); const LAS f32x4* pb = (const LAS f32x4*)(sB + t * 64 + q * 8);
                const LAS f32x4* pk = (const LAS f32x4*)(sK + t * 64 + q * 8); const LAS f32x4* pr = (const LAS f32x4*)(sR + t * 64 + q * 8);
                const f32x4 a0 = pa[0], a1 = pa[1], w0 = pw[0], w1 = pw[1], b0 = pb[0], b1 = pb[1], k0 = pk[0], k1 = pk[1], r0 = pr[0], r1 = pr[1];
                const float vi = sV[t * 64 + i];
                float sa = (s[0] * a0.x + s[1] * a0.y) + (s[2] * a0.z + s[3] * a0.w) + (s[4] * a1.x + s[5] * a1.y) + (s[6] * a1.z + s[7] * a1.w);
                sa += __shfl_xor(sa, 1); sa += __shfl_xor(sa, 2); sa += __shfl_xor(sa, 4);
                s[0] = s[0] * w0.x + sa * b0.x + vi * k0.x; s[1] = s[1] * w0.y + sa * b0.y + vi * k0.y; s[2] = s[2] * w0.z + sa * b0.z + vi * k0.z; s[3] = s[3] * w0.w + sa * b0.w + vi * k0.w;
                s[4] = s[4] * w1.x + sa * b1.x + vi * k1.x; s[5] = s[5] * w1.y + sa * b1.y + vi * k1.y; s[6] = s[6] * w1.z + sa * b1.z + vi * k1.z; s[7] = s[7] * w1.w + sa * b1.w + vi * k1.w;
                float y = (s[0] * r0.x + s[1] * r0.y) + (s[2] * r0.z + s[3] * r0.w) + (s[4] * r1.x + s[5] * r1.y) + (s[6] * r1.z + s[7] * r1.w);
                y += __shfl_xor(y, 1); y += __shfl_xor(y, 2); y += __shfl_xor(y, 4);
                if (q == 0) sY[t * 64 + i] = y;
            }
            __syncthreads();
            {
                const f32x4 y4 = *(const LAS f32x4*)(sY + st * 64 + d4); const f32x4 v4 = *(const LAS f32x4*)(sV + st * 64 + d4);
                float sm = (y4.x + y4.y) + (y4.z + y4.w);
                sm += __shfl_xor(sm, 1); sm += __shfl_xor(sm, 2); sm += __shfl_xor(sm, 4); sm += __shfl_xor(sm, 8);
                const float mean = sm * (1.f / 64.f); const f32x4 dv = y4 - mean;
                float vs = (dv.x * dv.x + dv.y * dv.y) + (dv.z * dv.z + dv.w * dv.w);
                vs += __shfl_xor(vs, 1); vs += __shfl_xor(vs, 2); vs += __shfl_xor(vs, 4); vs += __shfl_xor(vs, 8);
                const float rstd = 1.0f / sqrtf(vs * (1.f / 64.f) + GN_EPS);
                const v2u gg = *(const v2u*)(GG + ro); const f32x4 g4 = {bflo(gg.x), bfhi(gg.x), bflo(gg.y), bfhi(gg.y)};
                const f32x4 o = (dv * rstd * gng + gnb + v4 * sRK[st]) * g4;
                v2u w; w.x = pk2(o.x, o.y); w.y = pk2(o.z, o.w); *(v2u*)(YG + ro) = w;
            }
            __syncthreads();
        }
    }
}

constexpr int RT_HS = 1028;
__device__ __forceinline__ void moe_router(Frame& F, int l, const float* xin, int cnt_off) {
    const float* g = F.in[5] + (size_t)l * D; const float* wrg = F.in[33] + (size_t)l * D * NGRP; const float* wre = F.in[34] + (size_t)l * D * NE;
    const float* mod = (const float*)(F.ws + WS_MOD) + (size_t)l * 4 * 6144;
    bf16* H2N = (bf16*)(F.ws + WS_H2N);
    int* asg_e = (int*)(F.ws + WS_ROUTE); int* asg_pos = asg_e + 2 * M; int* rowtok = (int*)(F.ws + WS_ROWTOK); float* rowgate = (float*)(F.ws + WS_ROWGATE);
    unsigned* cnt = (unsigned*)F.ctl + CW_CNT + 64 * l + cnt_off;
    LAS float* hs = (LAS float*)(F.lds + RING_OFF);
    LAS float* part = hs + 16 * RT_HS;
    LAS float* lgs = part + 8 * 768;
    const int lane = F.lane, w = F.wave, n16 = lane & 15, g4 = lane >> 4;
    float wreg[3][32];
    {   const int kb = 128 * w + 32 * g4;
        const float* pg = wrg + (size_t)kb * 4 + (n16 & 3); const float* pe0 = wre + (size_t)kb * 32 + ((n16 + 28) & 31); const float* pe1 = wre + (size_t)kb * 32 + 12 + n16; const float* pe2 = wre + (size_t)kb * 32 + 28 + (n16 & 3);
#pragma unroll
        for (int ks = 0; ks < 32; ++ks) { const float a = pg[ks * 4], bq = pe0[ks * 32], cq = pe2[ks * 32];
            wreg[0][ks] = (n16 < 4) ? a : bq; wreg[1][ks] = pe1[ks * 32]; wreg[2][ks] = (n16 < 4) ? cq : 0.f; } }
    const int ti_n = (M / 16 - (int)blockIdx.x + F.G - 1) / F.G;
    f32x4 xv[2][4];
#pragma unroll
    for (int rr = 0; rr < 2; ++rr) { const f32x4* xr = (const f32x4*)(xin + (size_t)(blockIdx.x * 16 + 2 * w + rr) * D) + lane;
#pragma unroll
        for (int j = 0; j < 4; ++j) xv[rr][j] = (ti_n > 0) ? xr[64 * j] : (f32x4){0.f, 0.f, 0.f, 0.f}; }
    for (int ti = 0; ti < ti_n; ++ti) { const int tile = blockIdx.x + ti * F.G;
#pragma unroll
        for (int rr = 0; rr < 2; ++rr) { const int rl = 2 * w + rr, row = tile * 16 + rl;
            const int b = row / T; const float* sh = mod + (size_t)b * 6144 + 3072; const float* sc = sh + 1024;
            f32x4 v[4]; float ss = 0.f;
#pragma unroll
            for (int j = 0; j < 4; ++j) { v[j] = xv[rr][j]; ss += (v[j].x * v[j].x + v[j].y * v[j].y) + (v[j].z * v[j].z + v[j].w * v[j].w); }
            const float rstd = 1.0f / sqrtf(wave_sum(ss) * (1.f / D) + RMS_EPS);
#pragma unroll
            for (int j = 0; j < 4; ++j) { const int c = 4 * lane + 256 * j; const f32x4 gg = *(const f32x4*)(g + c), s1 = *(const f32x4*)(sc + c), s0 = *(const f32x4*)(sh + c);
                v[j] = v[j] * rstd * gg * (s1 + 1.0f) + s0;
                v2u wv; wv.x = pk2(v[j].x, v[j].y); wv.y = pk2(v[j].z, v[j].w); *(v2u*)(H2N + (size_t)row * D + c) = wv;
                *(LAS f32x4*)(hs + rl * RT_HS + c) = v[j]; } }
        if (ti + 1 < ti_n) {
#pragma unroll
            for (int rr = 0; rr < 2; ++rr) { const f32x4* xr = (const f32x4*)(xin + (size_t)((tile + F.G) * 16 + 2 * w + rr) * D) + lane;
#pragma unroll
                for (int j = 0; j < 4; ++j) xv[rr][j] = xr[64 * j]; } }
        __syncthreads();
        f32x4 acc[3];
#pragma unroll
        for (int nt = 0; nt < 3; ++nt) acc[nt] = (f32x4){0.f, 0.f, 0.f, 0.f};
#pragma unroll
        for (int q = 0; q < 8; ++q) { const f32x4 a4 = *(const LAS f32x4*)(hs + n16 * RT_HS + 128 * w + 32 * g4 + 4 * q);
#pragma unroll
            for (int e = 0; e < 4; ++e)
#pragma unroll
                for (int nt = 0; nt < 3; ++nt) acc[nt] = __builtin_amdgcn_mfma_f32_16x16x4f32(a4[e], wreg[nt][4 * q + e], acc[nt], 0, 0, 0); }
#pragma unroll
        for (int nt = 0; nt < 3; ++nt)
#pragma unroll
            for (int reg = 0; reg < 4; ++reg) part[(w * 16 + 4 * g4 + reg) * 48 + 16 * nt + n16] = acc[nt][reg];
        __syncthreads();
        for (int o = F.tid; o < 768; o += 512) { float s = 0.f;
#pragma unroll
            for (int ww = 0; ww < 8; ++ww) s += part[ww * 768 + o];
            lgs[ti * 768 + o] = s; }
    }
    __syncthreads();
    LAS unsigned* lcnt = (LAS unsigned*)(lgs + 8 * 768);
    if (F.tid < 64) lcnt[F.tid] = 0u;
    __syncthreads();
    const int nrow = 16 * ti_n;
    int ea0 = 0, eb0 = 0, ea1 = 0, eb1 = 0; unsigned pa0 = 0, pb0 = 0, pa1 = 0, pb1 = 0; float ga0 = 0.f, gb0 = 0.f, ga1 = 0.f, gb1 = 0.f;
#pragma unroll
    for (int it = 0; it < 2; ++it) { const int rloc = F.tid + it * 512 * 0 + it * 64;
        if (F.tid < 64 && rloc < nrow) {
            float lg[36];
#pragma unroll
            for (int q = 0; q < 9; ++q) { const f32x4 pv = *(const LAS f32x4*)(lgs + rloc * 48 + 4 * q); lg[4 * q] = pv.x; lg[4 * q + 1] = pv.y; lg[4 * q + 2] = pv.z; lg[4 * q + 3] = pv.w; }
            int gi = 0; float gm = lg[0];
#pragma unroll
            for (int j = 1; j < 4; ++j) if (lg[j] > gm) { gm = lg[j]; gi = j; }
            float gs = 0.f;
#pragma unroll
            for (int j = 0; j < 4; ++j) gs += __expf(lg[j] - gm);
            const float ggate = 1.0f / gs;
            float el[8];
#pragma unroll
            for (int j = 0; j < 8; ++j) el[j] = (gi == 0) ? lg[4 + j] : (gi == 1) ? lg[12 + j] : (gi == 2) ? lg[20 + j] : lg[28 + j];
            int i1 = 0; float v1 = el[0];
#pragma unroll
            for (int j = 1; j < 8; ++j) if (el[j] > v1) { v1 = el[j]; i1 = j; }
            int i2 = -1; float v2 = -INFINITY;
#pragma unroll
            for (int j = 0; j < 8; ++j) if (j != i1 && el[j] > v2) { v2 = el[j]; i2 = j; }
            const float e2 = __expf(v2 - v1), p1 = 1.0f / (1.0f + e2), p2 = e2 * p1;
            const int ea = gi * 8 + i1, eb = gi * 8 + i2;
            const unsigned pa = __hip_atomic_fetch_add(lcnt + ea, 1u, __ATOMIC_RELAXED, __HIP_MEMORY_SCOPE_WORKGROUP), pb = __hip_atomic_fetch_add(lcnt + eb, 1u, __ATOMIC_RELAXED, __HIP_MEMORY_SCOPE_WORKGROUP);
            if (it == 0) { ea0 = ea; eb0 = eb; pa0 = pa; pb0 = pb; ga0 = ggate * p1; gb0 = ggate * p2; } else { ea1 = ea; eb1 = eb; pa1 = pa; pb1 = pb; ga1 = ggate * p1; gb1 = ggate * p2; }
        } }
    __syncthreads();
    if (F.tid < 32) { const unsigned n = lcnt[F.tid]; lcnt[32 + F.tid] = n ? atomicAdd(cnt + F.tid, n) : 0u; }
    __syncthreads();
#pragma unroll
    for (int it = 0; it < 2; ++it) { const int rloc = F.tid + it * 64;
        if (F.tid < 64 && rloc < nrow) { const int row = (blockIdx.x + (rloc >> 4) * F.G) * 16 + (rloc & 15);
            const int ea = it ? ea1 : ea0, eb = it ? eb1 : eb0; const unsigned pa = it ? pa1 : pa0, pb = it ? pb1 : pb0;
            const int qa = (int)(lcnt[32 + ea] + pa), qb = (int)(lcnt[32 + eb] + pb);
            asg_e[2 * row] = ea; asg_e[2 * row + 1] = eb; asg_pos[2 * row] = qa; asg_pos[2 * row + 1] = qb;
            rowtok[(size_t)ea * pg8::MOE_CAP + qa] = row; rowtok[(size_t)eb * pg8::MOE_CAP + qb] = row; rowgate[(size_t)ea * pg8::MOE_CAP + qa] = it ? ga1 : ga0; rowgate[(size_t)eb * pg8::MOE_CAP + qb] = it ? gb1 : gb0; } }
    __syncthreads();
}
__device__ __forceinline__ void moe_toff(Frame& F, int l) {
    LAS int* toff = (LAS int*)(F.lds + LDSCTL_OFF);
    if (F.tid == 0) { const unsigned* cnt = (const unsigned*)F.ctl + CW_CNT + 64 * l; int acc = 0;
        for (int e = 0; e < 32; ++e) { const int n = (int)__hip_atomic_load(cnt + e, RLX_AGENT); toff[e] = acc; toff[40 + e] = n; acc += (n + 255) >> 8; }
        toff[32] = acc; }
    __syncthreads();
}
template <int MODE> __device__ __forceinline__ void moe_combine(Frame& F, int l, const float* xin, float* xout) {
    moe_toff(F, l);
    const bf16* Y = (const bf16*)(F.ws + WS_Y);
    const int* asg_e = (const int*)(F.ws + WS_ROUTE); const int* asg_pos = asg_e + 2 * M; const LAS int* toff = (const LAS int*)(F.lds + LDSCTL_OFF);
    const float* mod = (const float*)(F.ws + WS_MOD) + (size_t)l * 4 * 6144;
    const float* mod1 = (const float*)(F.ws + WS_MOD) + (size_t)4 * 6144;
    const float* modkv = (const float*)(F.ws + WS_MOD) + (size_t)8 * 6144;
    const float* gq = F.in[4] + D; const float* gkv = F.in[24]; const float* gfin = F.in[38];
    bf16* HQ = (bf16*)(F.ws + WS_HQ); bf16* HK = (bf16*)(F.ws + WS_HK);
    const int gw = blockIdx.x * NWAVES + F.wave, NGW = F.G * NWAVES;
    for (int row = gw; row < M; row += NGW) {
        const int b = row / T; const float* gf = mod + (size_t)b * 6144 + 5120;
        const int r0 = toff[asg_e[2 * row]] * 256 + asg_pos[2 * row], r1 = toff[asg_e[2 * row + 1]] * 256 + asg_pos[2 * row + 1];
        const f32x4* xr = (const f32x4*)(xin + (size_t)row * D) + F.lane; f32x4 v[4]; float ss = 0.f;
#pragma unroll
        for (int j = 0; j < 4; ++j) { const int c = 4 * F.lane + 256 * j;
            const v2u y0 = *(const v2u*)(Y + (size_t)r0 * D + c), y1 = *(const v2u*)(Y + (size_t)r1 * D + c); const f32x4 gg = *(const f32x4*)(gf + c);
            const f32x4 ys = {bflo(y0.x) + bflo(y1.x), bfhi(y0.x) + bfhi(y1.x), bflo(y0.y) + bflo(y1.y), bfhi(y0.y) + bfhi(y1.y)};
            v[j] = xr[64 * j] + gg * ys; ss += (v[j].x * v[j].x + v[j].y * v[j].y) + (v[j].z * v[j].z + v[j].w * v[j].w); }
        const float rstd = 1.0f / sqrtf(wave_sum(ss) * (1.f / D) + RMS_EPS);
        if (MODE == 0) {
            const float* shq = mod1 + (size_t)b * 6144; const float* scq = shq + 1024; const float* shk = modkv + (size_t)b * 2048; const float* sck = shk + 1024;
#pragma unroll
            for (int j = 0; j < 4; ++j) { const int c = 4 * F.lane + 256 * j;
                *((f32x4*)(xout + (size_t)row * D) + F.lane + 64 * j) = v[j];
                const f32x4 n = v[j] * rstd;
                const f32x4 hq = n * *(const f32x4*)(gq + c) * (*(const f32x4*)(scq + c) + 1.0f) + *(const f32x4*)(shq + c);
                const f32x4 hk = n * *(const f32x4*)(gkv + c) * (*(const f32x4*)(sck + c) + 1.0f) + *(const f32x4*)(shk + c);
                v2u w; w.x = pk2(hq.x, hq.y); w.y = pk2(hq.z, hq.w); *(v2u*)(HQ + (size_t)row * D + c) = w;
                w.x = pk2(hk.x, hk.y); w.y = pk2(hk.z, hk.w); *(v2u*)(HK + (size_t)row * D + c) = w; }
        } else {
#pragma unroll
            for (int j = 0; j < 4; ++j) { const int c = 4 * F.lane + 256 * j; *((f32x4*)(xout + (size_t)row * D) + F.lane + 64 * j) = v[j] * rstd * *(const f32x4*)(gfin + c); }
        }
    }
}
__device__ __forceinline__ void attn_subln_rows(Frame& F, size_t row0, int h) {
    const bf16* OC = (const bf16*)(F.ws + WS_OC); bf16* ON = (bf16*)(F.ws + WS_ON);
    asm volatile("s_waitcnt vmcnt(0)" ::: "memory");
    const int lane = lane_id(), q4 = lane & 3;
    const float l1 = wave_sum(F.in[27][lane] * F.in[28][lane]), l2 = wave_sum(F.in[29][lane] * F.in[30][lane]);
    const float lam = __expf(l1) - __expf(l2) + LAMBDA_INIT1;
    const float* sg = F.in[31] + q4 * 32;
#pragma unroll 1
    for (int ps = 0; ps < 2; ++ps) { const size_t row = row0 + ps * 16 + (lane >> 2);
        const v4u* p0 = (const v4u*)(OC + row * 2048 + h * 256 + q4 * 32); const v4u* p1 = (const v4u*)(OC + row * 2048 + h * 256 + 128 + q4 * 32);
        float d[32]; float ss = 0.f;
#pragma unroll
        for (int q = 0; q < 4; ++q) { const v4u a = p0[q], bq = p1[q]; const unsigned aw[4] = {a.x, a.y, a.z, a.w}, bw[4] = {bq.x, bq.y, bq.z, bq.w};
#pragma unroll
            for (int e = 0; e < 4; ++e) { d[8 * q + 2 * e] = bflo(aw[e]) - lam * bflo(bw[e]); d[8 * q + 2 * e + 1] = bfhi(aw[e]) - lam * bfhi(bw[e]); } }
#pragma unroll
        for (int e = 0; e < 32; ++e) ss += d[e] * d[e];
        ss += __shfl_xor(ss, 1); ss += __shfl_xor(ss, 2);
        const float rstd = (1.0f - LAMBDA_INIT1) / sqrtf(ss * (1.f / 128.f) + SUBLN_EPS);
        v4u* op = (v4u*)(ON + row * D + h * 128 + q4 * 32);
#pragma unroll
        for (int q = 0; q < 4; ++q) { const f32x4 g0 = *(const f32x4*)(sg + 8 * q), g1 = *(const f32x4*)(sg + 8 * q + 4);
            v4u w; w.x = pk2(d[8 * q] * rstd * g0.x, d[8 * q + 1] * rstd * g0.y); w.y = pk2(d[8 * q + 2] * rstd * g0.z, d[8 * q + 3] * rstd * g0.w);
            w.z = pk2(d[8 * q + 4] * rstd * g1.x, d[8 * q + 5] * rstd * g1.y); w.w = pk2(d[8 * q + 6] * rstd * g1.z, d[8 * q + 7] * rstd * g1.w); op[q] = w; } }
}
struct AttnOrder {
    int vcu;
    __device__ __forceinline__ explicit AttnOrder(int grid, int block) : vcu((block % 8) * (grid / 8) + block / 8) {}
    __device__ __forceinline__ bool next(int i, attn_body::AttnUnit& u) const { if (i >= 8) return false; const int s = 2 * (i >> 1) + (vcu & 1); u.bh = vcu >> 1; u.qb = (i & 1) ? s : 15 - s; return true; }
    __device__ __forceinline__ void a_ready(const attn_body::AttnUnit&) const {}
    __device__ __forceinline__ void done(const attn_body::AttnUnit&) const {}
};

typedef float f32x16 __attribute__((ext_vector_type(16)));
typedef float f32x2_t __attribute__((ext_vector_type(2))); typedef __bf16 bf16x2_t __attribute__((ext_vector_type(2)));
__device__ __forceinline__ unsigned cvtpk(float lo, float hi) { f32x2_t v = {lo, hi}; bf16x2_t b = __builtin_convertvector(v, bf16x2_t); return __builtin_bit_cast(unsigned, b); }
#define MMA32(a, b, c) __builtin_amdgcn_mfma_f32_32x32x16_bf16((a), (b), (c), 0, 0, 0)
constexpr int SC_TS = 72, SC_TB = 64 * SC_TS * 2;
constexpr int SL_A = 0, SL_B = 1, SL_K = 2, SL_R = 3, SL_BH = 4, SL_KH = 5, SL_VT = 6, SL_ARB = 7, SL_ARK = 8;
constexpr int SC_RHS = 9 * SC_TB;
constexpr int SC_XT0 = SC_RHS + 32768, SC_XT1 = SC_XT0 + SC_TB;
constexpr int SC_GEND = SC_XT1 + SC_TB;
constexpr int SC_AD = 1 * SC_TB, SC_ADS = 20;
constexpr int SC_TBB = SC_AD + 4 * 16 * SC_ADS * 4;
constexpr int SC_LBUF = 7 * SC_TB, SC_SEG = SC_LBUF + 16384;
static_assert(SC_GEND + 256 <= LDSCTL_OFF && SC_SEG + 2048 <= 9 * SC_TB && SC_TBB + 2048 <= 2 * SC_TB, "scan LDS map");

__device__ __forceinline__ void tile_mma2(f32x16 (&acc)[2], const LAS unsigned char* TA, const LAS unsigned char* TBp, int mt, int r32, int hi) {
#pragma unroll
    for (int ks = 0; ks < 4; ++ks) {
        const bf16x8 a = *(const LAS bf16x8*)(TA + ((32 * mt + r32) * SC_TS + 16 * ks + 8 * hi) * 2);
        const bf16x8 b0 = *(const LAS bf16x8*)(TBp + ((r32) * SC_TS + 16 * ks + 8 * hi) * 2);
        const bf16x8 b1 = *(const LAS bf16x8*)(TBp + ((32 + r32) * SC_TS + 16 * ks + 8 * hi) * 2);
        acc[0] = MMA32(a, b0, acc[0]); acc[1] = MMA32(a, b1, acc[1]);
    }
}
#define P4REP(k) for (int rep_ = 0; rep_ < ((PROBE_PHASE == (k)) ? 2 : 1); ++rep_)
__device__ __forceinline__ void p4a_chunks(Frame& F) {
    LAS unsigned char* L = F.lds + RING_OFF;
    const bf16* Rb = (const bf16*)(F.ws + WS_RKV); const bf16* Kb = Rb + (size_t)M * D; const bf16* Vb = Kb + (size_t)M * D;
    const float* LW = (const float*)(F.ws + WS_LOGW); const bf16* AS = (const bf16*)(F.ws + WS_ASIG);
    bf16* QE = (bf16*)(F.ws + WS_QE); bf16* MCT = (bf16*)(F.ws + WS_MCT); bf16* NC = (bf16*)(F.ws + WS_NC); float* Y0 = (float*)(F.ws + WS_Y0); float* RK = (float*)(F.ws + WS_RK);
    const float* k_k = F.in[16]; const float* k_a = F.in[17]; const float* r_k = F.in[18];
    const int tid = F.tid, lane = F.lane, w = F.wave, r32 = lane & 31, hi = lane >> 5;
    const int t = tid >> 3, d8 = (tid & 7) * 8;
    LAS float* Lbuf = (LAS float*)(L + SC_LBUF); LAS float* Seg = (LAS float*)(L + SC_SEG); LAS float* RHS = (LAS float*)(L + SC_RHS); LAS float* Gend = (LAS float*)(L + SC_GEND);
    LAS float* AD = (LAS float*)(L + SC_AD);
    v4u nr8, nk8, nv8, na8; f32x4 nlw0, nlw1;
#define P4A_LOAD(CU) do { const int bh_ = (CU) >> 6, c_ = (CU) & 63; const size_t ro_ = ((size_t)(bh_ >> 4) * T + c_ * 64 + t) * D + (bh_ & 15) * 64 + d8; \
        nr8 = *(const v4u*)(Rb + ro_); nk8 = *(const v4u*)(Kb + ro_); nv8 = *(const v4u*)(Vb + ro_); na8 = *(const v4u*)(AS + ro_); nlw0 = *(const f32x4*)(LW + ro_); nlw1 = *(const f32x4*)(LW + ro_ + 4); } while (0)
    if ((int)blockIdx.x < BATCH * 16 * 64) P4A_LOAD(blockIdx.x);
    for (int cu = blockIdx.x; cu < BATCH * 16 * 64; cu += F.G) {
        const int bh = cu >> 6, c = cu & 63, b = bh >> 4, h = bh & 15; (void)b; (void)c;
        const v4u r8 = nr8, k8 = nk8, v8 = nv8, a8 = na8; const f32x4 lw0 = nlw0, lw1 = nlw1;
        P4REP(401) {
        *(LAS f32x4*)(Lbuf + t * 64 + d8) = lw0; *(LAS f32x4*)(Lbuf + t * 64 + d8 + 4) = lw1;
        __syncthreads();
        { const int d = tid & 63, seg = tid >> 6; float run = 0.f;
#pragma unroll
          for (int i = 0; i < 8; ++i) { run += Lbuf[(seg * 8 + i) * 64 + d]; Lbuf[(seg * 8 + i) * 64 + d] = run; }
          Seg[seg * 64 + d] = run; }
        __syncthreads();
        {
            float Lt[8], Le[8];
            { const f32x4 p0 = *(const LAS f32x4*)(Lbuf + t * 64 + d8), p1 = *(const LAS f32x4*)(Lbuf + t * 64 + d8 + 4);
              Lt[0] = p0.x; Lt[1] = p0.y; Lt[2] = p0.z; Lt[3] = p0.w; Lt[4] = p1.x; Lt[5] = p1.y; Lt[6] = p1.z; Lt[7] = p1.w; }
#pragma unroll
            for (int e = 0; e < 8; ++e) Le[e] = 0.f;
            const int myseg = t >> 3;
#pragma unroll
            for (int s = 0; s < 8; ++s) { const f32x4 q0 = *(const LAS f32x4*)(Seg + s * 64 + d8), q1 = *(const LAS f32x4*)(Seg + s * 64 + d8 + 4);
                const float sv[8] = {q0.x, q0.y, q0.z, q0.w, q1.x, q1.y, q1.z, q1.w};
#pragma unroll
                for (int e = 0; e < 8; ++e) { Le[e] += sv[e]; Lt[e] += (s < myseg) ? sv[e] : 0.f; } }
            const float lwv[8] = {lw0.x, lw0.y, lw0.z, lw0.w, lw1.x, lw1.y, lw1.z, lw1.w};
            const unsigned rw[4] = {r8.x, r8.y, r8.z, r8.w}, kw[4] = {k8.x, k8.y, k8.z, k8.w}, vw[4] = {v8.x, v8.y, v8.z, v8.w}, aw[4] = {a8.x, a8.y, a8.z, a8.w};
            float rr[8], kk[8], vv[8], aa[8];
#pragma unroll
            for (int e = 0; e < 4; ++e) { rr[2 * e] = bflo(rw[e]); rr[2 * e + 1] = bfhi(rw[e]); kk[2 * e] = bflo(kw[e]); kk[2 * e + 1] = bfhi(kw[e]);
                vv[2 * e] = bflo(vw[e]); vv[2 * e + 1] = bfhi(vw[e]); aa[2 * e] = bflo(aw[e]); aa[2 * e + 1] = bfhi(aw[e]); }
            const f32x4 kk0 = *(const f32x4*)(k_k + h * 64 + d8), kk1 = *(const f32x4*)(k_k + h * 64 + d8 + 4), ka0 = *(const f32x4*)(k_a + h * 64 + d8), ka1 = *(const f32x4*)(k_a + h * 64 + d8 + 4);
            const f32x4 rk0 = *(const f32x4*)(r_k + h * 64 + d8), rk1 = *(const f32x4*)(r_k + h * 64 + d8 + 4);
            const float kkv[8] = {kk0.x, kk0.y, kk0.z, kk0.w, kk1.x, kk1.y, kk1.z, kk1.w}, kav[8] = {ka0.x, ka0.y, ka0.z, ka0.w, ka1.x, ka1.y, ka1.z, ka1.w}, rkv[8] = {rk0.x, rk0.y, rk0.z, rk0.w, rk1.x, rk1.y, rk1.z, rk1.w};
            float kr[8], ss = 0.f, rs = 0.f, km[8];
#pragma unroll
            for (int e = 0; e < 8; ++e) { kr[e] = kk[e] * kkv[e]; ss += kr[e] * kr[e]; km[e] = kk[e] * (1.0f + (aa[e] - 1.0f) * kav[e]); rs += rr[e] * km[e] * rkv[e]; }
            ss += __shfl_xor(ss, 1); ss += __shfl_xor(ss, 2); ss += __shfl_xor(ss, 4);
            rs += __shfl_xor(rs, 1); rs += __shfl_xor(rs, 2); rs += __shfl_xor(rs, 4);
            const float inv = 1.0f / fmaxf(sqrtf(ss), 1e-12f);
            if ((tid & 7) == 0) RK[(size_t)cu * 64 + t] = rs;
            float At[8], Bt[8], Kt[8], Rt[8], Bh[8], Kh[8];
#pragma unroll
            for (int e = 0; e < 8; ++e) { const float kn = kr[e] * inv, av = -kn, bv = kn * aa[e];
                const float g = __expf(Lt[e]), gi = __expf(-Lt[e]), gp = __expf(Lt[e] - lwv[e]), ge = __expf(Le[e] - Lt[e]);
                At[e] = av * gp; Bt[e] = bv * gi; Kt[e] = km[e] * gi; Rt[e] = rr[e] * g; Bh[e] = bv * ge; Kh[e] = km[e] * ge;
                if (t == 63) Gend[d8 + e] = g; }
            const int ob = (t * SC_TS + d8) * 2;
            { v4u o; o.x = cvtpk(At[0], At[1]); o.y = cvtpk(At[2], At[3]); o.z = cvtpk(At[4], At[5]); o.w = cvtpk(At[6], At[7]); *(LAS v4u*)(L + SL_A * SC_TB + ob) = o; }
            { v4u o; o.x = cvtpk(Bt[0], Bt[1]); o.y = cvtpk(Bt[2], Bt[3]); o.z = cvtpk(Bt[4], Bt[5]); o.w = cvtpk(Bt[6], Bt[7]); *(LAS v4u*)(L + SL_B * SC_TB + ob) = o; }
            { v4u o; o.x = cvtpk(Kt[0], Kt[1]); o.y = cvtpk(Kt[2], Kt[3]); o.z = cvtpk(Kt[4], Kt[5]); o.w = cvtpk(Kt[6], Kt[7]); *(LAS v4u*)(L + SL_K * SC_TB + ob) = o; }
            { v4u o; o.x = cvtpk(Rt[0], Rt[1]); o.y = cvtpk(Rt[2], Rt[3]); o.z = cvtpk(Rt[4], Rt[5]); o.w = cvtpk(Rt[6], Rt[7]); *(LAS v4u*)(L + SL_R * SC_TB + ob) = o; }
            *(LAS f32x4*)(RHS + t * 128 + d8) = (f32x4){At[0], At[1], At[2], At[3]}; *(LAS f32x4*)(RHS + t * 128 + d8 + 4) = (f32x4){At[4], At[5], At[6], At[7]};
            LAS unsigned short* bhT = (LAS unsigned short*)(L + SL_BH * SC_TB); LAS unsigned short* khT = (LAS unsigned short*)(L + SL_KH * SC_TB); LAS unsigned short* vT = (LAS unsigned short*)(L + SL_VT * SC_TB);
#pragma unroll
            for (int e = 0; e < 8; ++e) { bhT[(d8 + e) * SC_TS + t] = (unsigned short)(cvtpk(Bh[e], 0.f) & 0xffffu); khT[(d8 + e) * SC_TS + t] = (unsigned short)(cvtpk(Kh[e], 0.f) & 0xffffu); }
#pragma unroll
            for (int e = 0; e < 4; ++e) { vT[(d8 + 2 * e) * SC_TS + t] = (unsigned short)(vw[e] & 0xffffu); vT[(d8 + 2 * e + 1) * SC_TS + t] = (unsigned short)(vw[e] >> 16); }
        }
        if (rep_ == 0 && PROBE_PHASE == 401) __syncthreads();
        }
        if (cu + F.G < BATCH * 16 * 64) P4A_LOAD(cu + F.G);
        __syncthreads();
        const int p = w >> 1, mt = w & 1;
        f32x16 acc[2];
        P4REP(402) {
        if (rep_ == 1) __syncthreads();
#pragma unroll
        for (int i = 0; i < 16; ++i) { acc[0][i] = 0.f; acc[1][i] = 0.f; }
        tile_mma2(acc, L + ((p & 1) ? SL_K : SL_B) * SC_TB, L + ((p & 2) ? SL_R : SL_A) * SC_TB, mt, r32, hi);
        __syncthreads();
#pragma unroll
        for (int nt = 0; nt < 2; ++nt) { const int s = 32 * nt + r32;
#pragma unroll
            for (int rg = 0; rg < 4; ++rg) { const int j0 = 32 * mt + 8 * rg + 4 * hi; float v[4];
#pragma unroll
                for (int e = 0; e < 4; ++e) { const bool keep = (p < 2) ? (j0 + e < s) : (j0 + e <= s); v[e] = keep ? acc[nt][4 * rg + e] : 0.f; }
                if (p == 0 && (s >> 4) == (j0 >> 4)) *(LAS f32x4*)(AD + ((s >> 4) * 16 + (s & 15)) * SC_ADS + (j0 & 15)) = (f32x4){v[0], v[1], v[2], v[3]};
                { v2u o; o.x = cvtpk(v[0], v[1]); o.y = cvtpk(v[2], v[3]); *(LAS v2u*)(L + ((p == 0) ? SL_A : (p == 1) ? SL_K : (p == 2) ? SL_ARB : SL_ARK) * SC_TB + (s * SC_TS + j0) * 2) = o; } } }
        }
        __syncthreads();
        P4REP(403) {
#pragma unroll
        for (int i = 0; i < 16; ++i) { acc[0][i] = 0.f; acc[1][i] = 0.f; }
        if (w < 2) {
            tile_mma2(acc, L + SL_K * SC_TB, L + SL_VT * SC_TB, w & 1, r32, hi);
#pragma unroll
            for (int nt = 0; nt < 2; ++nt)
#pragma unroll
                for (int reg = 0; reg < 16; ++reg) RHS[(32 * (w & 1) + (reg & 3) + 8 * (reg >> 2) + 4 * hi) * 128 + 64 + 32 * nt + r32] = acc[nt][reg];
        } else if (w == 2) {
            const int bb = lane >> 4, cc = lane & 15; const LAS float* ad = AD + bb * 16 * SC_ADS; float tt[16];
#pragma unroll
            for (int s = 0; s < 16; ++s) tt[s] = 0.f;
#pragma unroll
            for (int s = 0; s < 16; ++s) { float a = (s == cc) ? 1.0f : 0.0f;
#pragma unroll
                for (int j4 = 0; j4 < (s + 3) / 4; ++j4) { const f32x4 q = *(const LAS f32x4*)(ad + s * SC_ADS + 4 * j4);
                    a += q.x * tt[4 * j4]; a += q.y * tt[4 * j4 + 1]; a += q.z * tt[4 * j4 + 2]; a += q.w * tt[4 * j4 + 3]; }
                tt[s] = a; }
            LAS unsigned short* tb = (LAS unsigned short*)(L + SC_TBB) + bb * 256 + cc;
#pragma unroll
            for (int s = 0; s < 16; ++s) tb[s * 16] = (unsigned short)(cvtpk(tt[s], 0.f) & 0xffffu);
        } else if (w == 3) {
            LAS v4u* z = (LAS v4u*)(L + SC_XT0) + lane;
#pragma unroll
            for (int q = 0; q < 18; ++q) z[q * 64] = (v4u){0u, 0u, 0u, 0u};
        } else if (w < 6) tile_mma2(acc, L + SL_VT * SC_TB, L + SL_ARK * SC_TB, w & 1, r32, hi);
        else tile_mma2(acc, L + SL_KH * SC_TB, L + SL_VT * SC_TB, w & 1, r32, hi);
        }
        __syncthreads();
        P4REP(404)
        {   const int cl = lane & 15, g = lane >> 4; LAS unsigned char* xt = L + SC_XT0 + (w >> 2) * SC_TB + ((16 * (w & 3) + cl) * SC_TS) * 2;
#pragma unroll
            for (int bb = 0; bb < 4; ++bb) {
                f32x4 rp;
#pragma unroll
                for (int reg = 0; reg < 4; ++reg) rp[reg] = RHS[(16 * bb + 4 * g + reg) * 128 + 16 * w + cl];
#pragma unroll
                for (int ks = 0; ks < 2; ++ks) { const bf16x8 af = *(const LAS bf16x8*)(L + SL_A * SC_TB + ((16 * bb + cl) * SC_TS + 32 * ks + 8 * g) * 2);
                    const bf16x8 bf = *(const LAS bf16x8*)(xt + (32 * ks + 8 * g) * 2);
                    rp = __builtin_amdgcn_mfma_f32_16x16x32_bf16(af, bf, rp, 0, 0, 0); }
                const v2u tq = *(const LAS v2u*)(L + SC_TBB + ((bb * 16 + cl) * 16 + 4 * g) * 2);
                const v4u a2 = {tq.x, tq.y, 0u, 0u}, b2 = {cvtpk(rp[0], rp[1]), cvtpk(rp[2], rp[3]), 0u, 0u};
                const f32x4 xb = __builtin_amdgcn_mfma_f32_16x16x32_bf16(__builtin_bit_cast(bf16x8, a2), __builtin_bit_cast(bf16x8, b2), (f32x4){0.f, 0.f, 0.f, 0.f}, 0, 0, 0);
                v2u o; o.x = cvtpk(xb[0], xb[1]); o.y = cvtpk(xb[2], xb[3]); *(LAS v2u*)(xt + (16 * bb + 4 * g) * 2) = o;
                asm volatile("s_waitcnt lgkmcnt(0)" ::: "memory");
            } }
        __syncthreads();
        const LAS unsigned char* WMT = L + SC_XT0; const LAS unsigned char* U0T = L + SC_XT1;
        P4REP(405) {
        if (w < 4) {
#pragma unroll
            for (int i = 0; i < 16; ++i) { acc[0][i] = 0.f; acc[1][i] = 0.f; } }
        if (w < 2) {
            tile_mma2(acc, WMT, L + SL_ARB * SC_TB, w & 1, r32, hi);
            bf16* qo = QE + (size_t)cu * 4096;
#pragma unroll
            for (int nt = 0; nt < 2; ++nt) { const int tt = 32 * nt + r32;
#pragma unroll
                for (int rg = 0; rg < 4; ++rg) { const int d0 = 32 * (w & 1) + 8 * rg + 4 * hi; const v2u rt = *(const LAS v2u*)(L + SL_R * SC_TB + (tt * SC_TS + d0) * 2);
                    v2u o; o.x = cvtpk(acc[nt][4 * rg] + bflo(rt.x), acc[nt][4 * rg + 1] + bfhi(rt.x)); o.y = cvtpk(acc[nt][4 * rg + 2] + bflo(rt.y), acc[nt][4 * rg + 3] + bfhi(rt.y));
                    *(v2u*)(qo + tt * 64 + d0) = o; } }
        } else if (w < 4) {
            tile_mma2(acc, WMT, L + SL_BH * SC_TB, w & 1, r32, hi);
            bf16* mo = MCT + (size_t)cu * 4096;
#pragma unroll
            for (int nt = 0; nt < 2; ++nt) { const int dp = 32 * nt + r32; const float gc = Gend[dp];
#pragma unroll
                for (int rg = 0; rg < 4; ++rg) { const int d0 = 32 * (w & 1) + 8 * rg + 4 * hi; float v[4];
#pragma unroll
                    for (int e = 0; e < 4; ++e) v[e] = acc[nt][4 * rg + e] + ((d0 + e == dp) ? gc : 0.f);
                    v2u o; o.x = cvtpk(v[0], v[1]); o.y = cvtpk(v[2], v[3]); *(v2u*)(mo + dp * 64 + d0) = o; } }
        } else if (w < 6) {
            tile_mma2(acc, U0T, L + SL_ARB * SC_TB, w & 1, r32, hi);
            float* yo = Y0 + (size_t)cu * 4096;
#pragma unroll
            for (int nt = 0; nt < 2; ++nt) { const int tt = 32 * nt + r32;
#pragma unroll
                for (int rg = 0; rg < 4; ++rg) { const int i0 = 32 * (w & 1) + 8 * rg + 4 * hi; *(f32x4*)(yo + tt * 64 + i0) = (f32x4){acc[nt][4 * rg], acc[nt][4 * rg + 1], acc[nt][4 * rg + 2], acc[nt][4 * rg + 3]}; } }
        } else {
            tile_mma2(acc, L + SL_BH * SC_TB, U0T, w & 1, r32, hi);
            bf16* no = NC + (size_t)cu * 4096;
#pragma unroll
            for (int nt = 0; nt < 2; ++nt) { const int ii = 32 * nt + r32;
#pragma unroll
                for (int rg = 0; rg < 4; ++rg) { const int d0 = 32 * (w & 1) + 8 * rg + 4 * hi; v2u o; o.x = cvtpk(acc[nt][4 * rg], acc[nt][4 * rg + 1]); o.y = cvtpk(acc[nt][4 * rg + 2], acc[nt][4 * rg + 3]);
                    *(v2u*)(no + ii * 64 + d0) = o; } }
        }
        }
        __syncthreads();
    }
}
struct P4bOps { v2u af[4][2][2]; v2u nf[4]; };
__device__ __forceinline__ void p4b_load(P4bOps& o, const bf16* MCT, const bf16* NC, size_t cu, int ig, int il, int g) {
    const bf16* mc = MCT + cu * 4096; const bf16* nc = NC + cu * 4096;
#pragma unroll
    for (int m = 0; m < 4; ++m) { o.nf[m] = *(const v2u*)(nc + ig * 64 + 16 * m + 4 * g);
#pragma unroll
        for (int ks = 0; ks < 2; ++ks) { o.af[m][ks][0] = *(const v2u*)(mc + (16 * m + il) * 64 + 32 * ks + 4 * g); o.af[m][ks][1] = *(const v2u*)(mc + (16 * m + il) * 64 + 32 * ks + 16 + 4 * g); } }
}
__device__ __forceinline__ void p4b_step(f32x4 (&acc)[4], const P4bOps& o, bf16* SCB, size_t cu, int ig, int g) {
    unsigned pk[4][2];
#pragma unroll
    for (int m = 0; m < 4; ++m) { pk[m][0] = cvtpk(acc[m][0], acc[m][1]); pk[m][1] = cvtpk(acc[m][2], acc[m][3]);
        v2u ov; ov.x = pk[m][0]; ov.y = pk[m][1]; *(v2u*)(SCB + cu * 4096 + ig * 64 + 16 * m + 4 * g) = ov; }
    const v4u b0 = {pk[0][0], pk[0][1], pk[1][0], pk[1][1]}, b1 = {pk[2][0], pk[2][1], pk[3][0], pk[3][1]};
#pragma unroll
    for (int m = 0; m < 4; ++m) {
        f32x4 ci = {bflo(o.nf[m].x), bfhi(o.nf[m].x), bflo(o.nf[m].y), bfhi(o.nf[m].y)};
        const v4u a0 = {o.af[m][0][0].x, o.af[m][0][0].y, o.af[m][0][1].x, o.af[m][0][1].y}, a1 = {o.af[m][1][0].x, o.af[m][1][0].y, o.af[m][1][1].x, o.af[m][1][1].y};
        ci = __builtin_amdgcn_mfma_f32_16x16x32_bf16(__builtin_bit_cast(bf16x8, a0), __builtin_bit_cast(bf16x8, b0), ci, 0, 0, 0);
        acc[m] = __builtin_amdgcn_mfma_f32_16x16x32_bf16(__builtin_bit_cast(bf16x8, a1), __builtin_bit_cast(bf16x8, b1), ci, 0, 0, 0);
    }
}
__device__ __forceinline__ void p4b_state(Frame& F) {
    if (F.wave != 0) return;
    const bf16* MCT = (const bf16*)(F.ws + WS_MCT); const bf16* NC = (const bf16*)(F.ws + WS_NC); bf16* SCB = (bf16*)(F.ws + WS_SC);
    const int lane = F.lane, il = lane & 15, g = lane >> 4;
    for (int unit = blockIdx.x; unit < BATCH * 16 * 4; unit += F.G) {
        const int bh = unit >> 2, ig = (unit & 3) * 16 + il; const size_t cu0 = (size_t)bh * 64;
        f32x4 acc[4];
#pragma unroll
        for (int m = 0; m < 4; ++m) acc[m] = (f32x4){0.f, 0.f, 0.f, 0.f};
        P4bOps o0, o1, o2, o3;
        p4b_load(o0, MCT, NC, cu0 + 0, ig, il, g); p4b_load(o1, MCT, NC, cu0 + 1, ig, il, g); p4b_load(o2, MCT, NC, cu0 + 2, ig, il, g); p4b_load(o3, MCT, NC, cu0 + 3, ig, il, g);
        for (int c = 0; c < 64; c += 4) {
            const size_t cu = cu0 + c; const size_t nx = (c + 4 < 64) ? cu + 4 : cu;
            p4b_step(acc, o0, SCB, cu + 0, ig, g); p4b_load(o0, MCT, NC, nx + 0, ig, il, g);
            p4b_step(acc, o1, SCB, cu + 1, ig, g); p4b_load(o1, MCT, NC, nx + 1, ig, il, g);
            p4b_step(acc, o2, SCB, cu + 2, ig, g); p4b_load(o2, MCT, NC, nx + 2, ig, il, g);
            p4b_step(acc, o3, SCB, cu + 3, ig, g); p4b_load(o3, MCT, NC, nx + 3, ig, il, g);
        }
    }
}
__device__ __forceinline__ void p4c_out(Frame& F) {
    LAS float* stage = (LAS float*)(F.lds + RING_OFF);
    const bf16* QE = (const bf16*)(F.ws + WS_QE); const bf16* SCB = (const bf16*)(F.ws + WS_SC); const float* Y0 = (const float*)(F.ws + WS_Y0); const float* RK = (const float*)(F.ws + WS_RK);
    const bf16* Vb = (const bf16*)(F.ws + WS_RKV) + (size_t)2 * M * D; const bf16* GG = (const bf16*)(F.ws + WS_GG); bf16* YG = (bf16*)(F.ws + WS_YG);
    const float* gn_g = F.in[19]; const float* gn_b = F.in[20];
    const int lane = F.lane, w = F.wave, r32 = lane & 31, hi = lane >> 5, us = w >> 1, nt = w & 1;
    for (int grp = blockIdx.x; grp < BATCH * 16 * 64 / 4; grp += F.G) {
        const int cu = grp * 4 + us, bh = cu >> 6, c = cu & 63, b = bh >> 4, h = bh & 15;
        const bf16* sc = SCB + (size_t)cu * 4096; const bf16* qe = QE + (size_t)cu * 4096; const float* y0 = Y0 + (size_t)cu * 4096;
        const int tt = 32 * nt + r32;
        f32x16 acc[2];
#pragma unroll
        for (int mt = 0; mt < 2; ++mt)
#pragma unroll
            for (int rg = 0; rg < 4; ++rg) { const f32x4 q = *(const f32x4*)(y0 + tt * 64 + 32 * mt + 8 * rg + 4 * hi); acc[mt][4 * rg] = q.x; acc[mt][4 * rg + 1] = q.y; acc[mt][4 * rg + 2] = q.z; acc[mt][4 * rg + 3] = q.w; }
#pragma unroll
        for (int ks = 0; ks < 4; ++ks) { const bf16x8 bq = *(const bf16x8*)(qe + tt * 64 + 16 * ks + 8 * hi);
            const bf16x8 a0 = *(const bf16x8*)(sc + r32 * 64 + 16 * ks + 8 * hi), a1 = *(const bf16x8*)(sc + (32 + r32) * 64 + 16 * ks + 8 * hi);
            acc[0] = MMA32(a0, bq, acc[0]); acc[1] = MMA32(a1, bq, acc[1]); }
        float sm = 0.f;
#pragma unroll
        for (int i = 0; i < 16; ++i) sm += acc[0][i] + acc[1][i];
        sm += __shfl_xor(sm, 32); const float mean = sm * (1.f / 64.f);
        float vs = 0.f;
#pragma unroll
        for (int i = 0; i < 16; ++i) { const float d0 = acc[0][i] - mean, d1 = acc[1][i] - mean; vs += d0 * d0 + d1 * d1; }
        vs += __shfl_xor(vs, 32); const float rstd = 1.0f / sqrtf(vs * (1.f / 64.f) + GN_EPS);
        LAS float* st = stage + us * (64 * 68);
#pragma unroll
        for (int mt = 0; mt < 2; ++mt)
#pragma unroll
            for (int rg = 0; rg < 4; ++rg) *(LAS f32x4*)(st + tt * 68 + 32 * mt + 8 * rg + 4 * hi) = (f32x4){(acc[mt][4 * rg] - mean) * rstd, (acc[mt][4 * rg + 1] - mean) * rstd, (acc[mt][4 * rg + 2] - mean) * rstd, (acc[mt][4 * rg + 3] - mean) * rstd};
        __syncthreads();
        {   const int i8 = (lane & 7) * 8; const int cg = h * 64 + i8;
            const f32x4 g0 = *(const f32x4*)(gn_g + cg), g1 = *(const f32x4*)(gn_g + cg + 4), b0 = *(const f32x4*)(gn_b + cg), b1 = *(const f32x4*)(gn_b + cg + 4);
#pragma unroll
            for (int it = 0; it < 4; ++it) { const int t2 = 32 * nt + it * 8 + (lane >> 3); const size_t ro = ((size_t)b * T + c * 64 + t2) * D + cg;
                const f32x4 y0v = *(const LAS f32x4*)(st + t2 * 68 + i8), y1v = *(const LAS f32x4*)(st + t2 * 68 + i8 + 4);
                const v4u vv = *(const v4u*)(Vb + ro), gg = *(const v4u*)(GG + ro); const float rk = RK[(size_t)cu * 64 + t2];
                float o[8];
                o[0] = (y0v.x * g0.x + b0.x + rk * bflo(vv.x)) * bflo(gg.x); o[1] = (y0v.y * g0.y + b0.y + rk * bfhi(vv.x)) * bfhi(gg.x);
                o[2] = (y0v.z * g0.z + b0.z + rk * bflo(vv.y)) * bflo(gg.y); o[3] = (y0v.w * g0.w + b0.w + rk * bfhi(vv.y)) * bfhi(gg.y);
                o[4] = (y1v.x * g1.x + b1.x + rk * bflo(vv.z)) * bflo(gg.z); o[5] = (y1v.y * g1.y + b1.y + rk * bfhi(vv.z)) * bfhi(gg.z);
                o[6] = (y1v.z * g1.z + b1.z + rk * bflo(vv.w)) * bflo(gg.w); o[7] = (y1v.w * g1.w + b1.w + rk * bfhi(vv.w)) * bfhi(gg.w);
                v4u ov; ov.x = cvtpk(o[0], o[1]); ov.y = cvtpk(o[2], o[3]); ov.z = cvtpk(o[4], o[5]); ov.w = cvtpk(o[6], o[7]); *(v4u*)(YG + ro) = ov; }
        }
        __syncthreads();
    }
}

constexpr int NPHASE = 22;
#ifndef PROBE_PHASE
#define PROBE_PHASE (-1)
#endif
#define PROBE(k, ...) do { __VA_ARGS__; if (PROBE_PHASE == (k)) { xcd_barrier(bar); __VA_ARGS__; } } while (0)
#define IN(k) (lo <= (k) && (k) < hi)
#define SEAM(k) do { if (IN(k) && (k) + 1 < hi) xcd_barrier(bar); } while (0)
template <int L> __device__ __forceinline__ void moe_phases(Frame& F, const int lo, const int hi, const XcdBarrier& bar) {
    constexpr int pb = 11 * L;
    LAS unsigned char* ring = F.lds + RING_OFF;
    const LAS int* toff = (const LAS int*)(F.lds + LDSCTL_OFF);
        if (IN(pb + 6)) { F.lane = lane_id(); F.tid = F.wave * 64 + F.lane; if (PROBE_PHASE == 100 + pb) { moe_router(F, L, (const float*)(F.ws + WS_XA), 32); xcd_barrier(bar); F.lane = lane_id(); F.tid = F.wave * 64 + F.lane; }
            moe_router(F, L, (const float*)(F.ws + WS_XA), 0); PROBE(pb + 6, F.lane = lane_id(); F.tid = F.wave * 64 + F.lane; moe_weights(F, L); ); } SEAM(pb + 6);
        if (IN(pb + 8)) { PROBE(pb + 8, F.lane = lane_id(); F.tid = F.wave * 64 + F.lane;
            moe_toff(F, L);
            pg8::MoeOrder S; S.init(F.ws + WS_H2N, F.ws + WS_MOEGU, (size_t)1024 * 1024 * 2, toff, toff + 40, (const int*)(F.ws + WS_ROWTOK), 4, D, F.G, (int)blockIdx.x);
            pg8::EpiGU E{(bf16*)(F.ws + WS_HS)};
            pg8::gemm_phase_gather<pg8::EpiGU, pg8::MoeOrder>(ring, D, S, E, F.tid, F.wave);
        ); } SEAM(pb + 8);
        if (IN(pb + 9)) { PROBE(pb + 9, F.lane = lane_id(); F.tid = F.wave * 64 + F.lane;
            moe_toff(F, L);
            pg8::MoeOrder S; S.init(F.ws + WS_HS, F.ws + WS_MOED, (size_t)1024 * 512 * 2, toff, toff + 40, nullptr, 4, FF, F.G, (int)blockIdx.x);
            pg8::EpiDown E{(bf16*)(F.ws + WS_Y), (const float*)(F.ws + WS_ROWGATE), toff};
            pg8::gemm_phase<pg8::EpiDown, pg8::MoeOrder, true, true>(ring, FF, S, E, F.tid, F.wave);
        ); } SEAM(pb + 9);
        if (IN(pb + 10)) { PROBE(pb + 10, F.lane = lane_id(); F.tid = F.wave * 64 + F.lane;
            moe_combine<L>(F, L, (const float*)(F.ws + WS_XA), F.out);
        ); } SEAM(pb + 10);
}
#undef IN
#undef SEAM
struct Args { const float* in[39]; float* out; unsigned char* ws; int ph_lo, ph_hi; };
__global__ void __launch_bounds__(NWAVES * 64, 2) trunk_fwd(Args args) {
    extern __shared__ __attribute__((aligned(16))) unsigned char lds[];
    Frame F;
    F.lds = (LAS unsigned char*)lds;
    F.MISC = (volatile LAS unsigned*)(F.lds + MISC_OFF);
    F.wave = __builtin_amdgcn_readfirstlane(threadIdx.x >> 6); F.lane = lane_id(); F.tid = F.wave * 64 + F.lane;
    F.G = gridDim.x; { const int bx = blockIdx.x; F.vcu = (F.G % 8 == 0) ? (bx % 8) * (F.G / 8) + bx / 8 : bx; }
    F.ws = args.ws; F.ctl = (gu32*)(args.ws + WS_CTL); F.in = args.in; F.out = args.out;
    for (int u = F.tid; u < (LDS_BYTES - LDSCTL_OFF) / 4; u += NWAVES * 64) ((LAS unsigned*)(F.lds + LDSCTL_OFF))[u] = 0u;
    __syncthreads();
    const int lo = args.ph_lo, hi = args.ph_hi;
    const bool multi = (hi - lo) > 1;
    XcdBarrier bar; bar.bar = (unsigned*)(F.ctl + CW_BAR); bar.x = 0; bar.st = nullptr; bar.wave = F.wave;
    if (multi) bar = xcd_barrier_post((unsigned*)(F.ctl + CW_BAR), F.MISC + 8);
#define IN(k) (lo <= (k) && (k) < hi)
#define SEAM(k) do { if (IN(k) && (k) + 1 < hi) xcd_barrier(bar); } while (0)
    LAS unsigned char* ring = F.lds + RING_OFF;
    const LAS int* toff = (const LAS int*)(F.lds + LDSCTL_OFF);

    {
        {
            if (IN(0)) { PROBE(0, F.lane = lane_id(); F.tid = F.wave * 64 + F.lane; p0_mod(F); p0_weights(F); ); } SEAM(0);
            if (IN(1)) { PROBE(1, F.lane = lane_id(); F.tid = F.wave * 64 + F.lane; p1_norm_views(F); ); } SEAM(1);
            if (IN(2)) { PROBE(2, F.lane = lane_id(); F.tid = F.wave * 64 + F.lane;
                { pg8::BatchOrder S; S.init(F.ws + WS_VIEWS, F.ws + WS_WRKV, (size_t)M * D * 2, (size_t)D * D * 2, M, D, 3, D, F.G, (int)blockIdx.x);
                  pg8::EpiZBf16 E{(bf16*)(F.ws + WS_RKV), (size_t)M * D, 1.0f};
                  pg8::gemm_phase<pg8::EpiZBf16, pg8::BatchOrder, true, true>(ring, D, S, E, F.tid, F.wave); }
                { pg8::BatchOrder S; S.init(F.ws + WS_H2, F.ws + WS_WL1, 0, 0, M, 256, 1, 2048, F.G, (int)blockIdx.x);
                  pg8::EpiLora1 E{(bf16*)(F.ws + WS_A2)};
                  pg8::gemm_phase<pg8::EpiLora1, pg8::BatchOrder, true, true>(ring, 2048, S, E, F.tid, F.wave); }
            ); } SEAM(2);
            if (IN(3)) { PROBE(3, F.lane = lane_id(); F.tid = F.wave * 64 + F.lane;
                pg8::BatchOrder S; S.init(F.ws + WS_A2, F.ws + WS_WL2, 0, 0, M, 3072, 1, 256, F.G, (int)blockIdx.x);
                pg8::EpiLora2 E{(float*)(F.ws + WS_LOGW), (bf16*)(F.ws + WS_ASIG), (bf16*)(F.ws + WS_GG), F.in[8], F.in[11]};
                pg8::gemm_phase<pg8::EpiLora2, pg8::BatchOrder, true, true>(ring, 256, S, E, F.tid, F.wave);
            ); } SEAM(3);
#if defined(SCAN_SEQ)
            if (IN(4)) { PROBE(4, F.lane = lane_id(); F.tid = F.wave * 64 + F.lane; p4_scan_seq(F); ); } SEAM(4);
#else
            if (IN(4)) { PROBE(40, F.lane = lane_id(); F.tid = F.wave * 64 + F.lane; p4a_chunks(F); ); xcd_barrier(bar); PROBE(41, F.lane = lane_id(); F.tid = F.wave * 64 + F.lane; p4b_state(F); ); xcd_barrier(bar); PROBE(42, F.lane = lane_id(); F.tid = F.wave * 64 + F.lane; p4c_out(F); ); } SEAM(4);
#endif
            if (IN(5)) { PROBE(5, F.lane = lane_id(); F.tid = F.wave * 64 + F.lane;
                pg8::BatchOrder S; S.init(F.ws + WS_YG, F.ws + WS_WO0, 0, 0, M, D, 1, D, F.G, (int)blockIdx.x);
                pg8::EpiResid E{F.in[0], (float*)(F.ws + WS_XA), (const float*)(F.ws + WS_MOD) + 2048};
                pg8::gemm_phase<pg8::EpiResid, pg8::BatchOrder, true, true>(ring, D, S, E, F.tid, F.wave);
            ); } SEAM(5);
        }
        moe_phases<0>(F, lo, hi, bar);
        {
            if (IN(11)) { PROBE(11, F.lane = lane_id(); F.tid = F.wave * 64 + F.lane;
                { pg8::BatchOrder S; S.init(F.ws + WS_HQ, F.ws + WS_WQKV, (size_t)M * D * 2, (size_t)D * D * 2, M, D, 2, D, F.G, (int)blockIdx.x);
                  pg8::EpiZBf16 E{(bf16*)(F.ws + WS_QKV), (size_t)M * D, attn_body::C2};
                  pg8::gemm_phase<pg8::EpiZBf16, pg8::BatchOrder, true, true>(ring, D, S, E, F.tid, F.wave); }
                { pg8::BatchOrder S; S.init(F.ws + WS_HK, F.ws + WS_WQKV + (size_t)2 * D * D * 2, 0, 0, M, D, 1, D, F.G, (int)blockIdx.x);
                  pg8::EpiZBf16 E{(bf16*)(F.ws + WS_QKV) + (size_t)2 * M * D, 0, 1.0f};
                  pg8::gemm_phase<pg8::EpiZBf16, pg8::BatchOrder, true, true>(ring, D, S, E, F.tid, F.wave); }
            ); } SEAM(11);
            if (IN(12)) { PROBE(12, F.lane = lane_id(); F.tid = F.wave * 64 + F.lane;
                const attn_body::bf16* Q = (const attn_body::bf16*)(F.ws + WS_QKV); const attn_body::bf16* Kp = Q + (size_t)M * D; const attn_body::bf16* Vp = Kp + (size_t)M * D;
                attn_body::bf16* O = (attn_body::bf16*)(F.ws + WS_OC);
                int nrep = (PROBE_PHASE == 120) ? 2 : 1; asm volatile("" : "+s"(nrep));
                for (int rep = 0; rep < nrep; ++rep)
                for (int i = 0; ; ++i) { const int pr = (i >> 1) * F.G + F.vcu; if (pr >= BATCH * 8 * 8) break;
                    const int bh = pr >> 3, s = pr & 7, qb = (i & 1) ? s : 15 - s, b = bh >> 3, h = bh & 7;
                    _Pragma("unroll 1") for (int cv = 0; cv < 4; ++cv) { const int c = cv >> 1, vh = cv & 1;
                        attn_body::attn_unit<8>(b, qb, Q + (h * 2 + c) * 64, Kp + (h * 2 + c) * 64, Vp + h * 128 + vh * 64, O + (h * 2 + c) * 128 + vh * 64, (char*)lds + RING_OFF, F.tid, F.wave); }
                    attn_subln_rows(F, (size_t)b * T + qb * 256 + F.wave * 32, h);
                }
            ); } SEAM(12);
            if (IN(14)) { PROBE(14, F.lane = lane_id(); F.tid = F.wave * 64 + F.lane;
                pg8::BatchOrder S; S.init(F.ws + WS_ON, F.ws + WS_WO1, 0, 0, M, D, 1, D, F.G, (int)blockIdx.x);
                pg8::EpiResid E{F.out, (float*)(F.ws + WS_XA), (const float*)(F.ws + WS_MOD) + 4 * 6144 + 2048};
                pg8::gemm_phase<pg8::EpiResid, pg8::BatchOrder, true, true>(ring, D, S, E, F.tid, F.wave);
            ); } SEAM(14);
        }
        moe_phases<1>(F, lo, hi, bar);
    }
    if (multi && hi == NPHASE) { if (__hip_atomic_load((gu32*)((unsigned*)(F.ctl + CW_BAR) + XB_TMO), RLX_AGENT) != 0u) {
        const float q = __builtin_nanf(""); for (size_t i = (size_t)blockIdx.x * 512 + F.wave * 64 + lane_id(); i < (size_t)M * D; i += (size_t)F.G * 512) F.out[i] = q; } }
#undef IN
#undef SEAM
}

#ifndef N_LAUNCH_MODE
#define N_LAUNCH_MODE 1
#endif
extern "C" void kernel_launch(void* const* d_in, const int* in_sizes, int n_in, void* d_out, int out_size, void* d_ws, size_t ws_size, hipStream_t stream) {
    static int grid = 0;
    if (grid == 0) {
        if (n_in != 39 || in_sizes[0] != M * D || out_size != M * D || ws_size < WS_END) { fprintf(stderr, "kernel_launch: unexpected problem (n_in %d, in0 %d, out %d, ws %zu < %zu); nothing launched\n", n_in, n_in > 0 ? in_sizes[0] : -1, out_size, ws_size, (size_t)WS_END); grid = -1; return; }
        int dev = 0, cus = 0, per_cu = 0;
        if (hipGetDevice(&dev) != hipSuccess || hipDeviceGetAttribute(&cus, hipDeviceAttributeMultiprocessorCount, dev) != hipSuccess) { grid = -1; return; }
        if (hipFuncSetAttribute((const void*)trunk_fwd, hipFuncAttributeMaxDynamicSharedMemorySize, LDS_BYTES) != hipSuccess) { fprintf(stderr, "kernel_launch: hipFuncSetAttribute failed\n"); grid = -1; return; }
        if (hipOccupancyMaxActiveBlocksPerMultiprocessor(&per_cu, (const void*)trunk_fwd, NWAVES * 64, LDS_BYTES) != hipSuccess || per_cu < 1) fprintf(stderr, "kernel_launch: occupancy query reports %d\n", per_cu);
        (void)hipGetLastError();
        grid = cus;
    }
    if (grid < 0) return;
    if (hipMemsetAsync((char*)d_ws + WS_CTL, 0, CTL_ZERO_BYTES, stream) != hipSuccess) return;
    Args a{};
    for (int i = 0; i < 39; ++i) a.in[i] = (const float*)d_in[i];
    a.out = (float*)d_out; a.ws = (unsigned char*)d_ws;
    if (N_LAUNCH_MODE == 1) {
        a.ph_lo = 0; a.ph_hi = NPHASE;
        hipLaunchKernelGGL(trunk_fwd, dim3(grid), dim3(NWAVES * 64), LDS_BYTES, stream, a);
    } else {
        const int ids[17] = {0, 1, 2, 3, 4, 5, 6, 8, 9, 10, 11, 12, 14, 17, 19, 20, 21};
        for (int k = 0; k < 17; ++k) { a.ph_lo = ids[k]; a.ph_hi = ids[k] + 1; hipLaunchKernelGGL(trunk_fwd, dim3(grid), dim3(NWAVES * 64), LDS_BYTES, stream, a); }
    }
}
```

```cpp
#include <hip/hip_runtime.h>
#include <hip/hip_bf16.h>
#include <cstdio>
#include <cstdint>
#include <cmath>

namespace pg8 {
#define PG8_LAS __attribute__((address_space(3)))
typedef unsigned short bf16_t;
typedef short bf16x8 __attribute__((ext_vector_type(8)));
typedef float f32x4 __attribute__((ext_vector_type(4)));
typedef unsigned u32x4 __attribute__((ext_vector_type(4)));
typedef unsigned u32x2 __attribute__((ext_vector_type(2)));
constexpr int BM = 256, BK = 64, HALF = 128, HTB = HALF * BK * 2  , STAGE_BYTES = 8 * HTB, NXCD = 8, WGM = 8;

__host__ __device__ __forceinline__ int lds_byte(int r, int c) { const int st = (r >> 4) * 2 + (c >> 5), rr = r & 15, cc = c & 31, ob = rr * 64 + cc * 2; return st * 1024 + (ob ^ (((ob >> 9) & 1) << 5)); }
__host__ __device__ __forceinline__ void stage_rc(int b, int& R, int& C) { const int st = b / 1024, sb = b % 1024, swz = sb ^ (((sb >> 9) & 1) << 5); R = (st >> 1) * 16 + swz / 64; C = (st & 1) * 32 + (swz % 64) / 2; }
__host__ __device__ __forceinline__ int perm32(int rho) { const int n = rho >> 4, i = rho & 15; return 8 * (i >> 2) + 4 * n + (i & 3); }

struct Unit { int pm, pn, z; };

typedef float f32x2_cv __attribute__((ext_vector_type(2))); typedef __bf16 bf16x2_cv __attribute__((ext_vector_type(2)));
__device__ __forceinline__ unsigned cvt_pk_bf16(float lo, float hi) { const f32x2_cv v = {lo, hi}; const bf16x2_cv b = __builtin_convertvector(v, bf16x2_cv); return __builtin_bit_cast(unsigned, b); }

struct HandOff {
    unsigned* ready; unsigned* tmo; int role, wid; unsigned need;
    __device__ __forceinline__ void clear() { ready = nullptr; tmo = nullptr; role = 0; wid = 0; need = 0u; }
    __device__ __forceinline__ void set(int role_, unsigned* ready_, unsigned need_, unsigned* tmo_, int wid_) { role = role_; ready = ready_; need = need_; tmo = tmo_; wid = wid_; }
    __device__ __forceinline__ void a_ready(int pm) const {
        if (role != 2) return;
        if (wid == 0) {
            unsigned polls = 0;
            while ((unsigned)__builtin_amdgcn_readfirstlane(__hip_atomic_load(ready + 64 * pm, __ATOMIC_RELAXED, __HIP_MEMORY_SCOPE_AGENT)) < need) {
                if ((++polls & 255u) == 0u) { if (__builtin_amdgcn_readfirstlane(__hip_atomic_load(tmo, __ATOMIC_RELAXED, __HIP_MEMORY_SCOPE_AGENT)) != 0u) break;
                    if (polls > (1u << 19)) { __hip_atomic_store(tmo, 1u, __ATOMIC_RELAXED, __HIP_MEMORY_SCOPE_AGENT); break; } }
                __builtin_amdgcn_s_sleep(2); }
            __builtin_amdgcn_fence(__ATOMIC_ACQUIRE, "agent");
            asm volatile("s_waitcnt vmcnt(0)" ::: "memory");
        }
        asm volatile("" ::: "memory"); __builtin_amdgcn_s_barrier(); asm volatile("" ::: "memory");
    }
    __device__ __forceinline__ void done(int pm) const {
        if (role != 1) return;
        asm volatile("s_waitcnt vmcnt(0)" ::: "memory");
        if (__builtin_amdgcn_mbcnt_hi(~0u, __builtin_amdgcn_mbcnt_lo(~0u, 0u)) == 0u) __hip_atomic_fetch_add(ready + 64 * pm, 1u, __ATOMIC_RELAXED, __HIP_MEMORY_SCOPE_AGENT);
    }
};
__device__ __forceinline__ void store16_sc1(void* p, u32x4 v) { asm volatile("global_store_dwordx4 %0, %1, off sc1\n\ts_nop 1" :: "v"(p), "v"(v) : "memory"); }

struct BatchOrder {
    const char* A; const char* B; size_t sa, sb, tst; int nM, nN, nwg, tot, G, c; HandOff ho;
    __device__ __forceinline__ void init(const void* A_, const void* B_, size_t sa_, size_t sb_, int M, int N, int Z, int K, int G_, int c_) {
        A = (const char*)A_; B = (const char*)B_; sa = sa_; sb = sb_; tst = (size_t)BM * K * 2; nM = M / BM; nN = N / BM; nwg = nM * nN; tot = nwg * Z; G = G_; c = c_; ho.clear(); }
    __device__ __forceinline__ bool next(int i, Unit& u) const {
        const int L = i * G + c; if (c < 0 || L >= tot) return false;
        u.z = L / nwg; int wgid = L - u.z * nwg; { const int q = nwg / NXCD, r = nwg % NXCD, xcd = wgid % NXCD, off = wgid / NXCD; wgid = (xcd < r ? xcd * (q + 1) : r * (q + 1) + (xcd - r) * q) + off; }
        const int nig = WGM * nN, gid = wgid / nig, fm = gid * WGM, gsz = (nM - fm) < WGM ? (nM - fm) : WGM;
        u.pm = fm + ((wgid % nig) % gsz); u.pn = (wgid % nig) / gsz; return true;
    }
    __device__ __forceinline__ const char* a_base(const Unit& u) const { return A + (size_t)u.z * sa + (size_t)u.pm * tst; }
    __device__ __forceinline__ const char* b_base(const Unit& u) const { return B + (size_t)u.z * sb + (size_t)u.pn * tst; }
    __device__ __forceinline__ void a_ready(const Unit& u) const { ho.a_ready(u.pm); }
    __device__ __forceinline__ void done(const Unit& u) const { ho.done(u.pm); }
};
constexpr int MOE_CAP = 16384;
struct MoeOrder {
    const char* A; const char* B; size_t sbe, tst; const PG8_LAS int* toff; const PG8_LAS int* cnt; const int* rowtok; int nNt, tot, G, c, K;
    HandOff ho; int dealR;
    __device__ __forceinline__ void init(const void* A_, const void* B_, size_t sbe_, const PG8_LAS int* toff_, const PG8_LAS int* cnt_, const int* rowtok_, int nNt_, int K_, int G_, int c_) {
        A = (const char*)A_; B = (const char*)B_; sbe = sbe_; tst = (size_t)BM * K_ * 2; toff = toff_; cnt = cnt_; rowtok = rowtok_; nNt = nNt_; tot = __builtin_amdgcn_readfirstlane(toff_[32]) * nNt_; G = G_; c = c_; K = K_; ho.clear(); dealR = 0; }
    __device__ __forceinline__ void hand_off(int role_, unsigned* ready_, unsigned need_, unsigned* tmo_, int wid_) { ho.set(role_, ready_, need_, tmo_, wid_); }
    __device__ __forceinline__ void redeal(int r) { dealR = r; }
    __device__ __forceinline__ bool next(int i, Unit& u) const {
        int L = i * G + c;
        if (dealR > 0) { const int hg = G - dealR; L = (c >= dealR) ? ((i < 2) ? i * hg + (c - dealR) : 2 * hg + (i - 2) * G + c) : 2 * hg + i * G + c; }
        if (L >= tot) return false;
        const int tI = L / nNt; u.pm = tI; u.pn = L - tI * nNt; int e = 0;
#pragma unroll
        for (int j = 1; j < 32; ++j) e += (toff[j] <= tI) ? 1 : 0;
        u.z = __builtin_amdgcn_readfirstlane(e); return true;
    }
    __device__ __forceinline__ const char* a_base(const Unit& u) const { return rowtok ? A : A + (size_t)u.pm * tst; }
    __device__ __forceinline__ const char* b_base(const Unit& u) const { return B + (size_t)u.z * sbe + (size_t)u.pn * tst; }
    __device__ __forceinline__ unsigned a_goff(const Unit& u, int half, int R, int C) const {
        const int pos = 256 * (u.pm - toff[u.z]) + 128 * half + R; const int tok = (pos < cnt[u.z]) ? rowtok[(size_t)u.z * MOE_CAP + pos] : 0;
        return (unsigned)(tok * K + C) * 2u; }
    __device__ __forceinline__ void a_ready(const Unit& u) const { ho.a_ready(u.pm); }
    __device__ __forceinline__ void done(const Unit& u) const { ho.done(u.pm); }
};

__device__ __forceinline__ float sigmoidf_(float x) { return __builtin_amdgcn_rcpf(1.0f + __expf(-x)); }
__device__ __forceinline__ float tanh_fast(float x) { return 1.0f - 2.0f * __builtin_amdgcn_rcpf(__expf(2.0f * x) + 1.0f); }

struct EpiZBf16 {
    static constexpr bool PERM = true, AFTER_DRAIN = false;
    bf16_t* O; size_t zstride; float scale0;
    __device__ __forceinline__ void operator()(const f32x4 (&acc)[2][2][4][2], const Unit& u, int wr, int wc, int fr, int fq) const {
        const int row0 = u.pm * BM + wr * 64 + fr, col0 = u.pn * BM + wc * 32 + 8 * fq; bf16_t* base = O + (size_t)u.z * zstride; const float sc = (u.z == 0) ? scale0 : 1.0f;
#pragma unroll
        for (int ai = 0; ai < 2; ++ai)
#pragma unroll
            for (int m = 0; m < 4; ++m) { bf16_t* rowp = base + (size_t)(row0 + ai * HALF + m * 16) * 1024 + col0;
#pragma unroll
                for (int bj = 0; bj < 2; ++bj) { const f32x4 v0 = acc[ai][bj][m][0] * sc, v1 = acc[ai][bj][m][1] * sc;
                    u32x4 w; w.x = cvt_pk_bf16(v0[0], v0[1]); w.y = cvt_pk_bf16(v0[2], v0[3]); w.z = cvt_pk_bf16(v1[0], v1[1]); w.w = cvt_pk_bf16(v1[2], v1[3]);
                    *(u32x4*)(rowp + bj * HALF) = w; } }
    }
};
struct EpiLora1 {
    static constexpr bool PERM = true, AFTER_DRAIN = false;
    bf16_t* O;
    __device__ __forceinline__ void operator()(const f32x4 (&acc)[2][2][4][2], const Unit& u, int wr, int wc, int fr, int fq) const {
        const int row0 = u.pm * BM + wr * 64 + fr, col0 = wc * 32 + 8 * fq;
#pragma unroll
        for (int ai = 0; ai < 2; ++ai)
#pragma unroll
            for (int m = 0; m < 4; ++m) { bf16_t* rowp = O + (size_t)(row0 + ai * HALF + m * 16) * 256 + col0;
#pragma unroll
                for (int bj = 0; bj < 2; ++bj) { f32x4 v0 = acc[ai][bj][m][0], v1 = acc[ai][bj][m][1];
                    if (bj == 0 && wc < 2) {
#pragma unroll
                        for (int j = 0; j < 4; ++j) { v0[j] = tanh_fast(v0[j]); v1[j] = tanh_fast(v1[j]); } }
                    if (bj == 1) {
#pragma unroll
                        for (int j = 0; j < 4; ++j) { v0[j] = sigmoidf_(v0[j]); v1[j] = sigmoidf_(v1[j]); } }
                    u32x4 w; w.x = cvt_pk_bf16(v0[0], v0[1]); w.y = cvt_pk_bf16(v0[2], v0[3]); w.z = cvt_pk_bf16(v1[0], v1[1]); w.w = cvt_pk_bf16(v1[2], v1[3]);
                    store16_sc1(rowp + bj * HALF, w); } }
    }
};
struct EpiLora2 {
    static constexpr bool PERM = false, AFTER_DRAIN = false;
    _Float16* LW; bf16_t* AS; bf16_t* GG; const float* w0; const float* a0;
    __device__ __forceinline__ void operator()(const f32x4 (&acc)[2][2][4][2], const Unit& u, int wr, int wc, int fr, int fq) const {
        const int sect = u.pn >> 2, row0 = u.pm * BM + wr * 64 + fr, col0 = (u.pn & 3) * BM + wc * 32 + 8 * fq;
        typedef _Float16 h2_t __attribute__((ext_vector_type(2)));
        if (sect == 0) {
#pragma unroll
            for (int bj = 0; bj < 2; ++bj) { const int c = col0 + bj * HALF; unsigned pk[2][4][2];
                { const f32x4 b0 = *(const f32x4*)(w0 + c);
#pragma unroll
                  for (int ai = 0; ai < 2; ++ai)
#pragma unroll
                    for (int m = 0; m < 4; ++m) { f32x4 v0 = acc[ai][bj][m][0] + b0;
#pragma unroll
                        for (int j = 0; j < 4; ++j) v0[j] = -0.8750387749f * sigmoidf_(v0[j]);
                        const h2_t p0 = {(_Float16)v0[0], (_Float16)v0[1]}, p1 = {(_Float16)v0[2], (_Float16)v0[3]};
                        pk[ai][m][0] = __builtin_bit_cast(unsigned, p0); pk[ai][m][1] = __builtin_bit_cast(unsigned, p1); } }
                { const f32x4 b1 = *(const f32x4*)(w0 + c + 4);
#pragma unroll
                  for (int ai = 0; ai < 2; ++ai)
#pragma unroll
                    for (int m = 0; m < 4; ++m) { f32x4 v1 = acc[ai][bj][m][1] + b1;
#pragma unroll
                        for (int j = 0; j < 4; ++j) v1[j] = -0.8750387749f * sigmoidf_(v1[j]);
                        const h2_t p2 = {(_Float16)v1[0], (_Float16)v1[1]}, p3 = {(_Float16)v1[2], (_Float16)v1[3]};
                        u32x4 w; w.x = pk[ai][m][0]; w.y = pk[ai][m][1]; w.z = __builtin_bit_cast(unsigned, p2); w.w = __builtin_bit_cast(unsigned, p3);
                        *(u32x4*)(LW + (size_t)(row0 + ai * HALF + m * 16) * 1024 + c) = w; } } }
        } else if (sect == 1) {
#pragma unroll
            for (int bj = 0; bj < 2; ++bj) { const int c = col0 + bj * HALF; unsigned pk[2][4][2];
                { const f32x4 b0 = *(const f32x4*)(a0 + c);
#pragma unroll
                  for (int ai = 0; ai < 2; ++ai)
#pragma unroll
                    for (int m = 0; m < 4; ++m) { f32x4 v0 = acc[ai][bj][m][0] + b0;
#pragma unroll
                        for (int j = 0; j < 4; ++j) v0[j] = sigmoidf_(v0[j]);
                        pk[ai][m][0] = cvt_pk_bf16(v0[0], v0[1]); pk[ai][m][1] = cvt_pk_bf16(v0[2], v0[3]); } }
                { const f32x4 b1 = *(const f32x4*)(a0 + c + 4);
#pragma unroll
                  for (int ai = 0; ai < 2; ++ai)
#pragma unroll
                    for (int m = 0; m < 4; ++m) { f32x4 v1 = acc[ai][bj][m][1] + b1;
#pragma unroll
                        for (int j = 0; j < 4; ++j) v1[j] = sigmoidf_(v1[j]);
                        u32x4 w; w.x = pk[ai][m][0]; w.y = pk[ai][m][1]; w.z = cvt_pk_bf16(v1[0], v1[1]); w.w = cvt_pk_bf16(v1[2], v1[3]);
                        *(u32x4*)(AS + (size_t)(row0 + ai * HALF + m * 16) * 1024 + c) = w; } } }
        } else {
#pragma unroll
            for (int bj = 0; bj < 2; ++bj) { const int c = col0 + bj * HALF;
#pragma unroll
                for (int ai = 0; ai < 2; ++ai)
#pragma unroll
                    for (int m = 0; m < 4; ++m) { const f32x4 v0 = acc[ai][bj][m][0], v1 = acc[ai][bj][m][1];
                        u32x4 w; w.x = cvt_pk_bf16(v0[0], v0[1]); w.y = cvt_pk_bf16(v0[2], v0[3]); w.z = cvt_pk_bf16(v1[0], v1[1]); w.w = cvt_pk_bf16(v1[2], v1[3]);
                        *(u32x4*)(GG + (size_t)(row0 + ai * HALF + m * 16) * 1024 + c) = w; } }
        }
    }
};
struct EpiResid {
    static constexpr bool PERM = false, AFTER_DRAIN = false;
    const float* xin; float* xout; const float* gate;
    __device__ __forceinline__ void operator()(const f32x4 (&acc)[2][2][4][2], const Unit& u, int wr, int wc, int fr, int fq) const {
        const int row0 = u.pm * BM + wr * 64 + fr, col0 = u.pn * BM + wc * 32 + 4 * fq; const float* gp = gate + (size_t)(u.pm >> 4) * 6144 + col0;
        f32x4 gv[2][2];
#pragma unroll
        for (int bj = 0; bj < 2; ++bj)
#pragma unroll
            for (int n = 0; n < 2; ++n) gv[bj][n] = *(const f32x4*)(gp + bj * HALF + n * 16);
#pragma unroll
        for (int ai = 0; ai < 2; ++ai)
#pragma unroll
            for (int m = 0; m < 4; ++m) { const size_t ro = (size_t)(row0 + ai * HALF + m * 16) * 1024 + col0;
                f32x4 xi[2][2];
#pragma unroll
                for (int bj = 0; bj < 2; ++bj)
#pragma unroll
                    for (int n = 0; n < 2; ++n) xi[bj][n] = *(const f32x4*)(xin + ro + bj * HALF + n * 16);
#pragma unroll
                for (int bj = 0; bj < 2; ++bj)
#pragma unroll
                    for (int n = 0; n < 2; ++n) *(f32x4*)(xout + ro + bj * HALF + n * 16) = xi[bj][n] + gv[bj][n] * acc[ai][bj][m][n]; }
    }
};
struct EpiGU {
    static constexpr bool PERM = true, AFTER_DRAIN = false;
    bf16_t* H;
    __device__ __forceinline__ void operator()(const f32x4 (&acc)[2][2][4][2], const Unit& u, int wr, int wc, int fr, int fq) const {
        const int row0 = u.pm * BM + wr * 64 + fr, col0 = u.pn * HALF + wc * 32 + 8 * fq;
#pragma unroll
        for (int ai = 0; ai < 2; ++ai)
#pragma unroll
            for (int m = 0; m < 4; ++m) { float h[8];
#pragma unroll
                for (int n = 0; n < 2; ++n)
#pragma unroll
                    for (int j = 0; j < 4; ++j) { const float g = acc[ai][0][m][n][j], up = acc[ai][1][m][n][j]; h[n * 4 + j] = g * sigmoidf_(g) * up; }
                u32x4 w; w.x = cvt_pk_bf16(h[0], h[1]); w.y = cvt_pk_bf16(h[2], h[3]); w.z = cvt_pk_bf16(h[4], h[5]); w.w = cvt_pk_bf16(h[6], h[7]);
                store16_sc1(H + (size_t)(row0 + ai * HALF + m * 16) * 512 + col0, w); }
    }
};
struct EpiDown {
    static constexpr bool PERM = true, AFTER_DRAIN = false;
    bf16_t* Y; const float* rowgate; const PG8_LAS int* toff;
    __device__ __forceinline__ void operator()(const f32x4 (&acc)[2][2][4][2], const Unit& u, int wr, int wc, int fr, int fq) const {
        const int rl0 = wr * 64 + fr, col0 = u.pn * BM + wc * 32 + 8 * fq; const float* gp = rowgate + (size_t)u.z * MOE_CAP + 256 * (u.pm - toff[u.z]);
        float gtv[2][4];
#pragma unroll
        for (int ai = 0; ai < 2; ++ai)
#pragma unroll
            for (int m = 0; m < 4; ++m) gtv[ai][m] = gp[rl0 + ai * HALF + m * 16];
#pragma unroll
        for (int ai = 0; ai < 2; ++ai)
#pragma unroll
            for (int m = 0; m < 4; ++m) { const int rl = rl0 + ai * HALF + m * 16; const float gt = gtv[ai][m]; bf16_t* rowp = Y + (size_t)(u.pm * BM + rl) * 1024 + col0;
#pragma unroll
                for (int bj = 0; bj < 2; ++bj) { const f32x4 v0 = acc[ai][bj][m][0] * gt, v1 = acc[ai][bj][m][1] * gt;
                    u32x4 w; w.x = cvt_pk_bf16(v0[0], v0[1]); w.y = cvt_pk_bf16(v0[2], v0[3]); w.z = cvt_pk_bf16(v1[0], v1[1]); w.w = cvt_pk_bf16(v1[2], v1[3]);
                    *(u32x4*)(rowp + bj * HALF) = w; } }
    }
};

template <class Epi, class Sched, bool ALIGN_EPI = false, bool SP2 = false>
__device__ __forceinline__ void gemm_phase(PG8_LAS unsigned char* lds, const int K_, const Sched& S, const Epi& E, const int tid_, const int wid_) {
    const int tid = tid_, wid = wid_, lane = tid & 63, wr = wid >> 2, wc = wid & 3, fr = lane & 15, fq = lane >> 4;
    const int K = K_, nt = K / BK;
    unsigned voffA[2], voffB[2];
#pragma unroll
    for (int i = 0; i < 2; ++i) { int R, C; stage_rc(tid * 16 + i * 8192, R, C); const int Rb = Epi::PERM ? ((R & ~31) + perm32(R & 31)) : R;
        voffA[i] = (unsigned)(R * K + C) * 2u; voffB[i] = (unsigned)(Rb * K + C) * 2u; }
    const size_t kstep = (size_t)(BK * 2);
    const size_t hstep = (size_t)HALF * K * 2;
    const unsigned ldsw = (unsigned)wid * 1024u;
    const int aoff = lds_byte(wr * 64 + fr, fq * 8), boff = lds_byte(wc * 32 + fr, fq * 8);
#define PG8_SA(b, h) (((b) * 2 + (h)) * HTB)
#define PG8_SB(b, h) ((4 + (b) * 2 + (h)) * HTB)
#define PG8_STAGE(bufoff, gbase, voff) do { _Pragma("unroll") for (int _i = 0; _i < 2; ++_i) \
        __builtin_amdgcn_global_load_lds((const unsigned*)((const char*)(gbase) + (voff)[_i]), (PG8_LAS unsigned*)(lds + (bufoff) + ldsw + _i * 8192), 16, 0, 0); } while (0)
#define PG8_LDA(dst, b, h) do { _Pragma("unroll") for (int m = 0; m < 4; ++m) _Pragma("unroll") for (int k = 0; k < 2; ++k) dst[m][k] = *(const PG8_LAS bf16x8*)(lds + PG8_SA(b, h) + aoff + m * 2048 + k * 1024); } while (0)
#define PG8_LDB(dst, b, h) do { _Pragma("unroll") for (int n = 0; n < 2; ++n) _Pragma("unroll") for (int k = 0; k < 2; ++k) dst[n][k] = *(const PG8_LAS bf16x8*)(lds + PG8_SB(b, h) + boff + n * 2048 + k * 1024); } while (0)
#define PG8_MMA(ai, bj, At, Bt) do { __builtin_amdgcn_s_setprio(1); _Pragma("unroll") for (int m = 0; m < 4; ++m) _Pragma("unroll") for (int n = 0; n < 2; ++n) _Pragma("unroll") for (int k = 0; k < 2; ++k) \
        acc[ai][bj][m][n] = __builtin_amdgcn_mfma_f32_16x16x32_bf16(Bt[n][k], At[m][k], acc[ai][bj][m][n], 0, 0, 0); __builtin_amdgcn_s_setprio(0); } while (0)
#define PG8_WAIT_V(n) asm volatile("s_waitcnt vmcnt(" #n ")" ::: "memory")
#define PG8_WAIT_L(n) asm volatile("s_waitcnt lgkmcnt(" #n ")" ::: "memory")
#define PG8_BAR __builtin_amdgcn_s_barrier()
#define PG8_SCHED __builtin_amdgcn_sched_barrier(0)
    Unit cur, nxt; int ui = 0;
    if (!S.next(0, cur)) return;
    f32x4 acc[2][2][4][2];
#pragma unroll
    for (int a = 0; a < 2; ++a)
#pragma unroll
        for (int b = 0; b < 2; ++b)
#pragma unroll
            for (int m = 0; m < 4; ++m)
#pragma unroll
                for (int n = 0; n < 2; ++n) acc[a][b][m][n] = (f32x4){0.f, 0.f, 0.f, 0.f};
    bf16x8 At[4][2], B0[2][2], B1[2][2];
    const char* cA = S.a_base(cur); const char* cB = S.b_base(cur);
    S.a_ready(cur);
    if constexpr (SP2) {
        PG8_STAGE(PG8_SB(0, 0), cB, voffB); PG8_STAGE(PG8_SB(0, 1), cB + hstep, voffB); PG8_STAGE(PG8_SA(0, 0), cA, voffA); PG8_STAGE(PG8_SA(0, 1), cA + hstep, voffA);
        if (wr == 1) PG8_BAR;
        PG8_WAIT_V(2); PG8_BAR;
        PG8_STAGE(PG8_SB(1, 0), cB + kstep, voffB); PG8_STAGE(PG8_SA(1, 0), cA + kstep, voffA); PG8_STAGE(PG8_SB(1, 1), cB + hstep + kstep, voffB);
        PG8_WAIT_V(6); PG8_BAR;
    } else {
        PG8_STAGE(PG8_SB(0, 0), cB, voffB); PG8_STAGE(PG8_SA(0, 0), cA, voffA); PG8_STAGE(PG8_SB(0, 1), cB + hstep, voffB); PG8_STAGE(PG8_SA(0, 1), cA + hstep, voffA);
        if (wr == 1) PG8_BAR;
        PG8_WAIT_V(4); PG8_BAR;
        PG8_STAGE(PG8_SB(1, 0), cB + kstep, voffB); PG8_STAGE(PG8_SA(1, 0), cA + kstep, voffA); PG8_STAGE(PG8_SB(1, 1), cB + hstep + kstep, voffB);
        PG8_WAIT_V(6); PG8_BAR;
    }
    for (;;) {
        const bool has_next = S.next(ui + 1, nxt);
        const char* nA = has_next ? S.a_base(nxt) : cA; const char* nB = has_next ? S.b_base(nxt) : cB;
        for (int t = 0; t < nt; t += 2) {
            const bool last = (t == nt - 2);
            const char* a1 = cA + (size_t)(t + 1) * kstep;
            const char* a2 = last ? nA : cA + (size_t)(t + 2) * kstep; const char* b2 = last ? nB : cB + (size_t)(t + 2) * kstep;
            const char* a3 = a2 + kstep; const char* b3 = b2 + kstep;
            if (last && has_next) S.a_ready(nxt);
            if constexpr (SP2) {
            PG8_LDB(B0, 0, 0); PG8_LDB(B1, 0, 1); PG8_SCHED; PG8_LDA(At, 0, 0); PG8_STAGE(PG8_SA(1, 1), a1 + hstep, voffA);
            PG8_WAIT_V(8); PG8_WAIT_L(0); PG8_BAR; PG8_MMA(0, 0, At, B0); PG8_MMA(0, 1, At, B1); PG8_BAR; PG8_SCHED;
            PG8_LDA(At, 0, 1); PG8_STAGE(PG8_SB(0, 0), b2, voffB); PG8_STAGE(PG8_SB(0, 1), b2 + hstep, voffB); PG8_STAGE(PG8_SA(0, 0), a2, voffA);
            PG8_WAIT_V(8); PG8_WAIT_L(0); PG8_BAR; PG8_MMA(1, 0, At, B0); PG8_MMA(1, 1, At, B1); PG8_BAR; PG8_SCHED;
            PG8_LDB(B0, 1, 0); PG8_LDB(B1, 1, 1); PG8_SCHED; PG8_LDA(At, 1, 0); PG8_STAGE(PG8_SA(0, 1), a2 + hstep, voffA);
            PG8_WAIT_V(8); PG8_WAIT_L(0); PG8_BAR; PG8_MMA(0, 0, At, B0); PG8_MMA(0, 1, At, B1); PG8_BAR; PG8_SCHED;
            PG8_LDA(At, 1, 1); PG8_STAGE(PG8_SB(1, 0), b3, voffB); PG8_STAGE(PG8_SB(1, 1), b3 + hstep, voffB); PG8_STAGE(PG8_SA(1, 0), a3, voffA);
            PG8_WAIT_V(8); PG8_WAIT_L(0); PG8_BAR; PG8_MMA(1, 0, At, B0); PG8_MMA(1, 1, At, B1); PG8_BAR; PG8_SCHED;
            } else {
            PG8_LDB(B0, 0, 0); PG8_SCHED; PG8_LDA(At, 0, 0); PG8_STAGE(PG8_SA(1, 1), a1 + hstep, voffA);
            PG8_WAIT_L(8); PG8_BAR; PG8_WAIT_L(0); PG8_MMA(0, 0, At, B0); PG8_BAR; PG8_SCHED;
            PG8_LDB(B1, 0, 1); PG8_STAGE(PG8_SB(0, 0), b2, voffB);
            PG8_BAR; PG8_WAIT_L(0); PG8_MMA(0, 1, At, B1); PG8_BAR;
            PG8_LDA(At, 0, 1); PG8_STAGE(PG8_SA(0, 0), a2, voffA);
            PG8_BAR; PG8_WAIT_L(0); PG8_MMA(1, 0, At, B0); PG8_BAR; PG8_SCHED;
            PG8_STAGE(PG8_SB(0, 1), b2 + hstep, voffB);
            PG8_WAIT_V(6); PG8_BAR; PG8_MMA(1, 1, At, B1); PG8_BAR;
            PG8_LDB(B0, 1, 0); PG8_SCHED; PG8_LDA(At, 1, 0); PG8_STAGE(PG8_SA(0, 1), a2 + hstep, voffA);
            PG8_WAIT_L(8); PG8_BAR; PG8_WAIT_L(0); PG8_MMA(0, 0, At, B0); PG8_BAR; PG8_SCHED;
            PG8_LDB(B1, 1, 1); PG8_STAGE(PG8_SB(1, 0), b3, voffB);
            PG8_BAR; PG8_WAIT_L(0); PG8_MMA(0, 1, At, B1); PG8_BAR;
            PG8_LDA(At, 1, 1); PG8_STAGE(PG8_SA(1, 0), a3, voffA);
            PG8_BAR; PG8_WAIT_L(0); PG8_MMA(1, 0, At, B0); PG8_BAR; PG8_SCHED;
            PG8_STAGE(PG8_SB(1, 1), b3 + hstep, voffB);
            PG8_WAIT_V(6); PG8_BAR; PG8_MMA(1, 1, At, B1); PG8_BAR;
            }
        }
        if constexpr (ALIGN_EPI) { if (wr == 0) PG8_BAR; }
        if constexpr (!Epi::AFTER_DRAIN) { E(acc, cur, wr, wc, fr, fq); S.done(cur); }
        if (!has_next) break;
#pragma unroll
        for (int a = 0; a < 2; ++a)
#pragma unroll
            for (int b = 0; b < 2; ++b)
#pragma unroll
                for (int m = 0; m < 4; ++m)
#pragma unroll
                    for (int n = 0; n < 2; ++n) acc[a][b][m][n] = (f32x4){0.f, 0.f, 0.f, 0.f};
        cur = nxt; cA = nA; cB = nB; ++ui;
        if constexpr (ALIGN_EPI) { if (wr == 1) PG8_BAR; }
    }
    PG8_WAIT_V(0);
    if constexpr (!ALIGN_EPI) { if (wr == 0) PG8_BAR; }
    PG8_BAR;
    if constexpr (Epi::AFTER_DRAIN) { E.fused(acc, cur, wr, wc, fr, fq, lds, wid, lane); S.done(cur); }
#undef PG8_SA
#undef PG8_SB
#undef PG8_STAGE
#undef PG8_LDA
#undef PG8_LDB
#undef PG8_MMA
#undef PG8_WAIT_V
#undef PG8_WAIT_L
#undef PG8_BAR
#undef PG8_SCHED
}

template <class Epi, class Sched>
__device__ __forceinline__ void gemm_phase_gather(PG8_LAS unsigned char* lds, const int K_, const Sched& S, const Epi& E, const int tid_, const int wid_) {
    const int tid = tid_, wid = wid_, lane = tid & 63, wr = wid >> 2, wc = wid & 3, fr = lane & 15, fq = lane >> 4;
    const int K = K_, nt = K / BK;
    constexpr bool ALIGN_EPI = true, SP2 = true;
    unsigned voffA[2], voffB[2]; int Rg[2], Cg[2];
#pragma unroll
    for (int i = 0; i < 2; ++i) { int R, C; stage_rc(tid * 16 + i * 8192, R, C); const int Rb = Epi::PERM ? ((R & ~31) + perm32(R & 31)) : R;
        voffA[i] = 0u; Rg[i] = R; Cg[i] = C; voffB[i] = (unsigned)(Rb * K + C) * 2u; }
    unsigned va0[2], va1[2], nva0[2], nva1[2];
#define PG8_GOFF(dst0, dst1, U) do { _Pragma("unroll") for (int _i = 0; _i < 2; ++_i) { dst0[_i] = S.a_goff(U, 0, Rg[_i], Cg[_i]); dst1[_i] = S.a_goff(U, 1, Rg[_i], Cg[_i]); } } while (0)
#define PG8_SEL(last_, nv, v) { (last_) ? nv[0] : v[0], (last_) ? nv[1] : v[1] }
    const size_t kstep = (size_t)(BK * 2);
    const size_t hstep = (size_t)HALF * K * 2;
    const unsigned ldsw = (unsigned)wid * 1024u;
    const int aoff = lds_byte(wr * 64 + fr, fq * 8), boff = lds_byte(wc * 32 + fr, fq * 8);
#define PG8_SA(b, h) (((b) * 2 + (h)) * HTB)
#define PG8_SB(b, h) ((4 + (b) * 2 + (h)) * HTB)
#define PG8_STAGE(bufoff, gbase, voff) do { _Pragma("unroll") for (int _i = 0; _i < 2; ++_i) \
        __builtin_amdgcn_global_load_lds((const unsigned*)((const char*)(gbase) + (voff)[_i]), (PG8_LAS unsigned*)(lds + (bufoff) + ldsw + _i * 8192), 16, 0, 0); } while (0)
#define PG8_LDA(dst, b, h) do { _Pragma("unroll") for (int m = 0; m < 4; ++m) _Pragma("unroll") for (int k = 0; k < 2; ++k) dst[m][k] = *(const PG8_LAS bf16x8*)(lds + PG8_SA(b, h) + aoff + m * 2048 + k * 1024); } while (0)
#define PG8_LDB(dst, b, h) do { _Pragma("unroll") for (int n = 0; n < 2; ++n) _Pragma("unroll") for (int k = 0; k < 2; ++k) dst[n][k] = *(const PG8_LAS bf16x8*)(lds + PG8_SB(b, h) + boff + n * 2048 + k * 1024); } while (0)
#define PG8_MMA(ai, bj, At, Bt) do { __builtin_amdgcn_s_setprio(1); _Pragma("unroll") for (int m = 0; m < 4; ++m) _Pragma("unroll") for (int n = 0; n < 2; ++n) _Pragma("unroll") for (int k = 0; k < 2; ++k) \
        acc[ai][bj][m][n] = __builtin_amdgcn_mfma_f32_16x16x32_bf16(Bt[n][k], At[m][k], acc[ai][bj][m][n], 0, 0, 0); __builtin_amdgcn_s_setprio(0); } while (0)
#define PG8_WAIT_V(n) asm volatile("s_waitcnt vmcnt(" #n ")" ::: "memory")
#define PG8_WAIT_L(n) asm volatile("s_waitcnt lgkmcnt(" #n ")" ::: "memory")
#define PG8_BAR __builtin_amdgcn_s_barrier()
#define PG8_SCHED __builtin_amdgcn_sched_barrier(0)
    Unit cur, nxt; int ui = 0;
    if (!S.next(0, cur)) return;
    f32x4 acc[2][2][4][2];
#pragma unroll
    for (int a = 0; a < 2; ++a)
#pragma unroll
        for (int b = 0; b < 2; ++b)
#pragma unroll
            for (int m = 0; m < 4; ++m)
#pragma unroll
                for (int n = 0; n < 2; ++n) acc[a][b][m][n] = (f32x4){0.f, 0.f, 0.f, 0.f};
    bf16x8 At[4][2], B0[2][2], B1[2][2];
    const char* cA = S.a_base(cur); const char* cB = S.b_base(cur);
    S.a_ready(cur);
    if constexpr (SP2) {
        PG8_GOFF(va0, va1, cur);
        PG8_STAGE(PG8_SB(0, 0), cB, voffB); PG8_STAGE(PG8_SB(0, 1), cB + hstep, voffB); PG8_STAGE(PG8_SA(0, 0), cA, va0); PG8_STAGE(PG8_SA(0, 1), cA, va1);
        if (wr == 1) PG8_BAR;
        PG8_WAIT_V(2); PG8_BAR;
        PG8_STAGE(PG8_SB(1, 0), cB + kstep, voffB); PG8_STAGE(PG8_SA(1, 0), cA + kstep, va0); PG8_STAGE(PG8_SB(1, 1), cB + hstep + kstep, voffB);
        PG8_WAIT_V(6); PG8_BAR;
    } else {
        PG8_STAGE(PG8_SB(0, 0), cB, voffB); PG8_STAGE(PG8_SA(0, 0), cA, voffA); PG8_STAGE(PG8_SB(0, 1), cB + hstep, voffB); PG8_STAGE(PG8_SA(0, 1), cA + hstep, voffA);
        if (wr == 1) PG8_BAR;
        PG8_WAIT_V(4); PG8_BAR;
        PG8_STAGE(PG8_SB(1, 0), cB + kstep, voffB); PG8_STAGE(PG8_SA(1, 0), cA + kstep, voffA); PG8_STAGE(PG8_SB(1, 1), cB + hstep + kstep, voffB);
        PG8_WAIT_V(6); PG8_BAR;
    }
    for (;;) {
        const bool has_next = S.next(ui + 1, nxt);
        if (has_next) PG8_GOFF(nva0, nva1, nxt); else { nva0[0] = va0[0]; nva0[1] = va0[1]; nva1[0] = va1[0]; nva1[1] = va1[1]; }
        const char* nA = has_next ? S.a_base(nxt) : cA; const char* nB = has_next ? S.b_base(nxt) : cB;
        for (int t = 0; t < nt; t += 2) {
            const bool last = (t == nt - 2);
            const char* a1 = cA + (size_t)(t + 1) * kstep;
            const char* a2 = last ? nA : cA + (size_t)(t + 2) * kstep; const char* b2 = last ? nB : cB + (size_t)(t + 2) * kstep;
            const char* a3 = a2 + kstep; const char* b3 = b2 + kstep;
            if (last && has_next) S.a_ready(nxt);
            if constexpr (SP2) {
            PG8_LDB(B0, 0, 0); PG8_LDB(B1, 0, 1); PG8_SCHED; PG8_LDA(At, 0, 0); PG8_STAGE(PG8_SA(1, 1), a1, va1);
            PG8_WAIT_V(8); PG8_WAIT_L(0); PG8_BAR; PG8_MMA(0, 0, At, B0); PG8_MMA(0, 1, At, B1); PG8_BAR; PG8_SCHED;
            PG8_LDA(At, 0, 1); PG8_STAGE(PG8_SB(0, 0), b2, voffB); PG8_STAGE(PG8_SB(0, 1), b2 + hstep, voffB); { const unsigned sv[2] = PG8_SEL(last, nva0, va0); PG8_STAGE(PG8_SA(0, 0), a2, sv); }
            PG8_WAIT_V(8); PG8_WAIT_L(0); PG8_BAR; PG8_MMA(1, 0, At, B0); PG8_MMA(1, 1, At, B1); PG8_BAR; PG8_SCHED;
            PG8_LDB(B0, 1, 0); PG8_LDB(B1, 1, 1); PG8_SCHED; PG8_LDA(At, 1, 0); { const unsigned sv[2] = PG8_SEL(last, nva1, va1); PG8_STAGE(PG8_SA(0, 1), a2, sv); }
            PG8_WAIT_V(8); PG8_WAIT_L(0); PG8_BAR; PG8_MMA(0, 0, At, B0); PG8_MMA(0, 1, At, B1); PG8_BAR; PG8_SCHED;
            PG8_LDA(At, 1, 1); PG8_STAGE(PG8_SB(1, 0), b3, voffB); PG8_STAGE(PG8_SB(1, 1), b3 + hstep, voffB); { const unsigned sv[2] = PG8_SEL(last, nva0, va0); PG8_STAGE(PG8_SA(1, 0), a3, sv); }
            PG8_WAIT_V(8); PG8_WAIT_L(0); PG8_BAR; PG8_MMA(1, 0, At, B0); PG8_MMA(1, 1, At, B1); PG8_BAR; PG8_SCHED;
            } else {
            PG8_LDB(B0, 0, 0); PG8_SCHED; PG8_LDA(At, 0, 0); PG8_STAGE(PG8_SA(1, 1), a1 + hstep, voffA);
            PG8_WAIT_L(8); PG8_BAR; PG8_WAIT_L(0); PG8_MMA(0, 0, At, B0); PG8_BAR; PG8_SCHED;
            PG8_LDB(B1, 0, 1); PG8_STAGE(PG8_SB(0, 0), b2, voffB);
            PG8_BAR; PG8_WAIT_L(0); PG8_MMA(0, 1, At, B1); PG8_BAR;
            PG8_LDA(At, 0, 1); PG8_STAGE(PG8_SA(0, 0), a2, voffA);
            PG8_BAR; PG8_WAIT_L(0); PG8_MMA(1, 0, At, B0); PG8_BAR; PG8_SCHED;
            PG8_STAGE(PG8_SB(0, 1), b2 + hstep, voffB);
            PG8_WAIT_V(6); PG8_BAR; PG8_MMA(1, 1, At, B1); PG8_BAR;
            PG8_LDB(B0, 1, 0); PG8_SCHED; PG8_LDA(At, 1, 0); PG8_STAGE(PG8_SA(0, 1), a2 + hstep, voffA);
            PG8_WAIT_L(8); PG8_BAR; PG8_WAIT_L(0); PG8_MMA(0, 0, At, B0); PG8_BAR; PG8_SCHED;
            PG8_LDB(B1, 1, 1); PG8_STAGE(PG8_SB(1, 0), b3, voffB);
            PG8_BAR; PG8_WAIT_L(0); PG8_MMA(0, 1, At, B1); PG8_BAR;
            PG8_LDA(At, 1, 1); PG8_STAGE(PG8_SA(1, 0), a3, voffA);
            PG8_BAR; PG8_WAIT_L(0); PG8_MMA(1, 0, At, B0); PG8_BAR; PG8_SCHED;
            PG8_STAGE(PG8_SB(1, 1), b3 + hstep, voffB);
            PG8_WAIT_V(6); PG8_BAR; PG8_MMA(1, 1, At, B1); PG8_BAR;
            }
        }
        if constexpr (ALIGN_EPI) { if (wr == 0) PG8_BAR; }
        if constexpr (!Epi::AFTER_DRAIN) { E(acc, cur, wr, wc, fr, fq); S.done(cur); }
        if (!has_next) break;
#pragma unroll
        for (int a = 0; a < 2; ++a)
#pragma unroll
            for (int b = 0; b < 2; ++b)
#pragma unroll
                for (int m = 0; m < 4; ++m)
#pragma unroll
                    for (int n = 0; n < 2; ++n) acc[a][b][m][n] = (f32x4){0.f, 0.f, 0.f, 0.f};
        cur = nxt; cA = nA; cB = nB; ++ui; va0[0] = nva0[0]; va0[1] = nva0[1]; va1[0] = nva1[0]; va1[1] = nva1[1];
        if constexpr (ALIGN_EPI) { if (wr == 1) PG8_BAR; }
    }
    PG8_WAIT_V(0);
    if constexpr (!ALIGN_EPI) { if (wr == 0) PG8_BAR; }
    PG8_BAR;
    if constexpr (Epi::AFTER_DRAIN) { E.fused(acc, cur, wr, wc, fr, fq, lds, wid, lane); S.done(cur); }
#undef PG8_SA
#undef PG8_SB
#undef PG8_STAGE
#undef PG8_LDA
#undef PG8_LDB
#undef PG8_MMA
#undef PG8_WAIT_V
#undef PG8_WAIT_L
#undef PG8_BAR
#undef PG8_SCHED
#undef PG8_GOFF
#undef PG8_SEL
}
}

namespace attn_body {
using bf16=__hip_bfloat16;
using bf16x8=__attribute__((ext_vector_type(8)))short;
using s16x4=__attribute__((ext_vector_type(4)))short;
using f32x16=__attribute__((ext_vector_type(16)))float;
using u32x4=__attribute__((ext_vector_type(4)))unsigned;
constexpr int BATCH=4,SEQ=4096,D=64,QP=1024,KP=1024,VP=1024,OP=2048;
constexpr int NW=8,QBLK=32,QB=QBLK*NW,KVBLK=64,NQB=SEQ/QB;
constexpr int ATTN_UNIT_ROWS=QB;
__device__ __forceinline__ int crow(int r,int hi){return (r&3)+8*(r>>2)+4*hi;}
#define SBAR() __builtin_amdgcn_sched_barrier(0)
__device__ __forceinline__ void cmask(f32x16&p0,f32x16&p1,int jb,int qrel,int hi){
  const float NEG=-INFINITY; int kb=64*jb+4*hi;
  #pragma unroll
  for(int r=0;r<16;++r){int kv=kb+(r&3)+8*(r>>2); if(kv>qrel)p0[r]=NEG; if(kv+32>qrel)p1[r]=NEG;}
}

constexpr int NSLOT=3, SLOTB=8192;
constexpr int LDS_K=0, LDS_V=NSLOT*SLOTB, LDS_WS=2*NSLOT*SLOTB, LDS_OST=LDS_WS+NW*64*4, LDS_BYTES=LDS_OST+NW*4096;
constexpr float C2=0.125f*1.4426950408889634f;
__device__ __forceinline__ void glds16(const void*gsrc,unsigned lds_dst){unsigned keep;
  asm volatile("s_mov_b32 %0, m0\n\ts_mov_b32 m0, %2\n\ts_nop 0\n\tglobal_load_lds_dwordx4 %1, off\n\ts_mov_b32 m0, %0":"=&s"(keep):"v"(gsrc),"s"(lds_dst):"memory");}
__device__ __forceinline__ float max3f(float a,float b,float c){float r;asm("v_max3_f32 %0, %1, %2, %3":"=v"(r):"v"(a),"v"(b),"v"(c));return r;}
__device__ __forceinline__ float max2f(float a,float b){float r;asm("v_max_f32_e32 %0, %1, %2":"=v"(r):"v"(a),"v"(b));return r;}
__device__ __forceinline__ float fadd_s(float a,float b){float r;asm("v_add_f32_e32 %0, %1, %2":"=v"(r):"v"(a),"v"(b));return r;}
__device__ __forceinline__ float fsub_s(float a,float b){float r;asm("v_sub_f32_e32 %0, %1, %2":"=v"(r):"v"(a),"v"(b));return r;}
typedef float f32x2_t __attribute__((ext_vector_type(2))); typedef __bf16 bf16x2_t __attribute__((ext_vector_type(2)));
__device__ __forceinline__ unsigned cvtpk_s(float lo,float hi){f32x2_t v={lo,hi};bf16x2_t b=__builtin_convertvector(v,bf16x2_t);return __builtin_bit_cast(unsigned,b);}
#define WAIT_BAR(N) asm volatile("s_waitcnt vmcnt(" #N ") lgkmcnt(0)\n\ts_barrier":::"memory")

__device__ __forceinline__ void qkt(f32x16&p0,f32x16&p1,const char*Kslot,const bf16x8*qr,const f32x16&negm,int r32,int hi){
  const char*kb=Kslot+hi*1024+r32*16;
  #pragma unroll
  for(int d0=0;d0<4;++d0){
    const bf16x8 b0=*reinterpret_cast<const bf16x8*>(kb+d0*2048);
    const bf16x8 b1=*reinterpret_cast<const bf16x8*>(kb+d0*2048+512);
    if(d0==0){p0=__builtin_amdgcn_mfma_f32_32x32x16_bf16(b0,qr[0],negm,0,0,0);p1=__builtin_amdgcn_mfma_f32_32x32x16_bf16(b1,qr[0],negm,0,0,0);}
    else{p0=__builtin_amdgcn_mfma_f32_32x32x16_bf16(b0,qr[d0],p0,0,0,0);p1=__builtin_amdgcn_mfma_f32_32x32x16_bf16(b1,qr[d0],p1,0,0,0);}}
}
typedef __attribute__((address_space(3))) const char* lds_cptr;
typedef short v4i16_t __attribute__((ext_vector_type(4)));
__device__ __forceinline__ void kload8(bf16x8*kf,lds_cptr kp){
  kf[0]=*(const __attribute__((address_space(3))) bf16x8*)(kp);      kf[1]=*(const __attribute__((address_space(3))) bf16x8*)(kp+512);
  kf[2]=*(const __attribute__((address_space(3))) bf16x8*)(kp+2048); kf[3]=*(const __attribute__((address_space(3))) bf16x8*)(kp+2560);
  kf[4]=*(const __attribute__((address_space(3))) bf16x8*)(kp+4096); kf[5]=*(const __attribute__((address_space(3))) bf16x8*)(kp+4608);
  kf[6]=*(const __attribute__((address_space(3))) bf16x8*)(kp+6144); kf[7]=*(const __attribute__((address_space(3))) bf16x8*)(kp+6656);
}
__device__ __forceinline__ void kload2(bf16x8*kf,lds_cptr kp,int j){ kf[2*j]=*(const __attribute__((address_space(3))) bf16x8*)(kp+j*2048); kf[2*j+1]=*(const __attribute__((address_space(3))) bf16x8*)(kp+j*2048+512); }
__device__ __forceinline__ s16x4 vtr(lds_cptr p){ return __builtin_bit_cast(s16x4,__builtin_amdgcn_ds_read_tr16_b64_v4i16((__attribute__((address_space(3))) v4i16_t*)p)); }
__device__ __forceinline__ float rowmax(const f32x16&p0,const f32x16&p1){
  float a=max3f(p0[0],p0[1],p1[0]),b=max3f(p0[2],p0[3],p1[1]);a=max3f(a,p1[2],p1[3]);
  #pragma unroll
  for(int r=4;r<16;r+=4){a=max3f(a,p0[r],p0[r+1]);b=max3f(b,p0[r+2],p0[r+3]);a=max3f(a,p1[r],p1[r+1]);b=max3f(b,p1[r+2],p1[r+3]);}
  const float m=max2f(a,b);
  auto rr=__builtin_amdgcn_permlane32_swap(__float_as_uint(m),__float_as_uint(m),false,false);
  return max2f(__uint_as_float(rr[0]),__uint_as_float(rr[1]));
}
__device__ __forceinline__ void pv(f32x16*o,int vb,bf16x8 pa0,bf16x8 pa1,bf16x8 pa2,bf16x8 pa3){
  #pragma unroll
  for(int d0=0;d0<2;++d0){s16x4 lo[4],hi[4];
    #pragma unroll
    for(int ks=0;ks<4;++ks){
      asm volatile("ds_read_b64_tr_b16 %0,%1 offset:%c2":"=&v"(lo[ks]):"v"(vb),"i"(d0*4096+ks*1024):"memory");
      asm volatile("ds_read_b64_tr_b16 %0,%1 offset:%c2":"=&v"(hi[ks]):"v"(vb),"i"(d0*4096+ks*1024+512):"memory");}
    asm volatile("s_waitcnt lgkmcnt(0)":::"memory");SBAR();
    #define PK(k) (bf16x8){lo[k][0],lo[k][1],lo[k][2],lo[k][3],hi[k][0],hi[k][1],hi[k][2],hi[k][3]}
    o[d0]=__builtin_amdgcn_mfma_f32_32x32x16_bf16(pa0,PK(0),o[d0],0,0,0);
    o[d0]=__builtin_amdgcn_mfma_f32_32x32x16_bf16(pa1,PK(1),o[d0],0,0,0);
    o[d0]=__builtin_amdgcn_mfma_f32_32x32x16_bf16(pa2,PK(2),o[d0],0,0,0);
    o[d0]=__builtin_amdgcn_mfma_f32_32x32x16_bf16(pa3,PK(3),o[d0],0,0,0);
    #undef PK
  }
}

#ifndef ATTN_STORE16
#define ATTN_STORE16(p,v) (*(u32x4*)(p)=(v))
#endif
template<int THRL> __device__ __forceinline__ void attn_unit(int b,int qb,const bf16*Q,const bf16*__restrict__ K,const bf16*__restrict__ V,bf16*O,char*shm,const int tid_,const int wid_){
  const int tid=tid_,lane=tid&63,r32=lane&31,hi=lane>>5; const int wid=wid_;
  const long rowbase=(long)b*SEQ; const int q0=qb*QB;
  const bf16*Qw=Q+(rowbase+q0+wid*QBLK)*QP;
  const bf16*Kh=K+rowbase*KP,*Vh=V+rowbase*VP;
  const unsigned lds0=(unsigned)(uintptr_t)shm;
  float*wsf=(float*)(shm+LDS_WS)+wid*64;
  const bf16*ksrc=Kh+(long)lane*KP+wid*8;
  const bf16*vsrc=Vh+(long)(16*(wid&3)+(lane>>2))*VP+(wid>>2)*32+(lane&3)*8;
  const unsigned kdst=lds0+LDS_K+wid*1024, vdst=lds0+LDS_V+wid*1024;
  #define DMA_K(t,slot) glds16(ksrc+(long)(t)*KVBLK*KP,(unsigned)__builtin_amdgcn_readfirstlane(kdst+(slot)))
  #define DMA_V(t,slot) glds16(vsrc+(long)(t)*KVBLK*VP,(unsigned)__builtin_amdgcn_readfirstlane(vdst+(slot)))
  const int vb0=(int)(lds0+LDS_V)+((lane>>4)&1)*32+(lane&3)*8+(4*hi+((lane&15)>>2))*64;
  const char*Kbase=shm+LDS_K; bf16x8 kf[8];
  const lds_cptr shm3=(lds_cptr)shm; const lds_cptr kp0=shm3+LDS_K+hi*1024+r32*16; const lds_cptr vp0=shm3+LDS_V+((lane>>4)&1)*32+(lane&3)*8+(4*hi+((lane&15)>>2))*64;
  const int NT=(q0+QB)/KVBLK;
  DMA_K(0,0);DMA_V(0,0);DMA_K(1,SLOTB);
  bf16x8 qr[4];
  #pragma unroll
  for(int d0=0;d0<4;++d0)qr[d0]=*reinterpret_cast<const bf16x8*>(&Qw[(long)r32*QP+d0*16+hi*8]);
  float mhat=0.f,l_reg=0.f;f32x16 o[2];o[0]=f32x16{};o[1]=f32x16{};f32x16 negm=f32x16{};asm volatile("":"+v"(negm));
  const int qrel=wid*QBLK+r32;
  #define CMASK(P0,P1,t) do{int jb_=(t)-(NT-4); if(jb_>=0)cmask(P0,P1,jb_,qrel,hi);}while(0)
  bool resc=false;
  #define START(P0,P1) do{ const float rm=rowmax(P0,P1); resc=false; \
    { const float dl=rm; mhat=fadd_s(mhat,dl); \
      _Pragma("unroll") for(int r=0;r<16;++r){P0[r]=fsub_s(P0[r],dl);P1[r]=fsub_s(P1[r],dl);} \
      _Pragma("unroll") for(int r=0;r<16;++r)negm[r]=-mhat; asm volatile("":"+v"(negm)); } \
    _Pragma("unroll") for(int r=0;r<16;++r)P0[r]=__builtin_amdgcn_exp2f(P0[r]); }while(0)
  #define RESC() do{ if(resc){ asm volatile("s_waitcnt lgkmcnt(0)":::"memory"); \
      _Pragma("unroll") for(int d_=0;d_<2;++d_) _Pragma("unroll") for(int r=0;r<16;++r)o[d_][r]*=wsf[crow(r,hi)]; } }while(0)
  f32x16 pA0,pA1,pB0,pB1;
  int sl_prev=0,sl_cur=0,sl_next=SLOTB;
  #define ROT() do{sl_prev=sl_cur;sl_cur=sl_next;sl_next=(sl_next==(NSLOT-1)*SLOTB)?0:sl_next+SLOTB;}while(0)
  DMA_K(2,2*SLOTB);
  WAIT_BAR(3);
  qkt(pA0,pA1,Kbase,qr,negm,r32,hi);asm volatile("s_nop 15\n\ts_nop 7":"+v"(pA0),"+v"(pA1));CMASK(pA0,pA1,0);
  START(pA0,pA1);
  _Pragma("unroll") for(int r=0;r<16;++r)pA1[r]=__builtin_amdgcn_exp2f(pA1[r]);
  WAIT_BAR(0);
  DMA_K(3,0);DMA_V(1,SLOTB);
  ROT();
  kload8(kf,kp0+sl_cur);
  WAIT_BAR(2);
  s16x4 vlo[8],vhi[8]; u32x4 pw0,pw1,pw2,pw3;
  #define PKW(P,B) cvtpk_s(P[B],P[B+1])
  #define PAF(k) __builtin_bit_cast(bf16x8,pw##k)
  #define VFR(i) (bf16x8){vlo[i][0],vlo[i][1],vlo[i][2],vlo[i][3],vhi[i][0],vhi[i][1],vhi[i][2],vhi[i][3]}
  #define PIN(x) asm volatile("":"+v"(x))
  #define MX3(a,b,c) __builtin_fmaxf(__builtin_fmaxf((a),(b)),(c))
  #define GAPA(MF,A0,A1,A2,A3,W0,W1,PW) do{ MF; sacc+=A0; sacc+=A1; sacc+=A2; sacc+=A3; PIN(sacc); W0; W1; PIN(PW); SBAR(); }while(0)
  #define EX(v) __builtin_amdgcn_exp2f(v)
  #define GAPB(MF,X,B) do{ MF; X[B]=EX(X[B]); X[B+1]=EX(X[B+1]); X[B+2]=EX(X[B+2]); X[B+3]=EX(X[B+3]); PIN(X); SBAR(); }while(0)
  #define VRD(i) do{ vlo[i]=vtr(vp_+(((i)>>2)*4096+((i)&3)*1024)); vhi[i]=vtr(vp_+(((i)>>2)*4096+((i)&3)*1024+512)); }while(0)
  #define KRD(G,j) do{ if(G){ kload2(kf,kp0+sl_next,j); SBAR(); } }while(0)
  #define STEP(C0,C1,P0,P1,t,GK,GV,GL) do{ SBAR(); \
    const lds_cptr vp_=vp0+sl_prev; \
    VRD(0); SBAR(); float sacc=(P0[0]+P0[1]); \
    GAPA(C0=__builtin_amdgcn_mfma_f32_32x32x16_bf16(kf[0],qr[0],negm,0,0,0), P0[2],P0[3],P0[4],P0[5],     pw0[0]=PKW(P0,0), pw0[1]=PKW(P0,2), pw0); \
    VRD(4); SBAR(); GAPA(C1=__builtin_amdgcn_mfma_f32_32x32x16_bf16(kf[1],qr[0],negm,0,0,0), P0[6],P0[7],P0[8],P0[9],     pw0[2]=PKW(P0,4), pw0[3]=PKW(P0,6), pw0); \
    VRD(1); SBAR(); GAPA(C0=__builtin_amdgcn_mfma_f32_32x32x16_bf16(kf[2],qr[1],C0,0,0,0),   P0[10],P0[11],P0[12],P0[13], pw1[0]=PKW(P0,8), pw1[1]=PKW(P0,10), pw1); \
    VRD(5); SBAR(); GAPA(C1=__builtin_amdgcn_mfma_f32_32x32x16_bf16(kf[3],qr[1],C1,0,0,0),   P0[14],P0[15],P1[0],P1[1],   pw1[2]=PKW(P0,12),pw1[3]=PKW(P0,14), pw1); \
    VRD(2); SBAR(); GAPA(C0=__builtin_amdgcn_mfma_f32_32x32x16_bf16(kf[4],qr[2],C0,0,0,0),   P1[2],P1[3],P1[4],P1[5],     pw2[0]=PKW(P1,0), pw2[1]=PKW(P1,2), pw2); \
    VRD(6); SBAR(); GAPA(C1=__builtin_amdgcn_mfma_f32_32x32x16_bf16(kf[5],qr[2],C1,0,0,0),   P1[6],P1[7],P1[8],P1[9],     pw2[2]=PKW(P1,4), pw2[3]=PKW(P1,6), pw2); \
    VRD(3); SBAR(); GAPA(C0=__builtin_amdgcn_mfma_f32_32x32x16_bf16(kf[6],qr[3],C0,0,0,0),   P1[10],P1[11],P1[12],P1[13], pw3[0]=PKW(P1,8), pw3[1]=PKW(P1,10), pw3); \
    VRD(7); SBAR(); GAPA(C1=__builtin_amdgcn_mfma_f32_32x32x16_bf16(kf[7],qr[3],C1,0,0,0),   P1[14],P1[15],0.f,0.f,       pw3[2]=PKW(P1,12),pw3[3]=PKW(P1,14), pw3); \
    l_reg+=sacc; \
    if(GK){DMA_K((t)+3,sl_cur);} if(GV){DMA_V((t)+1,sl_next);} \
    CMASK(C0,C1,t); \
    { float a=MX3(C0[0],C0[1],C1[0]),b=MX3(C0[2],C0[3],C1[1]); a=MX3(a,C1[2],C1[3]); \
      _Pragma("unroll") for(int r=4;r<16;r+=4){a=MX3(a,C0[r],C0[r+1]);b=MX3(b,C0[r+2],C0[r+3]);a=MX3(a,C1[r],C1[r+1]);b=MX3(b,C1[r+2],C1[r+3]);} \
      float rm=__builtin_fmaxf(a,b); { auto rr=__builtin_amdgcn_permlane32_swap(__float_as_uint(rm),__float_as_uint(rm),false,false); rm=__builtin_fmaxf(__uint_as_float(rr[0]),__uint_as_float(rr[1])); } \
      resc=false; \
      if(__builtin_expect(__any(rm>(float)THRL),0)){ const float dl=__builtin_fmaxf(rm,0.f); mhat+=dl; \
        _Pragma("unroll") for(int r=0;r<16;++r){C0[r]-=dl;C1[r]-=dl;} \
        _Pragma("unroll") for(int r=0;r<16;++r)negm[r]=-mhat; asm volatile("":"+v"(negm)); \
        const float f=__builtin_amdgcn_exp2f(-dl); l_reg*=f; if(hi==0)wsf[r32]=f; resc=true; } } \
    SBAR(); \
    GAPB(o[0]=__builtin_amdgcn_mfma_f32_32x32x16_bf16(PAF(0),VFR(0),o[0],0,0,0), C0,0); \
    GAPB(o[1]=__builtin_amdgcn_mfma_f32_32x32x16_bf16(PAF(0),VFR(4),o[1],0,0,0), C0,4); \
    KRD(GL,0); GAPB(o[0]=__builtin_amdgcn_mfma_f32_32x32x16_bf16(PAF(1),VFR(1),o[0],0,0,0), C0,8); \
    KRD(GL,1); GAPB(o[1]=__builtin_amdgcn_mfma_f32_32x32x16_bf16(PAF(1),VFR(5),o[1],0,0,0), C0,12); \
    KRD(GL,2); GAPB(o[0]=__builtin_amdgcn_mfma_f32_32x32x16_bf16(PAF(2),VFR(2),o[0],0,0,0), C1,0); \
    KRD(GL,3); GAPB(o[1]=__builtin_amdgcn_mfma_f32_32x32x16_bf16(PAF(2),VFR(6),o[1],0,0,0), C1,4); \
    GAPB(o[0]=__builtin_amdgcn_mfma_f32_32x32x16_bf16(PAF(3),VFR(3),o[0],0,0,0), C1,8); \
    GAPB(o[1]=__builtin_amdgcn_mfma_f32_32x32x16_bf16(PAF(3),VFR(7),o[1],0,0,0), C1,12); \
    }while(0)
  int t=1;
  #undef CMASK
  #define CMASK(P0,P1,t) do{}while(0)
  for(;t+5<NT;t+=2){
    STEP(pB0,pB1,pA0,pA1,t,true,true,true);     WAIT_BAR(2); RESC(); ROT();
    STEP(pA0,pA1,pB0,pB1,t+1,true,true,true);   WAIT_BAR(2); RESC(); ROT();
  }
  #undef CMASK
  #define CMASK(P0,P1,t) do{int jb_=(t)-(NT-4); if(jb_>=0)cmask(P0,P1,jb_,qrel,hi);}while(0)
  #define ENDW(tt) do{ if((tt)+3<NT){WAIT_BAR(2);} else if((tt)+2<NT){WAIT_BAR(1);} else {WAIT_BAR(0);} }while(0)
  for(;t+1<NT;t+=2){
    STEP(pB0,pB1,pA0,pA1,t,(t+3<NT),(t+1<NT),(t+1<NT));       ENDW(t);   RESC(); ROT();
    STEP(pA0,pA1,pB0,pB1,t+1,(t+4<NT),(t+2<NT),(t+2<NT));     ENDW(t+1); RESC(); ROT();
  }
  STEP(pB0,pB1,pA0,pA1,NT-1,false,false,false); RESC();
  { float sacc=pB0[0]+pB0[1]; _Pragma("unroll") for(int r=2;r<16;++r)sacc+=pB0[r]; _Pragma("unroll") for(int r=0;r<16;++r)sacc+=pB1[r]; l_reg+=sacc;
    pw0=(u32x4){PKW(pB0,0),PKW(pB0,2),PKW(pB0,4),PKW(pB0,6)};pw1=(u32x4){PKW(pB0,8),PKW(pB0,10),PKW(pB0,12),PKW(pB0,14)};pw2=(u32x4){PKW(pB1,0),PKW(pB1,2),PKW(pB1,4),PKW(pB1,6)};pw3=(u32x4){PKW(pB1,8),PKW(pB1,10),PKW(pB1,12),PKW(pB1,14)};
    SBAR(); pv(o,vb0+sl_cur,PAF(0),PAF(1),PAF(2),PAF(3)); }
  #undef PKW
  #undef PAF
  #undef VFR
  #undef PIN
  #undef MX3
  #undef GAPA
  #undef GAPB
  #undef EX
  #undef VRD
  #undef KRD
  #undef STEP
  #undef ENDW
  {auto rr=__builtin_amdgcn_permlane32_swap(__float_as_uint(l_reg),__float_as_uint(l_reg),false,false);l_reg=__uint_as_float(rr[0])+__uint_as_float(rr[1]);}
  if(hi==0)wsf[32+r32]=l_reg;asm volatile("s_waitcnt lgkmcnt(0)":::"memory");
  float rli[16];
  #pragma unroll
  for(int r=0;r<16;++r)rli[r]=__builtin_amdgcn_rcpf(wsf[32+crow(r,hi)]);
  bf16*Ow=O+(rowbase+q0+wid*QBLK)*OP;
  { bf16*stg=(bf16*)(shm+LDS_OST)+wid*2048;
    #pragma unroll
    for(int r=0;r<16;++r){const int orow=crow(r,hi);
      #pragma unroll
      for(int d0=0;d0<2;++d0)stg[orow*64+d0*32+r32]=__float2bfloat16(o[d0][r]*rli[r]);}
    asm volatile("s_waitcnt lgkmcnt(0)":::"memory");
    #pragma unroll
    for(int i=0;i<4;++i){const int row=i*8+(lane>>3),ch=lane&7; const u32x4 v=*(const u32x4*)(stg+row*64+ch*8); ATTN_STORE16(Ow+(long)row*OP+ch*8,v);} }
  asm volatile("s_waitcnt lgkmcnt(0)\n\ts_barrier":::"memory");
  #undef DMA_K
  #undef DMA_V
  #undef CMASK
  #undef START
  #undef RESC
  #undef ROT
}
constexpr int LDS_V128=NSLOT*SLOTB, LDS_WS128=LDS_V128+NSLOT*2*SLOTB, LDS_OST128=LDS_WS128+NW*64*4, LDS_BYTES128=LDS_OST128+NW*8192;
__device__ __forceinline__ void pv128(f32x16*o,int vb,bf16x8 pa0,bf16x8 pa1,bf16x8 pa2,bf16x8 pa3){
  #pragma unroll
  for(int d0=0;d0<4;++d0){s16x4 lo[4],hi[4];
    #pragma unroll
    for(int ks=0;ks<4;++ks){
      asm volatile("ds_read_b64_tr_b16 %0,%1 offset:%c2":"=&v"(lo[ks]):"v"(vb),"i"(d0*4096+ks*1024):"memory");
      asm volatile("ds_read_b64_tr_b16 %0,%1 offset:%c2":"=&v"(hi[ks]):"v"(vb),"i"(d0*4096+ks*1024+512):"memory");}
    asm volatile("s_waitcnt lgkmcnt(0)":::"memory");SBAR();
    #define PK(k) (bf16x8){lo[k][0],lo[k][1],lo[k][2],lo[k][3],hi[k][0],hi[k][1],hi[k][2],hi[k][3]}
    o[d0]=__builtin_amdgcn_mfma_f32_32x32x16_bf16(pa0,PK(0),o[d0],0,0,0);
    o[d0]=__builtin_amdgcn_mfma_f32_32x32x16_bf16(pa1,PK(1),o[d0],0,0,0);
    o[d0]=__builtin_amdgcn_mfma_f32_32x32x16_bf16(pa2,PK(2),o[d0],0,0,0);
    o[d0]=__builtin_amdgcn_mfma_f32_32x32x16_bf16(pa3,PK(3),o[d0],0,0,0);
    #undef PK
  }
}
template<int THRL> __device__ __forceinline__ void attn_unit128(int b,int qb,const bf16*Q,const bf16*__restrict__ K,const bf16*__restrict__ V,bf16*O,char*shm,const int tid_,const int wid_,
    bf16x8 (&qr)[4],const bool pre,const bool has_next,const int nb,const int nqb,const bf16*nQ,const bf16*nK,const bf16*nV){
  int tidv=tid_; asm volatile("":"+v"(tidv));
  const int tid=tidv,lane=tid&63,r32=lane&31,hi=lane>>5; const int wid=wid_;
  const long rowbase=(long)b*SEQ; const int q0=qb*QB;
  const bf16*Qw=Q+(rowbase+q0+wid*QBLK)*QP;
  const bf16*Kh=K+rowbase*KP,*Vh=V+rowbase*VP;
  const unsigned lds0=(unsigned)(uintptr_t)shm;
  float*wsf=(float*)(shm+LDS_WS128)+wid*64;
  const bf16*ksrc=Kh+(long)lane*KP+wid*8;
  const bf16*vsrc=Vh+(long)(16*(wid&3)+(lane>>2))*VP+(wid>>2)*32+(lane&3)*8;
  const unsigned kdst=lds0+LDS_K+wid*1024, vdst=lds0+LDS_V128+wid*1024;
  #define DMA_K(t,slot) glds16(ksrc+(long)(t)*KVBLK*KP,(unsigned)__builtin_amdgcn_readfirstlane(kdst+(slot)))
  #define DMA_V(t,slot) do{ glds16(vsrc+(long)(t)*KVBLK*VP,(unsigned)__builtin_amdgcn_readfirstlane(vdst+2*(slot))); glds16(vsrc+(long)(t)*KVBLK*VP+64,(unsigned)__builtin_amdgcn_readfirstlane(vdst+2*(slot)+8192)); }while(0)
  const int vb0=(int)(lds0+LDS_V128)+((lane>>4)&1)*32+(lane&3)*8+(4*hi+((lane&15)>>2))*64;
  const char*Kbase=shm+LDS_K; bf16x8 kf[8];
  const lds_cptr shm3=(lds_cptr)shm; const lds_cptr kp0=shm3+LDS_K+hi*1024+r32*16; const lds_cptr vp0=shm3+LDS_V128+((lane>>4)&1)*32+(lane&3)*8+(4*hi+((lane&15)>>2))*64;
  const int NT=(q0+QB)/KVBLK;
  if(!pre){ DMA_K(0,0);DMA_V(0,0);DMA_K(1,SLOTB);
    _Pragma("unroll") for(int d0=0;d0<4;++d0)qr[d0]=*reinterpret_cast<const bf16x8*>(&Qw[(long)r32*QP+d0*16+hi*8]); }
  float mhat=0.f,l_reg=0.f;f32x16 o[4];o[0]=f32x16{};o[1]=f32x16{};o[2]=f32x16{};o[3]=f32x16{};
  const int qrel=wid*QBLK+r32;
  #define CMASK(P0,P1,t) do{int jb_=(t)-(NT-4); if(jb_>=0)cmask(P0,P1,jb_,qrel,hi);}while(0)
  bool resc=false;
  #define START(P0,P1) do{ const float rm=rowmax(P0,P1); resc=false; \
    { const float dl=rm; mhat=fadd_s(mhat,dl); \
      _Pragma("unroll") for(int r=0;r<16;++r){P0[r]=fsub_s(P0[r],dl);P1[r]=fsub_s(P1[r],dl);} } \
    _Pragma("unroll") for(int r=0;r<16;++r)P0[r]=__builtin_amdgcn_exp2f(P0[r]); }while(0)
  #define RESC() do{ if(resc){ asm volatile("s_waitcnt lgkmcnt(0)":::"memory"); \
      _Pragma("unroll") for(int d_=0;d_<4;++d_) _Pragma("unroll") for(int r=0;r<16;++r)o[d_][r]*=wsf[crow(r,hi)]; } }while(0)
  f32x16 pA0,pA1;
  int sl_prev=0,sl_cur=0,sl_next=SLOTB;
  #define ROT() do{sl_prev=sl_cur;sl_cur=sl_next;sl_next=(sl_next==(NSLOT-1)*SLOTB)?0:sl_next+SLOTB;}while(0)
  DMA_K(2,2*SLOTB);
  WAIT_BAR(4);
  qkt(pA0,pA1,Kbase,qr,f32x16{},r32,hi);asm volatile("s_nop 15\n\ts_nop 7":"+v"(pA0),"+v"(pA1));CMASK(pA0,pA1,0);
  START(pA0,pA1);
  _Pragma("unroll") for(int r=0;r<16;++r)pA1[r]=__builtin_amdgcn_exp2f(pA1[r]);
  u32x4 pw0,pw1,pw2,pw3;
  { float sacc=pA0[0]+pA0[1]; _Pragma("unroll") for(int r=2;r<16;++r)sacc+=pA0[r]; _Pragma("unroll") for(int r=0;r<16;++r)sacc+=pA1[r]; l_reg+=sacc;
    pw0=(u32x4){cvtpk_s(pA0[0],pA0[1]),cvtpk_s(pA0[2],pA0[3]),cvtpk_s(pA0[4],pA0[5]),cvtpk_s(pA0[6],pA0[7])};pw1=(u32x4){cvtpk_s(pA0[8],pA0[9]),cvtpk_s(pA0[10],pA0[11]),cvtpk_s(pA0[12],pA0[13]),cvtpk_s(pA0[14],pA0[15])};
    pw2=(u32x4){cvtpk_s(pA1[0],pA1[1]),cvtpk_s(pA1[2],pA1[3]),cvtpk_s(pA1[4],pA1[5]),cvtpk_s(pA1[6],pA1[7])};pw3=(u32x4){cvtpk_s(pA1[8],pA1[9]),cvtpk_s(pA1[10],pA1[11]),cvtpk_s(pA1[12],pA1[13]),cvtpk_s(pA1[14],pA1[15])}; }
  WAIT_BAR(0);
  DMA_K(3,0);DMA_V(1,SLOTB);
  ROT();
  kload8(kf,kp0+sl_cur);
  WAIT_BAR(3);
  s16x4 vlo[4],vhi[4];
  #define PKW(P,B) cvtpk_s(P[B],P[B+1])
  #define PAF(k) __builtin_bit_cast(bf16x8,pw##k)
  #define VFR(i) (bf16x8){vlo[i][0],vlo[i][1],vlo[i][2],vlo[i][3],vhi[i][0],vhi[i][1],vhi[i][2],vhi[i][3]}
  #define PIN(x) asm volatile("":"+v"(x))
  #define MX3(a,b,c) __builtin_fmaxf(__builtin_fmaxf((a),(b)),(c))
  #define GAPA(MF,A0,A1,A2,A3,W0,W1,PW) do{ MF; sacc+=A0; sacc+=A1; sacc+=A2; sacc+=A3; PIN(sacc); W0; W1; PIN(PW); SBAR(); }while(0)
  #define EX(v) __builtin_amdgcn_exp2f(v)
  #define GAPB(MF,X,B) do{ MF; X[B]=EX(X[B]); X[B+1]=EX(X[B+1]); X[B+2]=EX(X[B+2]); X[B+3]=EX(X[B+3]); PIN(X); SBAR(); }while(0)
  #define VRD(j,ks) do{ vlo[j]=vtr(vp_+((j)*4096+(ks)*1024)); vhi[j]=vtr(vp_+((j)*4096+(ks)*1024+512)); }while(0)
  #define GAPV(MF,J,KS) do{ MF; VRD(J,KS); SBAR(); }while(0)
  #define GAPB2(MF,J,KS,X,B) do{ MF; VRD(J,KS); X[B]=EX(X[B]); X[B+1]=EX(X[B+1]); X[B+2]=EX(X[B+2]); X[B+3]=EX(X[B+3]); PIN(X); SBAR(); }while(0)
  #define GAPC(MF,A0,A1,A2,A3,W0,W1,PW) do{ MF; sacc+=A0; sacc+=A1; sacc+=A2; sacc+=A3; PIN(sacc); W0; W1; PIN(PW); SBAR(); }while(0)
  #define KRD(G,j) do{ if(G){ kload2(kf,kp0+sl_next,j); SBAR(); } }while(0)
  #define Z16 f32x16{}
  #define MF32(a,b,c) __builtin_amdgcn_mfma_f32_32x32x16_bf16((a),(b),(c),0,0,0)
  #define STEP(C0,C1,t,GK,GV,GL) do{ SBAR(); \
    const lds_cptr vp_=vp0+2*sl_prev; \
    C0=MF32(kf[0],qr[0],Z16); SBAR(); C1=MF32(kf[1],qr[0],Z16); SBAR(); C0=MF32(kf[2],qr[1],C0); SBAR(); C1=MF32(kf[3],qr[1],C1); SBAR(); \
    GAPV(C0=MF32(kf[4],qr[2],C0),0,0); GAPV(C1=MF32(kf[5],qr[2],C1),1,0); GAPV(C0=MF32(kf[6],qr[3],C0),2,0); GAPV(C1=MF32(kf[7],qr[3],C1),3,0); \
    if(GK){DMA_K((t)+3,sl_cur);} if(GV){DMA_V((t)+1,sl_next);} \
    C0=C0-mhat; C1=C1-mhat; \
    CMASK(C0,C1,t); \
    { float a=MX3(C0[0],C0[1],C1[0]),b=MX3(C0[2],C0[3],C1[1]); a=MX3(a,C1[2],C1[3]); \
      _Pragma("unroll") for(int r=4;r<16;r+=4){a=MX3(a,C0[r],C0[r+1]);b=MX3(b,C0[r+2],C0[r+3]);a=MX3(a,C1[r],C1[r+1]);b=MX3(b,C1[r+2],C1[r+3]);} \
      float rm=__builtin_fmaxf(a,b); { auto rr=__builtin_amdgcn_permlane32_swap(__float_as_uint(rm),__float_as_uint(rm),false,false); rm=__builtin_fmaxf(__uint_as_float(rr[0]),__uint_as_float(rr[1])); } \
      resc=false; \
      if(__builtin_expect(__any(rm>(float)THRL),0)){ const float dl=__builtin_fmaxf(rm,0.f); mhat+=dl; \
        _Pragma("unroll") for(int r=0;r<16;++r){C0[r]-=dl;C1[r]-=dl;} \
        const float f=__builtin_amdgcn_exp2f(-dl); l_reg*=f; if(hi==0)wsf[r32]=f; resc=true; } } \
    SBAR(); \
    GAPB2(o[0]=MF32(PAF(0),VFR(0),o[0]), 0,1, C0,0); \
    GAPB2(o[1]=MF32(PAF(0),VFR(1),o[1]), 1,1, C0,4); \
    GAPB2(o[2]=MF32(PAF(0),VFR(2),o[2]), 2,1, C0,8); \
    GAPB2(o[3]=MF32(PAF(0),VFR(3),o[3]), 3,1, C0,12); \
    GAPB2(o[0]=MF32(PAF(1),VFR(0),o[0]), 0,2, C1,0); \
    GAPB2(o[1]=MF32(PAF(1),VFR(1),o[1]), 1,2, C1,4); \
    GAPB2(o[2]=MF32(PAF(1),VFR(2),o[2]), 2,2, C1,8); \
    GAPB2(o[3]=MF32(PAF(1),VFR(3),o[3]), 3,2, C1,12); \
    float sacc=(C0[0]+C0[1]); \
    GAPC(o[0]=MF32(PAF(2),VFR(0),o[0]); VRD(0,3), C0[2],C0[3],C0[4],C0[5],     pw0[0]=PKW(C0,0), pw0[1]=PKW(C0,2), pw0); \
    GAPC(o[1]=MF32(PAF(2),VFR(1),o[1]); VRD(1,3), C0[6],C0[7],C0[8],C0[9],     pw0[2]=PKW(C0,4), pw0[3]=PKW(C0,6), pw0); \
    GAPC(o[2]=MF32(PAF(2),VFR(2),o[2]); VRD(2,3), C0[10],C0[11],C0[12],C0[13], pw1[0]=PKW(C0,8), pw1[1]=PKW(C0,10), pw1); \
    GAPC(o[3]=MF32(PAF(2),VFR(3),o[3]); VRD(3,3), C0[14],C0[15],C1[0],C1[1],   pw1[2]=PKW(C0,12),pw1[3]=PKW(C0,14), pw1); \
    KRD(GL,0); GAPC(o[0]=MF32(PAF(3),VFR(0),o[0]), C1[2],C1[3],C1[4],C1[5],     pw2[0]=PKW(C1,0), pw2[1]=PKW(C1,2), pw2); \
    KRD(GL,1); GAPC(o[1]=MF32(PAF(3),VFR(1),o[1]), C1[6],C1[7],C1[8],C1[9],     pw2[2]=PKW(C1,4), pw2[3]=PKW(C1,6), pw2); \
    KRD(GL,2); { o[2]=MF32(PAF(3),VFR(2),o[2]); sacc+=C1[10]; sacc+=C1[11]; sacc+=C1[12]; sacc+=C1[13]; PIN(sacc); SBAR(); } \
    KRD(GL,3); { o[3]=MF32(PAF(3),VFR(3),o[3]); sacc+=C1[14]; sacc+=C1[15]; PIN(sacc); SBAR(); } \
    pw3[0]=PKW(C1,8); pw3[1]=PKW(C1,10); pw3[2]=PKW(C1,12); pw3[3]=PKW(C1,14); \
    l_reg+=sacc; \
    }while(0)
  int t=1;
  #undef CMASK
  #define CMASK(P0,P1,t) do{}while(0)
  for(;t+5<NT;t+=2){
    STEP(pA0,pA1,t,true,true,true);     WAIT_BAR(3); RESC(); ROT();
    STEP(pA0,pA1,t+1,true,true,true);   WAIT_BAR(3); RESC(); ROT();
  }
  #undef CMASK
  #define CMASK(P0,P1,t) do{int jb_=(t)-(NT-4); if(jb_>=0)cmask(P0,P1,jb_,qrel,hi);}while(0)
  #define ENDW(tt) do{ if((tt)+3<NT){WAIT_BAR(3);} else if((tt)+2<NT){WAIT_BAR(2);} else {WAIT_BAR(0);} }while(0)
  for(;t+1<NT;t+=2){
    STEP(pA0,pA1,t,(t+3<NT),(t+1<NT),(t+1<NT));       ENDW(t);   RESC(); ROT();
    STEP(pA0,pA1,t+1,(t+4<NT),(t+2<NT),(t+2<NT));     ENDW(t+1); RESC(); ROT();
  }
  STEP(pA0,pA1,NT-1,false,false,false); RESC();
  { SBAR(); pv128(o,vb0+2*sl_cur,PAF(0),PAF(1),PAF(2),PAF(3)); }
  asm volatile("s_waitcnt lgkmcnt(0)\n\ts_barrier":::"memory");
  if(has_next){ int ln=lane; asm volatile("":"+v"(ln));
    const long nrow=(long)nb*SEQ; const bf16*nks=nK+nrow*KP+(long)ln*KP+wid*8; const bf16*nvs=nV+nrow*VP+(long)(16*(wid&3)+(ln>>2))*VP+(wid>>2)*32+(ln&3)*8;
    glds16(nks,(unsigned)__builtin_amdgcn_readfirstlane(kdst)); glds16(nvs,(unsigned)__builtin_amdgcn_readfirstlane(vdst)); glds16(nvs+64,(unsigned)__builtin_amdgcn_readfirstlane(vdst+8192));
    glds16(nks+(long)KVBLK*KP,(unsigned)__builtin_amdgcn_readfirstlane(kdst+SLOTB));
    const bf16*nQw=nQ+(nrow+nqb*QB+wid*QBLK)*QP;
    _Pragma("unroll") for(int d0=0;d0<4;++d0)qr[d0]=*reinterpret_cast<const bf16x8*>(&nQw[(long)(ln&31)*QP+d0*16+(ln>>5)*8]); }
  #undef PKW
  #undef PAF
  #undef VFR
  #undef PIN
  #undef MX3
  #undef GAPA
  #undef GAPB
  #undef GAPB2
  #undef GAPC
  #undef GAPV
  #undef Z16
  #undef MF32
  #undef EX
  #undef VRD
  #undef KRD
  #undef STEP
  #undef ENDW
  {auto rr=__builtin_amdgcn_permlane32_swap(__float_as_uint(l_reg),__float_as_uint(l_reg),false,false);l_reg=__uint_as_float(rr[0])+__uint_as_float(rr[1]);}
  if(hi==0)wsf[32+r32]=l_reg;asm volatile("s_waitcnt lgkmcnt(0)":::"memory");
  float rli[16];
  #pragma unroll
  for(int r=0;r<16;++r)rli[r]=__builtin_amdgcn_rcpf(wsf[32+crow(r,hi)]);
  bf16*Ow=O+(rowbase+q0+wid*QBLK)*OP;
  { bf16*stg=(bf16*)(shm+LDS_OST128)+wid*4096;
    #pragma unroll
    for(int r=0;r<16;++r){const int orow=crow(r,hi);
      #pragma unroll
      for(int d0=0;d0<4;++d0)stg[orow*128+d0*32+r32]=__float2bfloat16(o[d0][r]*rli[r]);}
    asm volatile("s_waitcnt lgkmcnt(0)":::"memory");
    #pragma unroll
    for(int i=0;i<8;++i){const int row=i*4+(lane>>4),ch=lane&15; const u32x4 v=*(const u32x4*)(stg+row*128+ch*8); ATTN_STORE16(Ow+(long)row*OP+ch*8,v);} }
  asm volatile("s_waitcnt lgkmcnt(0)":::"memory");
  #undef DMA_K
  #undef DMA_V
  #undef CMASK
  #undef START
  #undef RESC
  #undef ROT
}
constexpr int ATTN_LDS_BYTES=LDS_BYTES;
struct AttnUnit { int bh; int qb; };
#undef SBAR
#undef WAIT_BAR
}

#ifndef PROBE_PHASE
#define PROBE_PHASE (-1)
#endif

constexpr int NWAVES = 8;
constexpr int BATCH = 4, T = 4096, D = 1024, M = BATCH * T;
constexpr int NE = 32, FF = 512, NGRP = 4, EPG = 8;
constexpr int MAXROWS = 40960;
constexpr float RMS_EPS = 1e-6f, GN_EPS = 64e-5f, SUBLN_EPS = 1e-5f;
constexpr float LAMBDA_INIT1 = 0.35550906759f;

constexpr size_t MiB = 1u << 20;
constexpr size_t WS_CTL = 0, CTL_ZERO_BYTES = 1 * MiB;
constexpr size_t WS_MOD = 1 * MiB;
constexpr size_t WS_WRKV = 2 * MiB, WS_WL1 = 8 * MiB, WS_WL2 = 9 * MiB, WS_WO0 = 11 * MiB, WS_WQKV = 13 * MiB, WS_WO1 = 19 * MiB;
constexpr size_t WS_ROWTOK = 22 * MiB, WS_ROWGATE = 24 * MiB;
constexpr size_t WS_ROUTE = 21 * MiB;
constexpr size_t WS_MOEGU = 32 * MiB, WS_MOED = 96 * MiB;
constexpr size_t WS_XA = 128 * MiB;
constexpr size_t WS_R = 192 * MiB;
constexpr size_t WS_VIEWS = WS_R, WS_H2 = WS_R + 96 * MiB, WS_A2 = WS_R + 160 * MiB, WS_RKV = WS_R + 168 * MiB;
constexpr size_t WS_LOGW = 128 * MiB, WS_ASIG = WS_R + 264 * MiB, WS_GG = WS_R + 296 * MiB;
constexpr size_t WS_YG = WS_R + 264 * MiB;
constexpr size_t WS_H2N = WS_R, WS_XS = WS_R + 32 * MiB, WS_HS = WS_R + 112 * MiB, WS_Y = WS_R + 152 * MiB;
constexpr size_t WS_HQ = WS_R, WS_HK = WS_R + 32 * MiB, WS_QKV = WS_R + 64 * MiB, WS_OC = WS_R + 160 * MiB, WS_ON = WS_R + 224 * MiB;
constexpr size_t WS_QE = WS_R, WS_MCT = WS_R + 32 * MiB, WS_SC = WS_R + 64 * MiB, WS_Y0 = WS_R + 96 * MiB, WS_NC = WS_R + 128 * MiB, WS_RK = WS_R + 160 * MiB;
constexpr size_t WS_END = WS_R + 328 * MiB;
static_assert(WS_RKV + 96 * MiB <= WS_END && WS_Y + 80 * MiB <= WS_END && WS_ON + 32 * MiB <= WS_END, "d_ws map");
constexpr int CW_BAR = 4096;
constexpr int CW_TMO = 2;
constexpr int CW_RDY = 16384;
constexpr int CW_CNT = 8192;

constexpr int RING_OFF = 0, RING_BYTES = 131072;
constexpr int LDSCTL_OFF = 146944, MISC_OFF = LDSCTL_OFF + 320;
constexpr int LDS_BYTES = 147456;

#define GAS __attribute__((address_space(1)))
#define LAS __attribute__((address_space(3)))
typedef unsigned short bf16;
typedef unsigned v4u __attribute__((ext_vector_type(4)));
typedef unsigned v2u __attribute__((ext_vector_type(2)));
typedef float f32x4 __attribute__((ext_vector_type(4)));
typedef short bf16x8 __attribute__((ext_vector_type(8)));
typedef GAS unsigned gu32;
#define RLX_AGENT __ATOMIC_RELAXED, __HIP_MEMORY_SCOPE_AGENT
#define LDS_WAIT() asm volatile("s_waitcnt lgkmcnt(0)" ::: "memory")
#define VM_WAIT() asm volatile("s_waitcnt vmcnt(0)" ::: "memory")
__device__ __forceinline__ unsigned pk2(float lo, float hi) { return pg8::cvt_pk_bf16(lo, hi); }
__device__ __forceinline__ float bflo(unsigned w) { return __uint_as_float(w << 16); }
__device__ __forceinline__ float bfhi(unsigned w) { return __uint_as_float(w & 0xffff0000u); }

#define XB_TMO      128
#define XB_XCNT(j)  (256  + 64 * (j))
#define XB_XSUB(j)  (1280 + 64 * (j))
#define XB_XGEN(j)  (2304 + 64 * (j))
#define XB_TOP      3328
#define XB_TOPGEN   3392
#define XCD_BAR_WORDS 3456
#define XB_SPIN_CAP (1u << 18)

__device__ __forceinline__ unsigned xb_ld(unsigned* p)              { return __hip_atomic_load(p, __ATOMIC_RELAXED, __HIP_MEMORY_SCOPE_AGENT); }
__device__ __forceinline__ unsigned xb_add(unsigned* p, unsigned v) { return __hip_atomic_fetch_add(p, v, __ATOMIC_RELAXED, __HIP_MEMORY_SCOPE_AGENT); }
__device__ __forceinline__ unsigned xb_xcc_id() { return (unsigned)__builtin_amdgcn_s_getreg((3 << 11) | 20) & 0xFu; }
#define XB_SPIN(cond, bar) do { unsigned _sp = 0; while (cond) { __builtin_amdgcn_s_sleep(1); \
    if ((++_sp & 255u) == 0u) { if (xb_ld(&(bar)[XB_TMO])) break; if (_sp > XB_SPIN_CAP) { atomicAdd(&(bar)[XB_TMO], 1u); break; } } } } while (0)

__device__ __forceinline__ int xb_lane() { int l; asm volatile("v_mbcnt_lo_u32_b32 %0, -1, 0\n\tv_mbcnt_hi_u32_b32 %0, -1, %0" : "=v"(l)); return l; }
struct XcdBarrier {
    unsigned* bar; unsigned x; int wave;
    volatile LAS unsigned* st;
};

__device__ __forceinline__ XcdBarrier xcd_barrier_post(unsigned* bar, volatile LAS unsigned* st) {
    XcdBarrier b; b.bar = bar; b.x = xb_xcc_id(); b.st = st; b.wave = __builtin_amdgcn_readfirstlane(threadIdx.x >> 6);
    if (threadIdx.x == 0) (void)xb_add(&bar[XB_XCNT(b.x)], 1u);
    return b;
}
__device__ __forceinline__ void xcd_barrier_complete(unsigned* bar, unsigned x, unsigned& nloc, unsigned& nx) {
    const unsigned G = gridDim.x * gridDim.y * gridDim.z;
    unsigned sum, cnt, mine, sp = 0u;
    for (;;) {
        sum = 0u; cnt = 0u; mine = 0u;
#pragma unroll
        for (unsigned j = 0; j < 16; ++j) { const unsigned c = xb_ld(&bar[XB_XCNT(j)]); sum += c; cnt += (c > 0u) ? 1u : 0u; mine = (j == x) ? c : mine; }
        if (sum == G) break;
        __builtin_amdgcn_s_sleep(1);
        if ((++sp & 255u) == 0u) { if (xb_ld(&bar[XB_TMO])) break; if (sp > XB_SPIN_CAP) { atomicAdd(&bar[XB_TMO], 1u); break; } }
    }
    nloc = mine > 0u ? mine : 1u; nx = cnt > 0u ? cnt : 1u;
}

__device__ __forceinline__ void xcd_barrier(const XcdBarrier& b) {
    asm volatile("s_waitcnt vmcnt(0)" ::: "memory");
    __syncthreads();
    if (b.wave == 0 && xb_lane() == 0) {
        unsigned* bar = b.bar;
        __builtin_amdgcn_s_waitcnt(0);
        unsigned nloc = b.st[0], nx = b.st[1];
        if (nloc == 0u) { xcd_barrier_complete(bar, b.x, nloc, nx); b.st[0] = nloc; b.st[1] = nx; }
        const unsigned old = xb_add(&bar[XB_XSUB(b.x)], 1u);
        const unsigned gen = old / nloc;
        if (old + 1u == (gen + 1u) * nloc) {
            __builtin_amdgcn_fence(__ATOMIC_RELEASE, "agent");
            asm volatile("s_waitcnt vmcnt(0)" ::: "memory");
            const unsigned og = xb_add(&bar[XB_TOP], 1u);
            const unsigned tg = og / nx;
            if (og + 1u == (tg + 1u) * nx) xb_add(&bar[XB_TOPGEN], 1u);
            else XB_SPIN(xb_ld(&bar[XB_TOPGEN]) == tg, bar);
            __builtin_amdgcn_fence(__ATOMIC_ACQUIRE, "agent");
            xb_add(&bar[XB_XGEN(b.x)], 1u);
            asm volatile("s_waitcnt vmcnt(0)" ::: "memory");
        } else {
            XB_SPIN(xb_ld(&bar[XB_XGEN(b.x)]) == gen, bar);
            __builtin_amdgcn_fence(__ATOMIC_ACQUIRE, "agent");
            asm volatile("s_waitcnt vmcnt(0)" ::: "memory");
        }
    }
    __syncthreads();
}


struct Frame {
    LAS unsigned char* lds;
    volatile LAS unsigned* MISC;
    gu32* ctl;
    unsigned char* ws;
    const float* const* in;
    float* out;
    int tid, lane, wave, vcu, G;
};
__device__ __forceinline__ int lane_id() { int l; asm volatile("v_mbcnt_lo_u32_b32 %0, -1, 0\n\tv_mbcnt_hi_u32_b32 %0, -1, %0" : "=v"(l)); return l; }
__device__ __forceinline__ float wave_sum(float v) {
#pragma unroll
    for (int o = 1; o < 64; o <<= 1) v += __shfl_xor(v, o);
    return v;
}
__device__ __forceinline__ void titem_load(float (&tv)[32], const float* W, int ldw, int k0, int n0, int lane) {
    const float* base = W + (size_t)k0 * ldw + n0; const unsigned loff = (unsigned)((lane >> 3) * ldw + 4 * (lane & 7));
#pragma unroll
    for (int i = 0; i < 8; ++i) { const f32x4 q = *(const f32x4*)(base + (size_t)(8 * i) * ldw + loff); tv[4 * i] = q.x; tv[4 * i + 1] = q.y; tv[4 * i + 2] = q.z; tv[4 * i + 3] = q.w; }
}
__device__ __forceinline__ void titem_store(const float (&tv)[32], int k0, bf16* WT, int ldo, int orow0, int ok0, const float* kscale, LAS float* scr, int lane) {
#pragma unroll
    for (int i = 0; i < 32; ++i) { const int kk = 8 * (i >> 2) + (lane >> 3); float v = tv[i]; if (kscale) v *= kscale[k0 + kk]; scr[kk * 33 + 4 * (lane & 7) + (i & 3)] = v; }
    LDS_WAIT(); asm volatile("" ::: "memory");
    const int c = lane & 7;
#pragma unroll
    for (int j = 0; j < 4; ++j) { const int n = (lane >> 3) + 8 * j; const LAS float* s = scr + (8 * c) * 33 + n;
        v4u o; o.x = pk2(s[0 * 33], s[1 * 33]); o.y = pk2(s[2 * 33], s[3 * 33]); o.z = pk2(s[4 * 33], s[5 * 33]); o.w = pk2(s[6 * 33], s[7 * 33]);
        *(GAS v4u*)(WT + (size_t)(orow0 + n) * ldo + ok0 + k0 + 8 * c) = o; }
    LDS_WAIT(); asm volatile("" ::: "memory");
}
__device__ __forceinline__ void transpose_item(const float* W, int ldw, int k0, int n0, bf16* WT, int ldo, int orow0, int ok0, const float* kscale, LAS float* scr, int lane) {
    float tv[32]; titem_load(tv, W, ldw, k0, n0, lane); titem_store(tv, k0, WT, ldo, orow0, ok0, kscale, scr, lane);
}
__device__ __forceinline__ void transpose_mat(Frame& F, const float* W, int K, int N, bf16* WT, int ldo, int row_off, int ok0, const float* kscale, int gw, int NGW) {
    LAS float* scr = (LAS float*)(F.lds + RING_OFF + F.wave * 16384);
    const int nblk = N / 32, items = (K / 64) * nblk;
    for (int it = gw; it < items; it += NGW) { const int kb = it / nblk, nb = it % nblk; transpose_item(W, N, 64 * kb, 32 * nb, WT, ldo, row_off + 32 * nb, ok0, kscale, scr, F.lane); }
}

__device__ __forceinline__ void p0_mod(Frame& F) {
    LAS float* cact = (LAS float*)(F.lds + RING_OFF);
    LAS float* red = cact + 4096;
    const float* c = F.in[1];
    { float cv[8];
#pragma unroll
      for (int i = 0; i < 8; ++i) cv[i] = c[F.tid + 512 * i];
#pragma unroll
      for (int i = 0; i < 8; ++i) cact[F.tid + 512 * i] = cv[i] / (1.0f + __expf(-cv[i])); }
    __syncthreads();
    float* modbase = (float*)(F.ws + WS_MOD);
    for (int it = blockIdx.x; it < 224; it += F.G) {
        const float* W; const float* bias; float* outp; int N, cc;
        if (it < 96) { W = F.in[2]; bias = F.in[3]; outp = modbase; N = 6144; cc = it; }
        else if (it < 192) { W = F.in[2] + (size_t)1024 * 6144; bias = F.in[3] + 6144; outp = modbase + 4 * 6144; N = 6144; cc = it - 96; }
        else { W = F.in[22]; bias = F.in[23]; outp = modbase + 8 * 6144; N = 2048; cc = it - 192; }
        const int kg = F.tid >> 4, cq = F.tid & 15, col = cc * 64 + cq * 4;
        f32x4 a0 = {0, 0, 0, 0}, a1 = a0, a2 = a0, a3 = a0;
#pragma unroll 16
        for (int kk = 0; kk < 32; ++kk) { const int k = kg * 32 + kk; const f32x4 w = *(const f32x4*)(W + (size_t)k * N + col);
            a0 += w * cact[k]; a1 += w * cact[1024 + k]; a2 += w * cact[2048 + k]; a3 += w * cact[3072 + k]; }
        LAS f32x4* rp = (LAS f32x4*)red + (kg * 16 + cq) * 4;
        rp[0] = a0; rp[1] = a1; rp[2] = a2; rp[3] = a3;
        __syncthreads();
        if (F.tid < 256) { const int b = F.tid >> 6, cl = F.tid & 63, cq2 = cl >> 2, j = cl & 3; float s = 0.f;
            for (int g = 0; g < 32; ++g) s += red[((g * 16 + cq2) * 4 + b) * 4 + j];
            outp[(size_t)b * N + cc * 64 + cl] = s + bias[cc * 64 + cl]; }
        __syncthreads();
    }
}
__device__ __forceinline__ void p0_weights(Frame& F) {
    const int gw = F.vcu * NWAVES + F.wave, NGW = F.G * NWAVES;
    bf16* Wrkv = (bf16*)(F.ws + WS_WRKV); bf16* Wl1 = (bf16*)(F.ws + WS_WL1); bf16* Wl2 = (bf16*)(F.ws + WS_WL2);
    bf16* Wo0 = (bf16*)(F.ws + WS_WO0); bf16* Wqkv = (bf16*)(F.ws + WS_WQKV); bf16* Wo1 = (bf16*)(F.ws + WS_WO1);
    LAS float* scr = (LAS float*)(F.lds + RING_OFF + F.wave * 16384);
    const float* mu = F.in[6];
    constexpr int NI = 1536 + 512 + 512 + 1024 + 512 + 256;
    for (int it = gw; it < NI; it += NGW) {
        const float* W; int N; bf16* WT; int ldo, row_off, ok0; const float* ksc = nullptr; int r = it;
        if (r < 1536) { const int z = r / 512; r -= z * 512; W = F.in[7] + (size_t)z * D * D; N = D; WT = Wrkv + (size_t)z * D * D; ldo = D; row_off = 0; ok0 = 0; }
        else if ((r -= 1536) < 512) { W = F.in[21]; N = D; WT = Wo0; ldo = D; row_off = 0; ok0 = 0; }
        else if ((r -= 512) < 512) { W = F.in[26]; N = D; WT = Wqkv; ldo = D; row_off = 0; ok0 = 0; }
        else if ((r -= 512) < 1024) { W = F.in[25]; N = 2 * D; WT = Wqkv; ldo = D; row_off = D; ok0 = 0; }
        else if ((r -= 1024) < 512) { W = F.in[32]; N = D; WT = Wo1; ldo = D; row_off = 0; ok0 = 0; }
        else { r -= 512; WT = Wl1; ldo = 2048;
            int half;
            if (r < 64) { W = F.in[9]; N = 64; row_off = 0; half = r >> 5; r &= 31; if (half) ksc = mu + 3 * D; }
            else if (r < 128) { r -= 64; W = F.in[12]; N = 64; row_off = 64; half = r >> 5; r &= 31; if (half) ksc = mu + 4 * D; }
            else { r -= 128; W = F.in[14]; N = 128; row_off = 128; half = r >> 6; r &= 63; if (half) ksc = mu + 5 * D; }
            ok0 = half ? 1024 : 0; }
        const int nblk = N / 32, kb = r / nblk, nb = r % nblk;
        transpose_item(W, N, 64 * kb, 32 * nb, WT, ldo, row_off + 32 * nb, ok0, ksc, scr, F.lane);
    }
    const float* w2 = F.in[10]; const float* a2 = F.in[13]; const float* g2 = F.in[15];
    for (int item = (blockIdx.x * 512 + F.tid); item < 3072 * 32; item += F.G * 512) {
        const int nr = item % 3072, k0 = (item / 3072) * 8; float v[8];
        const int n = (nr & ~31) + pg8::perm32(nr & 31);
#pragma unroll
        for (int e = 0; e < 8; ++e) { const int k = k0 + e; float x = 0.f;
            if (n < 1024) { if (k < 64) x = w2[(size_t)k * 1024 + n]; }
            else if (n < 2048) { if (k >= 64 && k < 128) x = a2[(size_t)(k - 64) * 1024 + (n - 1024)]; }
            else { if (k >= 128) x = g2[(size_t)(k - 128) * 1024 + (n - 2048)]; }
            v[e] = x; }
        v4u o; o.x = pk2(v[0], v[1]); o.y = pk2(v[2], v[3]); o.z = pk2(v[4], v[5]); o.w = pk2(v[6], v[7]);
        *(v4u*)(Wl2 + (size_t)nr * 256 + k0) = o;
    }
}
struct MoeItem { const float* W; int ldw, k0, n0; bf16* WT; int ldo, orow0; };
__device__ __forceinline__ MoeItem moe_item(Frame& F, int l, int it) {
    bf16* GU = (bf16*)(F.ws + WS_MOEGU); bf16* DW = (bf16*)(F.ws + WS_MOED);
    const float* wg = F.in[35] + (size_t)l * NE * D * FF; const float* wu = F.in[36] + (size_t)l * NE * D * FF; const float* wd = F.in[37] + (size_t)l * NE * FF * D;
    const int e = it / 768, r = it % 768; MoeItem m;
    if (r < 512) { const int up = r >> 8, q = r & 255, kb = q >> 4, nb = q & 15, n0 = 32 * nb;
        m.W = (up ? wu : wg) + (size_t)e * D * FF; m.ldw = FF; m.k0 = 64 * kb; m.n0 = n0; m.WT = GU + (size_t)e * 1024 * 1024; m.ldo = 1024; m.orow0 = 256 * (n0 >> 7) + (n0 & 127) + (up ? 128 : 0); }
    else { const int q = r - 512, kb = q >> 5, nb = q & 31;
        m.W = wd + (size_t)e * FF * D; m.ldw = D; m.k0 = 64 * kb; m.n0 = 32 * nb; m.WT = DW + (size_t)e * 1024 * 512; m.ldo = 512; m.orow0 = 32 * nb; }
    return m;
}
__device__ __forceinline__ void moe_weights(Frame& F, int l) {
    const int gw = F.vcu * NWAVES + F.wave, NGW = F.G * NWAVES;
    LAS float* scr = (LAS float*)(F.lds + RING_OFF + F.wave * 16384);
    bf16* GU = (bf16*)(F.ws + WS_MOEGU); bf16* DW = (bf16*)(F.ws + WS_MOED);
    const float* wg = F.in[35] + (size_t)l * NE * D * FF; const float* wu = F.in[36] + (size_t)l * NE * D * FF; const float* wd = F.in[37] + (size_t)l * NE * FF * D;
    for (int it = gw; it < NE * 768; it += NGW) {
        const int e = it / 768, r = it % 768;
        if (r < 512) { const int up = r >> 8, q = r & 255, kb = q >> 4, nb = q & 15, n0 = 32 * nb;
            const float* W = (up ? wu : wg) + (size_t)e * D * FF;
            transpose_item(W, FF, 64 * kb, n0, GU + (size_t)e * 1024 * 1024, 1024, 256 * (n0 >> 7) + (n0 & 127) + (up ? 128 : 0), 0, nullptr, scr, F.lane); }
        else { const int q = r - 512, kb = q >> 5, nb = q & 31;
            transpose_item(wd + (size_t)e * FF * D, D, 64 * kb, 32 * nb, DW + (size_t)e * 1024 * 512, 512, 32 * nb, 0, nullptr, scr, F.lane); }
    }
}

__device__ __forceinline__ void p1_norm_views(Frame& F) {
    LAS float* hrow = (LAS float*)(F.lds + RING_OFF);
    const float* x = F.in[0]; const float* g = F.in[4]; const float* mu = F.in[6];
    const float* mod = (const float*)(F.ws + WS_MOD);
    bf16* views = (bf16*)(F.ws + WS_VIEWS); bf16* H2 = (bf16*)(F.ws + WS_H2);
    f32x4 muv[3][4];
#pragma unroll
    for (int i = 0; i < 3; ++i)
#pragma unroll
        for (int j = 0; j < 4; ++j) muv[i][j] = *(const f32x4*)(mu + i * D + 4 * F.lane + 256 * j);
    f32x4 xn[4];
    { const int grp0 = blockIdx.x; if (grp0 < M / 8) { const f32x4* xr = (const f32x4*)(x + (size_t)(grp0 * 8 + F.wave) * D) + F.lane;
#pragma unroll
        for (int j = 0; j < 4; ++j) xn[j] = xr[64 * j]; } }
    for (int grp = blockIdx.x; grp < M / 8; grp += F.G) {
        const int m0 = grp * 8, b = m0 / T, t0 = m0 % T;
        const float* sh = mod + (size_t)b * 6144; const float* sc = sh + 1024;
        f32x4 hv[4], xc[4];
#pragma unroll
        for (int j = 0; j < 4; ++j) xc[j] = xn[j];
        if (grp + F.G < M / 8) { const f32x4* xr = (const f32x4*)(x + (size_t)((grp + F.G) * 8 + F.wave) * D) + F.lane;
#pragma unroll
            for (int j = 0; j < 4; ++j) xn[j] = xr[64 * j]; }
        __builtin_amdgcn_sched_barrier(0);
        for (int pass = 0; pass < 2; ++pass) {
            if (pass == 1 && F.wave != 0) break;
            f32x4 v[4];
            if (pass == 1 && t0 == 0) {
#pragma unroll
                for (int j = 0; j < 4; ++j) v[j] = (f32x4){0.f, 0.f, 0.f, 0.f};
            } else {
                float ss = 0.f;
                if (pass == 0) {
#pragma unroll
                    for (int j = 0; j < 4; ++j) v[j] = xc[j];
                } else { const f32x4* xr = (const f32x4*)(x + (size_t)(m0 - 1) * D) + F.lane;
#pragma unroll
                    for (int j = 0; j < 4; ++j) v[j] = xr[64 * j]; }
#pragma unroll
                for (int j = 0; j < 4; ++j) ss += (v[j].x * v[j].x + v[j].y * v[j].y) + (v[j].z * v[j].z + v[j].w * v[j].w);
                const float rstd = 1.0f / sqrtf(wave_sum(ss) * (1.f / D) + RMS_EPS);
#pragma unroll
                for (int j = 0; j < 4; ++j) { const int c = 4 * F.lane + 256 * j; const f32x4 gg = *(const f32x4*)(g + c), s1 = *(const f32x4*)(sc + c), s0 = *(const f32x4*)(sh + c);
                    v[j] = v[j] * rstd * gg * (s1 + 1.0f) + s0; }
            }
            LAS f32x4* hp = (LAS f32x4*)(hrow + ((pass == 0) ? (F.wave + 1) : 0) * 1024) + F.lane;
#pragma unroll
            for (int j = 0; j < 4; ++j) { hp[64 * j] = v[j]; if (pass == 0) hv[j] = v[j]; }
        }
        __syncthreads();
        {
            const int row = m0 + F.wave;
            const LAS f32x4* pp = (const LAS f32x4*)(hrow + F.wave * 1024) + F.lane;
#pragma unroll
            for (int j = 0; j < 4; ++j) { const int c = 4 * F.lane + 256 * j; const f32x4 xx = pp[64 * j] - hv[j];
#pragma unroll
                for (int i = 0; i < 3; ++i) { const f32x4 mm = muv[i][j]; const f32x4 o = hv[j] + xx * mm;
                    v2u w; w.x = pk2(o.x, o.y); w.y = pk2(o.z, o.w); *(v2u*)(views + ((size_t)i * M + row) * D + c) = w; }
                v2u w; w.x = pk2(hv[j].x, hv[j].y); w.y = pk2(hv[j].z, hv[j].w); *(v2u*)(H2 + (size_t)row * 2048 + c) = w;
                w.x = pk2(xx.x, xx.y); w.y = pk2(xx.z, xx.w); *(v2u*)(H2 + (size_t)row * 2048 + 1024 + c) = w; }
        }
        __syncthreads();
    }
}

__device__ __forceinline__ void p4_scan_seq(Frame& F) {
    constexpr int TS = 32;
    LAS float* sA = (LAS float*)(F.lds + RING_OFF);
    LAS float* sW = sA + TS * 64; LAS float* sB = sW + TS * 64; LAS float* sK = sB + TS * 64; LAS float* sR = sK + TS * 64; LAS float* sV = sR + TS * 64;
    LAS float* sY = sV + TS * 64; LAS float* sRK = sY + TS * 64;
    const bf16* Rb = (const bf16*)(F.ws + WS_RKV); const bf16* Kb = Rb + (size_t)M * D; const bf16* Vb = Kb + (size_t)M * D;
    const float* LW = (const float*)(F.ws + WS_LOGW); const bf16* AS = (const bf16*)(F.ws + WS_ASIG); const bf16* GG = (const bf16*)(F.ws + WS_GG);
    bf16* YG = (bf16*)(F.ws + WS_YG);
    const float* k_k = F.in[16]; const float* k_a = F.in[17]; const float* r_k = F.in[18]; const float* gn_g = F.in[19]; const float* gn_b = F.in[20];
    for (int bh = blockIdx.x; bh < BATCH * 16; bh += F.G) {
        const int b = bh >> 4, h = bh & 15;
        const int i = F.tid >> 3, q = F.tid & 7;
        const int st = F.tid >> 4, d4 = (F.tid & 15) * 4;
        const int cg = h * 64 + d4;
        const f32x4 kkv = *(const f32x4*)(k_k + cg), kav = *(const f32x4*)(k_a + cg), rkv = *(const f32x4*)(r_k + cg), gng = *(const f32x4*)(gn_g + cg), gnb = *(const f32x4*)(gn_b + cg);
        float s[8];
#pragma unroll
        for (int j = 0; j < 8; ++j) s[j] = 0.f;
        for (int t0 = 0; t0 < T; t0 += TS) {
            const size_t ro = ((size_t)b * T + t0 + st) * D + cg;
            {
                const v2u rr = *(const v2u*)(Rb + ro), kk2 = *(const v2u*)(Kb + ro), vv = *(const v2u*)(Vb + ro), aa = *(const v2u*)(AS + ro); const f32x4 lw = *(const f32x4*)(LW + ro);
                const f32x4 r4 = {bflo(rr.x), bfhi(rr.x), bflo(rr.y), bfhi(rr.y)}, k4 = {bflo(kk2.x), bfhi(kk2.x), bflo(kk2.y), bfhi(kk2.y)};
                const f32x4 v4 = {bflo(vv.x), bfhi(vv.x), bflo(vv.y), bfhi(vv.y)}, a4 = {bflo(aa.x), bfhi(aa.x), bflo(aa.y), bfhi(aa.y)};
                const f32x4 kr = k4 * kkv; float ss = (kr.x * kr.x + kr.y * kr.y) + (kr.z * kr.z + kr.w * kr.w);
                ss += __shfl_xor(ss, 1); ss += __shfl_xor(ss, 2); ss += __shfl_xor(ss, 4); ss += __shfl_xor(ss, 8);
                const float inv = 1.0f / fmaxf(sqrtf(ss), 1e-12f);
                const f32x4 kkn = kr * inv; const f32x4 km = k4 * ((a4 - 1.0f) * kav + 1.0f);
                const f32x4 rk4 = r4 * km * rkv; float rs = (rk4.x + rk4.y) + (rk4.z + rk4.w);
                rs += __shfl_xor(rs, 1); rs += __shfl_xor(rs, 2); rs += __shfl_xor(rs, 4); rs += __shfl_xor(rs, 8);
                f32x4 wv; wv.x = __expf(lw.x); wv.y = __expf(lw.y); wv.z = __expf(lw.z); wv.w = __expf(lw.w);
                *(LAS f32x4*)(sA + st * 64 + d4) = -kkn; *(LAS f32x4*)(sW + st * 64 + d4) = wv; *(LAS f32x4*)(sB + st * 64 + d4) = kkn * a4;
                *(LAS f32x4*)(sK + st * 64 + d4) = km; *(LAS f32x4*)(sR + st * 64 + d4) = r4; *(LAS f32x4*)(sV + st * 64 + d4) = v4;
                if ((F.tid & 15) == 0) sRK[st] = rs;
            }
            __syncthreads();
            for (int t = 0; t < TS; ++t) {
                const LAS f32x4* pa = (const LAS f32x4*)(sA + t * 64 + q * 8); const LAS f32x4* pw = (const LAS f32x4*)(sW + t * 64 + q * 8); const LAS f32x4* pb = (const LAS f32x4*)(sB + t * 64 + q * 8);
                const LAS f32x4* pk = (const LAS f32x4*)(sK + t * 64 + q * 8); const LAS f32x4* pr = (const LAS f32x4*)(sR + t * 64 + q * 8);
                const f32x4 a0 = pa[0], a1 = pa[1], w0 = pw[0], w1 = pw[1], b0 = pb[0], b1 = pb[1], k0 = pk[0], k1 = pk[1], r0 = pr[0], r1 = pr[1];
                const float vi = sV[t * 64 + i];
                float sa = (s[0] * a0.x + s[1] * a0.y) + (s[2] * a0.z + s[3] * a0.w) + (s[4] * a1.x + s[5] * a1.y) + (s[6] * a1.z + s[7] * a1.w);
                sa += __shfl_xor(sa, 1); sa += __shfl_xor(sa, 2); sa += __shfl_xor(sa, 4);
                s[0] = s[0] * w0.x + sa * b0.x + vi * k0.x; s[1] = s[1] * w0.y + sa * b0.y + vi * k0.y; s[2] = s[2] * w0.z + sa * b0.z + vi * k0.z; s[3] = s[3] * w0.w + sa * b0.w + vi * k0.w;
                s[4] = s[4] * w1.x + sa * b1.x + vi * k1.x; s[5] = s[5] * w1.y + sa * b1.y + vi * k1.y; s[6] = s[6] * w1.z + sa * b1.z + vi * k1.z; s[7] = s[7] * w1.w + sa * b1.w + vi * k1.w;
                float y = (s[0] * r0.x + s[1] * r0.y) + (s[2] * r0.z + s[3] * r0.w) + (s[4] * r1.x + s[5] * r1.y) + (s[6] * r1.z + s[7] * r1.w);
                y += __shfl_xor(y, 1); y += __shfl_xor(y, 2); y += __shfl_xor(y, 4);
                if (q == 0) sY[t * 64 + i] = y;
            }
            __syncthreads();
            {
                const f32x4 y4 = *(const LAS f32x4*)(sY + st * 64 + d4); const f32x4 v4 = *(const LAS f32x4*)(sV + st * 64 + d4);
                float sm = (y4.x + y4.y) + (y4.z + y4.w);
                sm += __shfl_xor(sm, 1); sm += __shfl_xor(sm, 2); sm += __shfl_xor(sm, 4); sm += __shfl_xor(sm, 8);
                const float mean = sm * (1.f / 64.f); const f32x4 dv = y4 - mean;
                float vs = (dv.x * dv.x + dv.y * dv.y) + (dv.z * dv.z + dv.w * dv.w);
                vs += __shfl_xor(vs, 1); vs += __shfl_xor(vs, 2); vs += __shfl_xor(vs, 4); vs += __shfl_xor(vs, 8);
                const float rstd = 1.0f / sqrtf(vs * (1.f / 64.f) + GN_EPS);
                const v2u gg = *(const v2u*)(GG + ro); const f32x4 g4 = {bflo(gg.x), bfhi(gg.x), bflo(gg.y), bfhi(gg.y)};
                const f32x4 o = (dv * rstd * gng + gnb + v4 * sRK[st]) * g4;
                v2u w; w.x = pk2(o.x, o.y); w.y = pk2(o.z, o.w); *(v2u*)(YG + ro) = w;
            }
            __syncthreads();
        }
    }
}

constexpr int RT_HS = 1028;
__device__ __forceinline__ void moe_router(Frame& F, int l, const float* xin, int cnt_off) {
    const float* g = F.in[5] + (size_t)l * D; const float* wrg = F.in[33] + (size_t)l * D * NGRP; const float* wre = F.in[34] + (size_t)l * D * NE;
    const float* mod = (const float*)(F.ws + WS_MOD) + (size_t)l * 4 * 6144;
    bf16* H2N = (bf16*)(F.ws + WS_H2N);
    int* asg_e = (int*)(F.ws + WS_ROUTE); int* asg_pos = asg_e + 2 * M; int* rowtok = (int*)(F.ws + WS_ROWTOK); float* rowgate = (float*)(F.ws + WS_ROWGATE);
    unsigned* cnt = (unsigned*)F.ctl + CW_CNT + 64 * l + cnt_off;
    LAS float* hs = (LAS float*)(F.lds + RING_OFF);
    LAS float* part = hs + 16 * RT_HS;
    LAS float* lgs = part + 8 * 768;
    const int lane = F.lane, w = F.wave, n16 = lane & 15, g4 = lane >> 4;
    float wreg[3][32];
    {   const int kb = 128 * w + 32 * g4;
        const float* pg = wrg + (size_t)kb * 4 + (n16 & 3); const float* pe0 = wre + (size_t)kb * 32 + ((n16 + 28) & 31); const float* pe1 = wre + (size_t)kb * 32 + 12 + n16; const float* pe2 = wre + (size_t)kb * 32 + 28 + (n16 & 3);
#pragma unroll
        for (int ks = 0; ks < 32; ++ks) { const float a = pg[ks * 4], bq = pe0[ks * 32], cq = pe2[ks * 32];
            wreg[0][ks] = (n16 < 4) ? a : bq; wreg[1][ks] = pe1[ks * 32]; wreg[2][ks] = (n16 < 4) ? cq : 0.f; } }
    const int ti_n = (M / 16 - (int)blockIdx.x + F.G - 1) / F.G;
    f32x4 xv[2][4];
#pragma unroll
    for (int rr = 0; rr < 2; ++rr) { const f32x4* xr = (const f32x4*)(xin + (size_t)(blockIdx.x * 16 + 2 * w + rr) * D) + lane;
#pragma unroll
        for (int j = 0; j < 4; ++j) xv[rr][j] = (ti_n > 0) ? xr[64 * j] : (f32x4){0.f, 0.f, 0.f, 0.f}; }
    for (int ti = 0; ti < ti_n; ++ti) { const int tile = blockIdx.x + ti * F.G;
#pragma unroll
        for (int rr = 0; rr < 2; ++rr) { const int rl = 2 * w + rr, row = tile * 16 + rl;
            const int b = row / T; const float* sh = mod + (size_t)b * 6144 + 3072; const float* sc = sh + 1024;
            f32x4 v[4]; float ss = 0.f;
#pragma unroll
            for (int j = 0; j < 4; ++j) { v[j] = xv[rr][j]; ss += (v[j].x * v[j].x + v[j].y * v[j].y) + (v[j].z * v[j].z + v[j].w * v[j].w); }
            const float rstd = 1.0f / sqrtf(wave_sum(ss) * (1.f / D) + RMS_EPS);
            f32x4 ga[4], gb[4];
#pragma unroll
            for (int j = 0; j < 4; ++j) { const int c = 4 * lane + 256 * j; ga[j] = *(const f32x4*)(g + c) * (*(const f32x4*)(sc + c) + 1.0f); gb[j] = *(const f32x4*)(sh + c); }
#pragma unroll
            for (int j = 0; j < 4; ++j) { const int c = 4 * lane + 256 * j;
                v[j] = v[j] * rstd * ga[j] + gb[j];
                v2u wv; wv.x = pk2(v[j].x, v[j].y); wv.y = pk2(v[j].z, v[j].w); *(v2u*)(H2N + (size_t)row * D + c) = wv;
                *(LAS f32x4*)(hs + rl * RT_HS + c) = v[j]; } }
        if (ti + 1 < ti_n) {
#pragma unroll
            for (int rr = 0; rr < 2; ++rr) { const f32x4* xr = (const f32x4*)(xin + (size_t)((tile + F.G) * 16 + 2 * w + rr) * D) + lane;
#pragma unroll
                for (int j = 0; j < 4; ++j) xv[rr][j] = xr[64 * j]; } }
        __syncthreads();
        f32x4 acc[3];
#pragma unroll
        for (int nt = 0; nt < 3; ++nt) acc[nt] = (f32x4){0.f, 0.f, 0.f, 0.f};
#pragma unroll
        for (int q = 0; q < 8; ++q) { const f32x4 a4 = *(const LAS f32x4*)(hs + n16 * RT_HS + 128 * w + 32 * g4 + 4 * q);
#pragma unroll
            for (int e = 0; e < 4; ++e)
#pragma unroll
                for (int nt = 0; nt < 3; ++nt) acc[nt] = __builtin_amdgcn_mfma_f32_16x16x4f32(a4[e], wreg[nt][4 * q + e], acc[nt], 0, 0, 0); }
#pragma unroll
        for (int nt = 0; nt < 3; ++nt)
#pragma unroll
            for (int reg = 0; reg < 4; ++reg) part[(w * 16 + 4 * g4 + reg) * 48 + 16 * nt + n16] = acc[nt][reg];
        __syncthreads();
        for (int o = F.tid; o < 768; o += 512) { float s = 0.f;
#pragma unroll
            for (int ww = 0; ww < 8; ++ww) s += part[ww * 768 + o];
            lgs[ti * 768 + o] = s; }
    }
    __syncthreads();
    LAS unsigned* lcnt = (LAS unsigned*)(lgs + 8 * 768);
    if (F.tid < 64) lcnt[F.tid] = 0u;
    __syncthreads();
    const int nrow = 16 * ti_n;
    int ea0 = 0, eb0 = 0, ea1 = 0, eb1 = 0; unsigned pa0 = 0, pb0 = 0, pa1 = 0, pb1 = 0; float ga0 = 0.f, gb0 = 0.f, ga1 = 0.f, gb1 = 0.f;
#pragma unroll
    for (int it = 0; it < 2; ++it) { const int rloc = F.tid + it * 512 * 0 + it * 64;
        if (F.tid < 64 && rloc < nrow) {
            float lg[36];
#pragma unroll
            for (int q = 0; q < 9; ++q) { const f32x4 pv = *(const LAS f32x4*)(lgs + rloc * 48 + 4 * q); lg[4 * q] = pv.x; lg[4 * q + 1] = pv.y; lg[4 * q + 2] = pv.z; lg[4 * q + 3] = pv.w; }
            int gi = 0; float gm = lg[0];
#pragma unroll
            for (int j = 1; j < 4; ++j) if (lg[j] > gm) { gm = lg[j]; gi = j; }
            float gs = 0.f;
#pragma unroll
            for (int j = 0; j < 4; ++j) gs += __expf(lg[j] - gm);
            const float ggate = 1.0f / gs;
            float el[8];
#pragma unroll
            for (int j = 0; j < 8; ++j) el[j] = (gi == 0) ? lg[4 + j] : (gi == 1) ? lg[12 + j] : (gi == 2) ? lg[20 + j] : lg[28 + j];
            int i1 = 0; float v1 = el[0];
#pragma unroll
            for (int j = 1; j < 8; ++j) if (el[j] > v1) { v1 = el[j]; i1 = j; }
            int i2 = -1; float v2 = -INFINITY;
#pragma unroll
            for (int j = 0; j < 8; ++j) if (j != i1 && el[j] > v2) { v2 = el[j]; i2 = j; }
            if (i2 < 0) i2 = (i1 == 0) ? 1 : 0;
            const float e2 = __expf(v2 - v1), p1 = 1.0f / (1.0f + e2), p2 = e2 * p1;
            const int ea = gi * 8 + i1, eb = gi * 8 + i2;
            const unsigned pa = __hip_atomic_fetch_add(lcnt + ea, 1u, __ATOMIC_RELAXED, __HIP_MEMORY_SCOPE_WORKGROUP), pb = __hip_atomic_fetch_add(lcnt + eb, 1u, __ATOMIC_RELAXED, __HIP_MEMORY_SCOPE_WORKGROUP);
            if (it == 0) { ea0 = ea; eb0 = eb; pa0 = pa; pb0 = pb; ga0 = ggate * p1; gb0 = ggate * p2; } else { ea1 = ea; eb1 = eb; pa1 = pa; pb1 = pb; ga1 = ggate * p1; gb1 = ggate * p2; }
        } }
    __syncthreads();
    if (F.tid < 32) { const unsigned n = lcnt[F.tid]; lcnt[32 + F.tid] = n ? atomicAdd(cnt + F.tid, n) : 0u; }
    __syncthreads();
#pragma unroll
    for (int it = 0; it < 2; ++it) { const int rloc = F.tid + it * 64;
        if (F.tid < 64 && rloc < nrow) { const int row = (blockIdx.x + (rloc >> 4) * F.G) * 16 + (rloc & 15);
            const int ea = it ? ea1 : ea0, eb = it ? eb1 : eb0; const unsigned pa = it ? pa1 : pa0, pb = it ? pb1 : pb0;
            const int qa = (int)(lcnt[32 + ea] + pa), qb = (int)(lcnt[32 + eb] + pb);
            asg_e[2 * row] = ea; asg_e[2 * row + 1] = eb; asg_pos[2 * row] = qa; asg_pos[2 * row + 1] = qb;
            rowtok[(size_t)ea * pg8::MOE_CAP + qa] = row; rowtok[(size_t)eb * pg8::MOE_CAP + qb] = row; rowgate[(size_t)ea * pg8::MOE_CAP + qa] = it ? ga1 : ga0; rowgate[(size_t)eb * pg8::MOE_CAP + qb] = it ? gb1 : gb0; } }
    __syncthreads();
}
__device__ __forceinline__ void moe_toff(Frame& F, int l) {
    LAS int* toff = (LAS int*)(F.lds + LDSCTL_OFF);
    if (F.wave == 0) { const unsigned* cnt = (const unsigned*)F.ctl + CW_CNT + 64 * l; const int lane = F.lane;
        const int n = (lane < 32) ? (int)__hip_atomic_load(cnt + lane, RLX_AGENT) : 0; const int tl = (n + 255) >> 8; int inc = tl;
#pragma unroll
        for (int o = 1; o < 32; o <<= 1) { const int v = __shfl_up(inc, o); if (lane >= o) inc += v; }
        if (lane < 32) { toff[lane] = inc - tl; toff[40 + lane] = n; }
        if (lane == 31) toff[32] = inc; }
    __syncthreads();
}
struct CombRow { f32x4 x[4]; v2u y0[4], y1[4]; };
__device__ __forceinline__ void comb_load(CombRow& r, const float* xin, const bf16* Y, const int* asg_e, const int* asg_pos, const LAS int* toff, int row, int lane) {
    const int r0 = toff[asg_e[2 * row]] * 256 + asg_pos[2 * row], r1 = toff[asg_e[2 * row + 1]] * 256 + asg_pos[2 * row + 1];
    const f32x4* xr = (const f32x4*)(xin + (size_t)row * D) + lane;
#pragma unroll
    for (int j = 0; j < 4; ++j) { const int c = 4 * lane + 256 * j; r.x[j] = xr[64 * j]; r.y0[j] = *(const v2u*)(Y + (size_t)r0 * D + c); r.y1[j] = *(const v2u*)(Y + (size_t)r1 * D + c); }
}
template <int MODE> __device__ __forceinline__ void moe_combine(Frame& F, int l, const float* xin, float* xout) {
    moe_toff(F, l);
    const bf16* Y = (const bf16*)(F.ws + WS_Y);
    const int* asg_e = (const int*)(F.ws + WS_ROUTE); const int* asg_pos = asg_e + 2 * M; const LAS int* toff = (const LAS int*)(F.lds + LDSCTL_OFF);
    const float* mod = (const float*)(F.ws + WS_MOD) + (size_t)l * 4 * 6144;
    const float* mod1 = (const float*)(F.ws + WS_MOD) + (size_t)4 * 6144;
    const float* modkv = (const float*)(F.ws + WS_MOD) + (size_t)8 * 6144;
    const float* gq = F.in[4] + D; const float* gkv = F.in[24]; const float* gfin = F.in[38];
    bf16* HQ = (bf16*)(F.ws + WS_HQ); bf16* HK = (bf16*)(F.ws + WS_HK);
    const int gw = blockIdx.x * NWAVES + F.wave, NGW = F.G * NWAVES;
    const int RPW = (M + NGW - 1) / NGW, rbeg = gw * RPW, rend = (rbeg + RPW < M) ? rbeg + RPW : M;
    CombRow cur, nxt;
    if (rbeg < rend) comb_load(cur, xin, Y, asg_e, asg_pos, toff, rbeg, F.lane);
    f32x4 gfv[4], aq[4], bq[4], ak[4], bk[4]; int bcur = -1;
    for (int row = rbeg; row < rend; ++row) {
        if (row + 1 < rend) comb_load(nxt, xin, Y, asg_e, asg_pos, toff, row + 1, F.lane);
        __builtin_amdgcn_sched_barrier(0);
        const int b = row / T;
        if (b != bcur) { bcur = b; const float* gf = mod + (size_t)b * 6144 + 5120;
            const float* shq = mod1 + (size_t)b * 6144; const float* scq = shq + 1024; const float* shk = modkv + (size_t)b * 2048; const float* sck = shk + 1024;
#pragma unroll
            for (int j = 0; j < 4; ++j) { const int c = 4 * F.lane + 256 * j; gfv[j] = *(const f32x4*)(gf + c);
                if (MODE == 0) { aq[j] = *(const f32x4*)(gq + c) * (*(const f32x4*)(scq + c) + 1.0f); bq[j] = *(const f32x4*)(shq + c); ak[j] = *(const f32x4*)(gkv + c) * (*(const f32x4*)(sck + c) + 1.0f); bk[j] = *(const f32x4*)(shk + c); }
                else { aq[j] = *(const f32x4*)(gfin + c); } } }
        f32x4 v[4]; float ss = 0.f;
#pragma unroll
        for (int j = 0; j < 4; ++j) { const v2u y0 = cur.y0[j], y1 = cur.y1[j];
            const f32x4 ys = {bflo(y0.x) + bflo(y1.x), bfhi(y0.x) + bfhi(y1.x), bflo(y0.y) + bflo(y1.y), bfhi(y0.y) + bfhi(y1.y)};
            v[j] = cur.x[j] + gfv[j] * ys; ss += (v[j].x * v[j].x + v[j].y * v[j].y) + (v[j].z * v[j].z + v[j].w * v[j].w); }
        const float rstd = 1.0f / sqrtf(wave_sum(ss) * (1.f / D) + RMS_EPS);
        if (MODE == 0) {
#pragma unroll
            for (int j = 0; j < 4; ++j) { const int c = 4 * F.lane + 256 * j;
                *((f32x4*)(xout + (size_t)row * D) + F.lane + 64 * j) = v[j];
                const f32x4 n = v[j] * rstd; const f32x4 hq = n * aq[j] + bq[j], hk = n * ak[j] + bk[j];
                v2u w; w.x = pk2(hq.x, hq.y); w.y = pk2(hq.z, hq.w); *(v2u*)(HQ + (size_t)row * D + c) = w;
                w.x = pk2(hk.x, hk.y); w.y = pk2(hk.z, hk.w); *(v2u*)(HK + (size_t)row * D + c) = w; }
        } else {
#pragma unroll
            for (int j = 0; j < 4; ++j) *((f32x4*)(xout + (size_t)row * D) + F.lane + 64 * j) = v[j] * rstd * aq[j];
        }
        __builtin_amdgcn_sched_barrier(0);
        cur = nxt;
    }
}
__device__ __forceinline__ void attn_subln_rows(Frame& F, size_t row0, int h) {
    const bf16* OC = (const bf16*)(F.ws + WS_OC); bf16* ON = (bf16*)(F.ws + WS_ON);
    asm volatile("s_waitcnt vmcnt(0)" ::: "memory");
    const int lane = lane_id(), q4 = lane & 3;
    const float l1 = wave_sum(F.in[27][lane] * F.in[28][lane]), l2 = wave_sum(F.in[29][lane] * F.in[30][lane]);
    const float lam = __expf(l1) - __expf(l2) + LAMBDA_INIT1;
    const float* sg = F.in[31] + q4 * 32;
    v4u oa[2][4], ob[2][4]; f32x4 sgv[8];
#pragma unroll
    for (int ps = 0; ps < 2; ++ps) { const size_t row = row0 + ps * 16 + (lane >> 2);
        const v4u* p0 = (const v4u*)(OC + row * 2048 + h * 256 + q4 * 32); const v4u* p1 = (const v4u*)(OC + row * 2048 + h * 256 + 128 + q4 * 32);
#pragma unroll
        for (int q = 0; q < 4; ++q) { oa[ps][q] = p0[q]; ob[ps][q] = p1[q]; } }
#pragma unroll
    for (int q = 0; q < 8; ++q) sgv[q] = *(const f32x4*)(sg + 4 * q);
#pragma unroll
    for (int ps = 0; ps < 2; ++ps) { const size_t row = row0 + ps * 16 + (lane >> 2);
        float d[32]; float ss = 0.f;
#pragma unroll
        for (int q = 0; q < 4; ++q) { const v4u a = oa[ps][q], bq = ob[ps][q]; const unsigned aw[4] = {a.x, a.y, a.z, a.w}, bw[4] = {bq.x, bq.y, bq.z, bq.w};
#pragma unroll
            for (int e = 0; e < 4; ++e) { d[8 * q + 2 * e] = bflo(aw[e]) - lam * bflo(bw[e]); d[8 * q + 2 * e + 1] = bfhi(aw[e]) - lam * bfhi(bw[e]); } }
#pragma unroll
        for (int e = 0; e < 32; ++e) ss += d[e] * d[e];
        ss += __shfl_xor(ss, 1); ss += __shfl_xor(ss, 2);
        const float rstd = (1.0f - LAMBDA_INIT1) / sqrtf(ss * (1.f / 128.f) + SUBLN_EPS);
        v4u* op = (v4u*)(ON + row * D + h * 128 + q4 * 32);
#pragma unroll
        for (int q = 0; q < 4; ++q) { const f32x4 g0 = sgv[2 * q], g1 = sgv[2 * q + 1];
            v4u w; w.x = pk2(d[8 * q] * rstd * g0.x, d[8 * q + 1] * rstd * g0.y); w.y = pk2(d[8 * q + 2] * rstd * g0.z, d[8 * q + 3] * rstd * g0.w);
            w.z = pk2(d[8 * q + 4] * rstd * g1.x, d[8 * q + 5] * rstd * g1.y); w.w = pk2(d[8 * q + 6] * rstd * g1.z, d[8 * q + 7] * rstd * g1.w); op[q] = w; } }
}
struct AttnOrder {
    int vcu;
    __device__ __forceinline__ explicit AttnOrder(int grid, int block) : vcu((block % 8) * (grid / 8) + block / 8) {}
    __device__ __forceinline__ bool next(int i, attn_body::AttnUnit& u) const { if (i >= 8) return false; const int s = 2 * (i >> 1) + (vcu & 1); u.bh = vcu >> 1; u.qb = (i & 1) ? s : 15 - s; return true; }
    __device__ __forceinline__ void a_ready(const attn_body::AttnUnit&) const {}
    __device__ __forceinline__ void done(const attn_body::AttnUnit&) const {}
};

typedef float f32x16 __attribute__((ext_vector_type(16)));
typedef float f32x2_t __attribute__((ext_vector_type(2))); typedef __bf16 bf16x2_t __attribute__((ext_vector_type(2)));
__device__ __forceinline__ unsigned cvtpk(float lo, float hi) { f32x2_t v = {lo, hi}; bf16x2_t b = __builtin_convertvector(v, bf16x2_t); return __builtin_bit_cast(unsigned, b); }
#define MMA32(a, b, c) __builtin_amdgcn_mfma_f32_32x32x16_bf16((a), (b), (c), 0, 0, 0)
constexpr int SC_TS = 72, SC_TB = 64 * SC_TS * 2;
constexpr int SL_A = 0, SL_B = 1, SL_K = 2, SL_R = 3, SL_BH = 4, SL_KH = 5, SL_VT = 6, SL_ARB = 7, SL_ARK = 8;
constexpr int SC_RHS = 9 * SC_TB;
constexpr int SC_XT0 = SC_RHS + 32768, SC_XT1 = SC_XT0 + SC_TB;
constexpr int SC_GEND = SC_XT1 + SC_TB;
constexpr int SC_AD = 1 * SC_TB, SC_ADS = 20;
constexpr int SC_TBB = SC_AD + 4 * 16 * SC_ADS * 4;
constexpr int SC_LBUF = 7 * SC_TB, SC_SEG = SC_LBUF + 16384;
static_assert(SC_GEND + 256 <= LDSCTL_OFF && SC_SEG + 2048 <= 9 * SC_TB && SC_TBB + 2048 <= 2 * SC_TB, "scan LDS map");

__device__ __forceinline__ void tile_mma2(f32x16 (&acc)[2], const LAS unsigned char* TA, const LAS unsigned char* TBp, int mt, int r32, int hi) {
#pragma unroll
    for (int ks = 0; ks < 4; ++ks) {
        const bf16x8 a = *(const LAS bf16x8*)(TA + ((32 * mt + r32) * SC_TS + 16 * ks + 8 * hi) * 2);
        const bf16x8 b0 = *(const LAS bf16x8*)(TBp + ((r32) * SC_TS + 16 * ks + 8 * hi) * 2);
        const bf16x8 b1 = *(const LAS bf16x8*)(TBp + ((32 + r32) * SC_TS + 16 * ks + 8 * hi) * 2);
        acc[0] = MMA32(a, b0, acc[0]); acc[1] = MMA32(a, b1, acc[1]);
    }
}
struct TrF { v2u f[4][2]; };
__device__ __forceinline__ void tr_load(TrF& o, const LAS unsigned char* N, int c, int lane) {
    const unsigned a = (unsigned)(uintptr_t)N + (unsigned)(((8 * (lane >> 5) + ((lane & 15) >> 2)) * SC_TS + 32 * c + 16 * ((lane >> 4) & 1) + 4 * (lane & 3)) * 2);
    asm volatile("ds_read_b64_tr_b16 %0, %8\n\tds_read_b64_tr_b16 %1, %8 offset:576\n\tds_read_b64_tr_b16 %2, %8 offset:2304\n\tds_read_b64_tr_b16 %3, %8 offset:2880\n\t"
                 "ds_read_b64_tr_b16 %4, %8 offset:4608\n\tds_read_b64_tr_b16 %5, %8 offset:5184\n\tds_read_b64_tr_b16 %6, %8 offset:6912\n\tds_read_b64_tr_b16 %7, %8 offset:7488\n\ts_waitcnt lgkmcnt(0)"
                 : "=&v"(o.f[0][0]), "=&v"(o.f[0][1]), "=&v"(o.f[1][0]), "=&v"(o.f[1][1]), "=&v"(o.f[2][0]), "=&v"(o.f[2][1]), "=&v"(o.f[3][0]), "=&v"(o.f[3][1]) : "v"(a) : "memory");
}
static_assert(SC_TS * 2 * 4 == 576 && SC_TS * 2 * 16 == 2304, "tr_load offsets");
__device__ __forceinline__ void tr_issue(TrF& o, const LAS unsigned char* N, int c, int lane) {
    const unsigned a = (unsigned)(uintptr_t)N + (unsigned)(((8 * (lane >> 5) + ((lane & 15) >> 2)) * SC_TS + 32 * c + 16 * ((lane >> 4) & 1) + 4 * (lane & 3)) * 2);
    asm volatile("ds_read_b64_tr_b16 %0, %8\n\tds_read_b64_tr_b16 %1, %8 offset:576\n\tds_read_b64_tr_b16 %2, %8 offset:2304\n\tds_read_b64_tr_b16 %3, %8 offset:2880\n\t"
                 "ds_read_b64_tr_b16 %4, %8 offset:4608\n\tds_read_b64_tr_b16 %5, %8 offset:5184\n\tds_read_b64_tr_b16 %6, %8 offset:6912\n\tds_read_b64_tr_b16 %7, %8 offset:7488"
                 : "=&v"(o.f[0][0]), "=&v"(o.f[0][1]), "=&v"(o.f[1][0]), "=&v"(o.f[1][1]), "=&v"(o.f[2][0]), "=&v"(o.f[2][1]), "=&v"(o.f[3][0]), "=&v"(o.f[3][1]) : "v"(a) : "memory");
}
__device__ __forceinline__ void tr_wait(TrF& o) {
    asm volatile("s_waitcnt lgkmcnt(0)" : "+v"(o.f[0][0]), "+v"(o.f[0][1]), "+v"(o.f[1][0]), "+v"(o.f[1][1]), "+v"(o.f[2][0]), "+v"(o.f[2][1]), "+v"(o.f[3][0]), "+v"(o.f[3][1]) :: "memory");
}
__device__ __forceinline__ bf16x8 tr_get(const TrF& o, int ks) { const v4u q = {o.f[ks][0].x, o.f[ks][0].y, o.f[ks][1].x, o.f[ks][1].y}; return __builtin_bit_cast(bf16x8, q); }
template <bool TRA, bool TRB> __device__ __forceinline__ void tile_mma2t(f32x16 (&acc)[2], const LAS unsigned char* TA, const LAS unsigned char* TBp, int mt, int r32, int hi, int lane) {
    TrF fa, fb0, fb1;
    if constexpr (TRA) tr_issue(fa, TA, mt, lane);
    if constexpr (TRB) { tr_issue(fb0, TBp, 0, lane); tr_issue(fb1, TBp, 1, lane); }
    if constexpr (TRA) tr_wait(fa);
    if constexpr (TRB) { tr_wait(fb0); tr_wait(fb1); }
#pragma unroll
    for (int ks = 0; ks < 4; ++ks) {
        bf16x8 a, b0, b1;
        if constexpr (TRA) a = tr_get(fa, ks); else a = *(const LAS bf16x8*)(TA + ((32 * mt + r32) * SC_TS + 16 * ks + 8 * hi) * 2);
        if constexpr (TRB) { b0 = tr_get(fb0, ks); b1 = tr_get(fb1, ks); }
        else { b0 = *(const LAS bf16x8*)(TBp + ((r32) * SC_TS + 16 * ks + 8 * hi) * 2); b1 = *(const LAS bf16x8*)(TBp + ((32 + r32) * SC_TS + 16 * ks + 8 * hi) * 2); }
        acc[0] = MMA32(a, b0, acc[0]); acc[1] = MMA32(a, b1, acc[1]);
    }
}
typedef _Float16 f16x8 __attribute__((ext_vector_type(8)));
constexpr int SC_LWT = SC_RHS + 2 * 8448;
static_assert(SC_LWT + SC_TB <= SC_RHS + 32768 && SL_KH == 5 && SL_VT == 6 && SL_ARK == 8, "scan LDS map (copy tiles)");
constexpr int SC_TRIL = SC_GEND + 256;
static_assert(SC_TRIL + SC_TB <= LDSCTL_OFF, "scan LDS map (tril)");
template <int S> __device__ __forceinline__ float bcast16(float x) { const int xi = __builtin_bit_cast(int, x); return __builtin_bit_cast(float, __builtin_amdgcn_update_dpp(xi, xi, 0x150 + S, 0xf, 0xf, true)); }
template <int S> __device__ __forceinline__ void inv_step(float (&tt)[16], const float (&ar)[16], int cc) {
    float a = (S == cc) ? 1.0f : 0.0f;
#pragma unroll
    for (int j = 0; j < S; ++j) a += bcast16<S>(ar[j]) * tt[j];
    tt[S] = a;
}
#define P4REP(k) for (int rep_ = 0; rep_ < ((PROBE_PHASE == (k)) ? 2 : 1); ++rep_)
__device__ __forceinline__ void p4a_chunks(Frame& F) {
    LAS unsigned char* L = F.lds + RING_OFF;
    const bf16* Rb = (const bf16*)(F.ws + WS_RKV); const bf16* Kb = Rb + (size_t)M * D; const bf16* Vb = Kb + (size_t)M * D;
    const _Float16* LW = (const _Float16*)(F.ws + WS_LOGW);     const bf16* AS = (const bf16*)(F.ws + WS_ASIG);
    bf16* QE = (bf16*)(F.ws + WS_QE); bf16* MCT = (bf16*)(F.ws + WS_MCT); bf16* NC = (bf16*)(F.ws + WS_NC); bf16* Y0 = (bf16*)(F.ws + WS_Y0); float* RK = (float*)(F.ws + WS_RK);
    const float* k_k = F.in[16]; const float* k_a = F.in[17]; const float* r_k = F.in[18];
    const int tid = F.tid, lane = F.lane, w = F.wave, r32 = lane & 31, hi = lane >> 5;
    const int t0_ = tid >> 3, d80_ = (tid & 7) * 8;
    LAS float* Lbuf = (LAS float*)(L + SC_LBUF); LAS float* Seg = (LAS float*)(L + SC_SEG); LAS float* RHS = (LAS float*)(L + SC_RHS); LAS float* Gend = (LAS float*)(L + SC_GEND);
    LAS float* AD = (LAS float*)(L + SC_AD);
    v4u nr8, nk8, nv8, na8, nlw;
#define P4A_LOAD(CU) do { const int bh_ = (CU) >> 6, c_ = (CU) & 63; const size_t ro_ = ((size_t)(bh_ >> 4) * T + c_ * 64 + t) * D + (bh_ & 15) * 64 + d8; \
        nr8 = *(const v4u*)(Rb + ro_); nk8 = *(const v4u*)(Kb + ro_); nv8 = *(const v4u*)(Vb + ro_); na8 = *(const v4u*)(AS + ro_); nlw = *(const v4u*)(LW + ro_); } while (0)
    { const int t = t0_, d8 = d80_; if ((int)blockIdx.x < BATCH * 16 * 64) P4A_LOAD(blockIdx.x); }
    { v4u o; const int t = t0_, k8 = d80_;
#define TRILW(j) (((k8 + 2 * (j) <= t) ? 0x3C00u : 0u) | ((k8 + 2 * (j) + 1 <= t) ? 0x3C000000u : 0u))
      o.x = TRILW(0); o.y = TRILW(1); o.z = TRILW(2); o.w = TRILW(3); *(LAS v4u*)(L + SC_TRIL + (t * SC_TS + k8) * 2) = o; }
#undef TRILW
    float tv[32]; int un = 0;
    for (int cu = blockIdx.x; cu < BATCH * 16 * 64; cu += F.G, ++un) {
        const int bh = cu >> 6, c = cu & 63, b = bh >> 4, h = bh & 15; (void)b; (void)c;
        const int mit = (un * F.G + (int)blockIdx.x) * NWAVES + w;
        int t = t0_, d8 = d80_; asm volatile("" : "+v"(t), "+v"(d8));
        const v4u r8 = nr8, k8 = nk8, v8 = nv8, a8 = na8, lwraw = nlw;
        f32x4 lw0, lw1; { typedef _Float16 h2_t __attribute__((ext_vector_type(2))); const unsigned u0 = nlw.x, u1 = nlw.y, u2 = nlw.z, u3 = nlw.w;
            const h2_t q0 = __builtin_bit_cast(h2_t, u0), q1 = __builtin_bit_cast(h2_t, u1), q2 = __builtin_bit_cast(h2_t, u2), q3 = __builtin_bit_cast(h2_t, u3);
            lw0 = (f32x4){(float)q0.x, (float)q0.y, (float)q1.x, (float)q1.y}; lw1 = (f32x4){(float)q2.x, (float)q2.y, (float)q3.x, (float)q3.y}; }
        const f32x4 kk0 = *(const f32x4*)(k_k + h * 64 + d8), kk1 = *(const f32x4*)(k_k + h * 64 + d8 + 4), ka0 = *(const f32x4*)(k_a + h * 64 + d8), ka1 = *(const f32x4*)(k_a + h * 64 + d8 + 4);
        const f32x4 rk0 = *(const f32x4*)(r_k + h * 64 + d8), rk1 = *(const f32x4*)(r_k + h * 64 + d8 + 4);
        P4REP(401) {
        *(LAS v4u*)(L + SC_LWT + (t * SC_TS + d8) * 2) = lwraw;
        __syncthreads();
        if (w < 4) {
            const int mt = w >> 1, nt = w & 1; TrF fb; tr_load(fb, L + SC_LWT, nt, lane);
            f32x16 cs;
#pragma unroll
            for (int i = 0; i < 16; ++i) cs[i] = 0.f;
#pragma unroll
            for (int ks = 0; ks < 4; ++ks) { if (ks < 2 || mt == 1) {
                const v4u af = *(const LAS v4u*)(L + SC_TRIL + ((32 * mt + r32) * SC_TS + 16 * ks + 8 * hi) * 2); const v4u bq = {fb.f[ks][0].x, fb.f[ks][0].y, fb.f[ks][1].x, fb.f[ks][1].y};
                cs = __builtin_amdgcn_mfma_f32_32x32x16_f16(__builtin_bit_cast(f16x8, af), __builtin_bit_cast(f16x8, bq), cs, 0, 0, 0); } }
#pragma unroll
            for (int i = 0; i < 16; ++i) Lbuf[(32 * mt + (i & 3) + 8 * (i >> 2) + 4 * hi) * 64 + 32 * nt + r32] = cs[i];
        }
        __syncthreads();
        {
            float Lt[8], Le[8];
            { const f32x4 p0 = *(const LAS f32x4*)(Lbuf + t * 64 + d8), p1 = *(const LAS f32x4*)(Lbuf + t * 64 + d8 + 4), q0 = *(const LAS f32x4*)(Lbuf + 63 * 64 + d8), q1 = *(const LAS f32x4*)(Lbuf + 63 * 64 + d8 + 4);
              Lt[0] = p0.x; Lt[1] = p0.y; Lt[2] = p0.z; Lt[3] = p0.w; Lt[4] = p1.x; Lt[5] = p1.y; Lt[6] = p1.z; Lt[7] = p1.w;
              Le[0] = q0.x; Le[1] = q0.y; Le[2] = q0.z; Le[3] = q0.w; Le[4] = q1.x; Le[5] = q1.y; Le[6] = q1.z; Le[7] = q1.w; }
            const float lwv[8] = {lw0.x, lw0.y, lw0.z, lw0.w, lw1.x, lw1.y, lw1.z, lw1.w};
            const unsigned rw[4] = {r8.x, r8.y, r8.z, r8.w}, kw[4] = {k8.x, k8.y, k8.z, k8.w}, vw[4] = {v8.x, v8.y, v8.z, v8.w}, aw[4] = {a8.x, a8.y, a8.z, a8.w};
            float rr[8], kk[8], vv[8], aa[8];
#pragma unroll
            for (int e = 0; e < 4; ++e) { rr[2 * e] = bflo(rw[e]); rr[2 * e + 1] = bfhi(rw[e]); kk[2 * e] = bflo(kw[e]); kk[2 * e + 1] = bfhi(kw[e]);
                vv[2 * e] = bflo(vw[e]); vv[2 * e + 1] = bfhi(vw[e]); aa[2 * e] = bflo(aw[e]); aa[2 * e + 1] = bfhi(aw[e]); }
            const float kkv[8] = {kk0.x, kk0.y, kk0.z, kk0.w, kk1.x, kk1.y, kk1.z, kk1.w}, kav[8] = {ka0.x, ka0.y, ka0.z, ka0.w, ka1.x, ka1.y, ka1.z, ka1.w}, rkv[8] = {rk0.x, rk0.y, rk0.z, rk0.w, rk1.x, rk1.y, rk1.z, rk1.w};
            float kr[8], ss = 0.f, rs = 0.f, km[8];
#pragma unroll
            for (int e = 0; e < 8; ++e) { kr[e] = kk[e] * kkv[e]; ss += kr[e] * kr[e]; km[e] = kk[e] * (1.0f + (aa[e] - 1.0f) * kav[e]); rs += rr[e] * km[e] * rkv[e]; }
            ss += __shfl_xor(ss, 1); ss += __shfl_xor(ss, 2); ss += __shfl_xor(ss, 4);
            rs += __shfl_xor(rs, 1); rs += __shfl_xor(rs, 2); rs += __shfl_xor(rs, 4);
            const float inv = 1.0f / fmaxf(sqrtf(ss), 1e-12f);
            if ((tid & 7) == 0) RK[(size_t)cu * 64 + t] = rs;
            float At[8], Bt[8], Kt[8], Rt[8], Bh[8], Kh[8];
#pragma unroll
            for (int e = 0; e < 8; ++e) { const float kn = kr[e] * inv, av = -kn, bv = kn * aa[e];
                const float g = __builtin_amdgcn_exp2f(Lt[e]), gi = __builtin_amdgcn_exp2f(-Lt[e]), gp = __builtin_amdgcn_exp2f(Lt[e] - lwv[e]), ge = __builtin_amdgcn_exp2f(Le[e] - Lt[e]);
                At[e] = av * gp; Bt[e] = bv * gi; Kt[e] = km[e] * gi; Rt[e] = rr[e] * g; Bh[e] = bv * ge; Kh[e] = km[e] * ge;
                if (t == 63) Gend[d8 + e] = g; }
            const int ob = (t * SC_TS + d8) * 2;
            { v4u o; o.x = cvtpk(At[0], At[1]); o.y = cvtpk(At[2], At[3]); o.z = cvtpk(At[4], At[5]); o.w = cvtpk(At[6], At[7]); *(LAS v4u*)(L + SL_A * SC_TB + ob) = o; }
            { v4u o; o.x = cvtpk(Bt[0], Bt[1]); o.y = cvtpk(Bt[2], Bt[3]); o.z = cvtpk(Bt[4], Bt[5]); o.w = cvtpk(Bt[6], Bt[7]); *(LAS v4u*)(L + SL_B * SC_TB + ob) = o; }
            { v4u o; o.x = cvtpk(Kt[0], Kt[1]); o.y = cvtpk(Kt[2], Kt[3]); o.z = cvtpk(Kt[4], Kt[5]); o.w = cvtpk(Kt[6], Kt[7]); *(LAS v4u*)(L + SL_K * SC_TB + ob) = o; }
            { v4u o; o.x = cvtpk(Rt[0], Rt[1]); o.y = cvtpk(Rt[2], Rt[3]); o.z = cvtpk(Rt[4], Rt[5]); o.w = cvtpk(Rt[6], Rt[7]); *(LAS v4u*)(L + SL_R * SC_TB + ob) = o; }
            *(LAS f32x4*)(RHS + t * 128 + d8) = (f32x4){At[0], At[1], At[2], At[3]}; *(LAS f32x4*)(RHS + t * 128 + d8 + 4) = (f32x4){At[4], At[5], At[6], At[7]};
            { v4u o; o.x = cvtpk(Bh[0], Bh[1]); o.y = cvtpk(Bh[2], Bh[3]); o.z = cvtpk(Bh[4], Bh[5]); o.w = cvtpk(Bh[6], Bh[7]); *(LAS v4u*)(L + SL_BH * SC_TB + ob) = o; }
            { v4u o; o.x = cvtpk(Kh[0], Kh[1]); o.y = cvtpk(Kh[2], Kh[3]); o.z = cvtpk(Kh[4], Kh[5]); o.w = cvtpk(Kh[6], Kh[7]); *(LAS v4u*)(L + SL_KH * SC_TB + ob) = o; }
            *(LAS v4u*)(L + SL_VT * SC_TB + ob) = v8;
        }
        if (rep_ == 0 && PROBE_PHASE == 401) __syncthreads();
        }
        if (cu + F.G < BATCH * 16 * 64) P4A_LOAD(cu + F.G);
        if (mit < NE * 768) { const MoeItem mi = moe_item(F, 0, mit); titem_load(tv, mi.W, mi.ldw, mi.k0, mi.n0, lane); }
        __syncthreads();
        const int p = w >> 1, mt = w & 1;
        f32x16 acc[2];
        P4REP(402) {
        if (rep_ == 1) __syncthreads();
#pragma unroll
        for (int i = 0; i < 16; ++i) { acc[0][i] = 0.f; acc[1][i] = 0.f; }
        tile_mma2(acc, L + ((p & 1) ? SL_K : SL_B) * SC_TB, L + ((p & 2) ? SL_R : SL_A) * SC_TB, mt, r32, hi);
        __syncthreads();
#pragma unroll
        for (int nt = 0; nt < 2; ++nt) { const int s = 32 * nt + r32;
#pragma unroll
            for (int rg = 0; rg < 4; ++rg) { const int j0 = 32 * mt + 8 * rg + 4 * hi; float v[4];
#pragma unroll
                for (int e = 0; e < 4; ++e) { const bool keep = (p < 2) ? (j0 + e < s) : (j0 + e <= s); v[e] = keep ? acc[nt][4 * rg + e] : 0.f; }
                if (p == 0 && (s >> 4) == (j0 >> 4)) *(LAS f32x4*)(AD + ((s >> 4) * 16 + (s & 15)) * SC_ADS + (j0 & 15)) = (f32x4){v[0], v[1], v[2], v[3]};
                { v2u o; o.x = cvtpk(v[0], v[1]); o.y = cvtpk(v[2], v[3]); *(LAS v2u*)(L + ((p == 0) ? SL_A : (p == 1) ? SL_K : (p == 2) ? SL_ARB : SL_ARK) * SC_TB + (s * SC_TS + j0) * 2) = o; } } }
        }
        __syncthreads();
        P4REP(403) {
#pragma unroll
        for (int i = 0; i < 16; ++i) { acc[0][i] = 0.f; acc[1][i] = 0.f; }
        if (w < 2) {
            tile_mma2t<false, true>(acc, L + SL_K * SC_TB, L + SL_VT * SC_TB, w & 1, r32, hi, lane);
#pragma unroll
            for (int nt = 0; nt < 2; ++nt)
#pragma unroll
                for (int reg = 0; reg < 16; ++reg) RHS[(32 * (w & 1) + (reg & 3) + 8 * (reg >> 2) + 4 * hi) * 128 + 64 + 32 * nt + r32] = acc[nt][reg];
        } else if (w == 2) {
            int bb = lane >> 4, cc = lane & 15; asm volatile("" : "+v"(bb), "+v"(cc));
            const LAS float* ad = AD + (bb * 16 + cc) * SC_ADS;
            const f32x4 r0 = *(const LAS f32x4*)(ad), r1 = *(const LAS f32x4*)(ad + 4), r2 = *(const LAS f32x4*)(ad + 8), r3 = *(const LAS f32x4*)(ad + 12);
            const float ar[16] = {r0.x, r0.y, r0.z, r0.w, r1.x, r1.y, r1.z, r1.w, r2.x, r2.y, r2.z, r2.w, r3.x, r3.y, r3.z, r3.w};
            float tt[16];
            inv_step<0>(tt, ar, cc); inv_step<1>(tt, ar, cc); inv_step<2>(tt, ar, cc); inv_step<3>(tt, ar, cc); inv_step<4>(tt, ar, cc); inv_step<5>(tt, ar, cc); inv_step<6>(tt, ar, cc); inv_step<7>(tt, ar, cc);
            inv_step<8>(tt, ar, cc); inv_step<9>(tt, ar, cc); inv_step<10>(tt, ar, cc); inv_step<11>(tt, ar, cc); inv_step<12>(tt, ar, cc); inv_step<13>(tt, ar, cc); inv_step<14>(tt, ar, cc); inv_step<15>(tt, ar, cc);
            LAS unsigned short* tb = (LAS unsigned short*)(L + SC_TBB) + bb * 256 + cc;
#pragma unroll
            for (int s = 0; s < 16; ++s) tb[s * 16] = (unsigned short)(cvtpk(tt[s], 0.f) & 0xffffu);
        } else if (w == 3) {
            LAS v4u* z = (LAS v4u*)(L + SC_XT0) + lane;
#pragma unroll
            for (int q = 0; q < 18; ++q) z[q * 64] = (v4u){0u, 0u, 0u, 0u};
        } else if (w < 6) tile_mma2t<true, false>(acc, L + SL_VT * SC_TB, L + SL_ARK * SC_TB, w & 1, r32, hi, lane);
        else tile_mma2t<true, true>(acc, L + SL_KH * SC_TB, L + SL_VT * SC_TB, w & 1, r32, hi, lane);
        }
        __syncthreads();
        P4REP(404)
        {   const int cl = lane & 15, g = lane >> 4; LAS unsigned char* xt = L + SC_XT0 + (w >> 2) * SC_TB + ((16 * (w & 3) + cl) * SC_TS) * 2;
#pragma unroll
            for (int bb = 0; bb < 4; ++bb) {
                f32x4 rp;
#pragma unroll
                for (int reg = 0; reg < 4; ++reg) rp[reg] = RHS[(16 * bb + 4 * g + reg) * 128 + 16 * w + cl];
#pragma unroll
                for (int ks = 0; ks < 2; ++ks) { const bf16x8 af = *(const LAS bf16x8*)(L + SL_A * SC_TB + ((16 * bb + cl) * SC_TS + 32 * ks + 8 * g) * 2);
                    const bf16x8 bf = *(const LAS bf16x8*)(xt + (32 * ks + 8 * g) * 2);
                    rp = __builtin_amdgcn_mfma_f32_16x16x32_bf16(af, bf, rp, 0, 0, 0); }
                const v2u tq = *(const LAS v2u*)(L + SC_TBB + ((bb * 16 + cl) * 16 + 4 * g) * 2);
                const v4u a2 = {tq.x, tq.y, 0u, 0u}, b2 = {cvtpk(rp[0], rp[1]), cvtpk(rp[2], rp[3]), 0u, 0u};
                const f32x4 xb = __builtin_amdgcn_mfma_f32_16x16x32_bf16(__builtin_bit_cast(bf16x8, a2), __builtin_bit_cast(bf16x8, b2), (f32x4){0.f, 0.f, 0.f, 0.f}, 0, 0, 0);
                v2u o; o.x = cvtpk(xb[0], xb[1]); o.y = cvtpk(xb[2], xb[3]); *(LAS v2u*)(xt + (16 * bb + 4 * g) * 2) = o;
                asm volatile("s_waitcnt lgkmcnt(0)" ::: "memory");
            } }
        __syncthreads();
        const LAS unsigned char* WMT = L + SC_XT0; const LAS unsigned char* U0T = L + SC_XT1;
        P4REP(405) {
        if (w < 4) {
#pragma unroll
            for (int i = 0; i < 16; ++i) { acc[0][i] = 0.f; acc[1][i] = 0.f; } }
        if (w < 2) {
            tile_mma2(acc, WMT, L + SL_ARB * SC_TB, w & 1, r32, hi);
            bf16* qo = QE + (size_t)cu * 4096;
#pragma unroll
            for (int nt = 0; nt < 2; ++nt) { const int tt = 32 * nt + r32;
#pragma unroll
                for (int rp = 0; rp < 2; ++rp) { v2u o[2];
#pragma unroll
                    for (int q = 0; q < 2; ++q) { const int rg = rp + 2 * q, d0 = 32 * (w & 1) + 8 * rg + 4 * hi; const v2u rt = *(const LAS v2u*)(L + SL_R * SC_TB + (tt * SC_TS + d0) * 2);
                        o[q].x = cvtpk(acc[nt][4 * rg] + bflo(rt.x), acc[nt][4 * rg + 1] + bfhi(rt.x)); o[q].y = cvtpk(acc[nt][4 * rg + 2] + bflo(rt.y), acc[nt][4 * rg + 3] + bfhi(rt.y)); }
                    *(v4u*)(qo + tt * 64 + 16 * (2 * rp + hi) + 8 * (w & 1)) = (v4u){o[0].x, o[0].y, o[1].x, o[1].y}; } }
        } else if (w < 4) {
            tile_mma2t<false, true>(acc, WMT, L + SL_BH * SC_TB, w & 1, r32, hi, lane);
            bf16* mo = MCT + (size_t)cu * 4096;
#pragma unroll
            for (int nt = 0; nt < 2; ++nt) { const int dp = 32 * nt + r32; const float gc = Gend[dp];
#pragma unroll
                for (int rp = 0; rp < 2; ++rp) { v2u o[2];
#pragma unroll
                    for (int q = 0; q < 2; ++q) { const int rg = rp + 2 * q, d0 = 32 * (w & 1) + 8 * rg + 4 * hi; float v[4];
#pragma unroll
                        for (int e = 0; e < 4; ++e) v[e] = acc[nt][4 * rg + e] + ((d0 + e == dp) ? gc : 0.f);
                        o[q].x = cvtpk(v[0], v[1]); o[q].y = cvtpk(v[2], v[3]); }
                    *(v4u*)(mo + dp * 64 + 32 * (w & 1) + 8 * (2 * rp + hi)) = (v4u){o[0].x, o[0].y, o[1].x, o[1].y}; } }
        } else if (w < 6) {
            tile_mma2(acc, U0T, L + SL_ARB * SC_TB, w & 1, r32, hi);
            bf16* yo = Y0 + (size_t)cu * 4096;
#pragma unroll
            for (int nt = 0; nt < 2; ++nt) { const int tt = 32 * nt + r32;
#pragma unroll
                for (int rp = 0; rp < 2; ++rp)
                    *(v4u*)(yo + tt * 64 + 32 * (w & 1) + 16 * rp + 8 * hi) = (v4u){cvtpk(acc[nt][4 * rp], acc[nt][4 * rp + 1]), cvtpk(acc[nt][4 * rp + 2], acc[nt][4 * rp + 3]), cvtpk(acc[nt][4 * rp + 8], acc[nt][4 * rp + 9]), cvtpk(acc[nt][4 * rp + 10], acc[nt][4 * rp + 11])}; }
        } else {
            tile_mma2t<true, false>(acc, L + SL_BH * SC_TB, U0T, w & 1, r32, hi, lane);
            bf16* no = NC + (size_t)cu * 4096;
#pragma unroll
            for (int nt = 0; nt < 2; ++nt) { const int ii = 32 * nt + r32;
#pragma unroll
                for (int rp = 0; rp < 2; ++rp)
                    *(v4u*)(no + ii * 64 + 16 * (2 * rp + hi) + 8 * (w & 1)) = (v4u){cvtpk(acc[nt][4 * rp], acc[nt][4 * rp + 1]), cvtpk(acc[nt][4 * rp + 2], acc[nt][4 * rp + 3]), cvtpk(acc[nt][4 * rp + 8], acc[nt][4 * rp + 9]), cvtpk(acc[nt][4 * rp + 10], acc[nt][4 * rp + 11])}; }
        }
        }
        if (mit < NE * 768) { const MoeItem mi = moe_item(F, 0, mit);
            const int coff = (w < 3) ? w * SC_TB : (w < 5) ? (w + 2) * SC_TB : (w == 5) ? SL_ARK * SC_TB : SC_RHS + (w - 6) * 8448;
            titem_store(tv, mi.k0, mi.WT, mi.ldo, mi.orow0, 0, nullptr, (LAS float*)(L + coff), lane); }
    }
}
struct P4bOps { v4u af[4][2]; v4u nf[2]; };
__device__ __forceinline__ void p4b_load(P4bOps& o, const bf16* MCT, const bf16* NC, size_t cu, int ig, int il, int g) {
    const bf16* mc = MCT + cu * 4096; const bf16* nc = NC + cu * 4096;
    o.nf[0] = *(const v4u*)(nc + ig * 64 + 16 * g); o.nf[1] = *(const v4u*)(nc + ig * 64 + 16 * g + 8);
#pragma unroll
    for (int m = 0; m < 4; ++m)
#pragma unroll
        for (int ks = 0; ks < 2; ++ks) o.af[m][ks] = *(const v4u*)(mc + (16 * m + il) * 64 + 32 * ks + 8 * g);
}
__device__ __forceinline__ void p4b_step(f32x4 (&acc)[4], const P4bOps& o, bf16* SCB, size_t cu, int ig, int g) {
    unsigned pk[4][2];
#pragma unroll
    for (int m = 0; m < 4; ++m) { pk[m][0] = cvtpk(acc[m][0], acc[m][1]); pk[m][1] = cvtpk(acc[m][2], acc[m][3]); }
    *(v4u*)(SCB + cu * 4096 + ig * 64 + 16 * g) = (v4u){pk[0][0], pk[0][1], pk[1][0], pk[1][1]}; *(v4u*)(SCB + cu * 4096 + ig * 64 + 16 * g + 8) = (v4u){pk[2][0], pk[2][1], pk[3][0], pk[3][1]};
    const v4u b0 = {pk[0][0], pk[0][1], pk[1][0], pk[1][1]}, b1 = {pk[2][0], pk[2][1], pk[3][0], pk[3][1]};
#pragma unroll
    for (int m = 0; m < 4; ++m) {
        const unsigned nlo = (m & 1) ? o.nf[m >> 1].z : o.nf[m >> 1].x, nhi = (m & 1) ? o.nf[m >> 1].w : o.nf[m >> 1].y;
        f32x4 ci = {bflo(nlo), bfhi(nlo), bflo(nhi), bfhi(nhi)};
        ci = __builtin_amdgcn_mfma_f32_16x16x32_bf16(__builtin_bit_cast(bf16x8, o.af[m][0]), __builtin_bit_cast(bf16x8, b0), ci, 0, 0, 0);
        acc[m] = __builtin_amdgcn_mfma_f32_16x16x32_bf16(__builtin_bit_cast(bf16x8, o.af[m][1]), __builtin_bit_cast(bf16x8, b1), ci, 0, 0, 0);
    }
}
__device__ __forceinline__ void p4b_state(Frame& F) {
    if (F.wave != 0) return;
    const bf16* MCT = (const bf16*)(F.ws + WS_MCT); const bf16* NC = (const bf16*)(F.ws + WS_NC); bf16* SCB = (bf16*)(F.ws + WS_SC);
    const int lane = F.lane, il = lane & 15, g = lane >> 4;
    for (int unit = F.vcu; unit < BATCH * 16 * 4; unit += F.G) {
        const int bh = unit >> 2, ig = (unit & 3) * 16 + il; const size_t cu0 = (size_t)bh * 64;
        f32x4 acc[4];
#pragma unroll
        for (int m = 0; m < 4; ++m) acc[m] = (f32x4){0.f, 0.f, 0.f, 0.f};
        P4bOps o0, o1, o2, o3;
        p4b_load(o0, MCT, NC, cu0 + 0, ig, il, g); p4b_load(o1, MCT, NC, cu0 + 1, ig, il, g); p4b_load(o2, MCT, NC, cu0 + 2, ig, il, g); p4b_load(o3, MCT, NC, cu0 + 3, ig, il, g);
        for (int c = 0; c < 64; c += 4) {
            const size_t cu = cu0 + c; const size_t nx = (c + 4 < 64) ? cu + 4 : cu;
            p4b_step(acc, o0, SCB, cu + 0, ig, g); __builtin_amdgcn_sched_barrier(0); p4b_load(o0, MCT, NC, nx + 0, ig, il, g); __builtin_amdgcn_sched_barrier(0);
            p4b_step(acc, o1, SCB, cu + 1, ig, g); __builtin_amdgcn_sched_barrier(0); p4b_load(o1, MCT, NC, nx + 1, ig, il, g); __builtin_amdgcn_sched_barrier(0);
            p4b_step(acc, o2, SCB, cu + 2, ig, g); __builtin_amdgcn_sched_barrier(0); p4b_load(o2, MCT, NC, nx + 2, ig, il, g); __builtin_amdgcn_sched_barrier(0);
            p4b_step(acc, o3, SCB, cu + 3, ig, g); __builtin_amdgcn_sched_barrier(0); p4b_load(o3, MCT, NC, nx + 3, ig, il, g); __builtin_amdgcn_sched_barrier(0);
        }
    }
}
__device__ __forceinline__ void p4c_out(Frame& F) {
    LAS float* stage = (LAS float*)(F.lds + RING_OFF);
    const bf16* QE = (const bf16*)(F.ws + WS_QE); const bf16* SCB = (const bf16*)(F.ws + WS_SC); const bf16* Y0 = (const bf16*)(F.ws + WS_Y0); const float* RK = (const float*)(F.ws + WS_RK);
    const bf16* Vb = (const bf16*)(F.ws + WS_RKV) + (size_t)2 * M * D; const bf16* GG = (const bf16*)(F.ws + WS_GG); bf16* YG = (bf16*)(F.ws + WS_YG);
    const float* gn_g = F.in[19]; const float* gn_b = F.in[20];
    const int lane = F.lane, w = F.wave, r32 = lane & 31, hi = lane >> 5, us = w >> 1, nt = w & 1;
    for (int grp = blockIdx.x; grp < BATCH * 16 * 64 / 4; grp += F.G) {
        const int cu = grp * 4 + us, bh = cu >> 6, c = cu & 63, b = bh >> 4, h = bh & 15;
        const bf16* sc = SCB + (size_t)cu * 4096; const bf16* qe = QE + (size_t)cu * 4096; const bf16* y0 = Y0 + (size_t)cu * 4096;
        const int tt = 32 * nt + r32;
        f32x16 acc[2];
#pragma unroll
        for (int mt = 0; mt < 2; ++mt)
#pragma unroll
            for (int rp = 0; rp < 2; ++rp) { const v4u q = *(const v4u*)(y0 + tt * 64 + 32 * mt + 16 * rp + 8 * hi);
                acc[mt][4 * rp] = bflo(q.x); acc[mt][4 * rp + 1] = bfhi(q.x); acc[mt][4 * rp + 2] = bflo(q.y); acc[mt][4 * rp + 3] = bfhi(q.y);
                acc[mt][4 * rp + 8] = bflo(q.z); acc[mt][4 * rp + 9] = bfhi(q.z); acc[mt][4 * rp + 10] = bflo(q.w); acc[mt][4 * rp + 11] = bfhi(q.w); }
#pragma unroll
        for (int ks = 0; ks < 4; ++ks) { const bf16x8 bq = *(const bf16x8*)(qe + tt * 64 + 16 * ks + 8 * hi);
            const bf16x8 a0 = *(const bf16x8*)(sc + r32 * 64 + 16 * ks + 8 * hi), a1 = *(const bf16x8*)(sc + (32 + r32) * 64 + 16 * ks + 8 * hi);
            acc[0] = MMA32(a0, bq, acc[0]); acc[1] = MMA32(a1, bq, acc[1]); }
        float sm = 0.f;
#pragma unroll
        for (int i = 0; i < 16; ++i) sm += acc[0][i] + acc[1][i];
        sm += __shfl_xor(sm, 32); const float mean = sm * (1.f / 64.f);
        float vs = 0.f;
#pragma unroll
        for (int i = 0; i < 16; ++i) { const float d0 = acc[0][i] - mean, d1 = acc[1][i] - mean; vs += d0 * d0 + d1 * d1; }
        vs += __shfl_xor(vs, 32); const float rstd = 1.0f / sqrtf(vs * (1.f / 64.f) + GN_EPS);
        LAS float* st = stage + us * (64 * 68);
#pragma unroll
        for (int mt = 0; mt < 2; ++mt)
#pragma unroll
            for (int rg = 0; rg < 4; ++rg) *(LAS f32x4*)(st + tt * 68 + 32 * mt + 8 * rg + 4 * hi) = (f32x4){(acc[mt][4 * rg] - mean) * rstd, (acc[mt][4 * rg + 1] - mean) * rstd, (acc[mt][4 * rg + 2] - mean) * rstd, (acc[mt][4 * rg + 3] - mean) * rstd};
        __syncthreads();
        {   const int i8 = (lane & 7) * 8; const int cg = h * 64 + i8;
            const f32x4 g0 = *(const f32x4*)(gn_g + cg), g1 = *(const f32x4*)(gn_g + cg + 4), b0 = *(const f32x4*)(gn_b + cg), b1 = *(const f32x4*)(gn_b + cg + 4);
            v4u vva[4], gga[4]; float rka[4];
#pragma unroll
            for (int it = 0; it < 4; ++it) { const int t2 = 32 * nt + it * 8 + (lane >> 3); const size_t ro = ((size_t)b * T + c * 64 + t2) * D + cg;
                vva[it] = *(const v4u*)(Vb + ro); gga[it] = *(const v4u*)(GG + ro); rka[it] = RK[(size_t)cu * 64 + t2]; }
#pragma unroll
            for (int it = 0; it < 4; ++it) { const int t2 = 32 * nt + it * 8 + (lane >> 3); const size_t ro = ((size_t)b * T + c * 64 + t2) * D + cg;
                const f32x4 y0v = *(const LAS f32x4*)(st + t2 * 68 + i8), y1v = *(const LAS f32x4*)(st + t2 * 68 + i8 + 4);
                const v4u vv = vva[it], gg = gga[it]; const float rk = rka[it];
                float o[8];
                o[0] = (y0v.x * g0.x + b0.x + rk * bflo(vv.x)) * bflo(gg.x); o[1] = (y0v.y * g0.y + b0.y + rk * bfhi(vv.x)) * bfhi(gg.x);
                o[2] = (y0v.z * g0.z + b0.z + rk * bflo(vv.y)) * bflo(gg.y); o[3] = (y0v.w * g0.w + b0.w + rk * bfhi(vv.y)) * bfhi(gg.y);
                o[4] = (y1v.x * g1.x + b1.x + rk * bflo(vv.z)) * bflo(gg.z); o[5] = (y1v.y * g1.y + b1.y + rk * bfhi(vv.z)) * bfhi(gg.z);
                o[6] = (y1v.z * g1.z + b1.z + rk * bflo(vv.w)) * bflo(gg.w); o[7] = (y1v.w * g1.w + b1.w + rk * bfhi(vv.w)) * bfhi(gg.w);
                v4u ov; ov.x = cvtpk(o[0], o[1]); ov.y = cvtpk(o[2], o[3]); ov.z = cvtpk(o[4], o[5]); ov.w = cvtpk(o[6], o[7]); *(v4u*)(YG + ro) = ov; }
        }
        __syncthreads();
    }
}

constexpr int NPHASE = 22;
#ifndef PROBE_PHASE
#define PROBE_PHASE (-1)
#endif
#define PROBE(k, ...) do { __VA_ARGS__; if (PROBE_PHASE == (k)) { xcd_barrier(bar); __VA_ARGS__; } } while (0)
#define IN(k) (lo <= (k) && (k) < hi)
#define SEAM(k) do { if (IN(k) && (k) + 1 < hi) xcd_barrier(bar); } while (0)
template <int L> __device__ __forceinline__ void moe_phases(Frame& F, const int lo, const int hi, const XcdBarrier& bar) {
    constexpr int pb = 11 * L;
    LAS unsigned char* ring = F.lds + RING_OFF;
    const LAS int* toff = (const LAS int*)(F.lds + LDSCTL_OFF);
        if (IN(pb + 6)) { F.lane = lane_id(); F.tid = F.wave * 64 + F.lane; if (PROBE_PHASE == 100 + pb) { moe_router(F, L, (const float*)(F.ws + WS_XA), 32); xcd_barrier(bar); F.lane = lane_id(); F.tid = F.wave * 64 + F.lane; }
            if (L == 1 && (F.vcu & 1)) { moe_weights(F, L); __syncthreads();   F.lane = lane_id(); F.tid = F.wave * 64 + F.lane; }
            moe_router(F, L, (const float*)(F.ws + WS_XA), 0); if (L == 1 && !(F.vcu & 1)) { PROBE(pb + 6, F.lane = lane_id(); F.tid = F.wave * 64 + F.lane; moe_weights(F, L); ); } } SEAM(pb + 6);
        if (IN(pb + 8)) { PROBE(pb + 8, F.lane = lane_id(); F.tid = F.wave * 64 + F.lane;
            moe_toff(F, L);
            pg8::MoeOrder S; S.init(F.ws + WS_H2N, F.ws + WS_MOEGU, (size_t)1024 * 1024 * 2, toff, toff + 40, (const int*)(F.ws + WS_ROWTOK), 4, D, F.G, F.vcu);
            S.hand_off(1, (unsigned*)F.ctl + CW_RDY + 16384 * L, 0u, (unsigned*)F.ctl + CW_TMO, F.wave);
            pg8::EpiGU E{(bf16*)(F.ws + WS_HS)};
            pg8::gemm_phase_gather<pg8::EpiGU, pg8::MoeOrder>(ring, D, S, E, F.tid, F.wave);
        ); }
        if (IN(pb + 9)) { PROBE(pb + 9, F.lane = lane_id(); F.tid = F.wave * 64 + F.lane;
            moe_toff(F, L);
            pg8::MoeOrder S; S.init(F.ws + WS_HS, F.ws + WS_MOED, (size_t)1024 * 512 * 2, toff, toff + 40, nullptr, 4, FF, F.G, F.vcu);
            S.hand_off(2, (unsigned*)F.ctl + CW_RDY + 16384 * L, 32u, (unsigned*)F.ctl + CW_TMO, F.wave);
            S.redeal(S.tot % F.G);
            pg8::EpiDown E{(bf16*)(F.ws + WS_Y), (const float*)(F.ws + WS_ROWGATE), toff};
            pg8::gemm_phase<pg8::EpiDown, pg8::MoeOrder, true, true>(ring, FF, S, E, F.tid, F.wave);
        ); } SEAM(pb + 9);
        if (IN(pb + 10)) { PROBE(pb + 10, F.lane = lane_id(); F.tid = F.wave * 64 + F.lane;
            moe_combine<L>(F, L, (const float*)(F.ws + WS_XA), F.out);
        ); } SEAM(pb + 10);
}
#undef IN
#undef SEAM
struct Args { const float* in[39]; float* out; unsigned char* ws; int ph_lo, ph_hi; };
__global__ void __launch_bounds__(NWAVES * 64, 2) trunk_fwd(Args args) {
    extern __shared__ __attribute__((aligned(16))) unsigned char lds[];
    Frame F;
    F.lds = (LAS unsigned char*)lds;
    F.MISC = (volatile LAS unsigned*)(F.lds + MISC_OFF);
    F.wave = __builtin_amdgcn_readfirstlane(threadIdx.x >> 6); F.lane = lane_id(); F.tid = F.wave * 64 + F.lane;
    F.G = gridDim.x; { const int bx = blockIdx.x; F.vcu = (F.G % 8 == 0) ? (bx % 8) * (F.G / 8) + bx / 8 : bx; }
    F.ws = args.ws; F.ctl = (gu32*)(args.ws + WS_CTL); F.in = args.in; F.out = args.out;
    for (int u = F.tid; u < (LDS_BYTES - LDSCTL_OFF) / 4; u += NWAVES * 64) ((LAS unsigned*)(F.lds + LDSCTL_OFF))[u] = 0u;
    __syncthreads();
    const int lo = args.ph_lo, hi = args.ph_hi;
    const bool multi = (hi - lo) > 1;
    XcdBarrier bar; bar.bar = (unsigned*)(F.ctl + CW_BAR); bar.x = 0; bar.st = nullptr; bar.wave = F.wave;
    if (multi) bar = xcd_barrier_post((unsigned*)(F.ctl + CW_BAR), F.MISC + 8);
#define IN(k) (lo <= (k) && (k) < hi)
#define SEAM(k) do { if (IN(k) && (k) + 1 < hi) xcd_barrier(bar); } while (0)
    LAS unsigned char* ring = F.lds + RING_OFF;
    const LAS int* toff = (const LAS int*)(F.lds + LDSCTL_OFF);

    {
        {
            if (IN(0)) { PROBE(0, F.lane = lane_id(); F.tid = F.wave * 64 + F.lane; p0_mod(F); ); } SEAM(0);
            if (IN(1)) { PROBE(1, F.lane = lane_id(); F.tid = F.wave * 64 + F.lane;
                if (F.vcu & 1) { p0_weights(F); __syncthreads(); F.lane = lane_id(); F.tid = F.wave * 64 + F.lane; p1_norm_views(F); }
                else { p1_norm_views(F); __syncthreads(); F.lane = lane_id(); F.tid = F.wave * 64 + F.lane; p0_weights(F); } ); } SEAM(1);
            if (IN(2)) { PROBE(2, F.lane = lane_id(); F.tid = F.wave * 64 + F.lane;
                { pg8::BatchOrder S; S.init(F.ws + WS_H2, F.ws + WS_WL1, 0, 0, M, 256, 1, 2048, F.G, (int)blockIdx.x);
                  S.ho.set(1, (unsigned*)F.ctl + CW_RDY + 2 * 16384, 0u, (unsigned*)F.ctl + CW_TMO, F.wave);
                  pg8::EpiLora1 E{(bf16*)(F.ws + WS_A2)};
                  pg8::gemm_phase<pg8::EpiLora1, pg8::BatchOrder, true, true>(ring, 2048, S, E, F.tid, F.wave); }
                { pg8::BatchOrder S; S.init(F.ws + WS_VIEWS, F.ws + WS_WRKV, (size_t)M * D * 2, (size_t)D * D * 2, M, D, 3, D, F.G, (int)blockIdx.x);
                  pg8::EpiZBf16 E{(bf16*)(F.ws + WS_RKV), (size_t)M * D, 1.0f};
                  pg8::gemm_phase<pg8::EpiZBf16, pg8::BatchOrder, true, true>(ring, D, S, E, F.tid, F.wave); }
                { const int nlo = (F.G >= 128) ? 64 : 0;
                  pg8::BatchOrder S; S.init(F.ws + WS_A2, F.ws + WS_WL2, 0, 0, M, 3072, 1, 256, F.G - nlo, (int)blockIdx.x - nlo);
                  S.ho.set(2, (unsigned*)F.ctl + CW_RDY + 2 * 16384, 8u, (unsigned*)F.ctl + CW_TMO, F.wave);
                  pg8::EpiLora2 E{(_Float16*)(F.ws + WS_LOGW), (bf16*)(F.ws + WS_ASIG), (bf16*)(F.ws + WS_GG), F.in[8], F.in[11]};
                  pg8::gemm_phase<pg8::EpiLora2, pg8::BatchOrder, true, true>(ring, 256, S, E, F.tid, F.wave); }
            ); } SEAM(2);
            if (IN(4)) { PROBE(40, F.lane = lane_id(); F.tid = F.wave * 64 + F.lane; p4a_chunks(F); ); xcd_barrier(bar); PROBE(41, F.lane = lane_id(); F.tid = F.wave * 64 + F.lane; p4b_state(F); ); xcd_barrier(bar); PROBE(42, F.lane = lane_id(); F.tid = F.wave * 64 + F.lane; p4c_out(F); ); } SEAM(4);
            if (IN(5)) { PROBE(5, F.lane = lane_id(); F.tid = F.wave * 64 + F.lane;
                pg8::BatchOrder S; S.init(F.ws + WS_YG, F.ws + WS_WO0, 0, 0, M, D, 1, D, F.G, (int)blockIdx.x);
                pg8::EpiResid E{F.in[0], (float*)(F.ws + WS_XA), (const float*)(F.ws + WS_MOD) + 2048};
                pg8::gemm_phase<pg8::EpiResid, pg8::BatchOrder, true, true>(ring, D, S, E, F.tid, F.wave);
            ); } SEAM(5);
        }
        moe_phases<0>(F, lo, hi, bar);
        {
            if (IN(11)) { PROBE(11, F.lane = lane_id(); F.tid = F.wave * 64 + F.lane;
                { pg8::BatchOrder S; S.init(F.ws + WS_HQ, F.ws + WS_WQKV, (size_t)M * D * 2, (size_t)D * D * 2, M, D, 2, D, F.G, (int)blockIdx.x);
                  pg8::EpiZBf16 E{(bf16*)(F.ws + WS_QKV), (size_t)M * D, attn_body::C2};
                  pg8::gemm_phase<pg8::EpiZBf16, pg8::BatchOrder, true, true>(ring, D, S, E, F.tid, F.wave); }
                { pg8::BatchOrder S; S.init(F.ws + WS_HK, F.ws + WS_WQKV + (size_t)2 * D * D * 2, 0, 0, M, D, 1, D, F.G, (int)blockIdx.x);
                  pg8::EpiZBf16 E{(bf16*)(F.ws + WS_QKV) + (size_t)2 * M * D, 0, 1.0f};
                  pg8::gemm_phase<pg8::EpiZBf16, pg8::BatchOrder, true, true>(ring, D, S, E, F.tid, F.wave); }
            ); } SEAM(11);
            if (IN(12)) { PROBE(12, F.lane = lane_id(); F.tid = F.wave * 64 + F.lane;
                const attn_body::bf16* Q = (const attn_body::bf16*)(F.ws + WS_QKV); const attn_body::bf16* Kp = Q + (size_t)M * D; const attn_body::bf16* Vp = Kp + (size_t)M * D;
                attn_body::bf16* O = (attn_body::bf16*)(F.ws + WS_OC);
                int nrep = (PROBE_PHASE == 120) ? 2 : 1; asm volatile("" : "+s"(nrep));
                for (int rep = 0; rep < nrep; ++rep)
                { attn_body::bf16x8 qr[4]; bool pre = false;
                for (int i = 0; ; ++i) { const int pr = (i >> 1) * F.G + F.vcu; if (pr >= BATCH * 8 * 8) break;
                    const int bh = pr >> 3, s = pr & 7, qb = (i & 1) ? s : 15 - s, b = bh >> 3, h = bh & 7;
                    const int npr = ((i + 1) >> 1) * F.G + F.vcu; const bool nval = npr < BATCH * 8 * 8;
                    const int nbh = npr >> 3, ns = npr & 7, nqb2 = ((i + 1) & 1) ? ns : 15 - ns, nb2 = nbh >> 3, nh2 = nbh & 7;
                    _Pragma("unroll 1") for (int c = 0; c < 2; ++c) {
                        const bool hn = (c == 0) ? true : nval; const int xb = (c == 0) ? b : nb2, xqb = (c == 0) ? qb : nqb2, xh = (c == 0) ? h : nh2, xc = (c == 0) ? 1 : 0;
                        attn_body::attn_unit128<8>(b, qb, Q + (h * 2 + c) * 64, Kp + (h * 2 + c) * 64, Vp + h * 128, O + (h * 2 + c) * 128, (char*)lds + RING_OFF, F.tid, F.wave,
                                                   qr, pre, hn, xb, xqb, Q + (xh * 2 + xc) * 64, Kp + (xh * 2 + xc) * 64, Vp + xh * 128);
                        pre = hn; }
                    attn_subln_rows(F, (size_t)b * T + qb * 256 + F.wave * 32, h);
                } }
            ); } SEAM(12);
            if (IN(14)) { PROBE(14, F.lane = lane_id(); F.tid = F.wave * 64 + F.lane;
                pg8::BatchOrder S; S.init(F.ws + WS_ON, F.ws + WS_WO1, 0, 0, M, D, 1, D, F.G, (int)blockIdx.x);
                pg8::EpiResid E{F.out, (float*)(F.ws + WS_XA), (const float*)(F.ws + WS_MOD) + 4 * 6144 + 2048};
                pg8::gemm_phase<pg8::EpiResid, pg8::BatchOrder, true, true>(ring, D, S, E, F.tid, F.wave);
            ); } SEAM(14);
        }
        moe_phases<1>(F, lo, hi, bar);
    }
    if (multi && hi == NPHASE) { if ((__hip_atomic_load((gu32*)((unsigned*)(F.ctl + CW_BAR) + XB_TMO), RLX_AGENT) | __hip_atomic_load(F.ctl + CW_TMO, RLX_AGENT)) != 0u) {
        const float q = __builtin_nanf(""); for (size_t i = (size_t)blockIdx.x * 512 + F.wave * 64 + lane_id(); i < (size_t)M * D; i += (size_t)F.G * 512) F.out[i] = q; } }
#undef IN
#undef SEAM
}

#ifndef N_LAUNCH_MODE
#define N_LAUNCH_MODE 1
#endif
extern "C" void kernel_launch(void* const* d_in, const int* in_sizes, int n_in, void* d_out, int out_size, void* d_ws, size_t ws_size, hipStream_t stream) {
    static int grid = 0;
    if (grid == 0) {
        if (n_in != 39 || in_sizes[0] != M * D || out_size != M * D || ws_size < WS_END) { fprintf(stderr, "kernel_launch: unexpected problem (n_in %d, in0 %d, out %d, ws %zu < %zu); nothing launched\n", n_in, n_in > 0 ? in_sizes[0] : -1, out_size, ws_size, (size_t)WS_END); grid = -1; return; }
        int dev = 0, cus = 0, per_cu = 0;
        if (hipGetDevice(&dev) != hipSuccess || hipDeviceGetAttribute(&cus, hipDeviceAttributeMultiprocessorCount, dev) != hipSuccess) { grid = -1; return; }
        if (hipFuncSetAttribute((const void*)trunk_fwd, hipFuncAttributeMaxDynamicSharedMemorySize, LDS_BYTES) != hipSuccess) { fprintf(stderr, "kernel_launch: hipFuncSetAttribute failed\n"); grid = -1; return; }
        if (hipOccupancyMaxActiveBlocksPerMultiprocessor(&per_cu, (const void*)trunk_fwd, NWAVES * 64, LDS_BYTES) != hipSuccess || per_cu < 1) fprintf(stderr, "kernel_launch: occupancy query reports %d\n", per_cu);
        (void)hipGetLastError();
        grid = cus;
    }
    if (grid < 0) return;
    if (hipMemsetAsync((char*)d_ws + WS_CTL, 0, CTL_ZERO_BYTES, stream) != hipSuccess) return;
    Args a{};
    for (int i = 0; i < 39; ++i) a.in[i] = (const float*)d_in[i];
    a.out = (float*)d_out; a.ws = (unsigned char*)d_ws;
    if (N_LAUNCH_MODE == 1) {
        a.ph_lo = 0; a.ph_hi = NPHASE;
        hipLaunchKernelGGL(trunk_fwd, dim3(grid), dim3(NWAVES * 64), LDS_BYTES, stream, a);
    } else {
        const int ids[16] = {0, 1, 2, 4, 5, 6, 8, 9, 10, 11, 12, 14, 17, 19, 20, 21};
        for (int k = 0; k < 16; ++k) { a.ph_lo = ids[k]; a.ph_hi = ids[k] + 1; hipLaunchKernelGGL(trunk_fwd, dim3(grid), dim3(NWAVES * 64), LDS_BYTES, stream, a); }
    }
}
```

```cpp
#include <hip/hip_runtime.h>
#include <hip/hip_bf16.h>
#include <cstdio>
#include <cstdint>
#include <cmath>

namespace pg8 {
#define PG8_LAS __attribute__((address_space(3)))
typedef unsigned short bf16_t;
typedef short bf16x8 __attribute__((ext_vector_type(8)));
typedef float f32x4 __attribute__((ext_vector_type(4)));
typedef unsigned u32x4 __attribute__((ext_vector_type(4)));
typedef unsigned u32x2 __attribute__((ext_vector_type(2)));
constexpr int BM = 256, BK = 64, HALF = 128, HTB = HALF * BK * 2  , STAGE_BYTES = 8 * HTB, NXCD = 8, WGM = 8;

__host__ __device__ __forceinline__ int lds_byte(int r, int c) { const int st = (r >> 4) * 2 + (c >> 5), rr = r & 15, cc = c & 31, ob = rr * 64 + cc * 2; return st * 1024 + (ob ^ (((ob >> 9) & 1) << 5)); }
__host__ __device__ __forceinline__ void stage_rc(int b, int& R, int& C) { const int st = b / 1024, sb = b % 1024, swz = sb ^ (((sb >> 9) & 1) << 5); R = (st >> 1) * 16 + swz / 64; C = (st & 1) * 32 + (swz % 64) / 2; }
__host__ __device__ __forceinline__ int perm32(int rho) { const int n = rho >> 4, i = rho & 15; return 8 * (i >> 2) + 4 * n + (i & 3); }

struct Unit { int pm, pn, z; };

typedef float f32x2_cv __attribute__((ext_vector_type(2))); typedef __bf16 bf16x2_cv __attribute__((ext_vector_type(2)));
__device__ __forceinline__ unsigned cvt_pk_bf16(float lo, float hi) { const f32x2_cv v = {lo, hi}; const bf16x2_cv b = __builtin_convertvector(v, bf16x2_cv); return __builtin_bit_cast(unsigned, b); }

struct HandOff {
    unsigned* ready; unsigned* tmo; int role, wid; unsigned need;
    __device__ __forceinline__ void clear() { ready = nullptr; tmo = nullptr; role = 0; wid = 0; need = 0u; }
    __device__ __forceinline__ void set(int role_, unsigned* ready_, unsigned need_, unsigned* tmo_, int wid_) { role = role_; ready = ready_; need = need_; tmo = tmo_; wid = wid_; }
    __device__ __forceinline__ void a_ready(int pm) const {
        if (role != 2) return;
        if (wid == 0) {
            unsigned polls = 0;
            while ((unsigned)__builtin_amdgcn_readfirstlane(__hip_atomic_load(ready + 64 * pm, __ATOMIC_RELAXED, __HIP_MEMORY_SCOPE_AGENT)) < need) {
                if ((++polls & 255u) == 0u) { if (__builtin_amdgcn_readfirstlane(__hip_atomic_load(tmo, __ATOMIC_RELAXED, __HIP_MEMORY_SCOPE_AGENT)) != 0u) break;
                    if (polls > (1u << 19)) { __hip_atomic_store(tmo, 1u, __ATOMIC_RELAXED, __HIP_MEMORY_SCOPE_AGENT); break; } }
                __builtin_amdgcn_s_sleep(2); }
            __builtin_amdgcn_fence(__ATOMIC_ACQUIRE, "agent");
            asm volatile("s_waitcnt vmcnt(0)" ::: "memory");
        }
        asm volatile("" ::: "memory"); __builtin_amdgcn_s_barrier(); asm volatile("" ::: "memory");
    }
    __device__ __forceinline__ void done(int pm) const {
        if (role != 1) return;
        asm volatile("s_waitcnt vmcnt(0)" ::: "memory");
        if (__builtin_amdgcn_mbcnt_hi(~0u, __builtin_amdgcn_mbcnt_lo(~0u, 0u)) == 0u) __hip_atomic_fetch_add(ready + 64 * pm, 1u, __ATOMIC_RELAXED, __HIP_MEMORY_SCOPE_AGENT);
    }
};
__device__ __forceinline__ void store16_sc1(void* p, u32x4 v) { asm volatile("global_store_dwordx4 %0, %1, off sc1\n\ts_nop 1" :: "v"(p), "v"(v) : "memory"); }

struct BatchOrder {
    const char* A; const char* B; size_t sa, sb, tst; int nM, nN, nwg, tot, G, c, zcl; HandOff ho;
    __device__ __forceinline__ void init(const void* A_, const void* B_, size_t sa_, size_t sb_, int M, int N, int Z, int K, int G_, int c_) {
        A = (const char*)A_; B = (const char*)B_; sa = sa_; sb = sb_; tst = (size_t)BM * K * 2; nM = M / BM; nN = N / BM; nwg = nM * nN; tot = nwg * Z; G = G_; c = c_; zcl = 1 << 20; ho.clear(); }
    __device__ __forceinline__ bool next(int i, Unit& u) const {
        const int L = i * G + c; if (c < 0 || L >= tot) return false;
        u.z = L / nwg; int wgid = L - u.z * nwg; { const int q = nwg / NXCD, r = nwg % NXCD, xcd = wgid % NXCD, off = wgid / NXCD; wgid = (xcd < r ? xcd * (q + 1) : r * (q + 1) + (xcd - r) * q) + off; }
        const int nig = WGM * nN, gid = wgid / nig, fm = gid * WGM, gsz = (nM - fm) < WGM ? (nM - fm) : WGM;
        u.pm = fm + ((wgid % nig) % gsz); u.pn = (wgid % nig) / gsz; return true;
    }
    __device__ __forceinline__ const char* a_base(const Unit& u) const { return A + (size_t)(u.z < zcl ? u.z : zcl) * sa + (size_t)u.pm * tst; }
    __device__ __forceinline__ const char* b_base(const Unit& u) const { return B + (size_t)u.z * sb + (size_t)u.pn * tst; }
    __device__ __forceinline__ void a_ready(const Unit& u) const { ho.a_ready(u.pm); }
    __device__ __forceinline__ void done(const Unit& u) const { ho.done(u.pm); }
};
constexpr int MOE_CAP = 16384;
struct MoeOrder {
    const char* A; const char* B; size_t sbe, tst; const PG8_LAS int* toff; const PG8_LAS int* cnt; const int* rowtok; int nNt, tot, G, c, K;
    HandOff ho; int dealR;
    __device__ __forceinline__ void init(const void* A_, const void* B_, size_t sbe_, const PG8_LAS int* toff_, const PG8_LAS int* cnt_, const int* rowtok_, int nNt_, int K_, int G_, int c_) {
        A = (const char*)A_; B = (const char*)B_; sbe = sbe_; tst = (size_t)BM * K_ * 2; toff = toff_; cnt = cnt_; rowtok = rowtok_; nNt = nNt_; tot = __builtin_amdgcn_readfirstlane(toff_[32]) * nNt_; G = G_; c = c_; K = K_; ho.clear(); dealR = 0; }
    __device__ __forceinline__ void hand_off(int role_, unsigned* ready_, unsigned need_, unsigned* tmo_, int wid_) { ho.set(role_, ready_, need_, tmo_, wid_); }
    __device__ __forceinline__ void redeal(int r) { dealR = r; }
    __device__ __forceinline__ bool next(int i, Unit& u) const {
        int L = i * G + c;
        if (dealR > 0) { const int hg = G - dealR; L = (c >= dealR) ? ((i < 2) ? i * hg + (c - dealR) : 2 * hg + (i - 2) * G + c) : 2 * hg + i * G + c; }
        if (L >= tot) return false;
        const int tI = L / nNt; u.pm = tI; u.pn = L - tI * nNt; int e = 0;
#pragma unroll
        for (int j = 1; j < 32; ++j) e += (toff[j] <= tI) ? 1 : 0;
        u.z = __builtin_amdgcn_readfirstlane(e); return true;
    }
    __device__ __forceinline__ const char* a_base(const Unit& u) const { return rowtok ? A : A + (size_t)u.pm * tst; }
    __device__ __forceinline__ const char* b_base(const Unit& u) const { return B + (size_t)u.z * sbe + (size_t)u.pn * tst; }
    __device__ __forceinline__ unsigned a_goff(const Unit& u, int half, int R, int C) const {
        const int pos = 256 * (u.pm - toff[u.z]) + 128 * half + R; const int tok = (pos < cnt[u.z]) ? rowtok[(size_t)u.z * MOE_CAP + pos] : 0;
        return (unsigned)(tok * K + C) * 2u; }
    __device__ __forceinline__ void a_ready(const Unit& u) const { ho.a_ready(u.pm); }
    __device__ __forceinline__ void done(const Unit& u) const { ho.done(u.pm); }
};

__device__ __forceinline__ float sigmoidf_(float x) { return __builtin_amdgcn_rcpf(1.0f + __expf(-x)); }
__device__ __forceinline__ float tanh_fast(float x) { return 1.0f - 2.0f * __builtin_amdgcn_rcpf(__expf(2.0f * x) + 1.0f); }

struct EpiZBf16 {
    static constexpr bool PERM = true, AFTER_DRAIN = false;
    bf16_t* O; size_t zstride; float scale0;
    __device__ __forceinline__ void operator()(const f32x4 (&acc)[2][2][4][2], const Unit& u, int wr, int wc, int fr, int fq) const {
        const int row0 = u.pm * BM + wr * 64 + fr, col0 = u.pn * BM + wc * 32 + 8 * fq; bf16_t* base = O + (size_t)u.z * zstride; const float sc = (u.z == 0) ? scale0 : 1.0f;
#pragma unroll
        for (int ai = 0; ai < 2; ++ai)
#pragma unroll
            for (int m = 0; m < 4; ++m) { bf16_t* rowp = base + (size_t)(row0 + ai * HALF + m * 16) * 1024 + col0;
#pragma unroll
                for (int bj = 0; bj < 2; ++bj) { const f32x4 v0 = acc[ai][bj][m][0] * sc, v1 = acc[ai][bj][m][1] * sc;
                    u32x4 w; w.x = cvt_pk_bf16(v0[0], v0[1]); w.y = cvt_pk_bf16(v0[2], v0[3]); w.z = cvt_pk_bf16(v1[0], v1[1]); w.w = cvt_pk_bf16(v1[2], v1[3]);
                    *(u32x4*)(rowp + bj * HALF) = w; } }
    }
};
struct EpiLora1 {
    static constexpr bool PERM = true, AFTER_DRAIN = false;
    bf16_t* O;
    __device__ __forceinline__ void operator()(const f32x4 (&acc)[2][2][4][2], const Unit& u, int wr, int wc, int fr, int fq) const {
        const int row0 = u.pm * BM + wr * 64 + fr, col0 = wc * 32 + 8 * fq;
#pragma unroll
        for (int ai = 0; ai < 2; ++ai)
#pragma unroll
            for (int m = 0; m < 4; ++m) { bf16_t* rowp = O + (size_t)(row0 + ai * HALF + m * 16) * 256 + col0;
#pragma unroll
                for (int bj = 0; bj < 2; ++bj) { f32x4 v0 = acc[ai][bj][m][0], v1 = acc[ai][bj][m][1];
                    if (bj == 0 && wc < 2) {
#pragma unroll
                        for (int j = 0; j < 4; ++j) { v0[j] = tanh_fast(v0[j]); v1[j] = tanh_fast(v1[j]); } }
                    if (bj == 1) {
#pragma unroll
                        for (int j = 0; j < 4; ++j) { v0[j] = sigmoidf_(v0[j]); v1[j] = sigmoidf_(v1[j]); } }
                    u32x4 w; w.x = cvt_pk_bf16(v0[0], v0[1]); w.y = cvt_pk_bf16(v0[2], v0[3]); w.z = cvt_pk_bf16(v1[0], v1[1]); w.w = cvt_pk_bf16(v1[2], v1[3]);
                    store16_sc1(rowp + bj * HALF, w); } }
    }
};
struct EpiLora2 {
    static constexpr bool PERM = false, AFTER_DRAIN = false;
    _Float16* LW; bf16_t* AS; bf16_t* GG; const PG8_LAS float* w0; const PG8_LAS float* a0;
    __device__ __forceinline__ void operator()(const f32x4 (&acc)[2][2][4][2], const Unit& u, int wr, int wc, int fr, int fq) const {
        const int sect = u.pn >> 2, row0 = u.pm * BM + wr * 64 + fr, col0 = (u.pn & 3) * BM + wc * 32 + 8 * fq;
        typedef _Float16 h2_t __attribute__((ext_vector_type(2)));
        if (sect == 0) {
#pragma unroll
            for (int bj = 0; bj < 2; ++bj) { const int c = col0 + bj * HALF; unsigned pk[2][4][2];
                { const f32x4 b0 = *(const PG8_LAS f32x4*)(w0 + c);
#pragma unroll
                  for (int ai = 0; ai < 2; ++ai)
#pragma unroll
                    for (int m = 0; m < 4; ++m) { f32x4 v0 = acc[ai][bj][m][0] + b0;
#pragma unroll
                        for (int j = 0; j < 4; ++j) v0[j] = -0.8750387749f * sigmoidf_(v0[j]);
                        const h2_t p0 = {(_Float16)v0[0], (_Float16)v0[1]}, p1 = {(_Float16)v0[2], (_Float16)v0[3]};
                        pk[ai][m][0] = __builtin_bit_cast(unsigned, p0); pk[ai][m][1] = __builtin_bit_cast(unsigned, p1); } }
                { const f32x4 b1 = *(const PG8_LAS f32x4*)(w0 + c + 4);
#pragma unroll
                  for (int ai = 0; ai < 2; ++ai)
#pragma unroll
                    for (int m = 0; m < 4; ++m) { f32x4 v1 = acc[ai][bj][m][1] + b1;
#pragma unroll
                        for (int j = 0; j < 4; ++j) v1[j] = -0.8750387749f * sigmoidf_(v1[j]);
                        const h2_t p2 = {(_Float16)v1[0], (_Float16)v1[1]}, p3 = {(_Float16)v1[2], (_Float16)v1[3]};
                        u32x4 w; w.x = pk[ai][m][0]; w.y = pk[ai][m][1]; w.z = __builtin_bit_cast(unsigned, p2); w.w = __builtin_bit_cast(unsigned, p3);
                        *(u32x4*)(LW + (size_t)(row0 + ai * HALF + m * 16) * 1024 + c) = w; } } }
        } else if (sect == 1) {
#pragma unroll
            for (int bj = 0; bj < 2; ++bj) { const int c = col0 + bj * HALF; unsigned pk[2][4][2];
                { const f32x4 b0 = *(const PG8_LAS f32x4*)(a0 + c);
#pragma unroll
                  for (int ai = 0; ai < 2; ++ai)
#pragma unroll
                    for (int m = 0; m < 4; ++m) { f32x4 v0 = acc[ai][bj][m][0] + b0;
#pragma unroll
                        for (int j = 0; j < 4; ++j) v0[j] = sigmoidf_(v0[j]);
                        pk[ai][m][0] = cvt_pk_bf16(v0[0], v0[1]); pk[ai][m][1] = cvt_pk_bf16(v0[2], v0[3]); } }
                { const f32x4 b1 = *(const PG8_LAS f32x4*)(a0 + c + 4);
#pragma unroll
                  for (int ai = 0; ai < 2; ++ai)
#pragma unroll
                    for (int m = 0; m < 4; ++m) { f32x4 v1 = acc[ai][bj][m][1] + b1;
#pragma unroll
                        for (int j = 0; j < 4; ++j) v1[j] = sigmoidf_(v1[j]);
                        u32x4 w; w.x = pk[ai][m][0]; w.y = pk[ai][m][1]; w.z = cvt_pk_bf16(v1[0], v1[1]); w.w = cvt_pk_bf16(v1[2], v1[3]);
                        *(u32x4*)(AS + (size_t)(row0 + ai * HALF + m * 16) * 1024 + c) = w; } } }
        } else {
#pragma unroll
            for (int bj = 0; bj < 2; ++bj) { const int c = col0 + bj * HALF;
#pragma unroll
                for (int ai = 0; ai < 2; ++ai)
#pragma unroll
                    for (int m = 0; m < 4; ++m) { const f32x4 v0 = acc[ai][bj][m][0], v1 = acc[ai][bj][m][1];
                        u32x4 w; w.x = cvt_pk_bf16(v0[0], v0[1]); w.y = cvt_pk_bf16(v0[2], v0[3]); w.z = cvt_pk_bf16(v1[0], v1[1]); w.w = cvt_pk_bf16(v1[2], v1[3]);
                        *(u32x4*)(GG + (size_t)(row0 + ai * HALF + m * 16) * 1024 + c) = w; } }
        }
    }
};
struct EpiResid {
    static constexpr bool PERM = false, AFTER_DRAIN = false;
    const float* xin; float* xout; const float* gate;
    __device__ __forceinline__ void operator()(const f32x4 (&acc)[2][2][4][2], const Unit& u, int wr, int wc, int fr, int fq) const {
        const int row0 = u.pm * BM + wr * 64 + fr, col0 = u.pn * BM + wc * 32 + 4 * fq; const float* gp = gate + (size_t)(u.pm >> 4) * 6144 + col0;
        f32x4 gv[2][2];
#pragma unroll
        for (int bj = 0; bj < 2; ++bj)
#pragma unroll
            for (int n = 0; n < 2; ++n) gv[bj][n] = *(const f32x4*)(gp + bj * HALF + n * 16);
#pragma unroll
        for (int ai = 0; ai < 2; ++ai)
#pragma unroll
            for (int m = 0; m < 4; ++m) { const size_t ro = (size_t)(row0 + ai * HALF + m * 16) * 1024 + col0;
                f32x4 xi[2][2];
#pragma unroll
                for (int bj = 0; bj < 2; ++bj)
#pragma unroll
                    for (int n = 0; n < 2; ++n) xi[bj][n] = *(const f32x4*)(xin + ro + bj * HALF + n * 16);
#pragma unroll
                for (int bj = 0; bj < 2; ++bj)
#pragma unroll
                    for (int n = 0; n < 2; ++n) store16_sc1(xout + ro + bj * HALF + n * 16, __builtin_bit_cast(u32x4, xi[bj][n] + gv[bj][n] * acc[ai][bj][m][n]));     }
    }
};
struct EpiGU {
    static constexpr bool PERM = true, AFTER_DRAIN = false;
    bf16_t* H;
    __device__ __forceinline__ void operator()(const f32x4 (&acc)[2][2][4][2], const Unit& u, int wr, int wc, int fr, int fq) const {
        const int row0 = u.pm * BM + wr * 64 + fr, col0 = u.pn * HALF + wc * 32 + 8 * fq;
#pragma unroll
        for (int ai = 0; ai < 2; ++ai)
#pragma unroll
            for (int m = 0; m < 4; ++m) { float h[8];
#pragma unroll
                for (int n = 0; n < 2; ++n)
#pragma unroll
                    for (int j = 0; j < 4; ++j) { const float g = acc[ai][0][m][n][j], up = acc[ai][1][m][n][j]; h[n * 4 + j] = g * sigmoidf_(g) * up; }
                u32x4 w; w.x = cvt_pk_bf16(h[0], h[1]); w.y = cvt_pk_bf16(h[2], h[3]); w.z = cvt_pk_bf16(h[4], h[5]); w.w = cvt_pk_bf16(h[6], h[7]);
                store16_sc1(H + (size_t)(row0 + ai * HALF + m * 16) * 512 + col0, w); }
    }
};
struct EpiDown {
    static constexpr bool PERM = true, AFTER_DRAIN = false;
    bf16_t* Y;
    __device__ __forceinline__ void operator()(const f32x4 (&acc)[2][2][4][2], const Unit& u, int wr, int wc, int fr, int fq) const {
        const int rl0 = wr * 64 + fr, col0 = u.pn * BM + wc * 32 + 8 * fq;
#pragma unroll
        for (int ai = 0; ai < 2; ++ai)
#pragma unroll
            for (int m = 0; m < 4; ++m) { const int rl = rl0 + ai * HALF + m * 16; bf16_t* rowp = Y + (size_t)(u.pm * BM + rl) * 1024 + col0;
#pragma unroll
                for (int bj = 0; bj < 2; ++bj) { const f32x4 v0 = acc[ai][bj][m][0], v1 = acc[ai][bj][m][1];
                    u32x4 w; w.x = cvt_pk_bf16(v0[0], v0[1]); w.y = cvt_pk_bf16(v0[2], v0[3]); w.z = cvt_pk_bf16(v1[0], v1[1]); w.w = cvt_pk_bf16(v1[2], v1[3]);
                    *(u32x4*)(rowp + bj * HALF) = w; } }
    }
};

template <class Epi, class Sched, bool ALIGN_EPI = false, bool SP2 = false>
__device__ __forceinline__ void gemm_phase(PG8_LAS unsigned char* lds, const int K_, const Sched& S, const Epi& E, const int tid_, const int wid_) {
    const int tid = tid_, wid = wid_, lane = tid & 63, wr = wid >> 2, wc = wid & 3, fr = lane & 15, fq = lane >> 4;
    const int K = K_, nt = K / BK;
    unsigned voffA[2], voffB[2];
#pragma unroll
    for (int i = 0; i < 2; ++i) { int R, C; stage_rc(tid * 16 + i * 8192, R, C); const int Rb = Epi::PERM ? ((R & ~31) + perm32(R & 31)) : R;
        voffA[i] = (unsigned)(R * K + C) * 2u; voffB[i] = (unsigned)(Rb * K + C) * 2u; }
    const size_t kstep = (size_t)(BK * 2);
    const size_t hstep = (size_t)HALF * K * 2;
    const unsigned ldsw = (unsigned)wid * 1024u;
    const int aoff = lds_byte(wr * 64 + fr, fq * 8), boff = lds_byte(wc * 32 + fr, fq * 8);
#define PG8_SA(b, h) (((b) * 2 + (h)) * HTB)
#define PG8_SB(b, h) ((4 + (b) * 2 + (h)) * HTB)
#define PG8_STAGE(bufoff, gbase, voff) do { _Pragma("unroll") for (int _i = 0; _i < 2; ++_i) \
        __builtin_amdgcn_global_load_lds((const unsigned*)((const char*)(gbase) + (voff)[_i]), (PG8_LAS unsigned*)(lds + (bufoff) + ldsw + _i * 8192), 16, 0, 0); } while (0)
#define PG8_LDA(dst, b, h) do { _Pragma("unroll") for (int m = 0; m < 4; ++m) _Pragma("unroll") for (int k = 0; k < 2; ++k) dst[m][k] = *(const PG8_LAS bf16x8*)(lds + PG8_SA(b, h) + aoff + m * 2048 + k * 1024); } while (0)
#define PG8_LDB(dst, b, h) do { _Pragma("unroll") for (int n = 0; n < 2; ++n) _Pragma("unroll") for (int k = 0; k < 2; ++k) dst[n][k] = *(const PG8_LAS bf16x8*)(lds + PG8_SB(b, h) + boff + n * 2048 + k * 1024); } while (0)
#define PG8_MMA(ai, bj, At, Bt) do { __builtin_amdgcn_s_setprio(1); _Pragma("unroll") for (int m = 0; m < 4; ++m) _Pragma("unroll") for (int n = 0; n < 2; ++n) _Pragma("unroll") for (int k = 0; k < 2; ++k) \
        acc[ai][bj][m][n] = __builtin_amdgcn_mfma_f32_16x16x32_bf16(Bt[n][k], At[m][k], acc[ai][bj][m][n], 0, 0, 0); __builtin_amdgcn_s_setprio(0); } while (0)
#define PG8_WAIT_V(n) asm volatile("s_waitcnt vmcnt(" #n ")" ::: "memory")
#define PG8_WAIT_L(n) asm volatile("s_waitcnt lgkmcnt(" #n ")" ::: "memory")
#define PG8_BAR __builtin_amdgcn_s_barrier()
#define PG8_SCHED __builtin_amdgcn_sched_barrier(0)
    Unit cur, nxt; int ui = 0;
    if (!S.next(0, cur)) return;
    f32x4 acc[2][2][4][2];
#pragma unroll
    for (int a = 0; a < 2; ++a)
#pragma unroll
        for (int b = 0; b < 2; ++b)
#pragma unroll
            for (int m = 0; m < 4; ++m)
#pragma unroll
                for (int n = 0; n < 2; ++n) acc[a][b][m][n] = (f32x4){0.f, 0.f, 0.f, 0.f};
    bf16x8 At[4][2], B0[2][2], B1[2][2];
    const char* cA = S.a_base(cur); const char* cB = S.b_base(cur);
    S.a_ready(cur);
    if constexpr (SP2) {
        PG8_STAGE(PG8_SB(0, 0), cB, voffB); PG8_STAGE(PG8_SB(0, 1), cB + hstep, voffB); PG8_STAGE(PG8_SA(0, 0), cA, voffA); PG8_STAGE(PG8_SA(0, 1), cA + hstep, voffA);
        if (wr == 1) PG8_BAR;
        PG8_WAIT_V(2); PG8_BAR;
        PG8_STAGE(PG8_SB(1, 0), cB + kstep, voffB); PG8_STAGE(PG8_SA(1, 0), cA + kstep, voffA); PG8_STAGE(PG8_SB(1, 1), cB + hstep + kstep, voffB);
        PG8_WAIT_V(6); PG8_BAR;
    } else {
        PG8_STAGE(PG8_SB(0, 0), cB, voffB); PG8_STAGE(PG8_SA(0, 0), cA, voffA); PG8_STAGE(PG8_SB(0, 1), cB + hstep, voffB); PG8_STAGE(PG8_SA(0, 1), cA + hstep, voffA);
        if (wr == 1) PG8_BAR;
        PG8_WAIT_V(4); PG8_BAR;
        PG8_STAGE(PG8_SB(1, 0), cB + kstep, voffB); PG8_STAGE(PG8_SA(1, 0), cA + kstep, voffA); PG8_STAGE(PG8_SB(1, 1), cB + hstep + kstep, voffB);
        PG8_WAIT_V(6); PG8_BAR;
    }
    for (;;) {
        const bool has_next = S.next(ui + 1, nxt);
        const char* nA = has_next ? S.a_base(nxt) : cA; const char* nB = has_next ? S.b_base(nxt) : cB;
        for (int t = 0; t < nt; t += 2) {
            const bool last = (t == nt - 2);
            const char* a1 = cA + (size_t)(t + 1) * kstep;
            const char* a2 = last ? nA : cA + (size_t)(t + 2) * kstep; const char* b2 = last ? nB : cB + (size_t)(t + 2) * kstep;
            const char* a3 = a2 + kstep; const char* b3 = b2 + kstep;
            if (last && has_next) S.a_ready(nxt);
            if constexpr (SP2) {
            PG8_LDB(B0, 0, 0); PG8_LDB(B1, 0, 1); PG8_SCHED; PG8_LDA(At, 0, 0); PG8_STAGE(PG8_SA(1, 1), a1 + hstep, voffA);
            PG8_WAIT_V(8); PG8_WAIT_L(0); PG8_BAR; PG8_MMA(0, 0, At, B0); PG8_MMA(0, 1, At, B1); PG8_BAR; PG8_SCHED;
            PG8_LDA(At, 0, 1); PG8_STAGE(PG8_SB(0, 0), b2, voffB); PG8_STAGE(PG8_SB(0, 1), b2 + hstep, voffB); PG8_STAGE(PG8_SA(0, 0), a2, voffA);
            PG8_WAIT_V(8); PG8_WAIT_L(0); PG8_BAR; PG8_MMA(1, 0, At, B0); PG8_MMA(1, 1, At, B1); PG8_BAR; PG8_SCHED;
            PG8_LDB(B0, 1, 0); PG8_LDB(B1, 1, 1); PG8_SCHED; PG8_LDA(At, 1, 0); PG8_STAGE(PG8_SA(0, 1), a2 + hstep, voffA);
            PG8_WAIT_V(8); PG8_WAIT_L(0); PG8_BAR; PG8_MMA(0, 0, At, B0); PG8_MMA(0, 1, At, B1); PG8_BAR; PG8_SCHED;
            PG8_LDA(At, 1, 1); PG8_STAGE(PG8_SB(1, 0), b3, voffB); PG8_STAGE(PG8_SB(1, 1), b3 + hstep, voffB); PG8_STAGE(PG8_SA(1, 0), a3, voffA);
            PG8_WAIT_V(8); PG8_WAIT_L(0); PG8_BAR; PG8_MMA(1, 0, At, B0); PG8_MMA(1, 1, At, B1); PG8_BAR; PG8_SCHED;
            } else {
            PG8_LDB(B0, 0, 0); PG8_SCHED; PG8_LDA(At, 0, 0); PG8_STAGE(PG8_SA(1, 1), a1 + hstep, voffA);
            PG8_WAIT_L(8); PG8_BAR; PG8_WAIT_L(0); PG8_MMA(0, 0, At, B0); PG8_BAR; PG8_SCHED;
            PG8_LDB(B1, 0, 1); PG8_STAGE(PG8_SB(0, 0), b2, voffB);
            PG8_BAR; PG8_WAIT_L(0); PG8_MMA(0, 1, At, B1); PG8_BAR;
            PG8_LDA(At, 0, 1); PG8_STAGE(PG8_SA(0, 0), a2, voffA);
            PG8_BAR; PG8_WAIT_L(0); PG8_MMA(1, 0, At, B0); PG8_BAR; PG8_SCHED;
            PG8_STAGE(PG8_SB(0, 1), b2 + hstep, voffB);
            PG8_WAIT_V(6); PG8_BAR; PG8_MMA(1, 1, At, B1); PG8_BAR;
            PG8_LDB(B0, 1, 0); PG8_SCHED; PG8_LDA(At, 1, 0); PG8_STAGE(PG8_SA(0, 1), a2 + hstep, voffA);
            PG8_WAIT_L(8); PG8_BAR; PG8_WAIT_L(0); PG8_MMA(0, 0, At, B0); PG8_BAR; PG8_SCHED;
            PG8_LDB(B1, 1, 1); PG8_STAGE(PG8_SB(1, 0), b3, voffB);
            PG8_BAR; PG8_WAIT_L(0); PG8_MMA(0, 1, At, B1); PG8_BAR;
            PG8_LDA(At, 1, 1); PG8_STAGE(PG8_SA(1, 0), a3, voffA);
            PG8_BAR; PG8_WAIT_L(0); PG8_MMA(1, 0, At, B0); PG8_BAR; PG8_SCHED;
            PG8_STAGE(PG8_SB(1, 1), b3 + hstep, voffB);
            PG8_WAIT_V(6); PG8_BAR; PG8_MMA(1, 1, At, B1); PG8_BAR;
            }
        }
        if constexpr (ALIGN_EPI) { if (wr == 0) PG8_BAR; }
        if constexpr (!Epi::AFTER_DRAIN) { E(acc, cur, wr, wc, fr, fq); S.done(cur); }
        if (!has_next) break;
#pragma unroll
        for (int a = 0; a < 2; ++a)
#pragma unroll
            for (int b = 0; b < 2; ++b)
#pragma unroll
                for (int m = 0; m < 4; ++m)
#pragma unroll
                    for (int n = 0; n < 2; ++n) acc[a][b][m][n] = (f32x4){0.f, 0.f, 0.f, 0.f};
        cur = nxt; cA = nA; cB = nB; ++ui;
        if constexpr (ALIGN_EPI) { if (wr == 1) PG8_BAR; }
    }
    PG8_WAIT_V(0);
    if constexpr (!ALIGN_EPI) { if (wr == 0) PG8_BAR; }
    PG8_BAR;
    if constexpr (Epi::AFTER_DRAIN) { E.fused(acc, cur, wr, wc, fr, fq, lds, wid, lane); S.done(cur); }
#undef PG8_SA
#undef PG8_SB
#undef PG8_STAGE
#undef PG8_LDA
#undef PG8_LDB
#undef PG8_MMA
#undef PG8_WAIT_V
#undef PG8_WAIT_L
#undef PG8_BAR
#undef PG8_SCHED
}

template <class Epi, class Sched>
__device__ __forceinline__ void gemm_phase_gather(PG8_LAS unsigned char* lds, const int K_, const Sched& S, const Epi& E, const int tid_, const int wid_) {
    const int tid = tid_, wid = wid_, lane = tid & 63, wr = wid >> 2, wc = wid & 3, fr = lane & 15, fq = lane >> 4;
    const int K = K_, nt = K / BK;
    constexpr bool ALIGN_EPI = true, SP2 = true;
    unsigned voffA[2], voffB[2]; int Rg[2], Cg[2];
#pragma unroll
    for (int i = 0; i < 2; ++i) { int R, C; stage_rc(tid * 16 + i * 8192, R, C); const int Rb = Epi::PERM ? ((R & ~31) + perm32(R & 31)) : R;
        voffA[i] = 0u; Rg[i] = R; Cg[i] = C; voffB[i] = (unsigned)(Rb * K + C) * 2u; }
    unsigned va0[2], va1[2], nva0[2], nva1[2];
#define PG8_GOFF(dst0, dst1, U) do { _Pragma("unroll") for (int _i = 0; _i < 2; ++_i) { dst0[_i] = S.a_goff(U, 0, Rg[_i], Cg[_i]); dst1[_i] = S.a_goff(U, 1, Rg[_i], Cg[_i]); } } while (0)
#define PG8_SEL(last_, nv, v) { (last_) ? nv[0] : v[0], (last_) ? nv[1] : v[1] }
    const size_t kstep = (size_t)(BK * 2);
    const size_t hstep = (size_t)HALF * K * 2;
    const unsigned ldsw = (unsigned)wid * 1024u;
    const int aoff = lds_byte(wr * 64 + fr, fq * 8), boff = lds_byte(wc * 32 + fr, fq * 8);
#define PG8_SA(b, h) (((b) * 2 + (h)) * HTB)
#define PG8_SB(b, h) ((4 + (b) * 2 + (h)) * HTB)
#define PG8_STAGE(bufoff, gbase, voff) do { _Pragma("unroll") for (int _i = 0; _i < 2; ++_i) \
        __builtin_amdgcn_global_load_lds((const unsigned*)((const char*)(gbase) + (voff)[_i]), (PG8_LAS unsigned*)(lds + (bufoff) + ldsw + _i * 8192), 16, 0, 0); } while (0)
#define PG8_LDA(dst, b, h) do { _Pragma("unroll") for (int m = 0; m < 4; ++m) _Pragma("unroll") for (int k = 0; k < 2; ++k) dst[m][k] = *(const PG8_LAS bf16x8*)(lds + PG8_SA(b, h) + aoff + m * 2048 + k * 1024); } while (0)
#define PG8_LDB(dst, b, h) do { _Pragma("unroll") for (int n = 0; n < 2; ++n) _Pragma("unroll") for (int k = 0; k < 2; ++k) dst[n][k] = *(const PG8_LAS bf16x8*)(lds + PG8_SB(b, h) + boff + n * 2048 + k * 1024); } while (0)
#define PG8_MMA(ai, bj, At, Bt) do { __builtin_amdgcn_s_setprio(1); _Pragma("unroll") for (int m = 0; m < 4; ++m) _Pragma("unroll") for (int n = 0; n < 2; ++n) _Pragma("unroll") for (int k = 0; k < 2; ++k) \
        acc[ai][bj][m][n] = __builtin_amdgcn_mfma_f32_16x16x32_bf16(Bt[n][k], At[m][k], acc[ai][bj][m][n], 0, 0, 0); __builtin_amdgcn_s_setprio(0); } while (0)
#define PG8_WAIT_V(n) asm volatile("s_waitcnt vmcnt(" #n ")" ::: "memory")
#define PG8_WAIT_L(n) asm volatile("s_waitcnt lgkmcnt(" #n ")" ::: "memory")
#define PG8_BAR __builtin_amdgcn_s_barrier()
#define PG8_SCHED __builtin_amdgcn_sched_barrier(0)
    Unit cur, nxt; int ui = 0;
    if (!S.next(0, cur)) return;
    f32x4 acc[2][2][4][2];
#pragma unroll
    for (int a = 0; a < 2; ++a)
#pragma unroll
        for (int b = 0; b < 2; ++b)
#pragma unroll
            for (int m = 0; m < 4; ++m)
#pragma unroll
                for (int n = 0; n < 2; ++n) acc[a][b][m][n] = (f32x4){0.f, 0.f, 0.f, 0.f};
    bf16x8 At[4][2], B0[2][2], B1[2][2];
    const char* cA = S.a_base(cur); const char* cB = S.b_base(cur);
    S.a_ready(cur);
    if constexpr (SP2) {
        PG8_GOFF(va0, va1, cur);
        PG8_STAGE(PG8_SB(0, 0), cB, voffB); PG8_STAGE(PG8_SB(0, 1), cB + hstep, voffB); PG8_STAGE(PG8_SA(0, 0), cA, va0); PG8_STAGE(PG8_SA(0, 1), cA, va1);
        if (wr == 1) PG8_BAR;
        PG8_WAIT_V(2); PG8_BAR;
        PG8_STAGE(PG8_SB(1, 0), cB + kstep, voffB); PG8_STAGE(PG8_SA(1, 0), cA + kstep, va0); PG8_STAGE(PG8_SB(1, 1), cB + hstep + kstep, voffB);
        PG8_WAIT_V(6); PG8_BAR;
    } else {
        PG8_STAGE(PG8_SB(0, 0), cB, voffB); PG8_STAGE(PG8_SA(0, 0), cA, voffA); PG8_STAGE(PG8_SB(0, 1), cB + hstep, voffB); PG8_STAGE(PG8_SA(0, 1), cA + hstep, voffA);
        if (wr == 1) PG8_BAR;
        PG8_WAIT_V(4); PG8_BAR;
        PG8_STAGE(PG8_SB(1, 0), cB + kstep, voffB); PG8_STAGE(PG8_SA(1, 0), cA + kstep, voffA); PG8_STAGE(PG8_SB(1, 1), cB + hstep + kstep, voffB);
        PG8_WAIT_V(6); PG8_BAR;
    }
    for (;;) {
        const bool has_next = S.next(ui + 1, nxt);
        if (has_next) PG8_GOFF(nva0, nva1, nxt); else { nva0[0] = va0[0]; nva0[1] = va0[1]; nva1[0] = va1[0]; nva1[1] = va1[1]; }
        const char* nA = has_next ? S.a_base(nxt) : cA; const char* nB = has_next ? S.b_base(nxt) : cB;
        for (int t = 0; t < nt; t += 2) {
            const bool last = (t == nt - 2);
            const char* a1 = cA + (size_t)(t + 1) * kstep;
            const char* a2 = last ? nA : cA + (size_t)(t + 2) * kstep; const char* b2 = last ? nB : cB + (size_t)(t + 2) * kstep;
            const char* a3 = a2 + kstep; const char* b3 = b2 + kstep;
            if (last && has_next) S.a_ready(nxt);
            if constexpr (SP2) {
            PG8_LDB(B0, 0, 0); PG8_LDB(B1, 0, 1); PG8_SCHED; PG8_LDA(At, 0, 0); PG8_STAGE(PG8_SA(1, 1), a1, va1);
            PG8_WAIT_V(8); PG8_WAIT_L(0); PG8_BAR; PG8_MMA(0, 0, At, B0); PG8_MMA(0, 1, At, B1); PG8_BAR; PG8_SCHED;
            PG8_LDA(At, 0, 1); PG8_STAGE(PG8_SB(0, 0), b2, voffB); PG8_STAGE(PG8_SB(0, 1), b2 + hstep, voffB); { const unsigned sv[2] = PG8_SEL(last, nva0, va0); PG8_STAGE(PG8_SA(0, 0), a2, sv); }
            PG8_WAIT_V(8); PG8_WAIT_L(0); PG8_BAR; PG8_MMA(1, 0, At, B0); PG8_MMA(1, 1, At, B1); PG8_BAR; PG8_SCHED;
            PG8_LDB(B0, 1, 0); PG8_LDB(B1, 1, 1); PG8_SCHED; PG8_LDA(At, 1, 0); { const unsigned sv[2] = PG8_SEL(last, nva1, va1); PG8_STAGE(PG8_SA(0, 1), a2, sv); }
            PG8_WAIT_V(8); PG8_WAIT_L(0); PG8_BAR; PG8_MMA(0, 0, At, B0); PG8_MMA(0, 1, At, B1); PG8_BAR; PG8_SCHED;
            PG8_LDA(At, 1, 1); PG8_STAGE(PG8_SB(1, 0), b3, voffB); PG8_STAGE(PG8_SB(1, 1), b3 + hstep, voffB); { const unsigned sv[2] = PG8_SEL(last, nva0, va0); PG8_STAGE(PG8_SA(1, 0), a3, sv); }
            PG8_WAIT_V(8); PG8_WAIT_L(0); PG8_BAR; PG8_MMA(1, 0, At, B0); PG8_MMA(1, 1, At, B1); PG8_BAR; PG8_SCHED;
            } else {
            PG8_LDB(B0, 0, 0); PG8_SCHED; PG8_LDA(At, 0, 0); PG8_STAGE(PG8_SA(1, 1), a1 + hstep, voffA);
            PG8_WAIT_L(8); PG8_BAR; PG8_WAIT_L(0); PG8_MMA(0, 0, At, B0); PG8_BAR; PG8_SCHED;
            PG8_LDB(B1, 0, 1); PG8_STAGE(PG8_SB(0, 0), b2, voffB);
            PG8_BAR; PG8_WAIT_L(0); PG8_MMA(0, 1, At, B1); PG8_BAR;
            PG8_LDA(At, 0, 1); PG8_STAGE(PG8_SA(0, 0), a2, voffA);
            PG8_BAR; PG8_WAIT_L(0); PG8_MMA(1, 0, At, B0); PG8_BAR; PG8_SCHED;
            PG8_STAGE(PG8_SB(0, 1), b2 + hstep, voffB);
            PG8_WAIT_V(6); PG8_BAR; PG8_MMA(1, 1, At, B1); PG8_BAR;
            PG8_LDB(B0, 1, 0); PG8_SCHED; PG8_LDA(At, 1, 0); PG8_STAGE(PG8_SA(0, 1), a2 + hstep, voffA);
            PG8_WAIT_L(8); PG8_BAR; PG8_WAIT_L(0); PG8_MMA(0, 0, At, B0); PG8_BAR; PG8_SCHED;
            PG8_LDB(B1, 1, 1); PG8_STAGE(PG8_SB(1, 0), b3, voffB);
            PG8_BAR; PG8_WAIT_L(0); PG8_MMA(0, 1, At, B1); PG8_BAR;
            PG8_LDA(At, 1, 1); PG8_STAGE(PG8_SA(1, 0), a3, voffA);
            PG8_BAR; PG8_WAIT_L(0); PG8_MMA(1, 0, At, B0); PG8_BAR; PG8_SCHED;
            PG8_STAGE(PG8_SB(1, 1), b3 + hstep, voffB);
            PG8_WAIT_V(6); PG8_BAR; PG8_MMA(1, 1, At, B1); PG8_BAR;
            }
        }
        if constexpr (ALIGN_EPI) { if (wr == 0) PG8_BAR; }
        if constexpr (!Epi::AFTER_DRAIN) { E(acc, cur, wr, wc, fr, fq); S.done(cur); }
        if (!has_next) break;
#pragma unroll
        for (int a = 0; a < 2; ++a)
#pragma unroll
            for (int b = 0; b < 2; ++b)
#pragma unroll
                for (int m = 0; m < 4; ++m)
#pragma unroll
                    for (int n = 0; n < 2; ++n) acc[a][b][m][n] = (f32x4){0.f, 0.f, 0.f, 0.f};
        cur = nxt; cA = nA; cB = nB; ++ui; va0[0] = nva0[0]; va0[1] = nva0[1]; va1[0] = nva1[0]; va1[1] = nva1[1];
        if constexpr (ALIGN_EPI) { if (wr == 1) PG8_BAR; }
    }
    PG8_WAIT_V(0);
    if constexpr (!ALIGN_EPI) { if (wr == 0) PG8_BAR; }
    PG8_BAR;
    if constexpr (Epi::AFTER_DRAIN) { E.fused(acc, cur, wr, wc, fr, fq, lds, wid, lane); S.done(cur); }
#undef PG8_SA
#undef PG8_SB
#undef PG8_STAGE
#undef PG8_LDA
#undef PG8_LDB
#undef PG8_MMA
#undef PG8_WAIT_V
#undef PG8_WAIT_L
#undef PG8_BAR
#undef PG8_SCHED
#undef PG8_GOFF
#undef PG8_SEL
}
}

namespace attn_body {
using bf16=__hip_bfloat16;
using bf16x8=__attribute__((ext_vector_type(8)))short;
using s16x4=__attribute__((ext_vector_type(4)))short;
using f32x16=__attribute__((ext_vector_type(16)))float;
using u32x4=__attribute__((ext_vector_type(4)))unsigned;
constexpr int BATCH=4,SEQ=4096,D=64,QP=1024,KP=1024,VP=1024,OP=2048;
constexpr int NW=8,QBLK=32,QB=QBLK*NW,KVBLK=64,NQB=SEQ/QB;
constexpr int ATTN_UNIT_ROWS=QB;
__device__ __forceinline__ int crow(int r,int hi){return (r&3)+8*(r>>2)+4*hi;}
#define SBAR() __builtin_amdgcn_sched_barrier(0)
__device__ __forceinline__ void cmask(f32x16&p0,f32x16&p1,int jb,int qrel,int hi){
  const float NEG=-INFINITY; int kb=64*jb+4*hi;
  #pragma unroll
  for(int r=0;r<16;++r){int kv=kb+(r&3)+8*(r>>2); if(kv>qrel)p0[r]=NEG; if(kv+32>qrel)p1[r]=NEG;}
}

constexpr int NSLOT=3, SLOTB=8192;
constexpr int LDS_K=0, LDS_V=NSLOT*SLOTB, LDS_WS=2*NSLOT*SLOTB, LDS_OST=LDS_WS+NW*64*4, LDS_BYTES=LDS_OST+NW*4096;
constexpr float C2=0.125f*1.4426950408889634f;
__device__ __forceinline__ void glds16(const void*gsrc,unsigned lds_dst){unsigned keep;
  asm volatile("s_mov_b32 %0, m0\n\ts_mov_b32 m0, %2\n\ts_nop 0\n\tglobal_load_lds_dwordx4 %1, off\n\ts_mov_b32 m0, %0":"=&s"(keep):"v"(gsrc),"s"(lds_dst):"memory");}
__device__ __forceinline__ float max3f(float a,float b,float c){float r;asm("v_max3_f32 %0, %1, %2, %3":"=v"(r):"v"(a),"v"(b),"v"(c));return r;}
__device__ __forceinline__ float max2f(float a,float b){float r;asm("v_max_f32_e32 %0, %1, %2":"=v"(r):"v"(a),"v"(b));return r;}
__device__ __forceinline__ float fadd_s(float a,float b){float r;asm("v_add_f32_e32 %0, %1, %2":"=v"(r):"v"(a),"v"(b));return r;}
__device__ __forceinline__ float fsub_s(float a,float b){float r;asm("v_sub_f32_e32 %0, %1, %2":"=v"(r):"v"(a),"v"(b));return r;}
typedef float f32x2_t __attribute__((ext_vector_type(2))); typedef __bf16 bf16x2_t __attribute__((ext_vector_type(2)));
__device__ __forceinline__ unsigned cvtpk_s(float lo,float hi){f32x2_t v={lo,hi};bf16x2_t b=__builtin_convertvector(v,bf16x2_t);return __builtin_bit_cast(unsigned,b);}
#define WAIT_BAR(N) asm volatile("s_waitcnt vmcnt(" #N ") lgkmcnt(0)\n\ts_barrier":::"memory")

__device__ __forceinline__ void qkt(f32x16&p0,f32x16&p1,const char*Kslot,const bf16x8*qr,const f32x16&negm,int r32,int hi){
  const char*kb=Kslot+hi*1024+r32*16;
  #pragma unroll
  for(int d0=0;d0<4;++d0){
    const bf16x8 b0=*reinterpret_cast<const bf16x8*>(kb+d0*2048);
    const bf16x8 b1=*reinterpret_cast<const bf16x8*>(kb+d0*2048+512);
    if(d0==0){p0=__builtin_amdgcn_mfma_f32_32x32x16_bf16(b0,qr[0],negm,0,0,0);p1=__builtin_amdgcn_mfma_f32_32x32x16_bf16(b1,qr[0],negm,0,0,0);}
    else{p0=__builtin_amdgcn_mfma_f32_32x32x16_bf16(b0,qr[d0],p0,0,0,0);p1=__builtin_amdgcn_mfma_f32_32x32x16_bf16(b1,qr[d0],p1,0,0,0);}}
}
typedef __attribute__((address_space(3))) const char* lds_cptr;
typedef short v4i16_t __attribute__((ext_vector_type(4)));
__device__ __forceinline__ void kload8(bf16x8*kf,lds_cptr kp){
  kf[0]=*(const __attribute__((address_space(3))) bf16x8*)(kp);      kf[1]=*(const __attribute__((address_space(3))) bf16x8*)(kp+512);
  kf[2]=*(const __attribute__((address_space(3))) bf16x8*)(kp+2048); kf[3]=*(const __attribute__((address_space(3))) bf16x8*)(kp+2560);
  kf[4]=*(const __attribute__((address_space(3))) bf16x8*)(kp+4096); kf[5]=*(const __attribute__((address_space(3))) bf16x8*)(kp+4608);
  kf[6]=*(const __attribute__((address_space(3))) bf16x8*)(kp+6144); kf[7]=*(const __attribute__((address_space(3))) bf16x8*)(kp+6656);
}
__device__ __forceinline__ void kload2(bf16x8*kf,lds_cptr kp,int j){ kf[2*j]=*(const __attribute__((address_space(3))) bf16x8*)(kp+j*2048); kf[2*j+1]=*(const __attribute__((address_space(3))) bf16x8*)(kp+j*2048+512); }
__device__ __forceinline__ s16x4 vtr(lds_cptr p){ return __builtin_bit_cast(s16x4,__builtin_amdgcn_ds_read_tr16_b64_v4i16((__attribute__((address_space(3))) v4i16_t*)p)); }
__device__ __forceinline__ float rowmax(const f32x16&p0,const f32x16&p1){
  float a=max3f(p0[0],p0[1],p1[0]),b=max3f(p0[2],p0[3],p1[1]);a=max3f(a,p1[2],p1[3]);
  #pragma unroll
  for(int r=4;r<16;r+=4){a=max3f(a,p0[r],p0[r+1]);b=max3f(b,p0[r+2],p0[r+3]);a=max3f(a,p1[r],p1[r+1]);b=max3f(b,p1[r+2],p1[r+3]);}
  const float m=max2f(a,b);
  auto rr=__builtin_amdgcn_permlane32_swap(__float_as_uint(m),__float_as_uint(m),false,false);
  return max2f(__uint_as_float(rr[0]),__uint_as_float(rr[1]));
}
__device__ __forceinline__ void pv(f32x16*o,int vb,bf16x8 pa0,bf16x8 pa1,bf16x8 pa2,bf16x8 pa3){
  #pragma unroll
  for(int d0=0;d0<2;++d0){s16x4 lo[4],hi[4];
    #pragma unroll
    for(int ks=0;ks<4;++ks){
      asm volatile("ds_read_b64_tr_b16 %0,%1 offset:%c2":"=&v"(lo[ks]):"v"(vb),"i"(d0*4096+ks*1024):"memory");
      asm volatile("ds_read_b64_tr_b16 %0,%1 offset:%c2":"=&v"(hi[ks]):"v"(vb),"i"(d0*4096+ks*1024+512):"memory");}
    asm volatile("s_waitcnt lgkmcnt(0)":::"memory");SBAR();
    #define PK(k) (bf16x8){lo[k][0],lo[k][1],lo[k][2],lo[k][3],hi[k][0],hi[k][1],hi[k][2],hi[k][3]}
    o[d0]=__builtin_amdgcn_mfma_f32_32x32x16_bf16(pa0,PK(0),o[d0],0,0,0);
    o[d0]=__builtin_amdgcn_mfma_f32_32x32x16_bf16(pa1,PK(1),o[d0],0,0,0);
    o[d0]=__builtin_amdgcn_mfma_f32_32x32x16_bf16(pa2,PK(2),o[d0],0,0,0);
    o[d0]=__builtin_amdgcn_mfma_f32_32x32x16_bf16(pa3,PK(3),o[d0],0,0,0);
    #undef PK
  }
}

#ifndef ATTN_STORE16
#define ATTN_STORE16(p,v) (*(u32x4*)(p)=(v))
#endif
template<int THRL> __device__ __forceinline__ void attn_unit(int b,int qb,const bf16*Q,const bf16*__restrict__ K,const bf16*__restrict__ V,bf16*O,char*shm,const int tid_,const int wid_){
  const int tid=tid_,lane=tid&63,r32=lane&31,hi=lane>>5; const int wid=wid_;
  const long rowbase=(long)b*SEQ; const int q0=qb*QB;
  const bf16*Qw=Q+(rowbase+q0+wid*QBLK)*QP;
  const bf16*Kh=K+rowbase*KP,*Vh=V+rowbase*VP;
  const unsigned lds0=(unsigned)(uintptr_t)shm;
  float*wsf=(float*)(shm+LDS_WS)+wid*64;
  const bf16*ksrc=Kh+(long)lane*KP+wid*8;
  const bf16*vsrc=Vh+(long)(16*(wid&3)+(lane>>2))*VP+(wid>>2)*32+(lane&3)*8;
  const unsigned kdst=lds0+LDS_K+wid*1024, vdst=lds0+LDS_V+wid*1024;
  #define DMA_K(t,slot) glds16(ksrc+(long)(t)*KVBLK*KP,(unsigned)__builtin_amdgcn_readfirstlane(kdst+(slot)))
  #define DMA_V(t,slot) glds16(vsrc+(long)(t)*KVBLK*VP,(unsigned)__builtin_amdgcn_readfirstlane(vdst+(slot)))
  const int vb0=(int)(lds0+LDS_V)+((lane>>4)&1)*32+(lane&3)*8+(4*hi+((lane&15)>>2))*64;
  const char*Kbase=shm+LDS_K; bf16x8 kf[8];
  const lds_cptr shm3=(lds_cptr)shm; const lds_cptr kp0=shm3+LDS_K+hi*1024+r32*16; const lds_cptr vp0=shm3+LDS_V+((lane>>4)&1)*32+(lane&3)*8+(4*hi+((lane&15)>>2))*64;
  const int NT=(q0+QB)/KVBLK;
  DMA_K(0,0);DMA_V(0,0);DMA_K(1,SLOTB);
  bf16x8 qr[4];
  #pragma unroll
  for(int d0=0;d0<4;++d0)qr[d0]=*reinterpret_cast<const bf16x8*>(&Qw[(long)r32*QP+d0*16+hi*8]);
  float mhat=0.f,l_reg=0.f;f32x16 o[2];o[0]=f32x16{};o[1]=f32x16{};f32x16 negm=f32x16{};asm volatile("":"+v"(negm));
  const int qrel=wid*QBLK+r32;
  #define CMASK(P0,P1,t) do{int jb_=(t)-(NT-4); if(jb_>=0)cmask(P0,P1,jb_,qrel,hi);}while(0)
  bool resc=false;
  #define START(P0,P1) do{ const float rm=rowmax(P0,P1); resc=false; \
    { const float dl=rm; mhat=fadd_s(mhat,dl); \
      _Pragma("unroll") for(int r=0;r<16;++r){P0[r]=fsub_s(P0[r],dl);P1[r]=fsub_s(P1[r],dl);} \
      _Pragma("unroll") for(int r=0;r<16;++r)negm[r]=-mhat; asm volatile("":"+v"(negm)); } \
    _Pragma("unroll") for(int r=0;r<16;++r)P0[r]=__builtin_amdgcn_exp2f(P0[r]); }while(0)
  #define RESC() do{ if(resc){ asm volatile("s_waitcnt lgkmcnt(0)":::"memory"); \
      _Pragma("unroll") for(int d_=0;d_<2;++d_) _Pragma("unroll") for(int r=0;r<16;++r)o[d_][r]*=wsf[crow(r,hi)]; } }while(0)
  f32x16 pA0,pA1,pB0,pB1;
  int sl_prev=0,sl_cur=0,sl_next=SLOTB;
  #define ROT() do{sl_prev=sl_cur;sl_cur=sl_next;sl_next=(sl_next==(NSLOT-1)*SLOTB)?0:sl_next+SLOTB;}while(0)
  DMA_K(2,2*SLOTB);
  WAIT_BAR(3);
  qkt(pA0,pA1,Kbase,qr,negm,r32,hi);asm volatile("s_nop 15\n\ts_nop 7":"+v"(pA0),"+v"(pA1));CMASK(pA0,pA1,0);
  START(pA0,pA1);
  _Pragma("unroll") for(int r=0;r<16;++r)pA1[r]=__builtin_amdgcn_exp2f(pA1[r]);
  WAIT_BAR(0);
  DMA_K(3,0);DMA_V(1,SLOTB);
  ROT();
  kload8(kf,kp0+sl_cur);
  WAIT_BAR(2);
  s16x4 vlo[8],vhi[8]; u32x4 pw0,pw1,pw2,pw3;
  #define PKW(P,B) cvtpk_s(P[B],P[B+1])
  #define PAF(k) __builtin_bit_cast(bf16x8,pw##k)
  #define VFR(i) (bf16x8){vlo[i][0],vlo[i][1],vlo[i][2],vlo[i][3],vhi[i][0],vhi[i][1],vhi[i][2],vhi[i][3]}
  #define PIN(x) asm volatile("":"+v"(x))
  #define MX3(a,b,c) __builtin_fmaxf(__builtin_fmaxf((a),(b)),(c))
  #define GAPA(MF,A0,A1,A2,A3,W0,W1,PW) do{ MF; sacc+=A0; sacc+=A1; sacc+=A2; sacc+=A3; PIN(sacc); W0; W1; PIN(PW); SBAR(); }while(0)
  #define EX(v) __builtin_amdgcn_exp2f(v)
  #define GAPB(MF,X,B) do{ MF; X[B]=EX(X[B]); X[B+1]=EX(X[B+1]); X[B+2]=EX(X[B+2]); X[B+3]=EX(X[B+3]); PIN(X); SBAR(); }while(0)
  #define VRD(i) do{ vlo[i]=vtr(vp_+(((i)>>2)*4096+((i)&3)*1024)); vhi[i]=vtr(vp_+(((i)>>2)*4096+((i)&3)*1024+512)); }while(0)
  #define KRD(G,j) do{ if(G){ kload2(kf,kp0+sl_next,j); SBAR(); } }while(0)
  #define STEP(C0,C1,P0,P1,t,GK,GV,GL) do{ SBAR(); \
    const lds_cptr vp_=vp0+sl_prev; \
    VRD(0); SBAR(); float sacc=(P0[0]+P0[1]); \
    GAPA(C0=__builtin_amdgcn_mfma_f32_32x32x16_bf16(kf[0],qr[0],negm,0,0,0), P0[2],P0[3],P0[4],P0[5],     pw0[0]=PKW(P0,0), pw0[1]=PKW(P0,2), pw0); \
    VRD(4); SBAR(); GAPA(C1=__builtin_amdgcn_mfma_f32_32x32x16_bf16(kf[1],qr[0],negm,0,0,0), P0[6],P0[7],P0[8],P0[9],     pw0[2]=PKW(P0,4), pw0[3]=PKW(P0,6), pw0); \
    VRD(1); SBAR(); GAPA(C0=__builtin_amdgcn_mfma_f32_32x32x16_bf16(kf[2],qr[1],C0,0,0,0),   P0[10],P0[11],P0[12],P0[13], pw1[0]=PKW(P0,8), pw1[1]=PKW(P0,10), pw1); \
    VRD(5); SBAR(); GAPA(C1=__builtin_amdgcn_mfma_f32_32x32x16_bf16(kf[3],qr[1],C1,0,0,0),   P0[14],P0[15],P1[0],P1[1],   pw1[2]=PKW(P0,12),pw1[3]=PKW(P0,14), pw1); \
    VRD(2); SBAR(); GAPA(C0=__builtin_amdgcn_mfma_f32_32x32x16_bf16(kf[4],qr[2],C0,0,0,0),   P1[2],P1[3],P1[4],P1[5],     pw2[0]=PKW(P1,0), pw2[1]=PKW(P1,2), pw2); \
    VRD(6); SBAR(); GAPA(C1=__builtin_amdgcn_mfma_f32_32x32x16_bf16(kf[5],qr[2],C1,0,0,0),   P1[6],P1[7],P1[8],P1[9],     pw2[2]=PKW(P1,4), pw2[3]=PKW(P1,6), pw2); \
    VRD(3); SBAR(); GAPA(C0=__builtin_amdgcn_mfma_f32_32x32x16_bf16(kf[6],qr[3],C0,0,0,0),   P1[10],P1[11],P1[12],P1[13], pw3[0]=PKW(P1,8), pw3[1]=PKW(P1,10), pw3); \
    VRD(7); SBAR(); GAPA(C1=__builtin_amdgcn_mfma_f32_32x32x16_bf16(kf[7],qr[3],C1,0,0,0),   P1[14],P1[15],0.f,0.f,       pw3[2]=PKW(P1,12),pw3[3]=PKW(P1,14), pw3); \
    l_reg+=sacc; \
    if(GK){DMA_K((t)+3,sl_cur);} if(GV){DMA_V((t)+1,sl_next);} \
    CMASK(C0,C1,t); \
    { float a=MX3(C0[0],C0[1],C1[0]),b=MX3(C0[2],C0[3],C1[1]); a=MX3(a,C1[2],C1[3]); \
      _Pragma("unroll") for(int r=4;r<16;r+=4){a=MX3(a,C0[r],C0[r+1]);b=MX3(b,C0[r+2],C0[r+3]);a=MX3(a,C1[r],C1[r+1]);b=MX3(b,C1[r+2],C1[r+3]);} \
      float rm=__builtin_fmaxf(a,b); { auto rr=__builtin_amdgcn_permlane32_swap(__float_as_uint(rm),__float_as_uint(rm),false,false); rm=__builtin_fmaxf(__uint_as_float(rr[0]),__uint_as_float(rr[1])); } \
      resc=false; \
      if(__builtin_expect(__any(rm>(float)THRL),0)){ const float dl=__builtin_fmaxf(rm,0.f); mhat+=dl; \
        _Pragma("unroll") for(int r=0;r<16;++r){C0[r]-=dl;C1[r]-=dl;} \
        _Pragma("unroll") for(int r=0;r<16;++r)negm[r]=-mhat; asm volatile("":"+v"(negm)); \
        const float f=__builtin_amdgcn_exp2f(-dl); l_reg*=f; if(hi==0)wsf[r32]=f; resc=true; } } \
    SBAR(); \
    GAPB(o[0]=__builtin_amdgcn_mfma_f32_32x32x16_bf16(PAF(0),VFR(0),o[0],0,0,0), C0,0); \
    GAPB(o[1]=__builtin_amdgcn_mfma_f32_32x32x16_bf16(PAF(0),VFR(4),o[1],0,0,0), C0,4); \
    KRD(GL,0); GAPB(o[0]=__builtin_amdgcn_mfma_f32_32x32x16_bf16(PAF(1),VFR(1),o[0],0,0,0), C0,8); \
    KRD(GL,1); GAPB(o[1]=__builtin_amdgcn_mfma_f32_32x32x16_bf16(PAF(1),VFR(5),o[1],0,0,0), C0,12); \
    KRD(GL,2); GAPB(o[0]=__builtin_amdgcn_mfma_f32_32x32x16_bf16(PAF(2),VFR(2),o[0],0,0,0), C1,0); \
    KRD(GL,3); GAPB(o[1]=__builtin_amdgcn_mfma_f32_32x32x16_bf16(PAF(2),VFR(6),o[1],0,0,0), C1,4); \
    GAPB(o[0]=__builtin_amdgcn_mfma_f32_32x32x16_bf16(PAF(3),VFR(3),o[0],0,0,0), C1,8); \
    GAPB(o[1]=__builtin_amdgcn_mfma_f32_32x32x16_bf16(PAF(3),VFR(7),o[1],0,0,0), C1,12); \
    }while(0)
  int t=1;
  #undef CMASK
  #define CMASK(P0,P1,t) do{}while(0)
  for(;t+5<NT;t+=2){
    STEP(pB0,pB1,pA0,pA1,t,true,true,true);     WAIT_BAR(2); RESC(); ROT();
    STEP(pA0,pA1,pB0,pB1,t+1,true,true,true);   WAIT_BAR(2); RESC(); ROT();
  }
  #undef CMASK
  #define CMASK(P0,P1,t) do{int jb_=(t)-(NT-4); if(jb_>=0)cmask(P0,P1,jb_,qrel,hi);}while(0)
  #define ENDW(tt) do{ if((tt)+3<NT){WAIT_BAR(2);} else if((tt)+2<NT){WAIT_BAR(1);} else {WAIT_BAR(0);} }while(0)
  for(;t+1<NT;t+=2){
    STEP(pB0,pB1,pA0,pA1,t,(t+3<NT),(t+1<NT),(t+1<NT));       ENDW(t);   RESC(); ROT();
    STEP(pA0,pA1,pB0,pB1,t+1,(t+4<NT),(t+2<NT),(t+2<NT));     ENDW(t+1); RESC(); ROT();
  }
  STEP(pB0,pB1,pA0,pA1,NT-1,false,false,false); RESC();
  { float sacc=pB0[0]+pB0[1]; _Pragma("unroll") for(int r=2;r<16;++r)sacc+=pB0[r]; _Pragma("unroll") for(int r=0;r<16;++r)sacc+=pB1[r]; l_reg+=sacc;
    pw0=(u32x4){PKW(pB0,0),PKW(pB0,2),PKW(pB0,4),PKW(pB0,6)};pw1=(u32x4){PKW(pB0,8),PKW(pB0,10),PKW(pB0,12),PKW(pB0,14)};pw2=(u32x4){PKW(pB1,0),PKW(pB1,2),PKW(pB1,4),PKW(pB1,6)};pw3=(u32x4){PKW(pB1,8),PKW(pB1,10),PKW(pB1,12),PKW(pB1,14)};
    SBAR(); pv(o,vb0+sl_cur,PAF(0),PAF(1),PAF(2),PAF(3)); }
  #undef PKW
  #undef PAF
  #undef VFR
  #undef PIN
  #undef MX3
  #undef GAPA
  #undef GAPB
  #undef EX
  #undef VRD
  #undef KRD
  #undef STEP
  #undef ENDW
  {auto rr=__builtin_amdgcn_permlane32_swap(__float_as_uint(l_reg),__float_as_uint(l_reg),false,false);l_reg=__uint_as_float(rr[0])+__uint_as_float(rr[1]);}
  if(hi==0)wsf[32+r32]=l_reg;asm volatile("s_waitcnt lgkmcnt(0)":::"memory");
  float rli[16];
  #pragma unroll
  for(int r=0;r<16;++r)rli[r]=__builtin_amdgcn_rcpf(wsf[32+crow(r,hi)]);
  bf16*Ow=O+(rowbase+q0+wid*QBLK)*OP;
  { bf16*stg=(bf16*)(shm+LDS_OST)+wid*2048;
    #pragma unroll
    for(int r=0;r<16;++r){const int orow=crow(r,hi);
      #pragma unroll
      for(int d0=0;d0<2;++d0)stg[orow*64+d0*32+r32]=__float2bfloat16(o[d0][r]*rli[r]);}
    asm volatile("s_waitcnt lgkmcnt(0)":::"memory");
    #pragma unroll
    for(int i=0;i<4;++i){const int row=i*8+(lane>>3),ch=lane&7; const u32x4 v=*(const u32x4*)(stg+row*64+ch*8); ATTN_STORE16(Ow+(long)row*OP+ch*8,v);} }
  asm volatile("s_waitcnt lgkmcnt(0)\n\ts_barrier":::"memory");
  #undef DMA_K
  #undef DMA_V
  #undef CMASK
  #undef START
  #undef RESC
  #undef ROT
}
constexpr int LDS_V128=NSLOT*SLOTB, LDS_WS128=LDS_V128+NSLOT*2*SLOTB, LDS_OST128=LDS_WS128+NW*64*4, LDS_BYTES128=LDS_OST128+NW*8192;
__device__ __forceinline__ void pv128(f32x16*o,int vb,bf16x8 pa0,bf16x8 pa1,bf16x8 pa2,bf16x8 pa3){
  #pragma unroll
  for(int d0=0;d0<4;++d0){s16x4 lo[4],hi[4];
    #pragma unroll
    for(int ks=0;ks<4;++ks){
      asm volatile("ds_read_b64_tr_b16 %0,%1 offset:%c2":"=&v"(lo[ks]):"v"(vb),"i"(d0*4096+ks*1024):"memory");
      asm volatile("ds_read_b64_tr_b16 %0,%1 offset:%c2":"=&v"(hi[ks]):"v"(vb),"i"(d0*4096+ks*1024+512):"memory");}
    asm volatile("s_waitcnt lgkmcnt(0)":::"memory");SBAR();
    #define PK(k) (bf16x8){lo[k][0],lo[k][1],lo[k][2],lo[k][3],hi[k][0],hi[k][1],hi[k][2],hi[k][3]}
    o[d0]=__builtin_amdgcn_mfma_f32_32x32x16_bf16(pa0,PK(0),o[d0],0,0,0);
    o[d0]=__builtin_amdgcn_mfma_f32_32x32x16_bf16(pa1,PK(1),o[d0],0,0,0);
    o[d0]=__builtin_amdgcn_mfma_f32_32x32x16_bf16(pa2,PK(2),o[d0],0,0,0);
    o[d0]=__builtin_amdgcn_mfma_f32_32x32x16_bf16(pa3,PK(3),o[d0],0,0,0);
    #undef PK
  }
}
template<int THRL> __device__ __forceinline__ void attn_unit128(int b,int qb,const bf16*Q,const bf16*__restrict__ K,const bf16*__restrict__ V,bf16*O,char*shm,const int tid_,const int wid_){
  const int tid=tid_,lane=tid&63,r32=lane&31,hi=lane>>5; const int wid=wid_;
  const long rowbase=(long)b*SEQ; const int q0=qb*QB;
  const bf16*Qw=Q+(rowbase+q0+wid*QBLK)*QP;
  const bf16*Kh=K+rowbase*KP,*Vh=V+rowbase*VP;
  const unsigned lds0=(unsigned)(uintptr_t)shm;
  float*wsf=(float*)(shm+LDS_WS128)+wid*64;
  const bf16*ksrc=Kh+(long)lane*KP+wid*8;
  const bf16*vsrc=Vh+(long)(16*(wid&3)+(lane>>2))*VP+(wid>>2)*32+(lane&3)*8;
  const unsigned kdst=lds0+LDS_K+wid*1024, vdst=lds0+LDS_V128+wid*1024;
  #define DMA_K(t,slot) glds16(ksrc+(long)(t)*KVBLK*KP,(unsigned)__builtin_amdgcn_readfirstlane(kdst+(slot)))
  #define DMA_V(t,slot) do{ glds16(vsrc+(long)(t)*KVBLK*VP,(unsigned)__builtin_amdgcn_readfirstlane(vdst+2*(slot))); glds16(vsrc+(long)(t)*KVBLK*VP+64,(unsigned)__builtin_amdgcn_readfirstlane(vdst+2*(slot)+8192)); }while(0)
  const int vb0=(int)(lds0+LDS_V128)+((lane>>4)&1)*32+(lane&3)*8+(4*hi+((lane&15)>>2))*64;
  const char*Kbase=shm+LDS_K; bf16x8 kf[8];
  const lds_cptr shm3=(lds_cptr)shm; const lds_cptr kp0=shm3+LDS_K+hi*1024+r32*16; const lds_cptr vp0=shm3+LDS_V128+((lane>>4)&1)*32+(lane&3)*8+(4*hi+((lane&15)>>2))*64;
  const int NT=(q0+QB)/KVBLK;
  DMA_K(0,0);DMA_V(0,0);DMA_K(1,SLOTB);
  bf16x8 qr[4];
  #pragma unroll
  for(int d0=0;d0<4;++d0)qr[d0]=*reinterpret_cast<const bf16x8*>(&Qw[(long)r32*QP+d0*16+hi*8]);
  float mhat=0.f,l_reg=0.f;f32x16 o[4];o[0]=f32x16{};o[1]=f32x16{};o[2]=f32x16{};o[3]=f32x16{};
  const int qrel=wid*QBLK+r32;
  #define CMASK(P0,P1,t) do{int jb_=(t)-(NT-4); if(jb_>=0)cmask(P0,P1,jb_,qrel,hi);}while(0)
  bool resc=false;
  #define START(P0,P1) do{ const float rm=rowmax(P0,P1); resc=false; \
    { const float dl=rm; mhat=fadd_s(mhat,dl); \
      _Pragma("unroll") for(int r=0;r<16;++r){P0[r]=fsub_s(P0[r],dl);P1[r]=fsub_s(P1[r],dl);} } \
    _Pragma("unroll") for(int r=0;r<16;++r)P0[r]=__builtin_amdgcn_exp2f(P0[r]); }while(0)
  #define RESC() do{ if(resc){ asm volatile("s_waitcnt lgkmcnt(0)":::"memory"); \
      _Pragma("unroll") for(int d_=0;d_<4;++d_) _Pragma("unroll") for(int r=0;r<16;++r)o[d_][r]*=wsf[crow(r,hi)]; } }while(0)
  f32x16 pA0,pA1;
  int sl_prev=0,sl_cur=0,sl_next=SLOTB;
  #define ROT() do{sl_prev=sl_cur;sl_cur=sl_next;sl_next=(sl_next==(NSLOT-1)*SLOTB)?0:sl_next+SLOTB;}while(0)
  DMA_K(2,2*SLOTB);
  WAIT_BAR(4);
  qkt(pA0,pA1,Kbase,qr,f32x16{},r32,hi);asm volatile("s_nop 15\n\ts_nop 7":"+v"(pA0),"+v"(pA1));CMASK(pA0,pA1,0);
  START(pA0,pA1);
  _Pragma("unroll") for(int r=0;r<16;++r)pA1[r]=__builtin_amdgcn_exp2f(pA1[r]);
  u32x4 pw0,pw1,pw2,pw3;
  { float sacc=pA0[0]+pA0[1]; _Pragma("unroll") for(int r=2;r<16;++r)sacc+=pA0[r]; _Pragma("unroll") for(int r=0;r<16;++r)sacc+=pA1[r]; l_reg+=sacc;
    pw0=(u32x4){cvtpk_s(pA0[0],pA0[1]),cvtpk_s(pA0[2],pA0[3]),cvtpk_s(pA0[4],pA0[5]),cvtpk_s(pA0[6],pA0[7])};pw1=(u32x4){cvtpk_s(pA0[8],pA0[9]),cvtpk_s(pA0[10],pA0[11]),cvtpk_s(pA0[12],pA0[13]),cvtpk_s(pA0[14],pA0[15])};
    pw2=(u32x4){cvtpk_s(pA1[0],pA1[1]),cvtpk_s(pA1[2],pA1[3]),cvtpk_s(pA1[4],pA1[5]),cvtpk_s(pA1[6],pA1[7])};pw3=(u32x4){cvtpk_s(pA1[8],pA1[9]),cvtpk_s(pA1[10],pA1[11]),cvtpk_s(pA1[12],pA1[13]),cvtpk_s(pA1[14],pA1[15])}; }
  WAIT_BAR(0);
  DMA_K(3,0);DMA_V(1,SLOTB);
  ROT();
  kload8(kf,kp0+sl_cur);
  WAIT_BAR(3);
  s16x4 vlo[4],vhi[4];
  #define PKW(P,B) cvtpk_s(P[B],P[B+1])
  #define PAF(k) __builtin_bit_cast(bf16x8,pw##k)
  #define VFR(i) (bf16x8){vlo[i][0],vlo[i][1],vlo[i][2],vlo[i][3],vhi[i][0],vhi[i][1],vhi[i][2],vhi[i][3]}
  #define PIN(x) asm volatile("":"+v"(x))
  #define MX3(a,b,c) __builtin_fmaxf(__builtin_fmaxf((a),(b)),(c))
  #define GAPA(MF,A0,A1,A2,A3,W0,W1,PW) do{ MF; sacc+=A0; sacc+=A1; sacc+=A2; sacc+=A3; PIN(sacc); W0; W1; PIN(PW); SBAR(); }while(0)
  #define EX(v) __builtin_amdgcn_exp2f(v)
  #define GAPB(MF,X,B) do{ MF; X[B]=EX(X[B]); X[B+1]=EX(X[B+1]); X[B+2]=EX(X[B+2]); X[B+3]=EX(X[B+3]); PIN(X); SBAR(); }while(0)
  #define VRD(j,ks) do{ vlo[j]=vtr(vp_+((j)*4096+(ks)*1024)); vhi[j]=vtr(vp_+((j)*4096+(ks)*1024+512)); }while(0)
  #define GAPV(MF,J,KS) do{ MF; VRD(J,KS); SBAR(); }while(0)
  #define GAPB2(MF,J,KS,X,B) do{ MF; VRD(J,KS); X[B]=EX(X[B]); X[B+1]=EX(X[B+1]); X[B+2]=EX(X[B+2]); X[B+3]=EX(X[B+3]); PIN(X); SBAR(); }while(0)
  #define GAPC(MF,A0,A1,A2,A3,W0,W1,PW) do{ MF; sacc+=A0; sacc+=A1; sacc+=A2; sacc+=A3; PIN(sacc); W0; W1; PIN(PW); SBAR(); }while(0)
  #define KRD(G,j) do{ if(G){ kload2(kf,kp0+sl_next,j); SBAR(); } }while(0)
  #define Z16 f32x16{}
  #define MF32(a,b,c) __builtin_amdgcn_mfma_f32_32x32x16_bf16((a),(b),(c),0,0,0)
  #define STEP(C0,C1,t,GK,GV,GL) do{ SBAR(); \
    const lds_cptr vp_=vp0+2*sl_prev; \
    C0=MF32(kf[0],qr[0],Z16); SBAR(); C1=MF32(kf[1],qr[0],Z16); SBAR(); C0=MF32(kf[2],qr[1],C0); SBAR(); C1=MF32(kf[3],qr[1],C1); SBAR(); \
    GAPV(C0=MF32(kf[4],qr[2],C0),0,0); GAPV(C1=MF32(kf[5],qr[2],C1),1,0); GAPV(C0=MF32(kf[6],qr[3],C0),2,0); GAPV(C1=MF32(kf[7],qr[3],C1),3,0); \
    if(GK){DMA_K((t)+3,sl_cur);} if(GV){DMA_V((t)+1,sl_next);} \
    C0=C0-mhat; C1=C1-mhat; \
    CMASK(C0,C1,t); \
    { float a=MX3(C0[0],C0[1],C1[0]),b=MX3(C0[2],C0[3],C1[1]); a=MX3(a,C1[2],C1[3]); \
      _Pragma("unroll") for(int r=4;r<16;r+=4){a=MX3(a,C0[r],C0[r+1]);b=MX3(b,C0[r+2],C0[r+3]);a=MX3(a,C1[r],C1[r+1]);b=MX3(b,C1[r+2],C1[r+3]);} \
      float rm=__builtin_fmaxf(a,b); { auto rr=__builtin_amdgcn_permlane32_swap(__float_as_uint(rm),__float_as_uint(rm),false,false); rm=__builtin_fmaxf(__uint_as_float(rr[0]),__uint_as_float(rr[1])); } \
      resc=false; \
      if(__builtin_expect(__any(rm>(float)THRL),0)){ const float dl=__builtin_fmaxf(rm,0.f); mhat+=dl; \
        _Pragma("unroll") for(int r=0;r<16;++r){C0[r]-=dl;C1[r]-=dl;} \
        const float f=__builtin_amdgcn_exp2f(-dl); l_reg*=f; if(hi==0)wsf[r32]=f; resc=true; } } \
    SBAR(); \
    GAPB2(o[0]=MF32(PAF(0),VFR(0),o[0]), 0,1, C0,0); \
    GAPB2(o[1]=MF32(PAF(0),VFR(1),o[1]), 1,1, C0,4); \
    GAPB2(o[2]=MF32(PAF(0),VFR(2),o[2]), 2,1, C0,8); \
    GAPB2(o[3]=MF32(PAF(0),VFR(3),o[3]), 3,1, C0,12); \
    GAPB2(o[0]=MF32(PAF(1),VFR(0),o[0]), 0,2, C1,0); \
    GAPB2(o[1]=MF32(PAF(1),VFR(1),o[1]), 1,2, C1,4); \
    GAPB2(o[2]=MF32(PAF(1),VFR(2),o[2]), 2,2, C1,8); \
    GAPB2(o[3]=MF32(PAF(1),VFR(3),o[3]), 3,2, C1,12); \
    float sacc=(C0[0]+C0[1]); \
    GAPC(o[0]=MF32(PAF(2),VFR(0),o[0]); VRD(0,3), C0[2],C0[3],C0[4],C0[5],     pw0[0]=PKW(C0,0), pw0[1]=PKW(C0,2), pw0); \
    GAPC(o[1]=MF32(PAF(2),VFR(1),o[1]); VRD(1,3), C0[6],C0[7],C0[8],C0[9],     pw0[2]=PKW(C0,4), pw0[3]=PKW(C0,6), pw0); \
    GAPC(o[2]=MF32(PAF(2),VFR(2),o[2]); VRD(2,3), C0[10],C0[11],C0[12],C0[13], pw1[0]=PKW(C0,8), pw1[1]=PKW(C0,10), pw1); \
    GAPC(o[3]=MF32(PAF(2),VFR(3),o[3]); VRD(3,3), C0[14],C0[15],C1[0],C1[1],   pw1[2]=PKW(C0,12),pw1[3]=PKW(C0,14), pw1); \
    KRD(GL,0); GAPC(o[0]=MF32(PAF(3),VFR(0),o[0]), C1[2],C1[3],C1[4],C1[5],     pw2[0]=PKW(C1,0), pw2[1]=PKW(C1,2), pw2); \
    KRD(GL,1); GAPC(o[1]=MF32(PAF(3),VFR(1),o[1]), C1[6],C1[7],C1[8],C1[9],     pw2[2]=PKW(C1,4), pw2[3]=PKW(C1,6), pw2); \
    KRD(GL,2); { o[2]=MF32(PAF(3),VFR(2),o[2]); sacc+=C1[10]; sacc+=C1[11]; sacc+=C1[12]; sacc+=C1[13]; PIN(sacc); SBAR(); } \
    KRD(GL,3); { o[3]=MF32(PAF(3),VFR(3),o[3]); sacc+=C1[14]; sacc+=C1[15]; PIN(sacc); SBAR(); } \
    pw3[0]=PKW(C1,8); pw3[1]=PKW(C1,10); pw3[2]=PKW(C1,12); pw3[3]=PKW(C1,14); \
    l_reg+=sacc; \
    }while(0)
  int t=1;
  #undef CMASK
  #define CMASK(P0,P1,t) do{}while(0)
  for(;t+5<NT;t+=2){
    STEP(pA0,pA1,t,true,true,true);     WAIT_BAR(3); RESC(); ROT();
    STEP(pA0,pA1,t+1,true,true,true);   WAIT_BAR(3); RESC(); ROT();
  }
  #undef CMASK
  #define CMASK(P0,P1,t) do{int jb_=(t)-(NT-4); if(jb_>=0)cmask(P0,P1,jb_,qrel,hi);}while(0)
  #define ENDW(tt) do{ if((tt)+3<NT){WAIT_BAR(3);} else if((tt)+2<NT){WAIT_BAR(2);} else {WAIT_BAR(0);} }while(0)
  for(;t+1<NT;t+=2){
    STEP(pA0,pA1,t,(t+3<NT),(t+1<NT),(t+1<NT));       ENDW(t);   RESC(); ROT();
    STEP(pA0,pA1,t+1,(t+4<NT),(t+2<NT),(t+2<NT));     ENDW(t+1); RESC(); ROT();
  }
  STEP(pA0,pA1,NT-1,false,false,false); RESC();
  if(wid>=6){ SBAR(); pv128(o,vb0+2*sl_cur,PAF(0),PAF(1),PAF(2),PAF(3)); }
  #undef PKW
  #undef PAF
  #undef VFR
  #undef PIN
  #undef MX3
  #undef GAPA
  #undef GAPB
  #undef GAPB2
  #undef GAPC
  #undef GAPV
  #undef Z16
  #undef MF32
  #undef EX
  #undef VRD
  #undef KRD
  #undef STEP
  #undef ENDW
  {auto rr=__builtin_amdgcn_permlane32_swap(__float_as_uint(l_reg),__float_as_uint(l_reg),false,false);l_reg=__uint_as_float(rr[0])+__uint_as_float(rr[1]);}
  if(hi==0)wsf[32+r32]=l_reg;asm volatile("s_waitcnt lgkmcnt(0)":::"memory");
  float rli[16];
  #pragma unroll
  for(int r=0;r<16;++r)rli[r]=__builtin_amdgcn_rcpf(wsf[32+crow(r,hi)]);
  bf16*Ow=O+(rowbase+q0+wid*QBLK)*OP;
  { bf16*stg=(bf16*)(shm+LDS_OST128)+wid*4096;
    #pragma unroll
    for(int r=0;r<16;++r){const int orow=crow(r,hi);
      #pragma unroll
      for(int d0=0;d0<4;++d0)stg[orow*128+d0*32+r32]=__float2bfloat16(o[d0][r]*rli[r]);}
    asm volatile("s_waitcnt lgkmcnt(0)":::"memory");
    #pragma unroll
    for(int i=0;i<8;++i){const int row=i*4+(lane>>4),ch=lane&15; const u32x4 v=*(const u32x4*)(stg+row*128+ch*8); ATTN_STORE16(Ow+(long)row*OP+ch*8,v);} }
  asm volatile("s_waitcnt lgkmcnt(0)\n\ts_barrier":::"memory");
  #undef DMA_K
  #undef DMA_V
  #undef CMASK
  #undef START
  #undef RESC
  #undef ROT
}
constexpr int ATTN_LDS_BYTES=LDS_BYTES;
struct AttnUnit { int bh; int qb; };
#undef SBAR
#undef WAIT_BAR
}

#ifndef PROBE_PHASE
#define PROBE_PHASE (-1)
#endif

constexpr int NWAVES = 8;
constexpr int BATCH = 4, T = 4096, D = 1024, M = BATCH * T;
constexpr int NE = 32, FF = 512, NGRP = 4, EPG = 8;
constexpr int MAXROWS = 40960;
constexpr float RMS_EPS = 1e-6f, GN_EPS = 64e-5f, SUBLN_EPS = 1e-5f;
constexpr float LAMBDA_INIT1 = 0.35550906759f;

constexpr size_t MiB = 1u << 20;
constexpr size_t WS_CTL = 0, CTL_ZERO_BYTES = 1 * MiB;
constexpr size_t WS_MOD = 1 * MiB;
constexpr size_t WS_WRKV = 2 * MiB, WS_WL1 = 8 * MiB, WS_WL2 = 9 * MiB, WS_WO0 = 11 * MiB, WS_WQKV = 13 * MiB, WS_WO1 = 19 * MiB;
constexpr size_t WS_ROWTOK = 22 * MiB, WS_ROWGATE = 24 * MiB;
constexpr size_t WS_ROUTE = 21 * MiB;
constexpr size_t WS_MOEGU = 32 * MiB, WS_MOED = 96 * MiB;
constexpr size_t WS_XA = 128 * MiB;
constexpr size_t WS_R = 192 * MiB;
constexpr size_t WS_VIEWS = WS_R, WS_H2 = WS_R + 96 * MiB, WS_A2 = WS_R + 160 * MiB, WS_RKV = WS_R + 168 * MiB;
constexpr size_t WS_LOGW = 128 * MiB, WS_ASIG = 160 * MiB, WS_GG = WS_R + 264 * MiB;
constexpr size_t WS_YG = WS_GG;
constexpr size_t WS_MOED1 = WS_R + 296 * MiB;
constexpr size_t WS_H2N = WS_R, WS_XS = WS_R + 32 * MiB, WS_HS = WS_R + 112 * MiB, WS_Y = WS_R + 152 * MiB;
constexpr size_t WS_HQ = WS_R, WS_HK = WS_R + 32 * MiB, WS_QKV = WS_R + 64 * MiB, WS_OC = WS_R + 160 * MiB, WS_ON = WS_R + 224 * MiB;
constexpr size_t WS_QE = WS_R, WS_MCT = WS_R + 32 * MiB, WS_SC = WS_R + 64 * MiB, WS_Y0 = WS_R + 96 * MiB, WS_NC = WS_R + 128 * MiB, WS_RK = WS_R + 160 * MiB;
constexpr size_t WS_END = WS_R + 328 * MiB;
static_assert(WS_RKV + 96 * MiB <= WS_GG && WS_GG + 32 * MiB <= WS_MOED1 && WS_MOED1 + 32 * MiB <= WS_END && WS_Y + 80 * MiB <= WS_MOED1 && WS_ON + 32 * MiB <= WS_MOED1 && WS_ASIG + 32 * MiB <= WS_XA + 64 * MiB && WS_LOGW + 32 * MiB <= WS_ASIG, "d_ws map");
constexpr int CW_BAR = 4096;
constexpr int CW_TMO = 2;
constexpr int CW_RDY = 16384;
constexpr int CW_CNT = 8192;

constexpr int RING_OFF = 0, RING_BYTES = 131072;
constexpr int LDSCTL_OFF = 146944, MISC_OFF = LDSCTL_OFF + 320;
constexpr int LDS_BYTES = 147456;

#define GAS __attribute__((address_space(1)))
#define LAS __attribute__((address_space(3)))
typedef unsigned short bf16;
typedef unsigned v4u __attribute__((ext_vector_type(4)));
typedef unsigned v2u __attribute__((ext_vector_type(2)));
typedef float f32x4 __attribute__((ext_vector_type(4)));
typedef short bf16x8 __attribute__((ext_vector_type(8)));
typedef GAS unsigned gu32;
#define RLX_AGENT __ATOMIC_RELAXED, __HIP_MEMORY_SCOPE_AGENT
#define LDS_WAIT() asm volatile("s_waitcnt lgkmcnt(0)" ::: "memory")
#define VM_WAIT() asm volatile("s_waitcnt vmcnt(0)" ::: "memory")
__device__ __forceinline__ void wt16(void* p, v4u v) { asm volatile("global_store_dwordx4 %0, %1, off sc1\n\ts_nop 1" :: "v"(p), "v"(v) : "memory"); }
__device__ __forceinline__ void wt16f(void* p, f32x4 v) { asm volatile("global_store_dwordx4 %0, %1, off sc1\n\ts_nop 1" :: "v"(p), "v"(v) : "memory"); }
__device__ __forceinline__ void wt8(void* p, v2u v) { asm volatile("global_store_dwordx2 %0, %1, off sc1\n\ts_nop 1" :: "v"(p), "v"(v) : "memory"); }
#define NT_LD(T, p) __builtin_nontemporal_load((const T*)(p))
__device__ __forceinline__ unsigned pk2(float lo, float hi) { return pg8::cvt_pk_bf16(lo, hi); }
__device__ __forceinline__ float bflo(unsigned w) { return __uint_as_float(w << 16); }
__device__ __forceinline__ float bfhi(unsigned w) { return __uint_as_float(w & 0xffff0000u); }

#define XB_TMO      128
#define XB_XCNT(j)  (256  + 64 * (j))
#define XB_XSUB(j)  (1280 + 64 * (j))
#define XB_XGEN(j)  (2304 + 64 * (j))
#define XB_TOP      3328
#define XB_TOPGEN   3392
#define XCD_BAR_WORDS 3456
#define XB_SPIN_CAP (1u << 18)

__device__ __forceinline__ unsigned xb_ld(unsigned* p)              { return __hip_atomic_load(p, __ATOMIC_RELAXED, __HIP_MEMORY_SCOPE_AGENT); }
__device__ __forceinline__ unsigned xb_add(unsigned* p, unsigned v) { return __hip_atomic_fetch_add(p, v, __ATOMIC_RELAXED, __HIP_MEMORY_SCOPE_AGENT); }
__device__ __forceinline__ unsigned xb_xcc_id() { return (unsigned)__builtin_amdgcn_s_getreg((3 << 11) | 20) & 0xFu; }
#define XB_SPIN(cond, bar) do { unsigned _sp = 0; while (cond) { __builtin_amdgcn_s_sleep(1); \
    if ((++_sp & 255u) == 0u) { if (xb_ld(&(bar)[XB_TMO])) break; if (_sp > XB_SPIN_CAP) { atomicAdd(&(bar)[XB_TMO], 1u); break; } } } } while (0)

__device__ __forceinline__ int xb_lane() { int l; asm volatile("v_mbcnt_lo_u32_b32 %0, -1, 0\n\tv_mbcnt_hi_u32_b32 %0, -1, %0" : "=v"(l)); return l; }
struct XcdBarrier {
    unsigned* bar; unsigned x; int wave;
    volatile LAS unsigned* st;
};

__device__ __forceinline__ XcdBarrier xcd_barrier_post(unsigned* bar, volatile LAS unsigned* st) {
    XcdBarrier b; b.bar = bar; b.x = xb_xcc_id(); b.st = st; b.wave = __builtin_amdgcn_readfirstlane(threadIdx.x >> 6);
    if (threadIdx.x == 0) (void)xb_add(&bar[XB_XCNT(b.x)], 1u);
    return b;
}
__device__ __forceinline__ void xcd_barrier_complete(unsigned* bar, unsigned x, unsigned& nloc, unsigned& nx) {
    const unsigned G = gridDim.x * gridDim.y * gridDim.z;
    unsigned sum, cnt, mine, sp = 0u;
    for (;;) {
        sum = 0u; cnt = 0u; mine = 0u;
#pragma unroll
        for (unsigned j = 0; j < 16; ++j) { const unsigned c = xb_ld(&bar[XB_XCNT(j)]); sum += c; cnt += (c > 0u) ? 1u : 0u; mine = (j == x) ? c : mine; }
        if (sum == G) break;
        __builtin_amdgcn_s_sleep(1);
        if ((++sp & 255u) == 0u) { if (xb_ld(&bar[XB_TMO])) break; if (sp > XB_SPIN_CAP) { atomicAdd(&bar[XB_TMO], 1u); break; } }
    }
    nloc = mine > 0u ? mine : 1u; nx = cnt > 0u ? cnt : 1u;
}

__device__ __forceinline__ void xcd_barrier(const XcdBarrier& b) {
    asm volatile("s_waitcnt vmcnt(0)" ::: "memory");
    __syncthreads();
    if (b.wave == 0 && xb_lane() == 0) {
        unsigned* bar = b.bar;
        __builtin_amdgcn_s_waitcnt(0);
        unsigned nloc = b.st[0], nx = b.st[1];
        if (nloc == 0u) { xcd_barrier_complete(bar, b.x, nloc, nx); b.st[0] = nloc; b.st[1] = nx; }
        const unsigned old = xb_add(&bar[XB_XSUB(b.x)], 1u);
        const unsigned gen = old / nloc;
        if (old + 1u == (gen + 1u) * nloc) {
            __builtin_amdgcn_fence(__ATOMIC_RELEASE, "agent");
            asm volatile("s_waitcnt vmcnt(0)" ::: "memory");
            const unsigned og = xb_add(&bar[XB_TOP], 1u);
            const unsigned tg = og / nx;
            if (og + 1u == (tg + 1u) * nx) xb_add(&bar[XB_TOPGEN], 1u);
            else XB_SPIN(xb_ld(&bar[XB_TOPGEN]) == tg, bar);
            __builtin_amdgcn_fence(__ATOMIC_ACQUIRE, "agent");
            xb_add(&bar[XB_XGEN(b.x)], 1u);
            asm volatile("s_waitcnt vmcnt(0)" ::: "memory");
        } else {
            XB_SPIN(xb_ld(&bar[XB_XGEN(b.x)]) == gen, bar);
            __builtin_amdgcn_fence(__ATOMIC_ACQUIRE, "agent");
            asm volatile("s_waitcnt vmcnt(0)" ::: "memory");
        }
    }
    __syncthreads();
}


struct Frame {
    LAS unsigned char* lds;
    volatile LAS unsigned* MISC;
    gu32* ctl;
    unsigned char* ws;
    const float* const* in;
    float* out;
    int tid, lane, wave, vcu, G;
};
__device__ __forceinline__ int lane_id() { int l; asm volatile("v_mbcnt_lo_u32_b32 %0, -1, 0\n\tv_mbcnt_hi_u32_b32 %0, -1, %0" : "=v"(l)); return l; }
__device__ __forceinline__ float wave_sum(float v) {
#pragma unroll
    for (int o = 1; o < 64; o <<= 1) v += __shfl_xor(v, o);
    return v;
}
__device__ __forceinline__ void titem_load(float (&tv)[32], const float* W, int ldw, int k0, int n0, int lane) {
    const float* base = W + (size_t)k0 * ldw + n0; const unsigned loff = (unsigned)((lane >> 3) * ldw + 4 * (lane & 7));
#pragma unroll
    for (int i = 0; i < 8; ++i) { const f32x4 q = __builtin_nontemporal_load((const f32x4*)(base + (size_t)(8 * i) * ldw + loff)); tv[4 * i] = q.x; tv[4 * i + 1] = q.y; tv[4 * i + 2] = q.z; tv[4 * i + 3] = q.w; }
}
__device__ __forceinline__ void titem_store(const float (&tv)[32], int k0, bf16* WT, int ldo, int orow0, int ok0, const float* kscale, LAS float* scr, int lane) {
#pragma unroll
    for (int i = 0; i < 32; ++i) { const int kk = 8 * (i >> 2) + (lane >> 3); float v = tv[i]; if (kscale) v *= kscale[k0 + kk]; scr[kk * 33 + 4 * (lane & 7) + (i & 3)] = v; }
    LDS_WAIT(); asm volatile("" ::: "memory");
    const int c = lane & 7;
#pragma unroll
    for (int j = 0; j < 4; ++j) { const int n = (lane >> 3) + 8 * j; const LAS float* s = scr + (8 * c) * 33 + n;
        v4u o; o.x = pk2(s[0 * 33], s[1 * 33]); o.y = pk2(s[2 * 33], s[3 * 33]); o.z = pk2(s[4 * 33], s[5 * 33]); o.w = pk2(s[6 * 33], s[7 * 33]);
        pg8::store16_sc1(WT + (size_t)(orow0 + n) * ldo + ok0 + k0 + 8 * c, o); }
    LDS_WAIT(); asm volatile("" ::: "memory");
}
__device__ __forceinline__ void transpose_item(const float* W, int ldw, int k0, int n0, bf16* WT, int ldo, int orow0, int ok0, const float* kscale, LAS float* scr, int lane) {
    float tv[32]; titem_load(tv, W, ldw, k0, n0, lane); titem_store(tv, k0, WT, ldo, orow0, ok0, kscale, scr, lane);
}
__device__ __forceinline__ void transpose_mat(Frame& F, const float* W, int K, int N, bf16* WT, int ldo, int row_off, int ok0, const float* kscale, int gw, int NGW) {
    LAS float* scr = (LAS float*)(F.lds + RING_OFF + F.wave * 16384);
    const int nblk = N / 32, items = (K / 64) * nblk;
    for (int it = gw; it < items; it += NGW) { const int kb = it / nblk, nb = it % nblk; transpose_item(W, N, 64 * kb, 32 * nb, WT, ldo, row_off + 32 * nb, ok0, kscale, scr, F.lane); }
}

__device__ __forceinline__ void p0_mod(Frame& F) {
    LAS float* cact = (LAS float*)(F.lds + RING_OFF);
    LAS float* red = cact + 4096;
    const float* c = F.in[1];
    { float cv[8];
#pragma unroll
      for (int i = 0; i < 8; ++i) cv[i] = c[F.tid + 512 * i];
#pragma unroll
      for (int i = 0; i < 8; ++i) cact[F.tid + 512 * i] = cv[i] / (1.0f + __expf(-cv[i])); }
    __syncthreads();
    float* modbase = (float*)(F.ws + WS_MOD);
    for (int it = blockIdx.x; it < 224; it += F.G) {
        const float* W; const float* bias; float* outp; int N, cc;
        if (it < 96) { W = F.in[2]; bias = F.in[3]; outp = modbase; N = 6144; cc = it; }
        else if (it < 192) { W = F.in[2] + (size_t)1024 * 6144; bias = F.in[3] + 6144; outp = modbase + 4 * 6144; N = 6144; cc = it - 96; }
        else { W = F.in[22]; bias = F.in[23]; outp = modbase + 8 * 6144; N = 2048; cc = it - 192; }
        const int kg = F.tid >> 4, cq = F.tid & 15, col = cc * 64 + cq * 4;
        f32x4 a0 = {0, 0, 0, 0}, a1 = a0, a2 = a0, a3 = a0;
#pragma unroll 16
        for (int kk = 0; kk < 32; ++kk) { const int k = kg * 32 + kk; const f32x4 w = NT_LD(f32x4, W + (size_t)k * N + col);
            a0 += w * cact[k]; a1 += w * cact[1024 + k]; a2 += w * cact[2048 + k]; a3 += w * cact[3072 + k]; }
        LAS f32x4* rp = (LAS f32x4*)red + (kg * 16 + cq) * 4;
        rp[0] = a0; rp[1] = a1; rp[2] = a2; rp[3] = a3;
        __syncthreads();
        if (F.tid < 256) { const int b = F.tid >> 6, cl = F.tid & 63, cq2 = cl >> 2, j = cl & 3; float s = 0.f;
            for (int g = 0; g < 32; ++g) s += red[((g * 16 + cq2) * 4 + b) * 4 + j];
            outp[(size_t)b * N + cc * 64 + cl] = s + bias[cc * 64 + cl]; }
        __syncthreads();
    }
}
__device__ __forceinline__ void p0_weights(Frame& F, const int part) {
    const bool split = (F.G >= 128);
    const int gw = (part == 0 ? F.vcu : (int)blockIdx.x) * NWAVES + F.wave, NGW = (part == 0 ? F.G : 64) * NWAVES;
    bf16* Wrkv = (bf16*)(F.ws + WS_WRKV); bf16* Wl1 = (bf16*)(F.ws + WS_WL1); bf16* Wl2 = (bf16*)(F.ws + WS_WL2);
    bf16* Wo0 = (bf16*)(F.ws + WS_WO0); bf16* Wqkv = (bf16*)(F.ws + WS_WQKV); bf16* Wo1 = (bf16*)(F.ws + WS_WO1);
    LAS float* scr = (LAS float*)(F.lds + RING_OFF + F.wave * 16384);
    const float* mu = F.in[6];
    constexpr int NI = 1536 + 512 + 512 + 1024 + 512 + 256;
    const int n0 = (part == 0) ? (split ? 1536 + 256 : NI) : 2560;
    for (int jt = gw; jt < n0; jt += NGW) {
        const int it = (part == 1) ? jt + 1536 : (split && jt >= 1536) ? jt + 2560 : jt;
        const float* W; int N; bf16* WT; int ldo, row_off, ok0; const float* ksc = nullptr; int r = it;
        if (r < 1536) { const int z = r / 512; r -= z * 512; W = F.in[7] + (size_t)z * D * D; N = D; WT = Wrkv + (size_t)z * D * D; ldo = D; row_off = 0; ok0 = 0; }
        else if ((r -= 1536) < 512) { W = F.in[21]; N = D; WT = Wo0; ldo = D; row_off = 0; ok0 = 0; }
        else if ((r -= 512) < 512) { W = F.in[26]; N = D; WT = Wqkv; ldo = D; row_off = 0; ok0 = 0; }
        else if ((r -= 512) < 1024) { W = F.in[25]; N = 2 * D; WT = Wqkv; ldo = D; row_off = D; ok0 = 0; }
        else if ((r -= 1024) < 512) { W = F.in[32]; N = D; WT = Wo1; ldo = D; row_off = 0; ok0 = 0; }
        else { r -= 512; WT = Wl1; ldo = 2048;
            int half;
            if (r < 64) { W = F.in[9]; N = 64; row_off = 0; half = r >> 5; r &= 31; if (half) ksc = mu + 3 * D; }
            else if (r < 128) { r -= 64; W = F.in[12]; N = 64; row_off = 64; half = r >> 5; r &= 31; if (half) ksc = mu + 4 * D; }
            else { r -= 128; W = F.in[14]; N = 128; row_off = 128; half = r >> 6; r &= 63; if (half) ksc = mu + 5 * D; }
            ok0 = half ? 1024 : 0; }
        const int nblk = N / 32, kb = r / nblk, nb = r % nblk;
        transpose_item(W, N, 64 * kb, 32 * nb, WT, ldo, row_off + 32 * nb, ok0, ksc, scr, F.lane);
    }
    if (part == 1) return;
    const float* w2 = F.in[10]; const float* a2 = F.in[13]; const float* g2 = F.in[15];
    for (int item = (blockIdx.x * 512 + F.tid); item < 3072 * 32; item += F.G * 512) {
        const int nr = item % 3072, k0 = (item / 3072) * 8; float v[8];
        const int n = (nr & ~31) + pg8::perm32(nr & 31);
#pragma unroll
        for (int e = 0; e < 8; ++e) { const int k = k0 + e; float x = 0.f;
            if (n < 1024) { if (k < 64) x = w2[(size_t)k * 1024 + n]; }
            else if (n < 2048) { if (k >= 64 && k < 128) x = a2[(size_t)(k - 64) * 1024 + (n - 1024)]; }
            else { if (k >= 128) x = g2[(size_t)(k - 128) * 1024 + (n - 2048)]; }
            v[e] = x; }
        v4u o; o.x = pk2(v[0], v[1]); o.y = pk2(v[2], v[3]); o.z = pk2(v[4], v[5]); o.w = pk2(v[6], v[7]);
        *(v4u*)(Wl2 + (size_t)nr * 256 + k0) = o;
    }
}
struct MoeItem { const float* W; int ldw, k0, n0; bf16* WT; int ldo, orow0; };
__device__ __forceinline__ MoeItem moe_item(Frame& F, int l, int it) {
    bf16* GU = (bf16*)(F.ws + WS_MOEGU); bf16* DW = (bf16*)(F.ws + (l ? WS_MOED1 : WS_MOED));
    const float* wg = F.in[35] + (size_t)l * NE * D * FF; const float* wu = F.in[36] + (size_t)l * NE * D * FF; const float* wd = F.in[37] + (size_t)l * NE * FF * D;
    const int e = it / 768, r = it % 768; MoeItem m;
    if (r < 512) { const int up = r >> 8, q = r & 255, kb = q >> 4, nb = q & 15, n0 = 32 * nb;
        m.W = (up ? wu : wg) + (size_t)e * D * FF; m.ldw = FF; m.k0 = 64 * kb; m.n0 = n0; m.WT = GU + (size_t)e * 1024 * 1024; m.ldo = 1024; m.orow0 = 256 * (n0 >> 7) + (n0 & 127) + (up ? 128 : 0); }
    else { const int q = r - 512, kb = q >> 5, nb = q & 31;
        m.W = wd + (size_t)e * FF * D; m.ldw = D; m.k0 = 64 * kb; m.n0 = 32 * nb; m.WT = DW + (size_t)e * 1024 * 512; m.ldo = 512; m.orow0 = 32 * nb; }
    return m;
}
__device__ __forceinline__ MoeItem moe_item4a(Frame& F, int mit) {
    if (mit < NE * 768) return moe_item(F, 0, mit);
    const int q = mit - NE * 768; return moe_item(F, 1, (q >> 8) * 768 + 512 + (q & 255));
}
__device__ __forceinline__ void moe_weights(Frame& F, int l) {
    const int gw = F.vcu * NWAVES + F.wave, NGW = F.G * NWAVES;
    LAS float* scr = (LAS float*)(F.lds + RING_OFF + F.wave * 16384);
    bf16* GU = (bf16*)(F.ws + WS_MOEGU); bf16* DW = (bf16*)(F.ws + WS_MOED);
    const float* wg = F.in[35] + (size_t)l * NE * D * FF; const float* wu = F.in[36] + (size_t)l * NE * D * FF; const float* wd = F.in[37] + (size_t)l * NE * FF * D;
    const int per = (l == 1) ? 512 : 768;
    for (int it = gw; it < NE * per; it += NGW) {
        const int e = it / per, r = it % per;
        if (r < 512) { const int up = r >> 8, q = r & 255, kb = q >> 4, nb = q & 15, n0 = 32 * nb;
            const float* W = (up ? wu : wg) + (size_t)e * D * FF;
            transpose_item(W, FF, 64 * kb, n0, GU + (size_t)e * 1024 * 1024, 1024, 256 * (n0 >> 7) + (n0 & 127) + (up ? 128 : 0), 0, nullptr, scr, F.lane); }
        else { const int q = r - 512, kb = q >> 5, nb = q & 31;
            transpose_item(wd + (size_t)e * FF * D, D, 64 * kb, 32 * nb, DW + (size_t)e * 1024 * 512, 512, 32 * nb, 0, nullptr, scr, F.lane); }
    }
}

__device__ __forceinline__ void p1_norm_views(Frame& F) {
    LAS float* hrow = (LAS float*)(F.lds + RING_OFF);
    const float* x = F.in[0]; const float* g = F.in[4]; const float* mu = F.in[6];
    const float* mod = (const float*)(F.ws + WS_MOD);
    bf16* views = (bf16*)(F.ws + WS_VIEWS); bf16* H2 = (bf16*)(F.ws + WS_H2);
    f32x4 muv[3][4];
#pragma unroll
    for (int i = 0; i < 3; ++i)
#pragma unroll
        for (int j = 0; j < 4; ++j) muv[i][j] = *(const f32x4*)(mu + i * D + 4 * F.lane + 256 * j);
    f32x4 xn[4];
    { const int grp0 = blockIdx.x; if (grp0 < M / 8) { const f32x4* xr = (const f32x4*)(x + (size_t)(grp0 * 8 + F.wave) * D) + F.lane;
#pragma unroll
        for (int j = 0; j < 4; ++j) xn[j] = NT_LD(f32x4, xr + 64 * j); } }
    for (int grp = blockIdx.x; grp < M / 8; grp += F.G) {
        const int m0 = grp * 8, b = m0 / T, t0 = m0 % T;
        const float* sh = mod + (size_t)b * 6144; const float* sc = sh + 1024;
        f32x4 hv[4], xc[4];
#pragma unroll
        for (int j = 0; j < 4; ++j) xc[j] = xn[j];
        if (grp + F.G < M / 8) { const f32x4* xr = (const f32x4*)(x + (size_t)((grp + F.G) * 8 + F.wave) * D) + F.lane;
#pragma unroll
            for (int j = 0; j < 4; ++j) xn[j] = NT_LD(f32x4, xr + 64 * j); }
        __builtin_amdgcn_sched_barrier(0);
        for (int pass = 0; pass < 2; ++pass) {
            if (pass == 1 && F.wave != 0) break;
            f32x4 v[4];
            if (pass == 1 && t0 == 0) {
#pragma unroll
                for (int j = 0; j < 4; ++j) v[j] = (f32x4){0.f, 0.f, 0.f, 0.f};
            } else {
                float ss = 0.f;
                if (pass == 0) {
#pragma unroll
                    for (int j = 0; j < 4; ++j) v[j] = xc[j];
                } else { const f32x4* xr = (const f32x4*)(x + (size_t)(m0 - 1) * D) + F.lane;
#pragma unroll
                    for (int j = 0; j < 4; ++j) v[j] = xr[64 * j]; }
#pragma unroll
                for (int j = 0; j < 4; ++j) ss += (v[j].x * v[j].x + v[j].y * v[j].y) + (v[j].z * v[j].z + v[j].w * v[j].w);
                const float rstd = 1.0f / sqrtf(wave_sum(ss) * (1.f / D) + RMS_EPS);
#pragma unroll
                for (int j = 0; j < 4; ++j) { const int c = 4 * F.lane + 256 * j; const f32x4 gg = *(const f32x4*)(g + c), s1 = *(const f32x4*)(sc + c), s0 = *(const f32x4*)(sh + c);
                    v[j] = v[j] * rstd * gg * (s1 + 1.0f) + s0; }
            }
            LAS f32x4* hp = (LAS f32x4*)(hrow + ((pass == 0) ? (F.wave + 1) : 0) * 1024) + F.lane;
#pragma unroll
            for (int j = 0; j < 4; ++j) { hp[64 * j] = v[j]; if (pass == 0) hv[j] = v[j]; }
        }
        __syncthreads();
        {
            const int row = m0 + F.wave;
            const LAS f32x4* pp = (const LAS f32x4*)(hrow + F.wave * 1024) + F.lane;
#pragma unroll
            for (int j = 0; j < 4; ++j) { const int c = 4 * F.lane + 256 * j; const f32x4 xx = pp[64 * j] - hv[j];
#pragma unroll
                for (int i = 0; i < 3; ++i) { const f32x4 mm = muv[i][j]; const f32x4 o = hv[j] + xx * mm;
                    v2u w; w.x = pk2(o.x, o.y); w.y = pk2(o.z, o.w); wt8(views + ((size_t)i * M + row) * D + c, w); }
                v2u w; w.x = pk2(hv[j].x, hv[j].y); w.y = pk2(hv[j].z, hv[j].w); wt8(H2 + (size_t)row * 2048 + c, w);
                w.x = pk2(xx.x, xx.y); w.y = pk2(xx.z, xx.w); wt8(H2 + (size_t)row * 2048 + 1024 + c, w); }
        }
        __syncthreads();
    }
}

__device__ __forceinline__ void p4_scan_seq(Frame& F) {
    constexpr int TS = 32;
    LAS float* sA = (LAS float*)(F.lds + RING_OFF);
    LAS float* sW = sA + TS * 64; LAS float* sB = sW + TS * 64; LAS float* sK = sB + TS * 64; LAS float* sR = sK + TS * 64; LAS float* sV = sR + TS * 64;
    LAS float* sY = sV + TS * 64; LAS float* sRK = sY + TS * 64;
    const bf16* Rb = (const bf16*)(F.ws + WS_RKV); const bf16* Kb = Rb + (size_t)M * D; const bf16* Vb = Kb + (size_t)M * D;
    const float* LW = (const float*)(F.ws + WS_LOGW); const bf16* AS = (const bf16*)(F.ws + WS_ASIG); const bf16* GG = (const bf16*)(F.ws + WS_GG);
    bf16* YG = (bf16*)(F.ws + WS_YG);
    const float* k_k = F.in[16]; const float* k_a = F.in[17]; const float* r_k = F.in[18]; const float* gn_g = F.in[19]; const float* gn_b = F.in[20];
    for (int bh = blockIdx.x; bh < BATCH * 16; bh += F.G) {
        const int b = bh >> 4, h = bh & 15;
        const int i = F.tid >> 3, q = F.tid & 7;
        const int st = F.tid >> 4, d4 = (F.tid & 15) * 4;
        const int cg = h * 64 + d4;
        const f32x4 kkv = *(const f32x4*)(k_k + cg), kav = *(const f32x4*)(k_a + cg), rkv = *(const f32x4*)(r_k + cg), gng = *(const f32x4*)(gn_g + cg), gnb = *(const f32x4*)(gn_b + cg);
        float s[8];
#pragma unroll
        for (int j = 0; j < 8; ++j) s[j] = 0.f;
        for (int t0 = 0; t0 < T; t0 += TS) {
            const size_t ro = ((size_t)b * T + t0 + st) * D + cg;
            {
                const v2u rr = *(const v2u*)(Rb + ro), kk2 = *(const v2u*)(Kb + ro), vv = *(const v2u*)(Vb + ro), aa = *(const v2u*)(AS + ro); const f32x4 lw = *(const f32x4*)(LW + ro);
                const f32x4 r4 = {bflo(rr.x), bfhi(rr.x), bflo(rr.y), bfhi(rr.y)}, k4 = {bflo(kk2.x), bfhi(kk2.x), bflo(kk2.y), bfhi(kk2.y)};
                const f32x4 v4 = {bflo(vv.x), bfhi(vv.x), bflo(vv.y), bfhi(vv.y)}, a4 = {bflo(aa.x), bfhi(aa.x), bflo(aa.y), bfhi(aa.y)};
                const f32x4 kr = k4 * kkv; float ss = (kr.x * kr.x + kr.y * kr.y) + (kr.z * kr.z + kr.w * kr.w);
                ss += __shfl_xor(ss, 1); ss += __shfl_xor(ss, 2); ss += __shfl_xor(ss, 4); ss += __shfl_xor(ss, 8);
                const float inv = 1.0f / fmaxf(sqrtf(ss), 1e-12f);
                const f32x4 kkn = kr * inv; const f32x4 km = k4 * ((a4 - 1.0f) * kav + 1.0f);
                const f32x4 rk4 = r4 * km * rkv; float rs = (rk4.x + rk4.y) + (rk4.z + rk4.w);
                rs += __shfl_xor(rs, 1); rs += __shfl_xor(rs, 2); rs += __shfl_xor(rs, 4); rs += __shfl_xor(rs, 8);
                f32x4 wv; wv.x = __expf(lw.x); wv.y = __expf(lw.y); wv.z = __expf(lw.z); wv.w = __expf(lw.w);
                *(LAS f32x4*)(sA + st * 64 + d4) = -kkn; *(LAS f32x4*)(sW + st * 64 + d4) = wv; *(LAS f32x4*)(sB + st * 64 + d4) = kkn * a4;
                *(LAS f32x4*)(sK + st * 64 + d4) = km; *(LAS f32x4*)(sR + st * 64 + d4) = r4; *(LAS f32x4*)(sV + st * 64 + d4) = v4;
                if ((F.tid & 15) == 0) sRK[st] = rs;
            }
            __syncthreads();
            for (int t = 0; t < TS; ++t) {
                const LAS f32x4* pa = (const LAS f32x4*)(sA + t * 64 + q * 8); const LAS f32x4* pw = (const LAS f32x4*)(sW + t * 64 + q * 8); const LAS f32x4* pb = (const LAS f32x4*)(sB + t * 64 + q * 8);
                const LAS f32x4* pk = (const LAS f32x4*)(sK + t * 64 + q * 8); const LAS f32x4* pr = (const LAS f32x4*)(sR + t * 64 + q * 8);
                const f32x4 a0 = pa[0], a1 = pa[1], w0 = pw[0], w1 = pw[1], b0 = pb[0], b1 = pb[1], k0 = pk[0], k1 = pk[1], r0 = pr[0], r1 = pr[1];
                const float vi = sV[t * 64 + i];
                float sa = (s[0] * a0.x + s[1] * a0.y) + (s[2] * a0.z + s[3] * a0.w) + (s[4] * a1.x + s[5] * a1.y) + (s[6] * a1.z + s[7] * a1.w);
                sa += __shfl_xor(sa, 1); sa += __shfl_xor(sa, 2); sa += __shfl_xor(sa, 4);
                s[0] = s[0] * w0.x + sa * b0.x + vi * k0.x; s[1] = s[1] * w0.y + sa * b0.y + vi * k0.y; s[2] = s[2] * w0.z + sa * b0.z + vi * k0.z; s[3] = s[3] * w0.w + sa * b0.w + vi * k0.w;
                s[4] = s[4] * w1.x + sa * b1.x + vi * k1.x; s[5] = s[5] * w1.y + sa * b1.y + vi * k1.y; s[6] = s[6] * w1.z + sa * b1.z + vi * k1.z; s[7] = s[7] * w1.w + sa * b1.w + vi * k1.w;
                float y = (s[0] * r0.x + s[1] * r0.y) + (s[2] * r0.z + s[3] * r0.w) + (s[4] * r1.x + s[5] * r1.y) + (s[6] * r1.z + s[7] * r1.w);
                y += __shfl_xor(y, 1); y += __shfl_xor(y, 2); y += __shfl_xor(y, 4);
                if (q == 0) sY[t * 64 + i] = y;
            }
            __syncthreads();
            {
                const f32x4 y4 = *(const LAS f32x4*)(sY + st * 64 + d4); const f32x4 v4 = *(const LAS f32x4*)(sV + st * 64 + d4);
                float sm = (y4.x + y4.y) + (y4.z + y4.w);
                sm += __shfl_xor(sm, 1); sm += __shfl_xor(sm, 2); sm += __shfl_xor(sm, 4); sm += __shfl_xor(sm, 8);
                const float mean = sm * (1.f / 64.f); const f32x4 dv = y4 - mean;
                float vs = (dv.x * dv.x + dv.y * dv.y) + (dv.z * dv.z + dv.w * dv.w);
                vs += __shfl_xor(vs, 1); vs += __shfl_xor(vs, 2); vs += __shfl_xor(vs, 4); vs += __shfl_xor(vs, 8);
                const float rstd = 1.0f / sqrtf(vs * (1.f / 64.f) + GN_EPS);
                const v2u gg = *(const v2u*)(GG + ro); const f32x4 g4 = {bflo(gg.x), bfhi(gg.x), bflo(gg.y), bfhi(gg.y)};
                const f32x4 o = (dv * rstd * gng + gnb + v4 * sRK[st]) * g4;
                v2u w; w.x = pk2(o.x, o.y); w.y = pk2(o.z, o.w); *(v2u*)(YG + ro) = w;
            }
            __syncthreads();
        }
    }
}

constexpr int RT_HS = 1028;
__device__ __forceinline__ void moe_router(Frame& F, int l, const float* xin, int cnt_off) {
    const float* g = F.in[5] + (size_t)l * D; const float* wrg = F.in[33] + (size_t)l * D * NGRP; const float* wre = F.in[34] + (size_t)l * D * NE;
    const float* mod = (const float*)(F.ws + WS_MOD) + (size_t)l * 4 * 6144;
    bf16* H2N = (bf16*)(F.ws + WS_H2N);
    int* asg_e = (int*)(F.ws + WS_ROUTE); int* asg_pos = asg_e + 2 * M; int* rowtok = (int*)(F.ws + WS_ROWTOK); float* rowgate = (float*)(F.ws + WS_ROWGATE);
    unsigned* cnt = (unsigned*)F.ctl + CW_CNT + 64 * l + cnt_off;
    LAS float* hs = (LAS float*)(F.lds + RING_OFF);
    LAS float* part = hs + 16 * RT_HS;
    LAS float* lgs = part + 8 * 768;
    const int lane = F.lane, w = F.wave, n16 = lane & 15, g4 = lane >> 4;
    const int ti_n = (M / 16 - (int)blockIdx.x + F.G - 1) / F.G;
    f32x4 xv[2][4];
#pragma unroll
    for (int rr = 0; rr < 2; ++rr) { const f32x4* xr = (const f32x4*)(xin + (size_t)(blockIdx.x * 16 + 2 * w + rr) * D) + lane;
#pragma unroll
        for (int j = 0; j < 4; ++j) xv[rr][j] = (ti_n > 0) ? xr[64 * j] : (f32x4){0.f, 0.f, 0.f, 0.f}; }
    typedef _Float16 f16x8_t __attribute__((ext_vector_type(8)));
    f16x8_t whi[3][4], wlo[3][4];
    {   const int kb = 128 * w + 32 * g4;
        const float* pg = wrg + (size_t)kb * 4 + (n16 & 3); const float* pe0 = wre + (size_t)kb * 32 + ((n16 + 28) & 31); const float* pe1 = wre + (size_t)kb * 32 + 12 + n16; const float* pe2 = wre + (size_t)kb * 32 + 28 + (n16 & 3);
#pragma unroll
        for (int s = 0; s < 4; ++s)
#pragma unroll
            for (int j = 0; j < 8; ++j) { const int ks = 8 * s + j; const float a = pg[ks * 4], bq = pe0[ks * 32], cq = pe2[ks * 32];
                const float w0 = ((n16 < 4) ? a : bq) * 1024.0f, w1 = pe1[ks * 32] * 1024.0f, w2 = ((n16 < 4) ? cq : 0.f) * 1024.0f;
                const _Float16 h0 = (_Float16)w0, h1 = (_Float16)w1, h2 = (_Float16)w2;
                whi[0][s][j] = h0; wlo[0][s][j] = (_Float16)(w0 - (float)h0); whi[1][s][j] = h1; wlo[1][s][j] = (_Float16)(w1 - (float)h1); whi[2][s][j] = h2; wlo[2][s][j] = (_Float16)(w2 - (float)h2); } }
    for (int ti = 0; ti < ti_n; ++ti) { const int tile = blockIdx.x + ti * F.G;
        f32x4 vc[2][4];
#pragma unroll
        for (int rr = 0; rr < 2; ++rr)
#pragma unroll
            for (int j = 0; j < 4; ++j) vc[rr][j] = xv[rr][j];
        if (ti + 1 < ti_n) {
#pragma unroll
            for (int rr = 0; rr < 2; ++rr) { const f32x4* xr = (const f32x4*)(xin + (size_t)((tile + F.G) * 16 + 2 * w + rr) * D) + lane;
#pragma unroll
                for (int j = 0; j < 4; ++j) xv[rr][j] = NT_LD(f32x4, xr + 64 * j); } }
        __builtin_amdgcn_sched_barrier(0);
        f32x4 ga[4], gb[4];
        { const int b = (tile * 16) / T; const float* sh = mod + (size_t)b * 6144 + 3072; const float* sc = sh + 1024;
#pragma unroll
          for (int j = 0; j < 4; ++j) { const int c = 4 * lane + 256 * j; ga[j] = *(const f32x4*)(g + c) * (*(const f32x4*)(sc + c) + 1.0f); gb[j] = *(const f32x4*)(sh + c); } }
#pragma unroll
        for (int rr = 0; rr < 2; ++rr) { const int rl = 2 * w + rr, row = tile * 16 + rl;
            f32x4 v[4]; float ss = 0.f;
#pragma unroll
            for (int j = 0; j < 4; ++j) { v[j] = vc[rr][j]; ss += (v[j].x * v[j].x + v[j].y * v[j].y) + (v[j].z * v[j].z + v[j].w * v[j].w); }
            const float rstd = 1.0f / sqrtf(wave_sum(ss) * (1.f / D) + RMS_EPS);
#pragma unroll
            for (int j = 0; j < 4; ++j) { const int c = 4 * lane + 256 * j;
                v[j] = v[j] * rstd * ga[j] + gb[j];
                v2u wv; wv.x = pk2(v[j].x, v[j].y); wv.y = pk2(v[j].z, v[j].w); wt8(H2N + (size_t)row * D + c, wv);
                *(LAS f32x4*)(hs + rl * RT_HS + c) = v[j]; } }
        __syncthreads();
        f32x4 acc[3];
#pragma unroll
        for (int nt = 0; nt < 3; ++nt) acc[nt] = (f32x4){0.f, 0.f, 0.f, 0.f};
#pragma unroll
        for (int s = 0; s < 4; ++s) { const f32x4 a0 = *(const LAS f32x4*)(hs + n16 * RT_HS + 128 * w + 32 * g4 + 8 * s), a1 = *(const LAS f32x4*)(hs + n16 * RT_HS + 128 * w + 32 * g4 + 8 * s + 4);
            const float av[8] = {a0.x, a0.y, a0.z, a0.w, a1.x, a1.y, a1.z, a1.w}; f16x8_t ah, al;
#pragma unroll
            for (int j = 0; j < 8; ++j) { const float x = av[j] * 16.0f; const _Float16 h = (_Float16)x; ah[j] = h; al[j] = (_Float16)(x - (float)h); }
#pragma unroll
            for (int nt = 0; nt < 3; ++nt) { acc[nt] = __builtin_amdgcn_mfma_f32_16x16x32_f16(al, whi[nt][s], acc[nt], 0, 0, 0); acc[nt] = __builtin_amdgcn_mfma_f32_16x16x32_f16(ah, wlo[nt][s], acc[nt], 0, 0, 0);
                acc[nt] = __builtin_amdgcn_mfma_f32_16x16x32_f16(ah, whi[nt][s], acc[nt], 0, 0, 0); } }
#pragma unroll
        for (int nt = 0; nt < 3; ++nt)
#pragma unroll
            for (int reg = 0; reg < 4; ++reg) part[(w * 16 + 4 * g4 + reg) * 48 + 16 * nt + n16] = acc[nt][reg] * (1.0f / 16384.0f);
        __syncthreads();
        for (int o = F.tid; o < 768; o += 512) { float s = 0.f;
#pragma unroll
            for (int ww = 0; ww < 8; ++ww) s += part[ww * 768 + o];
            lgs[ti * 768 + o] = s; }
    }
    __syncthreads();
    LAS unsigned* lcnt = (LAS unsigned*)(lgs + 8 * 768);
    if (F.tid < 64) lcnt[F.tid] = 0u;
    __syncthreads();
    const int nrow = 16 * ti_n;
    int ea0 = 0, eb0 = 0, ea1 = 0, eb1 = 0; unsigned pa0 = 0, pb0 = 0, pa1 = 0, pb1 = 0; float ga0 = 0.f, gb0 = 0.f, ga1 = 0.f, gb1 = 0.f;
#pragma unroll
    for (int it = 0; it < 2; ++it) { const int rloc = F.tid + it * 512 * 0 + it * 64;
        if (F.tid < 64 && rloc < nrow) {
            float lg[36];
#pragma unroll
            for (int q = 0; q < 9; ++q) { const f32x4 pv = *(const LAS f32x4*)(lgs + rloc * 48 + 4 * q); lg[4 * q] = pv.x; lg[4 * q + 1] = pv.y; lg[4 * q + 2] = pv.z; lg[4 * q + 3] = pv.w; }
            int gi = 0; float gm = lg[0];
#pragma unroll
            for (int j = 1; j < 4; ++j) if (lg[j] > gm) { gm = lg[j]; gi = j; }
            float gs = 0.f;
#pragma unroll
            for (int j = 0; j < 4; ++j) gs += __expf(lg[j] - gm);
            const float ggate = 1.0f / gs;
            float el[8];
#pragma unroll
            for (int j = 0; j < 8; ++j) el[j] = (gi == 0) ? lg[4 + j] : (gi == 1) ? lg[12 + j] : (gi == 2) ? lg[20 + j] : lg[28 + j];
            int i1 = 0; float v1 = el[0];
#pragma unroll
            for (int j = 1; j < 8; ++j) if (el[j] > v1) { v1 = el[j]; i1 = j; }
            int i2 = -1; float v2 = -INFINITY;
#pragma unroll
            for (int j = 0; j < 8; ++j) if (j != i1 && el[j] > v2) { v2 = el[j]; i2 = j; }
            if (i2 < 0) i2 = (i1 == 0) ? 1 : 0;
            const float e2 = __expf(v2 - v1), p1 = 1.0f / (1.0f + e2), p2 = e2 * p1;
            const int ea = gi * 8 + i1, eb = gi * 8 + i2;
            const unsigned pa = __hip_atomic_fetch_add(lcnt + ea, 1u, __ATOMIC_RELAXED, __HIP_MEMORY_SCOPE_WORKGROUP), pb = __hip_atomic_fetch_add(lcnt + eb, 1u, __ATOMIC_RELAXED, __HIP_MEMORY_SCOPE_WORKGROUP);
            if (it == 0) { ea0 = ea; eb0 = eb; pa0 = pa; pb0 = pb; ga0 = ggate * p1; gb0 = ggate * p2; } else { ea1 = ea; eb1 = eb; pa1 = pa; pb1 = pb; ga1 = ggate * p1; gb1 = ggate * p2; }
        } }
    __syncthreads();
    if (F.tid < 32) { const unsigned n = lcnt[F.tid]; lcnt[32 + F.tid] = n ? atomicAdd(cnt + F.tid, n) : 0u; }
    __syncthreads();
#pragma unroll
    for (int it = 0; it < 2; ++it) { const int rloc = F.tid + it * 64;
        if (F.tid < 64 && rloc < nrow) { const int row = (blockIdx.x + (rloc >> 4) * F.G) * 16 + (rloc & 15);
            const int ea = it ? ea1 : ea0, eb = it ? eb1 : eb0; const unsigned pa = it ? pa1 : pa0, pb = it ? pb1 : pb0;
            const int qa = (int)(lcnt[32 + ea] + pa), qb = (int)(lcnt[32 + eb] + pb);
            asg_e[2 * row] = ea; asg_e[2 * row + 1] = eb; asg_pos[2 * row] = qa; asg_pos[2 * row + 1] = qb;
            rowtok[(size_t)ea * pg8::MOE_CAP + qa] = row; rowtok[(size_t)eb * pg8::MOE_CAP + qb] = row; rowgate[(size_t)ea * pg8::MOE_CAP + qa] = it ? ga1 : ga0; rowgate[(size_t)eb * pg8::MOE_CAP + qb] = it ? gb1 : gb0; } }
    __syncthreads();
}
__device__ __forceinline__ void moe_toff(Frame& F, int l) {
    LAS int* toff = (LAS int*)(F.lds + LDSCTL_OFF);
    if (F.wave == 0) { const unsigned* cnt = (const unsigned*)F.ctl + CW_CNT + 64 * l; const int lane = F.lane;
        const int n = (lane < 32) ? (int)__hip_atomic_load(cnt + lane, RLX_AGENT) : 0; const int tl = (n + 255) >> 8; int inc = tl;
#pragma unroll
        for (int o = 1; o < 32; o <<= 1) { const int v = __shfl_up(inc, o); if (lane >= o) inc += v; }
        if (lane < 32) { toff[lane] = inc - tl; toff[40 + lane] = n; }
        if (lane == 31) toff[32] = inc; }
    __syncthreads();
}
struct CombRow { f32x4 x[4]; v2u y0[4], y1[4]; float g0, g1; };
__device__ __forceinline__ void comb_load(CombRow& r, const float* xin, const bf16* Y, const int* asg_e, const int* asg_pos, const float* rowgate, const LAS int* toff, int row, int lane) {
    const int e0 = asg_e[2 * row], e1 = asg_e[2 * row + 1], p0 = asg_pos[2 * row], p1 = asg_pos[2 * row + 1];
    const int r0 = toff[e0] * 256 + p0, r1 = toff[e1] * 256 + p1;
    r.g0 = rowgate[(size_t)e0 * pg8::MOE_CAP + p0]; r.g1 = rowgate[(size_t)e1 * pg8::MOE_CAP + p1];
    const f32x4* xr = (const f32x4*)(xin + (size_t)row * D) + lane;
#pragma unroll
    for (int j = 0; j < 4; ++j) { const int c = 4 * lane + 256 * j; r.x[j] = NT_LD(f32x4, xr + 64 * j); r.y0[j] = NT_LD(v2u, Y + (size_t)r0 * D + c); r.y1[j] = NT_LD(v2u, Y + (size_t)r1 * D + c); }
}
__device__ __forceinline__ void comb_load2(CombRow& r, const float* xin, const bf16* Y, int r0, int r1, float g0, float g1, int row, int lane) {
    r.g0 = g0; r.g1 = g1;
    const f32x4* xr = (const f32x4*)(xin + (size_t)row * D) + lane;
#pragma unroll
    for (int j = 0; j < 4; ++j) { const int c = 4 * lane + 256 * j; r.x[j] = NT_LD(f32x4, xr + 64 * j); r.y0[j] = NT_LD(v2u, Y + (size_t)r0 * D + c); r.y1[j] = NT_LD(v2u, Y + (size_t)r1 * D + c); }
}
template <int MODE> __device__ __forceinline__ void moe_combine(Frame& F, int l, const float* xin, float* xout) {
    moe_toff(F, l);
    const bf16* Y = (const bf16*)(F.ws + WS_Y); const float* rowgate = (const float*)(F.ws + WS_ROWGATE);
    const int* asg_e = (const int*)(F.ws + WS_ROUTE); const int* asg_pos = asg_e + 2 * M; const LAS int* toff = (const LAS int*)(F.lds + LDSCTL_OFF);
    const float* mod = (const float*)(F.ws + WS_MOD) + (size_t)l * 4 * 6144;
    const float* mod1 = (const float*)(F.ws + WS_MOD) + (size_t)4 * 6144;
    const float* modkv = (const float*)(F.ws + WS_MOD) + (size_t)8 * 6144;
    const float* gq = F.in[4] + D; const float* gkv = F.in[24]; const float* gfin = F.in[38];
    bf16* HQ = (bf16*)(F.ws + WS_HQ); bf16* HK = (bf16*)(F.ws + WS_HK);
    const int gw = blockIdx.x * NWAVES + F.wave, NGW = F.G * NWAVES;
    const int RPW = (M + NGW - 1) / NGW, rbeg = gw * RPW, rend = (rbeg + RPW < M) ? rbeg + RPW : M;
    int yr0 = 0, yr1 = 0; float gt0 = 0.f, gt1 = 0.f; const bool fast = (RPW <= 64);
    if (fast) { const int rr = rbeg + F.lane; if (F.lane < RPW && rr < rend) { const int e0 = asg_e[2 * rr], e1 = asg_e[2 * rr + 1], p0 = asg_pos[2 * rr], p1 = asg_pos[2 * rr + 1];
        yr0 = toff[e0] * 256 + p0; yr1 = toff[e1] * 256 + p1; gt0 = rowgate[(size_t)e0 * pg8::MOE_CAP + p0]; gt1 = rowgate[(size_t)e1 * pg8::MOE_CAP + p1]; } }
#define COMB_LOAD(dst, rw) do { if (fast) { const int li_ = (rw) - rbeg; comb_load2(dst, xin, Y, __builtin_amdgcn_readlane(yr0, li_), __builtin_amdgcn_readlane(yr1, li_), \
        __builtin_bit_cast(float, __builtin_amdgcn_readlane(__builtin_bit_cast(int, gt0), li_)), __builtin_bit_cast(float, __builtin_amdgcn_readlane(__builtin_bit_cast(int, gt1), li_)), (rw), F.lane); } \
    else comb_load(dst, xin, Y, asg_e, asg_pos, rowgate, toff, (rw), F.lane); } while (0)
    CombRow cur, nxt;
    if (rbeg < rend) COMB_LOAD(cur, rbeg);
    f32x4 gfv[4], aq[4], bq[4], ak[4], bk[4]; int bcur = -1;
    for (int row = rbeg; row < rend; ++row) {
        if (row + 1 < rend) COMB_LOAD(nxt, row + 1);
        __builtin_amdgcn_sched_barrier(0);
        const int b = row / T;
        if (b != bcur) { bcur = b; const float* gf = mod + (size_t)b * 6144 + 5120;
            const float* shq = mod1 + (size_t)b * 6144; const float* scq = shq + 1024; const float* shk = modkv + (size_t)b * 2048; const float* sck = shk + 1024;
#pragma unroll
            for (int j = 0; j < 4; ++j) { const int c = 4 * F.lane + 256 * j; gfv[j] = *(const f32x4*)(gf + c);
                if (MODE == 0) { aq[j] = *(const f32x4*)(gq + c) * (*(const f32x4*)(scq + c) + 1.0f); bq[j] = *(const f32x4*)(shq + c); ak[j] = *(const f32x4*)(gkv + c) * (*(const f32x4*)(sck + c) + 1.0f); bk[j] = *(const f32x4*)(shk + c); }
                else { aq[j] = *(const f32x4*)(gfin + c); } } }
        f32x4 v[4]; float ss = 0.f;
#pragma unroll
        for (int j = 0; j < 4; ++j) { const v2u y0 = cur.y0[j], y1 = cur.y1[j];
            const float ga = cur.g0, gb = cur.g1;
            const f32x4 ys = {ga * bflo(y0.x) + gb * bflo(y1.x), ga * bfhi(y0.x) + gb * bfhi(y1.x), ga * bflo(y0.y) + gb * bflo(y1.y), ga * bfhi(y0.y) + gb * bfhi(y1.y)};
            v[j] = cur.x[j] + gfv[j] * ys; ss += (v[j].x * v[j].x + v[j].y * v[j].y) + (v[j].z * v[j].z + v[j].w * v[j].w); }
        const float rstd = 1.0f / sqrtf(wave_sum(ss) * (1.f / D) + RMS_EPS);
        if (MODE == 0) {
#pragma unroll
            for (int j = 0; j < 4; ++j) { const int c = 4 * F.lane + 256 * j;
                wt16f((f32x4*)(xout + (size_t)row * D) + F.lane + 64 * j, v[j]);
                const f32x4 n = v[j] * rstd; const f32x4 hq = n * aq[j] + bq[j], hk = n * ak[j] + bk[j];
                v2u w; w.x = pk2(hq.x, hq.y); w.y = pk2(hq.z, hq.w); wt8(HQ + (size_t)row * D + c, w);
                w.x = pk2(hk.x, hk.y); w.y = pk2(hk.z, hk.w); wt8(HK + (size_t)row * D + c, w); }
        } else {
#pragma unroll
            for (int j = 0; j < 4; ++j) wt16f((f32x4*)(xout + (size_t)row * D) + F.lane + 64 * j, v[j] * rstd * aq[j]);
        }
        __builtin_amdgcn_sched_barrier(0);
        cur = nxt;
    }
}
#undef COMB_LOAD
__device__ __forceinline__ void attn_subln_rows(Frame& F, size_t row0, int h) {
    const bf16* OC = (const bf16*)(F.ws + WS_OC); bf16* ON = (bf16*)(F.ws + WS_ON);
    asm volatile("s_waitcnt vmcnt(0)" ::: "memory");
    const int lane = lane_id(), q4 = lane & 3;
    const float l1 = wave_sum(F.in[27][lane] * F.in[28][lane]), l2 = wave_sum(F.in[29][lane] * F.in[30][lane]);
    const float lam = __expf(l1) - __expf(l2) + LAMBDA_INIT1;
    const float* sg = F.in[31] + q4 * 32;
    v4u oa[2][4], ob[2][4]; f32x4 sgv[8];
#pragma unroll
    for (int ps = 0; ps < 2; ++ps) { const size_t row = row0 + ps * 16 + (lane >> 2);
        const v4u* p0 = (const v4u*)(OC + row * 2048 + h * 256 + q4 * 32); const v4u* p1 = (const v4u*)(OC + row * 2048 + h * 256 + 128 + q4 * 32);
#pragma unroll
        for (int q = 0; q < 4; ++q) { oa[ps][q] = p0[q]; ob[ps][q] = p1[q]; } }
#pragma unroll
    for (int q = 0; q < 8; ++q) sgv[q] = *(const f32x4*)(sg + 4 * q);
#pragma unroll
    for (int ps = 0; ps < 2; ++ps) { const size_t row = row0 + ps * 16 + (lane >> 2);
        float d[32]; float ss = 0.f;
#pragma unroll
        for (int q = 0; q < 4; ++q) { const v4u a = oa[ps][q], bq = ob[ps][q]; const unsigned aw[4] = {a.x, a.y, a.z, a.w}, bw[4] = {bq.x, bq.y, bq.z, bq.w};
#pragma unroll
            for (int e = 0; e < 4; ++e) { d[8 * q + 2 * e] = bflo(aw[e]) - lam * bflo(bw[e]); d[8 * q + 2 * e + 1] = bfhi(aw[e]) - lam * bfhi(bw[e]); } }
#pragma unroll
        for (int e = 0; e < 32; ++e) ss += d[e] * d[e];
        ss += __shfl_xor(ss, 1); ss += __shfl_xor(ss, 2);
        const float rstd = (1.0f - LAMBDA_INIT1) / sqrtf(ss * (1.f / 128.f) + SUBLN_EPS);
        v4u* op = (v4u*)(ON + row * D + h * 128 + q4 * 32);
#pragma unroll
        for (int q = 0; q < 4; ++q) { const f32x4 g0 = sgv[2 * q], g1 = sgv[2 * q + 1];
            v4u w; w.x = pk2(d[8 * q] * rstd * g0.x, d[8 * q + 1] * rstd * g0.y); w.y = pk2(d[8 * q + 2] * rstd * g0.z, d[8 * q + 3] * rstd * g0.w);
            w.z = pk2(d[8 * q + 4] * rstd * g1.x, d[8 * q + 5] * rstd * g1.y); w.w = pk2(d[8 * q + 6] * rstd * g1.z, d[8 * q + 7] * rstd * g1.w); op[q] = w; } }
}
struct AttnOrder {
    int vcu;
    __device__ __forceinline__ explicit AttnOrder(int grid, int block) : vcu((block % 8) * (grid / 8) + block / 8) {}
    __device__ __forceinline__ bool next(int i, attn_body::AttnUnit& u) const { if (i >= 8) return false; const int s = 2 * (i >> 1) + (vcu & 1); u.bh = vcu >> 1; u.qb = (i & 1) ? s : 15 - s; return true; }
    __device__ __forceinline__ void a_ready(const attn_body::AttnUnit&) const {}
    __device__ __forceinline__ void done(const attn_body::AttnUnit&) const {}
};

typedef float f32x16 __attribute__((ext_vector_type(16)));
typedef float f32x2_t __attribute__((ext_vector_type(2))); typedef __bf16 bf16x2_t __attribute__((ext_vector_type(2)));
__device__ __forceinline__ unsigned cvtpk(float lo, float hi) { f32x2_t v = {lo, hi}; bf16x2_t b = __builtin_convertvector(v, bf16x2_t); return __builtin_bit_cast(unsigned, b); }
#define MMA32(a, b, c) __builtin_amdgcn_mfma_f32_32x32x16_bf16((a), (b), (c), 0, 0, 0)
constexpr int SC_TS = 72, SC_TB = 64 * SC_TS * 2;
constexpr int SL_A = 0, SL_B = 1, SL_K = 2, SL_R = 3, SL_BH = 4, SL_KH = 5, SL_VT = 6, SL_ARB = 7, SL_ARK = 8;
constexpr int SC_RHS = 9 * SC_TB;
constexpr int SC_XT0 = SC_RHS + 32768, SC_XT1 = SC_XT0 + SC_TB;
constexpr int SC_GEND = SC_XT1 + SC_TB;
constexpr int SC_AD = 1 * SC_TB, SC_ADS = 20;
constexpr int SC_TBB = SC_AD + 4 * 16 * SC_ADS * 4;
constexpr int SC_LBUF = 7 * SC_TB, SC_SEG = SC_LBUF + 16384;
static_assert(SC_GEND + 256 <= LDSCTL_OFF && SC_SEG + 2048 <= 9 * SC_TB && SC_TBB + 2048 <= 2 * SC_TB, "scan LDS map");

__device__ __forceinline__ void tile_mma2(f32x16 (&acc)[2], const LAS unsigned char* TA, const LAS unsigned char* TBp, int mt, int r32, int hi) {
#pragma unroll
    for (int ks = 0; ks < 4; ++ks) {
        const bf16x8 a = *(const LAS bf16x8*)(TA + ((32 * mt + r32) * SC_TS + 16 * ks + 8 * hi) * 2);
        const bf16x8 b0 = *(const LAS bf16x8*)(TBp + ((r32) * SC_TS + 16 * ks + 8 * hi) * 2);
        const bf16x8 b1 = *(const LAS bf16x8*)(TBp + ((32 + r32) * SC_TS + 16 * ks + 8 * hi) * 2);
        acc[0] = MMA32(a, b0, acc[0]); acc[1] = MMA32(a, b1, acc[1]);
    }
}
struct TrF { v2u f[4][2]; };
__device__ __forceinline__ void tr_load(TrF& o, const LAS unsigned char* N, int c, int lane) {
    const unsigned a = (unsigned)(uintptr_t)N + (unsigned)(((8 * (lane >> 5) + ((lane & 15) >> 2)) * SC_TS + 32 * c + 16 * ((lane >> 4) & 1) + 4 * (lane & 3)) * 2);
    asm volatile("ds_read_b64_tr_b16 %0, %8\n\tds_read_b64_tr_b16 %1, %8 offset:576\n\tds_read_b64_tr_b16 %2, %8 offset:2304\n\tds_read_b64_tr_b16 %3, %8 offset:2880\n\t"
                 "ds_read_b64_tr_b16 %4, %8 offset:4608\n\tds_read_b64_tr_b16 %5, %8 offset:5184\n\tds_read_b64_tr_b16 %6, %8 offset:6912\n\tds_read_b64_tr_b16 %7, %8 offset:7488\n\ts_waitcnt lgkmcnt(0)"
                 : "=&v"(o.f[0][0]), "=&v"(o.f[0][1]), "=&v"(o.f[1][0]), "=&v"(o.f[1][1]), "=&v"(o.f[2][0]), "=&v"(o.f[2][1]), "=&v"(o.f[3][0]), "=&v"(o.f[3][1]) : "v"(a) : "memory");
}
static_assert(SC_TS * 2 * 4 == 576 && SC_TS * 2 * 16 == 2304, "tr_load offsets");
__device__ __forceinline__ void tr_issue(TrF& o, const LAS unsigned char* N, int c, int lane) {
    const unsigned a = (unsigned)(uintptr_t)N + (unsigned)(((8 * (lane >> 5) + ((lane & 15) >> 2)) * SC_TS + 32 * c + 16 * ((lane >> 4) & 1) + 4 * (lane & 3)) * 2);
    asm volatile("ds_read_b64_tr_b16 %0, %8\n\tds_read_b64_tr_b16 %1, %8 offset:576\n\tds_read_b64_tr_b16 %2, %8 offset:2304\n\tds_read_b64_tr_b16 %3, %8 offset:2880\n\t"
                 "ds_read_b64_tr_b16 %4, %8 offset:4608\n\tds_read_b64_tr_b16 %5, %8 offset:5184\n\tds_read_b64_tr_b16 %6, %8 offset:6912\n\tds_read_b64_tr_b16 %7, %8 offset:7488"
                 : "=&v"(o.f[0][0]), "=&v"(o.f[0][1]), "=&v"(o.f[1][0]), "=&v"(o.f[1][1]), "=&v"(o.f[2][0]), "=&v"(o.f[2][1]), "=&v"(o.f[3][0]), "=&v"(o.f[3][1]) : "v"(a) : "memory");
}
__device__ __forceinline__ void tr_wait(TrF& o) {
    asm volatile("s_waitcnt lgkmcnt(0)" : "+v"(o.f[0][0]), "+v"(o.f[0][1]), "+v"(o.f[1][0]), "+v"(o.f[1][1]), "+v"(o.f[2][0]), "+v"(o.f[2][1]), "+v"(o.f[3][0]), "+v"(o.f[3][1]) :: "memory");
}
__device__ __forceinline__ bf16x8 tr_get(const TrF& o, int ks) { const v4u q = {o.f[ks][0].x, o.f[ks][0].y, o.f[ks][1].x, o.f[ks][1].y}; return __builtin_bit_cast(bf16x8, q); }
template <bool TRA, bool TRB> __device__ __forceinline__ void tile_mma2t(f32x16 (&acc)[2], const LAS unsigned char* TA, const LAS unsigned char* TBp, int mt, int r32, int hi, int lane) {
    TrF fa, fb0, fb1;
    if constexpr (TRA) tr_issue(fa, TA, mt, lane);
    if constexpr (TRB) { tr_issue(fb0, TBp, 0, lane); tr_issue(fb1, TBp, 1, lane); }
    if constexpr (TRA) tr_wait(fa);
    if constexpr (TRB) { tr_wait(fb0); tr_wait(fb1); }
#pragma unroll
    for (int ks = 0; ks < 4; ++ks) {
        bf16x8 a, b0, b1;
        if constexpr (TRA) a = tr_get(fa, ks); else a = *(const LAS bf16x8*)(TA + ((32 * mt + r32) * SC_TS + 16 * ks + 8 * hi) * 2);
        if constexpr (TRB) { b0 = tr_get(fb0, ks); b1 = tr_get(fb1, ks); }
        else { b0 = *(const LAS bf16x8*)(TBp + ((r32) * SC_TS + 16 * ks + 8 * hi) * 2); b1 = *(const LAS bf16x8*)(TBp + ((32 + r32) * SC_TS + 16 * ks + 8 * hi) * 2); }
        acc[0] = MMA32(a, b0, acc[0]); acc[1] = MMA32(a, b1, acc[1]);
    }
}
typedef _Float16 f16x8 __attribute__((ext_vector_type(8)));
constexpr int SC_LWT = SC_RHS + 2 * 8448;
static_assert(SC_LWT + SC_TB <= SC_RHS + 32768 && SL_KH == 5 && SL_VT == 6 && SL_ARK == 8, "scan LDS map (copy tiles)");
constexpr int SC_TRIL = SC_GEND + 256;
static_assert(SC_TRIL + SC_TB <= LDSCTL_OFF, "scan LDS map (tril)");
template <int S> __device__ __forceinline__ float bcast16(float x) { const int xi = __builtin_bit_cast(int, x); return __builtin_bit_cast(float, __builtin_amdgcn_update_dpp(xi, xi, 0x150 + S, 0xf, 0xf, true)); }
template <int S> __device__ __forceinline__ void inv_step(float (&tt)[16], const float (&ar)[16], int cc) {
    float a = (S == cc) ? 1.0f : 0.0f;
#pragma unroll
    for (int j = 0; j < S; ++j) a += bcast16<S>(ar[j]) * tt[j];
    tt[S] = a;
}
__device__ __forceinline__ float sum8_dpp(float x, int lane) {
    int xi = __builtin_bit_cast(int, x);
    x += __builtin_bit_cast(float, __builtin_amdgcn_update_dpp(xi, xi, 0xB1, 0xf, 0xf, true)); xi = __builtin_bit_cast(int, x);
    x += __builtin_bit_cast(float, __builtin_amdgcn_update_dpp(xi, xi, 0x4E, 0xf, 0xf, true)); xi = __builtin_bit_cast(int, x);
    const float up = __builtin_bit_cast(float, __builtin_amdgcn_update_dpp(0, xi, 0x114, 0xf, 0xf, true));
    const float dn = __builtin_bit_cast(float, __builtin_amdgcn_update_dpp(0, xi, 0x104, 0xf, 0xf, true));
    return x + ((lane & 4) ? up : dn);
}
#define P4REP(k) for (int rep_ = 0; rep_ < ((PROBE_PHASE == (k)) ? 2 : 1); ++rep_)
__device__ __forceinline__ void p4a_chunks(Frame& F) {
    LAS unsigned char* L = F.lds + RING_OFF;
    const bf16* Rb = (const bf16*)(F.ws + WS_RKV); const bf16* Kb = Rb + (size_t)M * D; const bf16* Vb = Kb + (size_t)M * D;
    const _Float16* LW = (const _Float16*)(F.ws + WS_LOGW);     const bf16* AS = (const bf16*)(F.ws + WS_ASIG);
    bf16* QE = (bf16*)(F.ws + WS_QE); bf16* MCT = (bf16*)(F.ws + WS_MCT); bf16* NC = (bf16*)(F.ws + WS_NC); bf16* Y0 = (bf16*)(F.ws + WS_Y0); float* RK = (float*)(F.ws + WS_RK);
    const float* k_k = F.in[16]; const float* k_a = F.in[17]; const float* r_k = F.in[18];
    const int tid = F.tid, lane = F.lane, w = F.wave, r32 = lane & 31, hi = lane >> 5;
    const int t0_ = tid >> 3, d80_ = (tid & 7) * 8;
    LAS float* Lbuf = (LAS float*)(L + SC_LBUF); LAS float* Seg = (LAS float*)(L + SC_SEG); LAS float* RHS = (LAS float*)(L + SC_RHS); LAS float* Gend = (LAS float*)(L + SC_GEND);
    LAS float* AD = (LAS float*)(L + SC_AD);
    v4u nr8, nk8, nv8, na8, nlw;
#define P4A_LOAD(CU) do { const int bh_ = (CU) >> 6, c_ = (CU) & 63; const size_t ro_ = ((size_t)(bh_ >> 4) * T + c_ * 64 + t) * D + (bh_ & 15) * 64 + d8; \
        nr8 = NT_LD(v4u, Rb + ro_); nk8 = NT_LD(v4u, Kb + ro_); nv8 = *(const v4u*)(Vb + ro_); na8 = NT_LD(v4u, AS + ro_); nlw = NT_LD(v4u, LW + ro_); } while (0)
    { const int t = t0_, d8 = d80_; if ((int)blockIdx.x < BATCH * 16 * 64) P4A_LOAD(blockIdx.x); }
    { v4u o; const int t = t0_, k8 = d80_;
#define TRILW(j) (((k8 + 2 * (j) <= t) ? 0x3C00u : 0u) | ((k8 + 2 * (j) + 1 <= t) ? 0x3C000000u : 0u))
      o.x = TRILW(0); o.y = TRILW(1); o.z = TRILW(2); o.w = TRILW(3); *(LAS v4u*)(L + SC_TRIL + (t * SC_TS + k8) * 2) = o; }
#undef TRILW
    float tv[32]; int un = 0;
    for (int cu = blockIdx.x; cu < BATCH * 16 * 64; cu += F.G, ++un) {
        const int bh = cu >> 6, c = cu & 63, b = bh >> 4, h = bh & 15; (void)b; (void)c;
        const int mit = (un * F.G + (int)blockIdx.x) * NWAVES + w;
        int t = t0_, d8 = d80_; asm volatile("" : "+v"(t), "+v"(d8));
        const v4u r8 = nr8, k8 = nk8, v8 = nv8, a8 = na8, lwraw = nlw;
        f32x4 lw0, lw1; { typedef _Float16 h2_t __attribute__((ext_vector_type(2))); const unsigned u0 = nlw.x, u1 = nlw.y, u2 = nlw.z, u3 = nlw.w;
            const h2_t q0 = __builtin_bit_cast(h2_t, u0), q1 = __builtin_bit_cast(h2_t, u1), q2 = __builtin_bit_cast(h2_t, u2), q3 = __builtin_bit_cast(h2_t, u3);
            lw0 = (f32x4){(float)q0.x, (float)q0.y, (float)q1.x, (float)q1.y}; lw1 = (f32x4){(float)q2.x, (float)q2.y, (float)q3.x, (float)q3.y}; }
        const f32x4 kk0 = *(const f32x4*)(k_k + h * 64 + d8), kk1 = *(const f32x4*)(k_k + h * 64 + d8 + 4), ka0 = *(const f32x4*)(k_a + h * 64 + d8), ka1 = *(const f32x4*)(k_a + h * 64 + d8 + 4);
        const f32x4 rk0 = *(const f32x4*)(r_k + h * 64 + d8), rk1 = *(const f32x4*)(r_k + h * 64 + d8 + 4);
        P4REP(401) {
        *(LAS v4u*)(L + SC_LWT + (t * SC_TS + d8) * 2) = lwraw;
        __syncthreads();
        if (w < 4) {
            const int mt = w >> 1, nt = w & 1; TrF fb; tr_load(fb, L + SC_LWT, nt, lane);
            f32x16 cs;
#pragma unroll
            for (int i = 0; i < 16; ++i) cs[i] = 0.f;
#pragma unroll
            for (int ks = 0; ks < 4; ++ks) { if (ks < 2 || mt == 1) {
                const v4u af = *(const LAS v4u*)(L + SC_TRIL + ((32 * mt + r32) * SC_TS + 16 * ks + 8 * hi) * 2); const v4u bq = {fb.f[ks][0].x, fb.f[ks][0].y, fb.f[ks][1].x, fb.f[ks][1].y};
                cs = __builtin_amdgcn_mfma_f32_32x32x16_f16(__builtin_bit_cast(f16x8, af), __builtin_bit_cast(f16x8, bq), cs, 0, 0, 0); } }
#pragma unroll
            for (int i = 0; i < 16; ++i) Lbuf[(32 * mt + (i & 3) + 8 * (i >> 2) + 4 * hi) * 64 + 32 * nt + r32] = cs[i];
        }
        __syncthreads();
        {
            float Lt[8], Le[8];
            { const f32x4 p0 = *(const LAS f32x4*)(Lbuf + t * 64 + d8), p1 = *(const LAS f32x4*)(Lbuf + t * 64 + d8 + 4), q0 = *(const LAS f32x4*)(Lbuf + 63 * 64 + d8), q1 = *(const LAS f32x4*)(Lbuf + 63 * 64 + d8 + 4);
              Lt[0] = p0.x; Lt[1] = p0.y; Lt[2] = p0.z; Lt[3] = p0.w; Lt[4] = p1.x; Lt[5] = p1.y; Lt[6] = p1.z; Lt[7] = p1.w;
              Le[0] = q0.x; Le[1] = q0.y; Le[2] = q0.z; Le[3] = q0.w; Le[4] = q1.x; Le[5] = q1.y; Le[6] = q1.z; Le[7] = q1.w; }
            const float lwv[8] = {lw0.x, lw0.y, lw0.z, lw0.w, lw1.x, lw1.y, lw1.z, lw1.w};
            const unsigned rw[4] = {r8.x, r8.y, r8.z, r8.w}, kw[4] = {k8.x, k8.y, k8.z, k8.w}, vw[4] = {v8.x, v8.y, v8.z, v8.w}, aw[4] = {a8.x, a8.y, a8.z, a8.w};
            float rr[8], kk[8], vv[8], aa[8];
#pragma unroll
            for (int e = 0; e < 4; ++e) { rr[2 * e] = bflo(rw[e]); rr[2 * e + 1] = bfhi(rw[e]); kk[2 * e] = bflo(kw[e]); kk[2 * e + 1] = bfhi(kw[e]);
                vv[2 * e] = bflo(vw[e]); vv[2 * e + 1] = bfhi(vw[e]); aa[2 * e] = bflo(aw[e]); aa[2 * e + 1] = bfhi(aw[e]); }
            const float kkv[8] = {kk0.x, kk0.y, kk0.z, kk0.w, kk1.x, kk1.y, kk1.z, kk1.w}, kav[8] = {ka0.x, ka0.y, ka0.z, ka0.w, ka1.x, ka1.y, ka1.z, ka1.w}, rkv[8] = {rk0.x, rk0.y, rk0.z, rk0.w, rk1.x, rk1.y, rk1.z, rk1.w};
            float kr[8], ss = 0.f, rs = 0.f, km[8];
#pragma unroll
            for (int e = 0; e < 8; ++e) { kr[e] = kk[e] * kkv[e]; ss += kr[e] * kr[e]; km[e] = kk[e] * (1.0f + (aa[e] - 1.0f) * kav[e]); rs += rr[e] * km[e] * rkv[e]; }
            ss = sum8_dpp(ss, lane); rs = sum8_dpp(rs, lane);
            const float inv = 1.0f / fmaxf(sqrtf(ss), 1e-12f);
            if ((tid & 7) == 0) RK[(size_t)cu * 64 + t] = rs;
            float At[8], Bt[8], Kt[8], Rt[8], Bh[8], Kh[8];
#pragma unroll
            for (int e = 0; e < 8; ++e) { const float kn = kr[e] * inv, av = -kn, bv = kn * aa[e];
                const float g = __builtin_amdgcn_exp2f(Lt[e]), gi = __builtin_amdgcn_exp2f(-Lt[e]), gp = __builtin_amdgcn_exp2f(Lt[e] - lwv[e]), ge = __builtin_amdgcn_exp2f(Le[e] - Lt[e]);
                At[e] = av * gp; Bt[e] = bv * gi; Kt[e] = km[e] * gi; Rt[e] = rr[e] * g; Bh[e] = bv * ge; Kh[e] = km[e] * ge;
                if (t == 63) Gend[d8 + e] = g; }
            const int ob = (t * SC_TS + d8) * 2;
            { v4u o; o.x = cvtpk(At[0], At[1]); o.y = cvtpk(At[2], At[3]); o.z = cvtpk(At[4], At[5]); o.w = cvtpk(At[6], At[7]); *(LAS v4u*)(L + SL_A * SC_TB + ob) = o; }
            { v4u o; o.x = cvtpk(Bt[0], Bt[1]); o.y = cvtpk(Bt[2], Bt[3]); o.z = cvtpk(Bt[4], Bt[5]); o.w = cvtpk(Bt[6], Bt[7]); *(LAS v4u*)(L + SL_B * SC_TB + ob) = o; }
            { v4u o; o.x = cvtpk(Kt[0], Kt[1]); o.y = cvtpk(Kt[2], Kt[3]); o.z = cvtpk(Kt[4], Kt[5]); o.w = cvtpk(Kt[6], Kt[7]); *(LAS v4u*)(L + SL_K * SC_TB + ob) = o; }
            { v4u o; o.x = cvtpk(Rt[0], Rt[1]); o.y = cvtpk(Rt[2], Rt[3]); o.z = cvtpk(Rt[4], Rt[5]); o.w = cvtpk(Rt[6], Rt[7]); *(LAS v4u*)(L + SL_R * SC_TB + ob) = o; }
            *(LAS f32x4*)(RHS + t * 128 + d8) = (f32x4){At[0], At[1], At[2], At[3]}; *(LAS f32x4*)(RHS + t * 128 + d8 + 4) = (f32x4){At[4], At[5], At[6], At[7]};
            { v4u o; o.x = cvtpk(Bh[0], Bh[1]); o.y = cvtpk(Bh[2], Bh[3]); o.z = cvtpk(Bh[4], Bh[5]); o.w = cvtpk(Bh[6], Bh[7]); *(LAS v4u*)(L + SL_BH * SC_TB + ob) = o; }
            { v4u o; o.x = cvtpk(Kh[0], Kh[1]); o.y = cvtpk(Kh[2], Kh[3]); o.z = cvtpk(Kh[4], Kh[5]); o.w = cvtpk(Kh[6], Kh[7]); *(LAS v4u*)(L + SL_KH * SC_TB + ob) = o; }
            *(LAS v4u*)(L + SL_VT * SC_TB + ob) = v8;
        }
        if (rep_ == 0 && PROBE_PHASE == 401) __syncthreads();
        }
        if (cu + F.G < BATCH * 16 * 64) P4A_LOAD(cu + F.G);
        { const MoeItem mi = moe_item4a(F, mit); titem_load(tv, mi.W, mi.ldw, mi.k0, mi.n0, lane); }
        __syncthreads();
        const int p = w >> 1, mt = w & 1;
        f32x16 acc[2];
        P4REP(402) {
        if (rep_ == 1) __syncthreads();
#pragma unroll
        for (int i = 0; i < 16; ++i) { acc[0][i] = 0.f; acc[1][i] = 0.f; }
        tile_mma2(acc, L + ((p & 1) ? SL_K : SL_B) * SC_TB, L + ((p & 2) ? SL_R : SL_A) * SC_TB, mt, r32, hi);
        __syncthreads();
#pragma unroll
        for (int nt = 0; nt < 2; ++nt) { const int s = 32 * nt + r32;
#pragma unroll
            for (int rg = 0; rg < 4; ++rg) { const int j0 = 32 * mt + 8 * rg + 4 * hi; float v[4];
#pragma unroll
                for (int e = 0; e < 4; ++e) { const bool keep = (p < 2) ? (j0 + e < s) : (j0 + e <= s); v[e] = keep ? acc[nt][4 * rg + e] : 0.f; }
                if (p == 0 && (s >> 4) == (j0 >> 4)) *(LAS f32x4*)(AD + ((s >> 4) * 16 + (s & 15)) * SC_ADS + (j0 & 15)) = (f32x4){v[0], v[1], v[2], v[3]};
                { v2u o; o.x = cvtpk(v[0], v[1]); o.y = cvtpk(v[2], v[3]); *(LAS v2u*)(L + ((p == 0) ? SL_A : (p == 1) ? SL_K : (p == 2) ? SL_ARB : SL_ARK) * SC_TB + (s * SC_TS + j0) * 2) = o; } } }
        }
        __syncthreads();
        P4REP(403) {
#pragma unroll
        for (int i = 0; i < 16; ++i) { acc[0][i] = 0.f; acc[1][i] = 0.f; }
        if (w < 2) {
            tile_mma2t<false, true>(acc, L + SL_K * SC_TB, L + SL_VT * SC_TB, w & 1, r32, hi, lane);
#pragma unroll
            for (int nt = 0; nt < 2; ++nt)
#pragma unroll
                for (int reg = 0; reg < 16; ++reg) RHS[(32 * (w & 1) + (reg & 3) + 8 * (reg >> 2) + 4 * hi) * 128 + 64 + 32 * nt + r32] = acc[nt][reg];
        } else if (w == 2) {
            int bb = lane >> 4, cc = lane & 15; asm volatile("" : "+v"(bb), "+v"(cc));
            const LAS float* ad = AD + (bb * 16 + cc) * SC_ADS;
            const f32x4 r0 = *(const LAS f32x4*)(ad), r1 = *(const LAS f32x4*)(ad + 4), r2 = *(const LAS f32x4*)(ad + 8), r3 = *(const LAS f32x4*)(ad + 12);
            const float ar[16] = {r0.x, r0.y, r0.z, r0.w, r1.x, r1.y, r1.z, r1.w, r2.x, r2.y, r2.z, r2.w, r3.x, r3.y, r3.z, r3.w};
            float tt[16];
            inv_step<0>(tt, ar, cc); inv_step<1>(tt, ar, cc); inv_step<2>(tt, ar, cc); inv_step<3>(tt, ar, cc); inv_step<4>(tt, ar, cc); inv_step<5>(tt, ar, cc); inv_step<6>(tt, ar, cc); inv_step<7>(tt, ar, cc);
            inv_step<8>(tt, ar, cc); inv_step<9>(tt, ar, cc); inv_step<10>(tt, ar, cc); inv_step<11>(tt, ar, cc); inv_step<12>(tt, ar, cc); inv_step<13>(tt, ar, cc); inv_step<14>(tt, ar, cc); inv_step<15>(tt, ar, cc);
            LAS unsigned short* tb = (LAS unsigned short*)(L + SC_TBB) + bb * 256 + cc;
#pragma unroll
            for (int s = 0; s < 16; ++s) tb[s * 16] = (unsigned short)(cvtpk(tt[s], 0.f) & 0xffffu);
        } else if (w == 3) {
            LAS v4u* z = (LAS v4u*)(L + SC_XT0) + lane;
#pragma unroll
            for (int q = 0; q < 18; ++q) z[q * 64] = (v4u){0u, 0u, 0u, 0u};
        } else if (w < 6) tile_mma2t<true, false>(acc, L + SL_VT * SC_TB, L + SL_ARK * SC_TB, w & 1, r32, hi, lane);
        else tile_mma2t<true, true>(acc, L + SL_KH * SC_TB, L + SL_VT * SC_TB, w & 1, r32, hi, lane);
        }
        __syncthreads();
        P4REP(404)
        {   const int cl = lane & 15, g = lane >> 4; LAS unsigned char* xt = L + SC_XT0 + (w >> 2) * SC_TB + ((16 * (w & 3) + cl) * SC_TS) * 2;
#pragma unroll
            for (int bb = 0; bb < 4; ++bb) {
                f32x4 rp;
#pragma unroll
                for (int reg = 0; reg < 4; ++reg) rp[reg] = RHS[(16 * bb + 4 * g + reg) * 128 + 16 * w + cl];
#pragma unroll
                for (int ks = 0; ks < 2; ++ks) { const bf16x8 af = *(const LAS bf16x8*)(L + SL_A * SC_TB + ((16 * bb + cl) * SC_TS + 32 * ks + 8 * g) * 2);
                    const bf16x8 bf = *(const LAS bf16x8*)(xt + (32 * ks + 8 * g) * 2);
                    rp = __builtin_amdgcn_mfma_f32_16x16x32_bf16(af, bf, rp, 0, 0, 0); }
                const v2u tq = *(const LAS v2u*)(L + SC_TBB + ((bb * 16 + cl) * 16 + 4 * g) * 2);
                const v4u a2 = {tq.x, tq.y, 0u, 0u}, b2 = {cvtpk(rp[0], rp[1]), cvtpk(rp[2], rp[3]), 0u, 0u};
                const f32x4 xb = __builtin_amdgcn_mfma_f32_16x16x32_bf16(__builtin_bit_cast(bf16x8, a2), __builtin_bit_cast(bf16x8, b2), (f32x4){0.f, 0.f, 0.f, 0.f}, 0, 0, 0);
                v2u o; o.x = cvtpk(xb[0], xb[1]); o.y = cvtpk(xb[2], xb[3]); *(LAS v2u*)(xt + (16 * bb + 4 * g) * 2) = o;
                asm volatile("s_waitcnt lgkmcnt(0)" ::: "memory");
            } }
        __syncthreads();
        const LAS unsigned char* WMT = L + SC_XT0; const LAS unsigned char* U0T = L + SC_XT1;
        P4REP(405) {
        if (w < 4) {
#pragma unroll
            for (int i = 0; i < 16; ++i) { acc[0][i] = 0.f; acc[1][i] = 0.f; } }
        if (w < 2) {
            tile_mma2(acc, WMT, L + SL_ARB * SC_TB, w & 1, r32, hi);
            bf16* qo = QE + (size_t)cu * 4096;
#pragma unroll
            for (int nt = 0; nt < 2; ++nt) { const int tt = 32 * nt + r32;
#pragma unroll
                for (int rp = 0; rp < 2; ++rp) { v2u o[2];
#pragma unroll
                    for (int q = 0; q < 2; ++q) { const int rg = rp + 2 * q, d0 = 32 * (w & 1) + 8 * rg + 4 * hi; const v2u rt = *(const LAS v2u*)(L + SL_R * SC_TB + (tt * SC_TS + d0) * 2);
                        o[q].x = cvtpk(acc[nt][4 * rg] + bflo(rt.x), acc[nt][4 * rg + 1] + bfhi(rt.x)); o[q].y = cvtpk(acc[nt][4 * rg + 2] + bflo(rt.y), acc[nt][4 * rg + 3] + bfhi(rt.y)); }
                    *(v4u*)(qo + tt * 64 + 16 * (2 * rp + hi) + 8 * (w & 1)) = (v4u){o[0].x, o[0].y, o[1].x, o[1].y}; } }
        } else if (w < 4) {
            tile_mma2t<false, true>(acc, WMT, L + SL_BH * SC_TB, w & 1, r32, hi, lane);
            bf16* mo = MCT + (size_t)cu * 4096;
#pragma unroll
            for (int nt = 0; nt < 2; ++nt) { const int dp = 32 * nt + r32; const float gc = Gend[dp];
#pragma unroll
                for (int rp = 0; rp < 2; ++rp) { v2u o[2];
#pragma unroll
                    for (int q = 0; q < 2; ++q) { const int rg = rp + 2 * q, d0 = 32 * (w & 1) + 8 * rg + 4 * hi; float v[4];
#pragma unroll
                        for (int e = 0; e < 4; ++e) v[e] = acc[nt][4 * rg + e] + ((d0 + e == dp) ? gc : 0.f);
                        o[q].x = cvtpk(v[0], v[1]); o[q].y = cvtpk(v[2], v[3]); }
                    *(v4u*)(mo + dp * 64 + 32 * (w & 1) + 8 * (2 * rp + hi)) = (v4u){o[0].x, o[0].y, o[1].x, o[1].y}; } }
        } else if (w < 6) {
            tile_mma2(acc, U0T, L + SL_ARB * SC_TB, w & 1, r32, hi);
            bf16* yo = Y0 + (size_t)cu * 4096;
#pragma unroll
            for (int nt = 0; nt < 2; ++nt) { const int tt = 32 * nt + r32;
#pragma unroll
                for (int rp = 0; rp < 2; ++rp)
                    *(v4u*)(yo + tt * 64 + 32 * (w & 1) + 16 * rp + 8 * hi) = (v4u){cvtpk(acc[nt][4 * rp], acc[nt][4 * rp + 1]), cvtpk(acc[nt][4 * rp + 2], acc[nt][4 * rp + 3]), cvtpk(acc[nt][4 * rp + 8], acc[nt][4 * rp + 9]), cvtpk(acc[nt][4 * rp + 10], acc[nt][4 * rp + 11])}; }
        } else {
            tile_mma2t<true, false>(acc, L + SL_BH * SC_TB, U0T, w & 1, r32, hi, lane);
            bf16* no = NC + (size_t)cu * 4096;
#pragma unroll
            for (int nt = 0; nt < 2; ++nt) { const int ii = 32 * nt + r32;
#pragma unroll
                for (int rp = 0; rp < 2; ++rp)
                    *(v4u*)(no + ii * 64 + 16 * (2 * rp + hi) + 8 * (w & 1)) = (v4u){cvtpk(acc[nt][4 * rp], acc[nt][4 * rp + 1]), cvtpk(acc[nt][4 * rp + 2], acc[nt][4 * rp + 3]), cvtpk(acc[nt][4 * rp + 8], acc[nt][4 * rp + 9]), cvtpk(acc[nt][4 * rp + 10], acc[nt][4 * rp + 11])}; }
        }
        }
        { const MoeItem mi = moe_item4a(F, mit);
            const int coff = (w < 3) ? w * SC_TB : (w < 5) ? (w + 2) * SC_TB : (w == 5) ? SL_ARK * SC_TB : SC_RHS + (w - 6) * 8448;
            titem_store(tv, mi.k0, mi.WT, mi.ldo, mi.orow0, 0, nullptr, (LAS float*)(L + coff), lane); }
    }
}
struct P4bOps { v4u af[4][2]; v4u nf[2]; };
__device__ __forceinline__ void p4b_load(P4bOps& o, const bf16* MCT, const bf16* NC, size_t cu, int ig, int il, int g) {
    const bf16* mc = MCT + cu * 4096; const bf16* nc = NC + cu * 4096;
    o.nf[0] = *(const v4u*)(nc + ig * 64 + 16 * g); o.nf[1] = *(const v4u*)(nc + ig * 64 + 16 * g + 8);
#pragma unroll
    for (int m = 0; m < 4; ++m)
#pragma unroll
        for (int ks = 0; ks < 2; ++ks) o.af[m][ks] = *(const v4u*)(mc + (16 * m + il) * 64 + 32 * ks + 8 * g);
}
__device__ __forceinline__ void p4b_step(f32x4 (&acc)[4], const P4bOps& o, bf16* SCB, size_t cu, int ig, int g) {
    unsigned pk[4][2];
#pragma unroll
    for (int m = 0; m < 4; ++m) { pk[m][0] = cvtpk(acc[m][0], acc[m][1]); pk[m][1] = cvtpk(acc[m][2], acc[m][3]); }
    *(v4u*)(SCB + cu * 4096 + ig * 64 + 16 * g) = (v4u){pk[0][0], pk[0][1], pk[1][0], pk[1][1]}; *(v4u*)(SCB + cu * 4096 + ig * 64 + 16 * g + 8) = (v4u){pk[2][0], pk[2][1], pk[3][0], pk[3][1]};
    const v4u b0 = {pk[0][0], pk[0][1], pk[1][0], pk[1][1]}, b1 = {pk[2][0], pk[2][1], pk[3][0], pk[3][1]};
#pragma unroll
    for (int m = 0; m < 4; ++m) {
        const unsigned nlo = (m & 1) ? o.nf[m >> 1].z : o.nf[m >> 1].x, nhi = (m & 1) ? o.nf[m >> 1].w : o.nf[m >> 1].y;
        f32x4 ci = {bflo(nlo), bfhi(nlo), bflo(nhi), bfhi(nhi)};
        ci = __builtin_amdgcn_mfma_f32_16x16x32_bf16(__builtin_bit_cast(bf16x8, o.af[m][0]), __builtin_bit_cast(bf16x8, b0), ci, 0, 0, 0);
        acc[m] = __builtin_amdgcn_mfma_f32_16x16x32_bf16(__builtin_bit_cast(bf16x8, o.af[m][1]), __builtin_bit_cast(bf16x8, b1), ci, 0, 0, 0);
    }
}
__device__ __forceinline__ void p4b_state(Frame& F) {
    if (F.wave != 0) return;
    const bf16* MCT = (const bf16*)(F.ws + WS_MCT); const bf16* NC = (const bf16*)(F.ws + WS_NC); bf16* SCB = (bf16*)(F.ws + WS_SC);
    const int lane = F.lane, il = lane & 15, g = lane >> 4;
    for (int unit = F.vcu; unit < BATCH * 16 * 4; unit += F.G) {
        const int bh = unit >> 2, ig = (unit & 3) * 16 + il; const size_t cu0 = (size_t)bh * 64;
        f32x4 acc[4];
#pragma unroll
        for (int m = 0; m < 4; ++m) acc[m] = (f32x4){0.f, 0.f, 0.f, 0.f};
        P4bOps o0, o1, o2, o3;
        p4b_load(o0, MCT, NC, cu0 + 0, ig, il, g); p4b_load(o1, MCT, NC, cu0 + 1, ig, il, g); p4b_load(o2, MCT, NC, cu0 + 2, ig, il, g); p4b_load(o3, MCT, NC, cu0 + 3, ig, il, g);
        for (int c = 0; c < 64; c += 4) {
            const size_t cu = cu0 + c; const size_t nx = (c + 4 < 64) ? cu + 4 : cu;
            p4b_step(acc, o0, SCB, cu + 0, ig, g); __builtin_amdgcn_sched_barrier(0); p4b_load(o0, MCT, NC, nx + 0, ig, il, g); __builtin_amdgcn_sched_barrier(0);
            p4b_step(acc, o1, SCB, cu + 1, ig, g); __builtin_amdgcn_sched_barrier(0); p4b_load(o1, MCT, NC, nx + 1, ig, il, g); __builtin_amdgcn_sched_barrier(0);
            p4b_step(acc, o2, SCB, cu + 2, ig, g); __builtin_amdgcn_sched_barrier(0); p4b_load(o2, MCT, NC, nx + 2, ig, il, g); __builtin_amdgcn_sched_barrier(0);
            p4b_step(acc, o3, SCB, cu + 3, ig, g); __builtin_amdgcn_sched_barrier(0); p4b_load(o3, MCT, NC, nx + 3, ig, il, g); __builtin_amdgcn_sched_barrier(0);
        }
    }
}
__device__ __forceinline__ void p4c_out(Frame& F) {
    LAS float* stage = (LAS float*)(F.lds + RING_OFF);
    const bf16* QE = (const bf16*)(F.ws + WS_QE); const bf16* SCB = (const bf16*)(F.ws + WS_SC); const bf16* Y0 = (const bf16*)(F.ws + WS_Y0); const float* RK = (const float*)(F.ws + WS_RK);
    const bf16* Vb = (const bf16*)(F.ws + WS_RKV) + (size_t)2 * M * D; const bf16* GG = (const bf16*)(F.ws + WS_GG); bf16* YG = (bf16*)(F.ws + WS_YG);
    const float* gn_g = F.in[19]; const float* gn_b = F.in[20];
    const int lane = F.lane, w = F.wave, r32 = lane & 31, hi = lane >> 5, us = w >> 1, nt = w & 1;
    for (int grp = blockIdx.x; grp < BATCH * 16 * 64 / 4; grp += F.G) {
        const int cu = grp * 4 + us, bh = cu >> 6, c = cu & 63, b = bh >> 4, h = bh & 15;
        const bf16* sc = SCB + (size_t)cu * 4096; const bf16* qe = QE + (size_t)cu * 4096; const bf16* y0 = Y0 + (size_t)cu * 4096;
        const int tt = 32 * nt + r32;
        v4u vva[4], gga[4]; float rka[4];
        { const int i8h = (lane & 7) * 8, cgh = h * 64 + i8h;
#pragma unroll
          for (int it = 0; it < 4; ++it) { const int t2 = 32 * nt + it * 8 + (lane >> 3); const size_t ro = ((size_t)b * T + c * 64 + t2) * D + cgh;
              vva[it] = NT_LD(v4u, Vb + ro); gga[it] = NT_LD(v4u, GG + ro); rka[it] = RK[(size_t)cu * 64 + t2]; } }
        f32x16 acc[2];
#pragma unroll
        for (int mt = 0; mt < 2; ++mt)
#pragma unroll
            for (int rp = 0; rp < 2; ++rp) { const v4u q = *(const v4u*)(y0 + tt * 64 + 32 * mt + 16 * rp + 8 * hi);
                acc[mt][4 * rp] = bflo(q.x); acc[mt][4 * rp + 1] = bfhi(q.x); acc[mt][4 * rp + 2] = bflo(q.y); acc[mt][4 * rp + 3] = bfhi(q.y);
                acc[mt][4 * rp + 8] = bflo(q.z); acc[mt][4 * rp + 9] = bfhi(q.z); acc[mt][4 * rp + 10] = bflo(q.w); acc[mt][4 * rp + 11] = bfhi(q.w); }
#pragma unroll
        for (int ks = 0; ks < 4; ++ks) { const bf16x8 bq = *(const bf16x8*)(qe + tt * 64 + 16 * ks + 8 * hi);
            const bf16x8 a0 = *(const bf16x8*)(sc + r32 * 64 + 16 * ks + 8 * hi), a1 = *(const bf16x8*)(sc + (32 + r32) * 64 + 16 * ks + 8 * hi);
            acc[0] = MMA32(a0, bq, acc[0]); acc[1] = MMA32(a1, bq, acc[1]); }
        float sm = 0.f;
#pragma unroll
        for (int i = 0; i < 16; ++i) sm += acc[0][i] + acc[1][i];
        sm += __shfl_xor(sm, 32); const float mean = sm * (1.f / 64.f);
        float vs = 0.f;
#pragma unroll
        for (int i = 0; i < 16; ++i) { const float d0 = acc[0][i] - mean, d1 = acc[1][i] - mean; vs += d0 * d0 + d1 * d1; }
        vs += __shfl_xor(vs, 32); const float rstd = 1.0f / sqrtf(vs * (1.f / 64.f) + GN_EPS);
        LAS float* st = stage + us * (64 * 68);
#pragma unroll
        for (int mt = 0; mt < 2; ++mt)
#pragma unroll
            for (int rg = 0; rg < 4; ++rg) *(LAS f32x4*)(st + tt * 68 + 32 * mt + 8 * rg + 4 * hi) = (f32x4){(acc[mt][4 * rg] - mean) * rstd, (acc[mt][4 * rg + 1] - mean) * rstd, (acc[mt][4 * rg + 2] - mean) * rstd, (acc[mt][4 * rg + 3] - mean) * rstd};
        __syncthreads();
        {   const int i8 = (lane & 7) * 8; const int cg = h * 64 + i8;
            const f32x4 g0 = *(const f32x4*)(gn_g + cg), g1 = *(const f32x4*)(gn_g + cg + 4), b0 = *(const f32x4*)(gn_b + cg), b1 = *(const f32x4*)(gn_b + cg + 4);
#pragma unroll
            for (int it = 0; it < 4; ++it) { const int t2 = 32 * nt + it * 8 + (lane >> 3); const size_t ro = ((size_t)b * T + c * 64 + t2) * D + cg;
                const f32x4 y0v = *(const LAS f32x4*)(st + t2 * 68 + i8), y1v = *(const LAS f32x4*)(st + t2 * 68 + i8 + 4);
                const v4u vv = vva[it], gg = gga[it]; const float rk = rka[it];
                float o[8];
                o[0] = (y0v.x * g0.x + b0.x + rk * bflo(vv.x)) * bflo(gg.x); o[1] = (y0v.y * g0.y + b0.y + rk * bfhi(vv.x)) * bfhi(gg.x);
                o[2] = (y0v.z * g0.z + b0.z + rk * bflo(vv.y)) * bflo(gg.y); o[3] = (y0v.w * g0.w + b0.w + rk * bfhi(vv.y)) * bfhi(gg.y);
                o[4] = (y1v.x * g1.x + b1.x + rk * bflo(vv.z)) * bflo(gg.z); o[5] = (y1v.y * g1.y + b1.y + rk * bfhi(vv.z)) * bfhi(gg.z);
                o[6] = (y1v.z * g1.z + b1.z + rk * bflo(vv.w)) * bflo(gg.w); o[7] = (y1v.w * g1.w + b1.w + rk * bfhi(vv.w)) * bfhi(gg.w);
                v4u ov; ov.x = cvtpk(o[0], o[1]); ov.y = cvtpk(o[2], o[3]); ov.z = cvtpk(o[4], o[5]); ov.w = cvtpk(o[6], o[7]); wt16(YG + ro, ov); }
        }
        __syncthreads();
    }
}

constexpr int NPHASE = 22;
#ifndef PROBE_PHASE
#define PROBE_PHASE (-1)
#endif
#define PROBE(k, ...) do { __VA_ARGS__; if (PROBE_PHASE == (k)) { xcd_barrier(bar); __VA_ARGS__; } } while (0)
#define IN(k) (lo <= (k) && (k) < hi)
#define SEAM(k) do { if (IN(k) && (k) + 1 < hi) xcd_barrier(bar); } while (0)
template <int L> __device__ __forceinline__ void moe_phases(Frame& F, const int lo, const int hi, const XcdBarrier& bar) {
    constexpr int pb = 11 * L;
    LAS unsigned char* ring = F.lds + RING_OFF;
    const LAS int* toff = (const LAS int*)(F.lds + LDSCTL_OFF);
        if (IN(pb + 6)) { F.lane = lane_id(); F.tid = F.wave * 64 + F.lane; if (PROBE_PHASE == 100 + pb) { moe_router(F, L, (const float*)(F.ws + WS_XA), 32); xcd_barrier(bar); F.lane = lane_id(); F.tid = F.wave * 64 + F.lane; }
            if (L == 1 && (F.vcu & 1)) { moe_weights(F, L); __syncthreads();   F.lane = lane_id(); F.tid = F.wave * 64 + F.lane; }
            moe_router(F, L, (const float*)(F.ws + WS_XA), 0); if (L == 1 && !(F.vcu & 1)) { PROBE(pb + 6, F.lane = lane_id(); F.tid = F.wave * 64 + F.lane; moe_weights(F, L); ); } } SEAM(pb + 6);
        if (IN(pb + 8)) { PROBE(pb + 8, F.lane = lane_id(); F.tid = F.wave * 64 + F.lane;
            moe_toff(F, L);
            pg8::MoeOrder S; S.init(F.ws + WS_H2N, F.ws + WS_MOEGU, (size_t)1024 * 1024 * 2, toff, toff + 40, (const int*)(F.ws + WS_ROWTOK), 4, D, F.G, F.vcu);
            S.hand_off(1, (unsigned*)F.ctl + CW_RDY + 16384 * L, 0u, (unsigned*)F.ctl + CW_TMO, F.wave);
            pg8::EpiGU E{(bf16*)(F.ws + WS_HS)};
            pg8::gemm_phase_gather<pg8::EpiGU, pg8::MoeOrder>(ring, D, S, E, F.tid, F.wave);
        ); }
        if (IN(pb + 9)) { PROBE(pb + 9, F.lane = lane_id(); F.tid = F.wave * 64 + F.lane;
            moe_toff(F, L);
            pg8::MoeOrder S; S.init(F.ws + WS_HS, F.ws + (L ? WS_MOED1 : WS_MOED), (size_t)1024 * 512 * 2, toff, toff + 40, nullptr, 4, FF, F.G, F.vcu);
            S.hand_off(2, (unsigned*)F.ctl + CW_RDY + 16384 * L, 32u, (unsigned*)F.ctl + CW_TMO, F.wave);
            S.redeal(S.tot % F.G);
            pg8::EpiDown E{(bf16*)(F.ws + WS_Y)};
            pg8::gemm_phase<pg8::EpiDown, pg8::MoeOrder, true, true>(ring, FF, S, E, F.tid, F.wave);
        ); } SEAM(pb + 9);
        if (IN(pb + 10)) { PROBE(pb + 10, F.lane = lane_id(); F.tid = F.wave * 64 + F.lane;
            moe_combine<L>(F, L, (const float*)(F.ws + WS_XA), F.out);
        ); } SEAM(pb + 10);
}
#undef IN
#undef SEAM
struct Args { const float* in[39]; float* out; unsigned char* ws; int ph_lo, ph_hi; };
__global__ void __launch_bounds__(NWAVES * 64, 2) trunk_fwd(Args args) {
    extern __shared__ __attribute__((aligned(16))) unsigned char lds[];
    Frame F;
    F.lds = (LAS unsigned char*)lds;
    F.MISC = (volatile LAS unsigned*)(F.lds + MISC_OFF);
    F.wave = __builtin_amdgcn_readfirstlane(threadIdx.x >> 6); F.lane = lane_id(); F.tid = F.wave * 64 + F.lane;
    F.G = gridDim.x; { const int bx = blockIdx.x; F.vcu = (F.G % 8 == 0) ? (bx % 8) * (F.G / 8) + bx / 8 : bx; }
    F.ws = args.ws; F.ctl = (gu32*)(args.ws + WS_CTL); F.in = args.in; F.out = args.out;
    for (int u = F.tid; u < (LDS_BYTES - LDSCTL_OFF) / 4; u += NWAVES * 64) ((LAS unsigned*)(F.lds + LDSCTL_OFF))[u] = 0u;
    __syncthreads();
    const int lo = args.ph_lo, hi = args.ph_hi;
    const bool multi = (hi - lo) > 1;
    XcdBarrier bar; bar.bar = (unsigned*)(F.ctl + CW_BAR); bar.x = 0; bar.st = nullptr; bar.wave = F.wave;
    if (multi) bar = xcd_barrier_post((unsigned*)(F.ctl + CW_BAR), F.MISC + 8);
#define IN(k) (lo <= (k) && (k) < hi)
#define SEAM(k) do { if (IN(k) && (k) + 1 < hi) xcd_barrier(bar); } while (0)
    LAS unsigned char* ring = F.lds + RING_OFF;
    const LAS int* toff = (const LAS int*)(F.lds + LDSCTL_OFF);

    {
        {
            if (IN(0)) { PROBE(0, F.lane = lane_id(); F.tid = F.wave * 64 + F.lane; p0_mod(F); ); } SEAM(0);
            if (IN(1)) { PROBE(1, F.lane = lane_id(); F.tid = F.wave * 64 + F.lane;
                if (F.vcu & 1) { p0_weights(F, 0); __syncthreads(); F.lane = lane_id(); F.tid = F.wave * 64 + F.lane; p1_norm_views(F); }
                else { p1_norm_views(F); __syncthreads(); F.lane = lane_id(); F.tid = F.wave * 64 + F.lane; p0_weights(F, 0); } ); } SEAM(1);
            if (IN(2)) { PROBE(2, F.lane = lane_id(); F.tid = F.wave * 64 + F.lane;
                { pg8::BatchOrder S; S.init(F.ws + WS_H2, F.ws + WS_WL1, 0, 0, M, 256, 1, 2048, F.G, (int)blockIdx.x);
                  S.ho.set(1, (unsigned*)F.ctl + CW_RDY + 2 * 16384, 0u, (unsigned*)F.ctl + CW_TMO, F.wave);
                  pg8::EpiLora1 E{(bf16*)(F.ws + WS_A2)};
                  pg8::gemm_phase<pg8::EpiLora1, pg8::BatchOrder, true, true>(ring, 2048, S, E, F.tid, F.wave); }
                { pg8::BatchOrder S; S.init(F.ws + WS_VIEWS, F.ws + WS_WRKV, (size_t)M * D * 2, (size_t)D * D * 2, M, D, 3, D, F.G, (int)blockIdx.x);
                  pg8::EpiZBf16 E{(bf16*)(F.ws + WS_RKV), (size_t)M * D, 1.0f};
                  pg8::gemm_phase<pg8::EpiZBf16, pg8::BatchOrder, true, true>(ring, D, S, E, F.tid, F.wave); }
                if (F.G >= 128 && (int)blockIdx.x < 64) { F.lane = lane_id(); F.tid = F.wave * 64 + F.lane; p0_weights(F, 1); }
                { const int nlo = (F.G >= 128) ? 64 : 0;
                  pg8::BatchOrder S; S.init(F.ws + WS_A2, F.ws + WS_WL2, 0, 0, M, 3072, 1, 256, F.G - nlo, (int)blockIdx.x - nlo);
                  S.ho.set(2, (unsigned*)F.ctl + CW_RDY + 2 * 16384, 8u, (unsigned*)F.ctl + CW_TMO, F.wave);
                  LAS float* lb = (LAS float*)(F.lds + RING_BYTES);
                  { const int t4 = (int)(F.wave * 64 + lane_id()) * 4; *(LAS f32x4*)(lb + t4) = *(const f32x4*)((t4 < 1024 ? F.in[8] : F.in[11] - 1024) + t4); }
                  __syncthreads();
                  pg8::EpiLora2 E{(_Float16*)(F.ws + WS_LOGW), (bf16*)(F.ws + WS_ASIG), (bf16*)(F.ws + WS_GG), lb, lb + 1024};
                  pg8::gemm_phase<pg8::EpiLora2, pg8::BatchOrder, true, true>(ring, 256, S, E, F.tid, F.wave); }
            ); } SEAM(2);
            if (IN(4)) { PROBE(40, F.lane = lane_id(); F.tid = F.wave * 64 + F.lane; p4a_chunks(F); ); xcd_barrier(bar); PROBE(41, F.lane = lane_id(); F.tid = F.wave * 64 + F.lane; p4b_state(F); ); xcd_barrier(bar); PROBE(42, F.lane = lane_id(); F.tid = F.wave * 64 + F.lane; p4c_out(F); ); } SEAM(4);
            if (IN(5)) { PROBE(5, F.lane = lane_id(); F.tid = F.wave * 64 + F.lane;
                pg8::BatchOrder S; S.init(F.ws + WS_YG, F.ws + WS_WO0, 0, 0, M, D, 1, D, F.G, (int)blockIdx.x);
                pg8::EpiResid E{F.in[0], (float*)(F.ws + WS_XA), (const float*)(F.ws + WS_MOD) + 2048};
                pg8::gemm_phase<pg8::EpiResid, pg8::BatchOrder, true, true>(ring, D, S, E, F.tid, F.wave);
            ); } SEAM(5);
        }
        moe_phases<0>(F, lo, hi, bar);
        {
            if (IN(11)) { PROBE(11, F.lane = lane_id(); F.tid = F.wave * 64 + F.lane;
                { pg8::BatchOrder S; S.init(F.ws + WS_HQ, F.ws + WS_WQKV, (size_t)M * D * 2, (size_t)D * D * 2, M, D, 3, D, F.G, (int)blockIdx.x); S.zcl = 1;
                  pg8::EpiZBf16 E{(bf16*)(F.ws + WS_QKV), (size_t)M * D, attn_body::C2};
                  pg8::gemm_phase<pg8::EpiZBf16, pg8::BatchOrder, true, true>(ring, D, S, E, F.tid, F.wave); }
            ); } SEAM(11);
            if (IN(12)) { PROBE(12, F.lane = lane_id(); F.tid = F.wave * 64 + F.lane;
                const attn_body::bf16* Q = (const attn_body::bf16*)(F.ws + WS_QKV); const attn_body::bf16* Kp = Q + (size_t)M * D; const attn_body::bf16* Vp = Kp + (size_t)M * D;
                attn_body::bf16* O = (attn_body::bf16*)(F.ws + WS_OC);
                int nrep = (PROBE_PHASE == 120) ? 2 : 1; asm volatile("" : "+s"(nrep));
                for (int rep = 0; rep < nrep; ++rep)
                for (int i = 0; ; ++i) { const int pr = (i >> 1) * F.G + F.vcu; if (pr >= BATCH * 8 * 8) break;
                    const int bh = pr >> 3, s = pr & 7, qb = (i & 1) ? s : 15 - s, b = bh >> 3, h = bh & 7;
                    _Pragma("unroll 1") for (int c = 0; c < 2; ++c)
                        attn_body::attn_unit128<8>(b, qb, Q + (h * 2 + c) * 64, Kp + (h * 2 + c) * 64, Vp + h * 128, O + (h * 2 + c) * 128, (char*)lds + RING_OFF, F.tid, F.wave);
                    attn_subln_rows(F, (size_t)b * T + qb * 256 + F.wave * 32, h);
                }
            ); } SEAM(12);
            if (IN(14)) { PROBE(14, F.lane = lane_id(); F.tid = F.wave * 64 + F.lane;
                pg8::BatchOrder S; S.init(F.ws + WS_ON, F.ws + WS_WO1, 0, 0, M, D, 1, D, F.G, (int)blockIdx.x);
                pg8::EpiResid E{F.out, (float*)(F.ws + WS_XA), (const float*)(F.ws + WS_MOD) + 4 * 6144 + 2048};
                pg8::gemm_phase<pg8::EpiResid, pg8::BatchOrder, true, true>(ring, D, S, E, F.tid, F.wave);
            ); } SEAM(14);
        }
        moe_phases<1>(F, lo, hi, bar);
    }
    if (multi && hi == NPHASE) { if ((__hip_atomic_load((gu32*)((unsigned*)(F.ctl + CW_BAR) + XB_TMO), RLX_AGENT) | __hip_atomic_load(F.ctl + CW_TMO, RLX_AGENT)) != 0u) {
        const float q = __builtin_nanf(""); for (size_t i = (size_t)blockIdx.x * 512 + F.wave * 64 + lane_id(); i < (size_t)M * D; i += (size_t)F.G * 512) F.out[i] = q; } }
#undef IN
#undef SEAM
}

#ifndef N_LAUNCH_MODE
#define N_LAUNCH_MODE 1
#endif
extern "C" void kernel_launch(void* const* d_in, const int* in_sizes, int n_in, void* d_out, int out_size, void* d_ws, size_t ws_size, hipStream_t stream) {
    static int grid = 0;
    if (grid == 0) {
        if (n_in != 39 || in_sizes[0] != M * D || out_size != M * D || ws_size < WS_END) { fprintf(stderr, "kernel_launch: unexpected problem (n_in %d, in0 %d, out %d, ws %zu < %zu); nothing launched\n", n_in, n_in > 0 ? in_sizes[0] : -1, out_size, ws_size, (size_t)WS_END); grid = -1; return; }
        int dev = 0, cus = 0, per_cu = 0;
        if (hipGetDevice(&dev) != hipSuccess || hipDeviceGetAttribute(&cus, hipDeviceAttributeMultiprocessorCount, dev) != hipSuccess) { grid = -1; return; }
        if (hipFuncSetAttribute((const void*)trunk_fwd, hipFuncAttributeMaxDynamicSharedMemorySize, LDS_BYTES) != hipSuccess) { fprintf(stderr, "kernel_launch: hipFuncSetAttribute failed\n"); grid = -1; return; }
        if (hipOccupancyMaxActiveBlocksPerMultiprocessor(&per_cu, (const void*)trunk_fwd, NWAVES * 64, LDS_BYTES) != hipSuccess || per_cu < 1) fprintf(stderr, "kernel_launch: occupancy query reports %d\n", per_cu);
        (void)hipGetLastError();
        grid = cus;
    }
    if (grid < 0) return;
    if (hipMemsetAsync((char*)d_ws + WS_CTL, 0, CTL_ZERO_BYTES, stream) != hipSuccess) return;
    Args a{};
    for (int i = 0; i < 39; ++i) a.in[i] = (const float*)d_in[i];
    a.out = (float*)d_out; a.ws = (unsigned char*)d_ws;
    if (N_LAUNCH_MODE == 1) {
        a.ph_lo = 0; a.ph_hi = NPHASE;
        hipLaunchKernelGGL(trunk_fwd, dim3(grid), dim3(NWAVES * 64), LDS_BYTES, stream, a);
    } else {
        const int ids[16] = {0, 1, 2, 4, 5, 6, 8, 9, 10, 11, 12, 14, 17, 19, 20, 21};
        for (int k = 0; k < 16; ++k) { a.ph_lo = ids[k]; a.ph_hi = ids[k] + 1; hipLaunchKernelGGL(trunk_fwd, dim3(grid), dim3(NWAVES * 64), LDS_BYTES, stream, a); }
    }
}
```
